# Optimizing an MI355X kernel written in HIP

```python
import math, functools
import jax
import jax.numpy as jnp
from jax import lax
import numpy as np

D_MODEL = 1024
BATCH = 8
SEQ = 2048
DEPTH = 4

CTX_LEN = 256
GRID_W = 64

GLA_HEADS = 4
GLA_DK = 64
GLA_DV = 128
GLA_RANK = 16
GLA_NORMALIZER = 16.0
GLA_CHUNK = 16
ML_HEADS = 4
ML_DQK = 64
ML_DV = 128
ML_CHUNK = 64
M2_HEADS = 8
M2_HEADDIM = 64
M2_GROUPS = 2
M2_DSTATE = 128
M2_CHUNK = 64
DT_MIN = 0.001
DT_MAX = 0.1
CONV_W = 7

GLA_WIDTH = GLA_HEADS * GLA_DV
ML_WIDTH = ML_HEADS * ML_DV
M2_WIDTH = M2_HEADS * M2_HEADDIM
MIX_WIDTH = GLA_WIDTH + ML_WIDTH + M2_WIDTH

GLA_IN = 2 * GLA_HEADS * GLA_DK + 2 * GLA_WIDTH + 2 * GLA_RANK
ML_IN = 2 * ML_HEADS * ML_DQK + 2 * ML_WIDTH + 4 * ML_HEADS
M2_CONV_DIM = M2_WIDTH + 2 * M2_GROUPS * M2_DSTATE
M2_IN = M2_WIDTH + M2_CONV_DIM + 2 * M2_HEADS
IN_WIDTH = GLA_IN + ML_IN + M2_IN

N_EXPERTS = 32
TOP_K = 4
D_EXPERT = D_MODEL
SWIGLU_LIMIT = 7.0
SWIGLU_ALPHA = 1.702
MOE_BLOCK = 128

EPS = 1e-6
M_INIT = -1e30

kernel_name = "hybrid_gla_mlstm_ssd_moe_dit"


def rmsnorm(x, g):
    xf = x.astype(jnp.float32)
    y = xf * lax.rsqrt(jnp.mean(xf * xf, axis=-1, keepdims=True) + EPS)
    return (y * g.astype(jnp.float32)).astype(x.dtype)


def modulate(h, shift, scale):
    return h * (1 + scale) + shift


def conv_centred(u, w, b):
    ch = u.shape[-1]
    y = lax.conv_general_dilated(u, w[:, None, :].astype(u.dtype), window_strides=(1,),
                                 padding=[(CONV_W // 2, CONV_W // 2)],
                                 dimension_numbers=('NWC', 'WIO', 'NWC'), feature_group_count=ch)
    return y + b.astype(u.dtype)


def to_colmajor(u, rows):
    b_, t, ch = u.shape
    return u.reshape(b_, rows, GRID_W, ch).transpose(0, 2, 1, 3).reshape(b_, t, ch)


def from_colmajor(u, rows):
    b_, t, ch = u.shape
    return u.reshape(b_, GRID_W, rows, ch).transpose(0, 2, 1, 3).reshape(b_, t, ch)


def prefix_scan(scan_fn, ctx_args, lat_args, init, reverse):
    if reverse:
        ctx_args = [jnp.flip(t, axis=1) for t in ctx_args]
        lat_args = [jnp.flip(t, axis=1) for t in lat_args]
    o_c, state = scan_fn(*ctx_args, init)
    o_l, _ = scan_fn(*lat_args, state)
    if reverse:
        o_c, o_l = jnp.flip(o_c, axis=1), jnp.flip(o_l, axis=1)
    return o_c, o_l


def gla_scan(q, k, v, log_a, s0):
    dtype = v.dtype
    b_, t, h, dk = q.shape
    dv = v.shape[-1]
    L = GLA_CHUNK
    n = t // L
    f32 = jnp.float32
    q, k, la = (z.astype(f32).reshape(b_, n, L, h, dk) for z in (q, k, log_a))
    v = v.astype(f32).reshape(b_, n, L, h, dv)
    cum = jnp.cumsum(la, axis=2)
    cum_last = cum[:, :, -1]
    lower = jnp.tril(jnp.ones((L, L), bool))
    diff = cum[:, :, :, None] - cum[:, :, None, :]
    decay = jnp.exp(jnp.where(lower[:, :, None, None], diff, -jnp.inf))
    attn = jnp.einsum('bnihk,bnjhk,bnijhk->bnhij', q, k, decay)
    o = jnp.einsum('bnhij,bnjhv->bnihv', attn, v)
    k_end = k * jnp.exp(cum_last[:, :, None] - cum)
    d_state = jnp.einsum('bnjhk,bnjhv->nbhkv', k_end, v)

    def step(s, inp):
        a_c, ds_c = inp
        return a_c[..., None] * s + ds_c, s

    s_final, s_starts = lax.scan(step, s0, (jnp.exp(cum_last).transpose(1, 0, 2, 3), d_state))
    o = o + jnp.einsum('bnihk,nbhkv->bnihv', q * jnp.exp(cum), s_starts)
    return o.reshape(b_, t, h, dv).astype(dtype), s_final


def mlstm_scan(q, k, v, i_pre, log_f, state):
    dtype = v.dtype
    b_, t, h, dk = q.shape
    dv = v.shape[-1]
    L = ML_CHUNK
    n = t // L
    f32 = jnp.float32
    q, k = (z.astype(f32).reshape(b_, n, L, h, dk) for z in (q, k))
    v = v.astype(f32).reshape(b_, n, L, h, dv)
    ig, lf = (z.astype(f32).reshape(b_, n, L, h) for z in (i_pre, log_f))
    F = jnp.cumsum(lf, axis=2)
    F_last = F[:, :, -1]
    g_end = F_last[:, :, None] - F + ig
    m_loc = jnp.max(g_end, axis=2)
    w_end = jnp.exp(g_end - m_loc[:, :, None])
    dC = jnp.einsum('bnjh,bnjhk,bnjhv->nbhkv', w_end, k, v)
    dn = jnp.einsum('bnjh,bnjhk->nbhk', w_end, k)

    def step(carry, inp):
        C, nn, m = carry
        fl, ml, dC_c, dn_c = inp
        m_new = jnp.maximum(fl + m, ml)
        a = jnp.exp(fl + m - m_new)
        s = jnp.exp(ml - m_new)
        C_new = a[..., None, None] * C + s[..., None, None] * dC_c
        n_new = a[..., None] * nn + s[..., None] * dn_c
        return (C_new, n_new, m_new), (C, nn, m)

    final, (Cs, ns, ms) = lax.scan(step, state, (F_last.transpose(1, 0, 2), m_loc.transpose(1, 0, 2), dC, dn))
    lower = jnp.tril(jnp.ones((L, L), bool))
    Dlog = F[:, :, :, None] - F[:, :, None, :] + ig[:, :, None, :]
    Dlog = jnp.where(lower[:, :, None], Dlog, -jnp.inf)
    inter = F + ms.transpose(1, 0, 2)[:, :, None]
    m_row = jnp.maximum(inter, jnp.max(Dlog, axis=3))
    s_ij = jnp.einsum('bnihk,bnjhk->bnijh', q, k) * jnp.exp(Dlog - m_row[:, :, :, None])
    w_inter = jnp.exp(inter - m_row)
    num = jnp.einsum('bnijh,bnjhv->bnihv', s_ij, v) + w_inter[..., None] * jnp.einsum('bnihk,nbhkv->bnihv', q, Cs)
    den = jnp.sum(s_ij, axis=3) + w_inter * jnp.einsum('bnihk,nbhk->bnih', q, ns)
    hh = num / jnp.maximum(jnp.abs(den), jnp.exp(-m_row))[..., None]
    return hh.reshape(b_, t, h, dv).astype(dtype), final


def ssd_scan(A, x, dt, Bm, Cm, h0):
    dtype = x.dtype
    b_, t, h, p = x.shape
    rep = h // Bm.shape[2]
    ds = Bm.shape[-1]
    L = M2_CHUNK
    n = t // L
    f32 = jnp.float32
    Bh = jnp.repeat(Bm, rep, axis=2).astype(f32).reshape(b_, n, L, h, ds)
    Ch = jnp.repeat(Cm, rep, axis=2).astype(f32).reshape(b_, n, L, h, ds)
    dtf = dt.astype(f32).reshape(b_, n, L, h)
    xdt = x.astype(f32).reshape(b_, n, L, h, p) * dtf[..., None]
    cum = jnp.cumsum(dtf * A, axis=2)
    cum_last = cum[:, :, -1]
    lower = jnp.tril(jnp.ones((L, L), bool))
    seg = cum[:, :, :, None] - cum[:, :, None, :]
    decay = jnp.exp(jnp.where(lower[:, :, None], seg, -jnp.inf))
    sc = jnp.einsum('bnihs,bnjhs->bnijh', Ch, Bh) * decay
    y = jnp.einsum('bnijh,bnjhp->bnihp', sc, xdt)
    w_end = jnp.exp(cum_last[:, :, None] - cum)
    dH = jnp.einsum('bnjh,bnjhs,bnjhp->nbhps', w_end, Bh, xdt)

    def step(hs, inp):
        a_c, dh_c = inp
        return a_c[..., None, None] * hs + dh_c, hs

    h_final, h_starts = lax.scan(step, h0, (jnp.exp(cum_last).transpose(1, 0, 2), dH))
    y = y + jnp.einsum('bnihs,nbhps->bnihp', Ch * jnp.exp(cum)[..., None], h_starts)
    return y.reshape(b_, t, h, p).astype(dtype), h_final


def gla_mixer(u, uc, w_gate2, b_gate, norm_g):
    qk = GLA_HEADS * GLA_DK

    def prep(t):
        b_, n_t, _ = t.shape
        q = t[..., :qk].reshape(b_, n_t, GLA_HEADS, GLA_DK) * GLA_DK ** -0.5
        k = t[..., qk:2 * qk].reshape(b_, n_t, GLA_HEADS, GLA_DK)
        v = t[..., 2 * qk:2 * qk + GLA_WIDTH].reshape(b_, n_t, GLA_HEADS, GLA_DV)
        g = t[..., 2 * qk + GLA_WIDTH:2 * qk + 2 * GLA_WIDTH]
        lr = t[..., 2 * qk + 2 * GLA_WIDTH:].reshape(b_, n_t, 2, GLA_RANK)
        gk = jnp.einsum('btdr,drk->btdk', lr, w_gate2) + b_gate
        la = (jax.nn.log_sigmoid(gk.astype(jnp.float32)) / GLA_NORMALIZER).reshape(b_, n_t, 2, GLA_HEADS, GLA_DK)
        return q, k, v, g, la[:, :, 0], la[:, :, 1]

    q, k, v, g, la_f, la_b = prep(u)
    qc, kc, vc, gc, lac_f, lac_b = prep(uc)
    s0 = jnp.zeros((u.shape[0], GLA_HEADS, GLA_DK, GLA_DV), jnp.float32)
    oc_f, ol_f = prefix_scan(gla_scan, (qc, kc, vc, lac_f), (q, k, v, la_f), s0, False)
    oc_b, ol_b = prefix_scan(gla_scan, (qc, kc, vc, lac_b), (q, k, v, la_b), s0, True)

    def finish(o, gate):
        o = rmsnorm(o, norm_g)
        return (o.reshape(gate.shape) * jax.nn.silu(gate)).astype(u.dtype)

    return finish(ol_f + ol_b, g), finish(oc_f + oc_b, gc)


def mlstm_mixer(u, uc, conv_w, conv_b, b_i, b_f, norm_g):
    qk = ML_HEADS * ML_DQK

    def prep(t):
        b_, n_t, _ = t.shape
        qk_act = jax.nn.silu(conv_centred(t[..., :2 * qk], conv_w, conv_b))
        q = qk_act[..., :qk].reshape(b_, n_t, ML_HEADS, ML_DQK)
        k = qk_act[..., qk:].reshape(b_, n_t, ML_HEADS, ML_DQK) * ML_DQK ** -0.5
        v = t[..., 2 * qk:2 * qk + ML_WIDTH].reshape(b_, n_t, ML_HEADS, ML_DV)
        o = t[..., 2 * qk + ML_WIDTH:2 * qk + 2 * ML_WIDTH]
        gates = t[..., 2 * qk + 2 * ML_WIDTH:].reshape(b_, n_t, 4, ML_HEADS).astype(jnp.float32)
        i_f = gates[:, :, 0] + b_i[0]
        i_b = gates[:, :, 1] + b_i[1]
        lf_f = jax.nn.log_sigmoid(gates[:, :, 2] + b_f[0])
        lf_b = jax.nn.log_sigmoid(gates[:, :, 3] + b_f[1])
        return q, k, v, o, i_f, i_b, lf_f, lf_b

    q, k, v, o, i_f, i_b, lf_f, lf_b = prep(u)
    qc, kc, vc, oc, ic_f, ic_b, lfc_f, lfc_b = prep(uc)
    b_ = u.shape[0]
    init = (jnp.zeros((b_, ML_HEADS, ML_DQK, ML_DV), jnp.float32),
            jnp.zeros((b_, ML_HEADS, ML_DQK), jnp.float32),
            jnp.full((b_, ML_HEADS), M_INIT, jnp.float32))
    hc_f, hl_f = prefix_scan(mlstm_scan, (qc, kc, vc, ic_f, lfc_f), (q, k, v, i_f, lf_f), init, False)
    hc_b, hl_b = prefix_scan(mlstm_scan, (qc, kc, vc, ic_b, lfc_b), (q, k, v, i_b, lf_b), init, True)
    g_heads = norm_g.reshape(ML_HEADS, ML_DV)

    def finish(hh, ogate):
        hh = rmsnorm(hh, g_heads)
        return (hh.reshape(ogate.shape) * jax.nn.sigmoid(ogate)).astype(u.dtype)

    return finish(hl_f + hl_b, o), finish(hc_f + hc_b, oc)


def mamba2_mixer(u, uc, rows, conv_w, conv_b, dt_bias, A_log, D_skip, norm_g):
    gs = M2_GROUPS * M2_DSTATE

    def prep(t):
        b_, n_t, _ = t.shape
        z = t[..., :M2_WIDTH]
        xbc = jax.nn.silu(conv_centred(t[..., M2_WIDTH:M2_WIDTH + M2_CONV_DIM], conv_w, conv_b))
        xs = xbc[..., :M2_WIDTH].reshape(b_, n_t, M2_HEADS, M2_HEADDIM)
        Bm = xbc[..., M2_WIDTH:M2_WIDTH + gs].reshape(b_, n_t, M2_GROUPS, M2_DSTATE)
        Cm = xbc[..., M2_WIDTH + gs:].reshape(b_, n_t, M2_GROUPS, M2_DSTATE)
        dt_raw = t[..., M2_WIDTH + M2_CONV_DIM:].reshape(b_, n_t, 2, M2_HEADS).astype(jnp.float32)
        dt = jax.nn.softplus(dt_raw + dt_bias)
        return z, xs, Bm, Cm, dt[:, :, 0], dt[:, :, 1]

    z, xs, Bm, Cm, dt_f, dt_b = prep(to_colmajor(u, rows))
    zc, xsc, Bc, Cc, dtc_f, dtc_b = prep(uc)
    A = -jnp.exp(A_log.astype(jnp.float32))
    h0 = jnp.zeros((u.shape[0], M2_HEADS, M2_HEADDIM, M2_DSTATE), jnp.float32)
    yc_f, yl_f = prefix_scan(functools.partial(ssd_scan, A[0]), (xsc, dtc_f, Bc, Cc), (xs, dt_f, Bm, Cm), h0, False)
    yc_b, yl_b = prefix_scan(functools.partial(ssd_scan, A[1]), (xsc, dtc_b, Bc, Cc), (xs, dt_b, Bm, Cm), h0, True)
    g_groups = norm_g.reshape(M2_GROUPS, M2_WIDTH // M2_GROUPS)

    def finish(y, xv, zg):
        b_, n_t = y.shape[:2]
        y = (y + D_skip[:, None] * xv).reshape(b_, n_t, M2_WIDTH) * jax.nn.silu(zg)
        y = rmsnorm(y.reshape(b_, n_t, M2_GROUPS, M2_WIDTH // M2_GROUPS), g_groups)
        return y.reshape(b_, n_t, M2_WIDTH).astype(u.dtype)

    return from_colmajor(finish(yl_f + yl_b, xs, z), rows), finish(yc_f + yc_b, xsc, zc)


def swiglu_clamped(gu):
    glu = jnp.minimum(gu[..., :D_EXPERT], SWIGLU_LIMIT)
    lin = jnp.clip(gu[..., D_EXPERT:], -SWIGLU_LIMIT, SWIGLU_LIMIT)
    return glu * jax.nn.sigmoid(SWIGLU_ALPHA * glu) * (lin + 1)


def moe(h, router_w, router_b, w_gu, b_gu, w_dn, b_dn):
    n_tok, d = h.shape
    logits = (h @ router_w).astype(jnp.float32) + router_b.astype(jnp.float32)
    top_v, top_e = lax.top_k(logits, TOP_K)
    gates = jax.nn.softmax(top_v, axis=-1)
    n_assign = n_tok * TOP_K
    flat_e = top_e.reshape(-1).astype(jnp.int32)
    order = jnp.argsort(flat_e)
    sorted_e = flat_e[order]
    counts = jnp.bincount(flat_e, length=N_EXPERTS).astype(jnp.int32)
    padded = (counts + MOE_BLOCK - 1) // MOE_BLOCK * MOE_BLOCK
    pad_end = jnp.cumsum(padded)
    pad_start = pad_end - padded
    start = jnp.cumsum(counts) - counts
    slot = jnp.arange(n_assign, dtype=jnp.int32)
    row_sorted = (pad_start[sorted_e] + slot - start[sorted_e]).astype(jnp.int32)
    dest = jnp.zeros((n_assign,), jnp.int32).at[order].set(row_sorted)
    n_blocks = -(-n_assign // MOE_BLOCK) + N_EXPERTS
    n_rows = n_blocks * MOE_BLOCK
    row_tok = jnp.zeros((n_rows,), jnp.int32).at[dest].set(slot // TOP_K)
    block_start = jnp.arange(n_blocks, dtype=jnp.int32) * MOE_BLOCK
    block_e = jnp.minimum(jnp.searchsorted(pad_end, block_start, side='right'), N_EXPERTS - 1)
    xb = h[row_tok].reshape(n_blocks, MOE_BLOCK, d)

    def expert_block(args):
        xblk, e = args
        gu = xblk @ w_gu[e] + b_gu[e]
        return swiglu_clamped(gu) @ w_dn[e] + b_dn[e]

    yb = lax.map(expert_block, (xb, block_e)).reshape(n_rows, d)
    y = yb[dest].reshape(n_tok, TOP_K, d)
    return jnp.einsum('tk,tkd->td', gates.astype(y.dtype), y)


def hybrid_layer(x, xc, c_act, cc_act, rows, last,
                 w_mod, b_mod, norm1_g, w_in,
                 gla_w_gate2, gla_b_gate, gla_norm_g,
                 ml_conv_w, ml_conv_b, ml_b_i, ml_b_f, ml_norm_g,
                 m2_conv_w, m2_conv_b, m2_dt_bias, m2_A_log, m2_D, m2_norm_g,
                 w_out, norm2_g, router_w, router_b, moe_w_gu, moe_b_gu, moe_w_dn, moe_b_dn):
    b_, s, d = x.shape
    mod = (c_act @ w_mod + b_mod).reshape(b_, 6, 1, d)
    modc = (cc_act @ w_mod + b_mod).reshape(6, d)
    h = modulate(rmsnorm(x, norm1_g), mod[:, 0], mod[:, 1])
    hc = modulate(rmsnorm(xc, norm1_g), modc[0], modc[1])
    u = h @ w_in
    uc = hc @ w_in
    a0, a1 = GLA_IN, GLA_IN + ML_IN
    o_gla, oc_gla = gla_mixer(u[..., :a0], uc[..., :a0], gla_w_gate2, gla_b_gate, gla_norm_g)
    o_ml, oc_ml = mlstm_mixer(u[..., a0:a1], uc[..., a0:a1], ml_conv_w, ml_conv_b, ml_b_i, ml_b_f, ml_norm_g)
    o_m2, oc_m2 = mamba2_mixer(u[..., a1:], uc[..., a1:], rows, m2_conv_w, m2_conv_b, m2_dt_bias, m2_A_log, m2_D, m2_norm_g)
    x = x + mod[:, 2] * (jnp.concatenate([o_gla, o_ml, o_m2], axis=-1) @ w_out)
    h2 = modulate(rmsnorm(x, norm2_g), mod[:, 3], mod[:, 4])
    if last:
        y = moe(h2.reshape(-1, d), router_w, router_b, moe_w_gu, moe_b_gu, moe_w_dn, moe_b_dn)
        return x + mod[:, 5] * y.reshape(b_, s, d), xc
    xc = xc + modc[2] * (jnp.concatenate([oc_gla, oc_ml, oc_m2], axis=-1) @ w_out)
    h2c = modulate(rmsnorm(xc, norm2_g), modc[3], modc[4])
    tokens = jnp.concatenate([h2.reshape(-1, d), h2c.reshape(-1, d)], axis=0)
    y = moe(tokens, router_w, router_b, moe_w_gu, moe_b_gu, moe_w_dn, moe_b_dn)
    n_lat = b_ * s
    x = x + mod[:, 5] * y[:n_lat].reshape(b_, s, d)
    xc = xc + modc[5] * y[n_lat:].reshape(xc.shape)
    return x, xc


def setup_inputs(seed: int = 0) -> dict:
    key = jax.random.key(seed)
    ks = jax.random.split(key, 32)
    L = DEPTH
    D = D_MODEL

    def nrm(k, shape, s):
        return jax.random.normal(k, shape, jnp.float32) * s

    dt0 = jnp.exp(jax.random.uniform(ks[18], (L, 2, M2_HEADS), jnp.float32, math.log(DT_MIN), math.log(DT_MAX)))
    return {
        'x': nrm(ks[0], (BATCH, SEQ, D), 1.0),
        'c': nrm(ks[1], (BATCH, D), 1.0),
        'ctx': nrm(ks[2], (BATCH, CTX_LEN, D), 1.0),
        'c_ctx': nrm(ks[3], (D,), 1.0),
        'w_mod': nrm(ks[4], (L, D, 6 * D), 0.5 * D ** -0.5),
        'b_mod': nrm(ks[5], (L, 6 * D), 0.02),
        'norm1_g': 1.0 + nrm(ks[6], (L, D), 0.02),
        'w_in': nrm(ks[7], (L, D, IN_WIDTH), D ** -0.5),
        'gla_w_gate2': nrm(ks[8], (L, 2, GLA_RANK, GLA_HEADS * GLA_DK), GLA_RANK ** -0.5),
        'gla_b_gate': nrm(ks[9], (L, 2, GLA_HEADS * GLA_DK), 0.1),
        'gla_norm_g': 1.0 + nrm(ks[10], (L, GLA_DV), 0.02),
        'ml_conv_w': nrm(ks[11], (L, CONV_W, 2 * ML_HEADS * ML_DQK), CONV_W ** -0.5),
        'ml_conv_b': nrm(ks[12], (L, 2 * ML_HEADS * ML_DQK), 0.02),
        'ml_b_i': nrm(ks[13], (L, 2, ML_HEADS), 0.1),
        'ml_b_f': jnp.linspace(3.0, 6.0, ML_HEADS, dtype=jnp.float32) + nrm(ks[14], (L, 2, ML_HEADS), 0.1),
        'ml_norm_g': 1.0 + nrm(ks[15], (L, ML_WIDTH), 0.02),
        'm2_conv_w': nrm(ks[16], (L, CONV_W, M2_CONV_DIM), CONV_W ** -0.5),
        'm2_conv_b': nrm(ks[17], (L, M2_CONV_DIM), 0.02),
        'm2_dt_bias': dt0 + jnp.log(-jnp.expm1(-dt0)),
        'm2_A_log': jnp.log(jax.random.uniform(ks[19], (L, 2, M2_HEADS), jnp.float32, 1.0, 16.0)),
        'm2_D': 1.0 + nrm(ks[20], (L, M2_HEADS), 0.1),
        'm2_norm_g': 1.0 + nrm(ks[21], (L, M2_WIDTH), 0.02),
        'w_out': nrm(ks[22], (L, MIX_WIDTH, D), MIX_WIDTH ** -0.5),
        'norm2_g': 1.0 + nrm(ks[23], (L, D), 0.02),
        'router_w': nrm(ks[24], (L, D, N_EXPERTS), D ** -0.5),
        'router_b': nrm(ks[25], (L, N_EXPERTS), 0.01),
        'moe_w_gu': nrm(ks[26], (L, N_EXPERTS, D, 2 * D_EXPERT), D ** -0.5),
        'moe_b_gu': nrm(ks[27], (L, N_EXPERTS, 2 * D_EXPERT), 0.01),
        'moe_w_dn': nrm(ks[28], (L, N_EXPERTS, D_EXPERT, D), D_EXPERT ** -0.5),
        'moe_b_dn': nrm(ks[29], (L, N_EXPERTS, D), 0.01),
        'final_norm_g': 1.0 + nrm(ks[30], (D,), 0.02),
    }


def reference(x, c, ctx, c_ctx, w_mod, b_mod, norm1_g, w_in,
              gla_w_gate2, gla_b_gate, gla_norm_g,
              ml_conv_w, ml_conv_b, ml_b_i, ml_b_f, ml_norm_g,
              m2_conv_w, m2_conv_b, m2_dt_bias, m2_A_log, m2_D, m2_norm_g,
              w_out, norm2_g, router_w, router_b, moe_w_gu, moe_b_gu, moe_w_dn, moe_b_dn,
              final_norm_g):
    rows = x.shape[1] // GRID_W
    c_act = jax.nn.silu(c)
    cc_act = jax.nn.silu(c_ctx)
    xc = ctx
    for l in range(DEPTH):
        x, xc = hybrid_layer(x, xc, c_act, cc_act, rows, l == DEPTH - 1,
                             w_mod[l], b_mod[l], norm1_g[l], w_in[l],
                             gla_w_gate2[l], gla_b_gate[l], gla_norm_g[l],
                             ml_conv_w[l], ml_conv_b[l], ml_b_i[l], ml_b_f[l], ml_norm_g[l],
                             m2_conv_w[l], m2_conv_b[l], m2_dt_bias[l], m2_A_log[l], m2_D[l], m2_norm_g[l],
                             w_out[l], norm2_g[l], router_w[l], router_b[l],
                             moe_w_gu[l], moe_b_gu[l], moe_w_dn[l], moe_b_dn[l])
    return rmsnorm(x, final_norm_g)
```

```cpp
#ifndef CPU_TEST
#include <hip/hip_runtime.h>
#else
#include "cpu_shim.h"
#endif
#include <cstdio>
#include <cstdint>
#include <cmath>

#ifndef CFG_D
#define CFG_D 1024
#define CFG_B 8
#define CFG_SEQ 2048
#define CFG_DEPTH 4
#define CFG_CTX 256
#endif
constexpr int D = CFG_D, NB = CFG_B, SEQ = CFG_SEQ, DEPTH = CFG_DEPTH, CTX = CFG_CTX;
constexpr int GRID_W = 64, ROWS = SEQ / GRID_W;
constexpr int NLAT = NB * SEQ, NCTX = NB * CTX, NTOK = NLAT + NCTX;
constexpr int INW = 4672, INWX = 5184, INP = 5376, MIXW = 1536, NE = 32, TOPK = 4;
constexpr int U_GQ = 0, U_GK = 256, U_GV = 512, U_GG = 1024, U_GLR = 1536;
constexpr int U_MQK = 1568, U_MV = 2080, U_MO = 2592, U_MG = 3104;
constexpr int U_Z = 3120, U_XBC = 3632, U_DT = 4656, U_GGK = 4672;
constexpr float EPS = 1e-6f;
constexpr int GIN_N1 = 1536, GIN_C2 = 1568, GIN_N2 = 3584, GIN_CT = 5152;
static_assert(GIN_N1 == U_GLR && GIN_C2 == U_GLR + 32 && GIN_C2 + GIN_N2 == GIN_CT && GIN_CT + 32 == INWX && GIN_N1 % 256 == 0 && GIN_N2 % 256 == 0 && NTOK % 64 == 0, "w_in column split");
constexpr int MAXROWS = NTOK * TOPK + NE * 256;
static_assert(NTOK % 256 == 0 && NLAT % 256 == 0 && D % 128 == 0 && D >= 256, "shape");

constexpr size_t al256(size_t x) { return (x + 255) & ~(size_t)255; }
constexpr size_t WS_CTL = 0, CTL_BYTES = 1u << 20;
constexpr size_t WS_MOD = WS_CTL + CTL_BYTES;
constexpr size_t WS_WIN = al256(WS_MOD + (size_t)DEPTH * (NB + 1) * 6 * D * 4);
constexpr size_t WS_WOUT = al256(WS_WIN + (size_t)DEPTH * INP * D * 2);
constexpr size_t WS_WGU = al256(WS_WOUT + (size_t)DEPTH * D * MIXW * 2);
constexpr size_t WS_WDN = al256(WS_WGU + (size_t)DEPTH * NE * 2 * D * D * 2);
constexpr size_t WS_X = al256(WS_WDN + (size_t)DEPTH * NE * D * D * 2);
constexpr size_t WS_H = al256(WS_X + (size_t)NTOK * D * 4);
constexpr size_t WS_U = al256(WS_H + (size_t)NTOK * D * 2);
constexpr size_t WS_GLA_A = al256(WS_U + (size_t)NTOK * INP * 4);
constexpr size_t WS_ML_QK = al256(WS_GLA_A + (size_t)2 * NTOK * 256 * 4);
constexpr size_t WS_ML_G = al256(WS_ML_QK + (size_t)NTOK * 512 * 4);
constexpr size_t WS_XBC = al256(WS_ML_G + (size_t)NTOK * 16 * 4);
constexpr size_t WS_DT = al256(WS_XBC + (size_t)NTOK * 1024 * 4);
constexpr size_t WS_ODIR = al256(WS_DT + (size_t)NTOK * 16 * 4);
constexpr size_t WS_OD2 = al256(WS_ODIR + (size_t)2 * NTOK * MIXW * 4);
constexpr size_t WS_Y = al256(WS_OD2 + (size_t)2 * NTOK * 512 * 4);
constexpr size_t WS_TOPE = al256(WS_Y + (size_t)NTOK * MIXW * 2);
constexpr size_t WS_TOPG = al256(WS_TOPE + (size_t)NTOK * 4 * 4);
constexpr size_t WS_POS = al256(WS_TOPG + (size_t)NTOK * 4 * 4);
constexpr size_t WS_DEST = al256(WS_POS + (size_t)NTOK * 4 * 4);
constexpr size_t WS_XS = al256(WS_DEST + (size_t)NTOK * 4 * 4);
constexpr size_t WS_ACT = al256(WS_XS + (size_t)MAXROWS * D * 2);
constexpr size_t WS_YB = al256(WS_ACT + (size_t)MAXROWS * D * 2);
constexpr int NCH = (CTX + SEQ) / 64;
static_assert(CTX % 64 == 0 && SEQ % 64 == 0, "chunking");
constexpr size_t CH_G = (size_t)NB * 4 * 2 * NCH, CH_S = (size_t)NB * 8 * 2 * NCH, CH_SG = (size_t)NB * 2 * 2 * NCH;
constexpr size_t WS_GQA = al256(WS_YB + (size_t)MAXROWS * D * 4);
constexpr size_t WS_GKB = al256(WS_GQA + CH_G * 4096 * 2);
constexpr size_t WS_GKDT = al256(WS_GKB + CH_G * 4096 * 2);
constexpr size_t WS_GVT = al256(WS_GKDT + CH_G * 4096 * 2);
constexpr size_t WS_GAL = al256(WS_GVT + CH_G * 8192 * 2);
constexpr size_t WS_MQA = al256(WS_GAL + CH_G * 64 * 4);
constexpr size_t WS_MKB = al256(WS_MQA + CH_G * 4096 * 2);
constexpr size_t WS_MKDT = al256(WS_MKB + CH_G * 4096 * 2);
constexpr size_t WS_MVT = al256(WS_MKDT + CH_G * 4096 * 2);
constexpr size_t WS_MMS = al256(WS_MVT + CH_G * 8192 * 2);
constexpr size_t WS_SQA = al256(WS_MMS + CH_G * 256 * 4);
constexpr size_t WS_SKB = al256(WS_SQA + CH_SG * 8192 * 2);
constexpr size_t WS_SKDT = al256(WS_SKB + CH_SG * 8192 * 2);
constexpr size_t WS_SVT = al256(WS_SKDT + CH_SG * 8192 * 2);
constexpr size_t WS_SVHT = al256(WS_SVT + CH_S * 4096 * 2);
constexpr size_t WS_SCS = al256(WS_SVHT + CH_S * 4096 * 2);
constexpr size_t WS_RWT = al256(WS_SCS + CH_S * 128 * 4);
constexpr size_t WS_SSP = al256(WS_RWT + (size_t)DEPTH * 2 * NE * D * 2);
constexpr size_t WS_RTOK = al256(WS_SSP + (size_t)NTOK * 64 * 4);
constexpr size_t WS_END = al256(WS_RTOK + (size_t)MAXROWS * 4);
static_assert(D == 1024 || D == 256, "ssp slots assume D / 256 <= 4 column tiles");
constexpr int CW_BAR = 4096;
constexpr int CW_CNT = 131072, CNTS = 256;

enum { I_X = 0, I_C, I_CTX, I_CCTX, I_WMOD, I_BMOD, I_N1G, I_WIN, I_GW2, I_GBG, I_GNG, I_MCW, I_MCB, I_MBI, I_MBF, I_MNG,
       I_2CW, I_2CB, I_2DTB, I_2AL, I_2D, I_2NG, I_WOUT, I_N2G, I_RW, I_RB, I_WGU, I_BGU, I_WDN, I_BDN, I_FNG, N_IN };

struct Args { const float* in[N_IN]; float* out; unsigned char* ws; int lo, hi, li, pad; };

#ifndef CPU_TEST
#define KAS __attribute__((address_space(4)))
#else
#define KAS
#endif
typedef unsigned short bf16_t;
typedef float f32x4 __attribute__((ext_vector_type(4)));
typedef unsigned u32x4 __attribute__((ext_vector_type(4)));
typedef unsigned u32x2 __attribute__((ext_vector_type(2)));
typedef short bf16x8 __attribute__((ext_vector_type(8)));

__host__ __device__ __forceinline__ unsigned f2bf(float f) { unsigned u; __builtin_memcpy(&u, &f, 4); return (u + 0x7fffu + ((u >> 16) & 1u)) >> 16; }
#ifndef CPU_TEST
__device__ __forceinline__ unsigned pk2(float lo, float hi) { unsigned r; asm("v_cvt_pk_bf16_f32 %0, %1, %2" : "=v"(r) : "v"(lo), "v"(hi)); return r; }
#else
__host__ __device__ __forceinline__ unsigned pk2(float lo, float hi) { return f2bf(lo) | (f2bf(hi) << 16); }
#endif
__host__ __device__ __forceinline__ float bf2f(bf16_t b) { unsigned u = ((unsigned)b) << 16; float f; __builtin_memcpy(&f, &u, 4); return f; }
#ifndef CPU_TEST
#define FEXP(x) __expf(x)
#define FLOG(x) __logf(x)
#define FRCP(x) __builtin_amdgcn_rcpf(x)
#else
#define FEXP(x) expf(x)
#define FLOG(x) logf(x)
#define FRCP(x) (1.0f / (x))
#endif
__host__ __device__ __forceinline__ float sigmoidf_(float x) { return FRCP(1.0f + FEXP(-x)); }
__host__ __device__ __forceinline__ float siluf_(float x) { return x * sigmoidf_(x); }
__host__ __device__ __forceinline__ float logsigmoidf_(float x) { return fminf(x, 0.f) - FLOG(1.0f + FEXP(-fabsf(x))); }
__host__ __device__ __forceinline__ float softplusf_(float x) { return fmaxf(x, 0.f) + FLOG(1.0f + FEXP(-fabsf(x))); }

__host__ __device__ __forceinline__ f32x4 cvtb4(unsigned long long w) { const unsigned lo = (unsigned)w, hi = (unsigned)(w >> 32); f32x4 r;
    unsigned t; float f; t = lo << 16; __builtin_memcpy(&f, &t, 4); r[0] = f; t = lo & 0xffff0000u; __builtin_memcpy(&f, &t, 4); r[1] = f; t = hi << 16; __builtin_memcpy(&f, &t, 4); r[2] = f; t = hi & 0xffff0000u; __builtin_memcpy(&f, &t, 4); r[3] = f; return r; }
__host__ __device__ __forceinline__ f32x4 ldb4(const bf16_t* p) { const unsigned long long w = *(const unsigned long long*)p; const unsigned lo = (unsigned)w, hi = (unsigned)(w >> 32); f32x4 r;
    unsigned t; float f; t = lo << 16; __builtin_memcpy(&f, &t, 4); r[0] = f; t = lo & 0xffff0000u; __builtin_memcpy(&f, &t, 4); r[1] = f; t = hi << 16; __builtin_memcpy(&f, &t, 4); r[2] = f; t = hi & 0xffff0000u; __builtin_memcpy(&f, &t, 4); r[3] = f; return r; }
struct Ctx {
    const float* const KAS* in; float* out; unsigned char* ws;
    __host__ __device__ float* mod(int l, int r) const { return (float*)(ws + WS_MOD) + ((size_t)l * (NB + 1) + r) * 6 * D; }
    __host__ __device__ bf16_t* win(int l) const { return (bf16_t*)(ws + WS_WIN) + (size_t)l * INP * D; }
    __host__ __device__ bf16_t* wout(int l) const { return (bf16_t*)(ws + WS_WOUT) + (size_t)l * D * MIXW; }
    __host__ __device__ bf16_t* wgu(int l) const { return (bf16_t*)(ws + WS_WGU) + (size_t)l * NE * 2 * D * D; }
    __host__ __device__ bf16_t* wdn(int l) const { return (bf16_t*)(ws + WS_WDN) + (size_t)l * NE * D * D; }
    __host__ __device__ float* x() const { return (float*)(ws + WS_X); }
    __host__ __device__ bf16_t* h() const { return (bf16_t*)(ws + WS_H); }
    __host__ __device__ bf16_t* u() const { return (bf16_t*)(ws + WS_U); }
    __host__ __device__ float* gla_a() const { return (float*)(ws + WS_GLA_A); }
    __host__ __device__ float* ml_qk() const { return (float*)(ws + WS_ML_QK); }
    __host__ __device__ float* ml_g() const { return (float*)(ws + WS_ML_G); }
    __host__ __device__ bf16_t* xbc() const { return (bf16_t*)(ws + WS_XBC); }
    __host__ __device__ float* dt() const { return (float*)(ws + WS_DT); }
    __host__ __device__ bf16_t* odir() const { return (bf16_t*)(ws + WS_ODIR); }
    __host__ __device__ float* od2() const { return (float*)(ws + WS_OD2); }
    __host__ __device__ bf16_t* y() const { return (bf16_t*)(ws + WS_Y); }
    __host__ __device__ int* tope() const { return (int*)(ws + WS_TOPE); }
    __host__ __device__ float* topg() const { return (float*)(ws + WS_TOPG); }
    __host__ __device__ int* pos() const { return (int*)(ws + WS_POS); }
    __host__ __device__ int* dest() const { return (int*)(ws + WS_DEST); }
    __host__ __device__ bf16_t* xs() const { return (bf16_t*)(ws + WS_XS); }
    __host__ __device__ bf16_t* act() const { return (bf16_t*)(ws + WS_ACT); }
    __host__ __device__ bf16_t* yb() const { return (bf16_t*)(ws + WS_YB); }
    __host__ __device__ bf16_t* wsb(size_t off) const { return (bf16_t*)(ws + off); }
    __host__ __device__ float* wsf(size_t off) const { return (float*)(ws + off); }
    __host__ __device__ int* rtok() const { return (int*)(ws + WS_RTOK); }
    __host__ __device__ unsigned* ctl() const { return (unsigned*)(ws + WS_CTL); }
    static_assert((size_t)(CW_CNT + 2 * DEPTH * NE * CNTS) * 4 <= CTL_BYTES, "expert counters fit the zeroed control area");
    __host__ __device__ int* cnt(int l) const { return (int*)(ws + WS_CTL) + CW_CNT + l * NE * CNTS; }
};

constexpr size_t OF_G = 0, OF_M = (size_t)NB * 8 * NCH * 8192, OF_S = 2 * OF_M;
static_assert(OF_S + (size_t)NB * 16 * NCH * 4096 == (size_t)2 * NTOK * MIXW, "fragment layout fills the old [2][NTOK][MIXW] buffer exactly");
__host__ __device__ __forceinline__ int chunk_of(int is_lat, int q) { return (is_lat ? CTX / 64 : 0) + q / 64; }
__host__ __device__ __forceinline__ int mod_row(int row) { return row < NLAT ? row / SEQ : NB; }
__host__ __device__ __forceinline__ void seg_of(int row, int& base, int& pos, int& len) {
    if (row < NLAT) { base = (row / SEQ) * SEQ; pos = row - base; len = SEQ; } else { const int r = row - NLAT; base = NLAT + (r / CTX) * CTX; pos = row - base; len = CTX; }
}
__host__ __device__ __forceinline__ int tok_of_scan(int s) { return (s % ROWS) * GRID_W + s / ROWS; }
__host__ __device__ __forceinline__ int scan_of_tok(int t) { return (t % GRID_W) * ROWS + t / GRID_W; }
__host__ __device__ __forceinline__ int tokrow_of_srow(int srow) { if (srow >= NLAT) return srow; const int b = srow / SEQ; return b * SEQ + tok_of_scan(srow - b * SEQ); }
__host__ __device__ __forceinline__ int srow_of_tokrow(int row) { if (row >= NLAT) return row; const int b = row / SEQ; return b * SEQ + scan_of_tok(row - b * SEQ); }

#ifndef CPU_TEST
#define UNI(x) __builtin_amdgcn_readfirstlane(x)
#define CBAR() __builtin_amdgcn_sched_barrier(0)
#define LAS __attribute__((address_space(3)))
namespace pg8 {
#define PG8_LAS __attribute__((address_space(3)))
typedef unsigned short bf16_t;
typedef short bf16x8 __attribute__((ext_vector_type(8)));
typedef float f32x4 __attribute__((ext_vector_type(4)));
typedef unsigned u32x4 __attribute__((ext_vector_type(4)));
constexpr int BM = 256, BK = 64, HALF = 128, HTB = HALF * BK * 2  , STAGE_BYTES = 8 * HTB, NXCD = 8, WGM = 8;

__host__ __device__ __forceinline__ int lds_byte(int r, int c) { const int st = (r >> 4) * 2 + (c >> 5), rr = r & 15, cc = c & 31, ob = rr * 64 + cc * 2; return st * 1024 + (ob ^ (((ob >> 9) & 1) << 5)); }
__host__ __device__ __forceinline__ void stage_rc(int b, int& R, int& C) { const int st = b / 1024, sb = b % 1024, swz = sb ^ (((sb >> 9) & 1) << 5); R = (st >> 1) * 16 + swz / 64; C = (st & 1) * 32 + (swz % 64) / 2; }
__host__ __device__ __forceinline__ int perm32(int rho) { const int n = rho >> 4, i = rho & 15; return 8 * (i >> 2) + 4 * n + (i & 3); }

struct Unit { int pm, pn; };
struct Gemm { const bf16_t* A; const bf16_t* Bt; int M, N, K; };

struct StaticOrder {
    int nM, nN, nwg, G, c;
    __host__ __device__ void init(int M, int N, int G_, int c_) { nM = M / BM; nN = N / BM; nwg = nM * nN; G = G_; c = c_; }
    __host__ __device__ bool next(int i, Unit& u) const {
        const long L = (long)i * G + c; if (L >= nwg) return false;
        int wgid = (int)L; { const int q = nwg / NXCD, r = nwg % NXCD, xcd = wgid % NXCD, off = wgid / NXCD; wgid = (xcd < r ? xcd * (q + 1) : r * (q + 1) + (xcd - r) * q) + off; }
        const int nig = WGM * nN, gid = wgid / nig, fm = gid * WGM, gsz = (nM - fm) < WGM ? (nM - fm) : WGM;
        u.pm = fm + ((wgid % nig) % gsz); u.pn = (wgid % nig) / gsz; return true;
    }
    __device__ __forceinline__ void a_ready(const Unit&) const {}
    __device__ __forceinline__ void done(const Unit&) const {}
};
__device__ __forceinline__ unsigned cvt_pk_bf16(float lo, float hi) { unsigned r; asm volatile("v_cvt_pk_bf16_f32 %0, %1, %2" : "=v"(r) : "v"(lo), "v"(hi)); return r; }
typedef float f32x2 __attribute__((ext_vector_type(2)));
template <class Epi, class Sched, bool ALIGN_EPI = false, bool SP2 = false>
__device__ __forceinline__ void gemm_phase(PG8_LAS unsigned char* lds, const Gemm g, const Sched& S, const Epi& E, const int tid_in) {
    const int tid = tid_in, wid = __builtin_amdgcn_readfirstlane(tid >> 6), lane = tid & 63, wr = wid >> 2, wc = wid & 3, fr = lane & 15, fq = lane >> 4;
    const int K = g.K, nt = K / BK;
    static_assert(!Sched::GATHER || SP2, "the gathered A operand is wired into the SP2 loop only");
    unsigned voffA[2], voffB[2];
#pragma unroll
    for (int i = 0; i < 2; ++i) { int R, C; stage_rc(tid * 16 + i * 8192, R, C); const int Rb = Epi::PERM ? ((R & ~31) + perm32(R & 31)) : R;
        voffA[i] = (unsigned)(R * K + C) * 2u; voffB[i] = (unsigned)(Rb * K + C) * 2u; }
    unsigned gc00 = 0u, gc01 = 0u, gc10 = 0u, gc11 = 0u, gn00 = 0u, gn01 = 0u, gn10 = 0u, gn11 = 0u;
#define PG8_GOFS(d00, d01, d10, d11, uidx) do { int R0_, C0_, R1_, C1_; stage_rc(tid * 16, R0_, C0_); stage_rc(tid * 16 + 8192, R1_, C1_); \
        d00 = ((unsigned)S.grow((uidx), R0_) * (unsigned)K + (unsigned)C0_) * 2u; d01 = ((unsigned)S.grow((uidx), R1_) * (unsigned)K + (unsigned)C1_) * 2u; \
        d10 = ((unsigned)S.grow((uidx), 128 + R0_) * (unsigned)K + (unsigned)C0_) * 2u; d11 = ((unsigned)S.grow((uidx), 128 + R1_) * (unsigned)K + (unsigned)C1_) * 2u; } while (0)
#define PG8_STAGE2(bufoff, gbase, o0, o1) do { \
        __builtin_amdgcn_global_load_lds((const unsigned*)((const char*)(gbase) + (o0)), (PG8_LAS unsigned*)(lds + (bufoff) + ldsw), 16, 0, 0); \
        __builtin_amdgcn_global_load_lds((const unsigned*)((const char*)(gbase) + (o1)), (PG8_LAS unsigned*)(lds + (bufoff) + ldsw + 8192), 16, 0, 0); } while (0)
#define PG8_STAGE_A(bufoff, base, H, NX) do { if constexpr (Sched::GATHER) { const unsigned o0_ = (NX) ? ((H) ? gn10 : gn00) : ((H) ? gc10 : gc00), o1_ = (NX) ? ((H) ? gn11 : gn01) : ((H) ? gc11 : gc01); PG8_STAGE2(bufoff, base, o0_, o1_); } \
        else { PG8_STAGE(bufoff, (base) + (H) * hstep, voffA); } } while (0)
    const size_t kstep = (size_t)(BK * 2);
    const size_t hstep = (size_t)HALF * K * 2;
    const size_t tstep = 2 * hstep;
    const unsigned ldsw = (unsigned)wid * 1024u;
    const int aoff = lds_byte(wr * 64 + fr, fq * 8), boff = lds_byte(wc * 32 + fr, fq * 8);
#define PG8_SA(b, h) (((b) * 2 + (h)) * HTB)
#define PG8_SB(b, h) ((4 + (b) * 2 + (h)) * HTB)
#define PG8_STAGE(bufoff, gbase, voff) do { _Pragma("unroll") for (int _i = 0; _i < 2; ++_i) \
        __builtin_amdgcn_global_load_lds((const unsigned*)((const char*)(gbase) + (voff)[_i]), (PG8_LAS unsigned*)(lds + (bufoff) + ldsw + _i * 8192), 16, 0, 0); } while (0)
#define PG8_LDA(dst, b, h) do { _Pragma("unroll") for (int m = 0; m < 4; ++m) _Pragma("unroll") for (int k = 0; k < 2; ++k) dst[m][k] = *(const PG8_LAS bf16x8*)(lds + PG8_SA(b, h) + aoff + m * 2048 + k * 1024); } while (0)
#define PG8_LDB(dst, b, h) do { _Pragma("unroll") for (int n = 0; n < 2; ++n) _Pragma("unroll") for (int k = 0; k < 2; ++k) dst[n][k] = *(const PG8_LAS bf16x8*)(lds + PG8_SB(b, h) + boff + n * 2048 + k * 1024); } while (0)
#define PG8_MMA(ai, bj, At, Bt) do { __builtin_amdgcn_s_setprio(1); _Pragma("unroll") for (int m = 0; m < 4; ++m) _Pragma("unroll") for (int n = 0; n < 2; ++n) _Pragma("unroll") for (int k = 0; k < 2; ++k) \
        acc[ai][bj][m][n] = __builtin_amdgcn_mfma_f32_16x16x32_bf16(Bt[n][k], At[m][k], acc[ai][bj][m][n], 0, 0, 0); __builtin_amdgcn_s_setprio(0); } while (0)
#define PG8_WAIT_V(n) asm volatile("s_waitcnt vmcnt(" #n ")" ::: "memory")
#define PG8_WAIT_L(n) asm volatile("s_waitcnt lgkmcnt(" #n ")" ::: "memory")
#define PG8_BAR __builtin_amdgcn_s_barrier()
#define PG8_SCHED __builtin_amdgcn_sched_barrier(0)
    Unit cur, nxt; int ui = 0;
    if (!S.next(0, cur)) return;
    f32x4 acc[2][2][4][2];
#pragma unroll
    for (int a = 0; a < 2; ++a)
#pragma unroll
        for (int b = 0; b < 2; ++b)
#pragma unroll
            for (int m = 0; m < 4; ++m)
#pragma unroll
                for (int n = 0; n < 2; ++n) acc[a][b][m][n] = (f32x4){0.f, 0.f, 0.f, 0.f};
    bf16x8 At[4][2], B0[2][2], B1[2][2];
    const char* cA = (const char*)g.A + (Sched::GATHER ? (size_t)0 : (size_t)cur.pm * tstep); const char* cB = (const char*)g.Bt + (size_t)cur.pn * tstep;
    if constexpr (Sched::GATHER) PG8_GOFS(gc00, gc01, gc10, gc11, 0);
    S.a_ready(cur);
    if constexpr (SP2) {
        PG8_STAGE(PG8_SB(0, 0), cB, voffB); PG8_STAGE(PG8_SB(0, 1), cB + hstep, voffB); PG8_STAGE_A(PG8_SA(0, 0), cA, 0, false); PG8_STAGE_A(PG8_SA(0, 1), cA, 1, false);
        if (wr == 1) PG8_BAR;
        PG8_WAIT_V(2); PG8_BAR;
        PG8_STAGE(PG8_SB(1, 0), cB + kstep, voffB); PG8_STAGE_A(PG8_SA(1, 0), cA + kstep, 0, false); PG8_STAGE(PG8_SB(1, 1), cB + hstep + kstep, voffB);
        PG8_WAIT_V(6); PG8_BAR;
    } else {
        PG8_STAGE(PG8_SB(0, 0), cB, voffB); PG8_STAGE(PG8_SA(0, 0), cA, voffA); PG8_STAGE(PG8_SB(0, 1), cB + hstep, voffB); PG8_STAGE(PG8_SA(0, 1), cA + hstep, voffA);
        if (wr == 1) PG8_BAR;
        PG8_WAIT_V(4); PG8_BAR;
        PG8_STAGE(PG8_SB(1, 0), cB + kstep, voffB); PG8_STAGE(PG8_SA(1, 0), cA + kstep, voffA); PG8_STAGE(PG8_SB(1, 1), cB + hstep + kstep, voffB);
        PG8_WAIT_V(6); PG8_BAR;
    }
    for (;;) {
        const bool has_next = S.next(ui + 1, nxt);
        const char* nA = (has_next && !Sched::GATHER) ? (const char*)g.A + (size_t)nxt.pm * tstep : cA; const char* nB = has_next ? (const char*)g.Bt + (size_t)nxt.pn * tstep : cB;
        if constexpr (Sched::GATHER) { if (has_next) PG8_GOFS(gn00, gn01, gn10, gn11, ui + 1); else { gn00 = gc00; gn01 = gc01; gn10 = gc10; gn11 = gc11; } }
        for (int t = 0; t < nt; t += 2) {
            const bool last = (t == nt - 2);
            const char* a1 = cA + (size_t)(t + 1) * kstep;
            const char* a2 = last ? nA : cA + (size_t)(t + 2) * kstep; const char* b2 = last ? nB : cB + (size_t)(t + 2) * kstep;
            const char* a3 = a2 + kstep; const char* b3 = b2 + kstep;
            if (last && has_next) S.a_ready(nxt);
            if constexpr (SP2) {
            PG8_LDB(B0, 0, 0); PG8_LDB(B1, 0, 1); PG8_SCHED; PG8_LDA(At, 0, 0); PG8_STAGE_A(PG8_SA(1, 1), a1, 1, false);
            PG8_WAIT_V(8); PG8_WAIT_L(0); PG8_BAR; PG8_MMA(0, 0, At, B0); PG8_MMA(0, 1, At, B1); PG8_BAR; PG8_SCHED;
            PG8_LDA(At, 0, 1); PG8_STAGE(PG8_SB(0, 0), b2, voffB); PG8_STAGE(PG8_SB(0, 1), b2 + hstep, voffB); PG8_STAGE_A(PG8_SA(0, 0), a2, 0, last);
            PG8_WAIT_V(8); PG8_WAIT_L(0); PG8_BAR; PG8_MMA(1, 0, At, B0); PG8_MMA(1, 1, At, B1); PG8_BAR; PG8_SCHED;
            PG8_LDB(B0, 1, 0); PG8_LDB(B1, 1, 1); PG8_SCHED; PG8_LDA(At, 1, 0); PG8_STAGE_A(PG8_SA(0, 1), a2, 1, last);
            PG8_WAIT_V(8); PG8_WAIT_L(0); PG8_BAR; PG8_MMA(0, 0, At, B0); PG8_MMA(0, 1, At, B1); PG8_BAR; PG8_SCHED;
            PG8_LDA(At, 1, 1); PG8_STAGE(PG8_SB(1, 0), b3, voffB); PG8_STAGE(PG8_SB(1, 1), b3 + hstep, voffB); PG8_STAGE_A(PG8_SA(1, 0), a3, 0, last);
            PG8_WAIT_V(8); PG8_WAIT_L(0); PG8_BAR; PG8_MMA(1, 0, At, B0); PG8_MMA(1, 1, At, B1); PG8_BAR; PG8_SCHED;
            } else {
            PG8_LDB(B0, 0, 0); PG8_SCHED; PG8_LDA(At, 0, 0); PG8_STAGE(PG8_SA(1, 1), a1 + hstep, voffA);
            PG8_WAIT_L(8); PG8_BAR; PG8_WAIT_L(0); PG8_MMA(0, 0, At, B0); PG8_BAR; PG8_SCHED;
            PG8_LDB(B1, 0, 1); PG8_STAGE(PG8_SB(0, 0), b2, voffB);
            PG8_BAR; PG8_WAIT_L(0); PG8_MMA(0, 1, At, B1); PG8_BAR;
            PG8_LDA(At, 0, 1); PG8_STAGE(PG8_SA(0, 0), a2, voffA);
            PG8_BAR; PG8_WAIT_L(0); PG8_MMA(1, 0, At, B0); PG8_BAR; PG8_SCHED;
            PG8_STAGE(PG8_SB(0, 1), b2 + hstep, voffB);
            PG8_WAIT_V(6); PG8_BAR; PG8_MMA(1, 1, At, B1); PG8_BAR;
            PG8_LDB(B0, 1, 0); PG8_SCHED; PG8_LDA(At, 1, 0); PG8_STAGE(PG8_SA(0, 1), a2 + hstep, voffA);
            PG8_WAIT_L(8); PG8_BAR; PG8_WAIT_L(0); PG8_MMA(0, 0, At, B0); PG8_BAR; PG8_SCHED;
            PG8_LDB(B1, 1, 1); PG8_STAGE(PG8_SB(1, 0), b3, voffB);
            PG8_BAR; PG8_WAIT_L(0); PG8_MMA(0, 1, At, B1); PG8_BAR;
            PG8_LDA(At, 1, 1); PG8_STAGE(PG8_SA(1, 0), a3, voffA);
            PG8_BAR; PG8_WAIT_L(0); PG8_MMA(1, 0, At, B0); PG8_BAR; PG8_SCHED;
            PG8_STAGE(PG8_SB(1, 1), b3 + hstep, voffB);
            PG8_WAIT_V(6); PG8_BAR; PG8_MMA(1, 1, At, B1); PG8_BAR;
            }
        }
        if constexpr (ALIGN_EPI) { if (wr == 0) PG8_BAR; }
        if constexpr (!Epi::AFTER_DRAIN) { E(acc, cur, wr, wc, fr, fq); S.done(cur); }
        if (!has_next) break;
#pragma unroll
        for (int a = 0; a < 2; ++a)
#pragma unroll
            for (int b = 0; b < 2; ++b)
#pragma unroll
                for (int m = 0; m < 4; ++m)
#pragma unroll
                    for (int n = 0; n < 2; ++n) acc[a][b][m][n] = (f32x4){0.f, 0.f, 0.f, 0.f};
        cur = nxt; cA = nA; cB = nB; ++ui;
        if constexpr (Sched::GATHER) { gc00 = gn00; gc01 = gn01; gc10 = gn10; gc11 = gn11; }
        if constexpr (ALIGN_EPI) { if (wr == 1) PG8_BAR; }
    }
    PG8_WAIT_V(0);
    if constexpr (!ALIGN_EPI) { if (wr == 0) PG8_BAR; }
    PG8_BAR;
    if constexpr (Epi::AFTER_DRAIN) { E.fused(acc, cur, wr, wc, fr, fq, lds, wid, lane); S.done(cur); }
#undef PG8_SA
#undef PG8_SB
#undef PG8_STAGE
#undef PG8_LDA
#undef PG8_LDB
#undef PG8_MMA
#undef PG8_WAIT_V
#undef PG8_WAIT_L
#undef PG8_BAR
#undef PG8_SCHED
#undef PG8_GOFS
#undef PG8_STAGE_A
#undef PG8_STAGE2
}
}
#define XB_TMO      128
#define XB_XCNT(j)  (256  + 64 * (j))
#define XB_XSUB(j)  (1280 + 64 * (j))
#define XB_XGEN(j)  (2304 + 64 * (j))
#define XB_TOP      3328
#define XB_TOPGEN   3392
#define XCD_BAR_WORDS 3456
#define XB_SPIN_CAP (1u << 22)

__device__ __forceinline__ unsigned xb_ld(unsigned* p)              { return __hip_atomic_load(p, __ATOMIC_RELAXED, __HIP_MEMORY_SCOPE_AGENT); }
__device__ __forceinline__ unsigned xb_add(unsigned* p, unsigned v) { return __hip_atomic_fetch_add(p, v, __ATOMIC_RELAXED, __HIP_MEMORY_SCOPE_AGENT); }
__device__ __forceinline__ unsigned xb_xcc_id() { return (unsigned)__builtin_amdgcn_s_getreg((3 << 11) | 20) & 0xFu; }
#define XB_SPIN(cond, bar) do { unsigned _sp = 0; while (cond) { __builtin_amdgcn_s_sleep(1); \
    if ((++_sp & 255u) == 0u) { if (xb_ld(&(bar)[XB_TMO])) break; if (_sp > XB_SPIN_CAP) { atomicAdd(&(bar)[XB_TMO], 1u); break; } } } } while (0)

struct XcdBarrier {
    unsigned* bar; unsigned x;
    volatile LAS unsigned* st;
};

__device__ __forceinline__ XcdBarrier xcd_barrier_post(unsigned* bar, volatile LAS unsigned* st) {
    XcdBarrier b; b.bar = bar; b.x = xb_xcc_id(); b.st = st;
    if (threadIdx.x == 0) (void)xb_add(&bar[XB_XCNT(b.x)], 1u);
    return b;
}
__device__ __forceinline__ void xcd_barrier_complete(unsigned* bar, unsigned x, unsigned& nloc, unsigned& nx) {
    const unsigned G = gridDim.x * gridDim.y * gridDim.z;
    unsigned sum, cnt, mine, sp = 0u;
    for (;;) {
        sum = 0u; cnt = 0u; mine = 0u;
#pragma unroll
        for (unsigned j = 0; j < 16; ++j) { const unsigned c = xb_ld(&bar[XB_XCNT(j)]); sum += c; cnt += (c > 0u) ? 1u : 0u; mine = (j == x) ? c : mine; }
        if (sum == G) break;
        __builtin_amdgcn_s_sleep(1);
        if ((++sp & 255u) == 0u) { if (xb_ld(&bar[XB_TMO])) break; if (sp > XB_SPIN_CAP) { atomicAdd(&bar[XB_TMO], 1u); break; } }
    }
    nloc = mine > 0u ? mine : 1u; nx = cnt > 0u ? cnt : 1u;
}

__device__ __forceinline__ void xcd_barrier(const XcdBarrier& b) {
    asm volatile("s_waitcnt vmcnt(0)" ::: "memory");
    __syncthreads();
    if (threadIdx.x == 0) {
        unsigned* bar = b.bar;
        __builtin_amdgcn_s_waitcnt(0);
        unsigned nloc = b.st[0], nx = b.st[1];
        if (nloc == 0u) { xcd_barrier_complete(bar, b.x, nloc, nx); b.st[0] = nloc; b.st[1] = nx; }
        const unsigned old = xb_add(&bar[XB_XSUB(b.x)], 1u);
        const unsigned gen = old / nloc;
        if (old + 1u == (gen + 1u) * nloc) {
            __builtin_amdgcn_fence(__ATOMIC_RELEASE, "agent");
            asm volatile("s_waitcnt vmcnt(0)" ::: "memory");
            const unsigned og = xb_add(&bar[XB_TOP], 1u);
            const unsigned tg = og / nx;
            if (og + 1u == (tg + 1u) * nx) xb_add(&bar[XB_TOPGEN], 1u);
            else XB_SPIN(xb_ld(&bar[XB_TOPGEN]) == tg, bar);
            __builtin_amdgcn_fence(__ATOMIC_ACQUIRE, "agent");
            xb_add(&bar[XB_XGEN(b.x)], 1u);
            asm volatile("s_waitcnt vmcnt(0)" ::: "memory");
        } else {
            XB_SPIN(xb_ld(&bar[XB_XGEN(b.x)]) == gen, bar);
            __builtin_amdgcn_fence(__ATOMIC_ACQUIRE, "agent");
            asm volatile("s_waitcnt vmcnt(0)" ::: "memory");
        }
    }
    __syncthreads();
}
#else
#define UNI(x) (x)
#define CBAR()
namespace pg8 { typedef float f32x4 __attribute__((ext_vector_type(4))); struct Unit { int pm, pn; }; struct Gemm { const unsigned short* A; const unsigned short* Bt; int M, N, K; }; }
#endif

__host__ __device__ __forceinline__ int scan_row(int b, int dir, int st) {
    return st < CTX ? NLAT + b * CTX + (dir == 0 ? st : CTX - 1 - st) : b * SEQ + (dir == 0 ? st - CTX : SEQ - 1 - (st - CTX));
}
__host__ __device__ __forceinline__ void expert_tile_base(const int* cnt, int* tb) { int a = 0; for (int e = 0; e < NE; ++e) { tb[e] = a; const int nt = (cnt[e * CNTS] + 255) / 256; for (int t = 0; t < nt; ++t) tb[NE + 1 + a + t] = e; a += nt; } tb[NE] = a; }
constexpr int TB_WORDS = NE + 1 + MAXROWS / 256;
struct DenseOrder {
    static constexpr bool GATHER = false;
    __device__ __forceinline__ int grow(int, int) const { return 0; }
    int nM, nN, nwg, G, c;
    __host__ __device__ void init(int M, int N, int G_, int c_) { nM = M / 256; nN = N / 256; nwg = nM * nN; G = G_; c = c_; }
    __host__ __device__ __forceinline__ bool next(int i, pg8::Unit& u) const {
        const long L = (long)i * G + c; if (L >= nwg) return false;
        int wgid = (int)L; { const int q = nwg / 8, r = nwg % 8, xcd = wgid % 8, off = wgid / 8; wgid = (xcd < r ? xcd * (q + 1) : r * (q + 1) + (xcd - r) * q) + off; }
        const int nig = 8 * nN, gid = wgid / nig, fm = gid * 8, gsz = (nM - fm) < 8 ? (nM - fm) : 8;
        u.pm = fm + ((wgid % nig) % gsz); u.pn = (wgid % nig) / gsz; return true;
    }
    __device__ __forceinline__ void a_ready(const pg8::Unit&) const {}
    __device__ __forceinline__ void done(const pg8::Unit&) const {}
};
template <class TB> struct MoeOrder {
    static constexpr bool GATHER = false;
    __device__ __forceinline__ int grow(int, int) const { return 0; }
    TB tb; int nN, G, c; int wgm = 8; int rev = 0;
    __host__ __device__ __forceinline__ bool next(int i, pg8::Unit& u) const {
        const int nRT = tb[NE], nwg = nRT * nN;
        const long L = (long)i * G + c; if (L >= nwg) return false;
        int wgid = (int)L; { const int q = nwg / 8, r = nwg % 8, xcd = wgid % 8, off = wgid / 8; wgid = (xcd < r ? xcd * (q + 1) : r * (q + 1) + (xcd - r) * q) + off; }
        if (rev) wgid = nwg - 1 - wgid;
        const int nig = wgm * nN, gid = wgid / nig, fm = gid * wgm, gsz = (nRT - fm) < wgm ? (nRT - fm) : wgm;
        const int rt = fm + ((wgid % nig) % gsz), ln = (wgid % nig) / gsz;
        const int e = tb[NE + 1 + rt];
#ifndef CPU_TEST
        u.pm = __builtin_amdgcn_readfirstlane(rt); u.pn = __builtin_amdgcn_readfirstlane(e * nN + ln);
#else
        u.pm = rt; u.pn = e * nN + ln;
#endif
        return true;
    }
    __device__ __forceinline__ void a_ready(const pg8::Unit&) const {}
    __device__ __forceinline__ void done(const pg8::Unit&) const {}
};
template <class TB, class GT> struct MoeOrderG : MoeOrder<TB> {
    static constexpr bool GATHER = true;
    GT gtab; const int* rowtok;
    __host__ __device__ MoeOrderG(TB tb_, int nN_, int G_, int c_, GT gt_, const int* rt_) { this->tb = tb_; this->nN = nN_; this->G = G_; this->c = c_; this->wgm = 8; gtab = gt_; rowtok = rt_; }
    __device__ __forceinline__ int grow(int ui, int r) const { return (int)gtab[ui * 256 + r]; }
};
#ifdef CPU_TEST
static inline unsigned cvt_pk_bf16(float lo, float hi) { return pk2(lo, hi); }
#else
using pg8::cvt_pk_bf16;
#endif
typedef pg8::f32x4 accq;
struct EpiU {
    static constexpr bool PERM = true, AFTER_DRAIN = false;
    bf16_t* C; int ldc;
    __device__ __forceinline__ void operator()(const accq (&acc)[2][2][4][2], const pg8::Unit& u, int wr, int wc, int fr, int fq) const {
        const int row0 = u.pm * 256 + wr * 64 + fr, col0 = u.pn * 256 + wc * 32 + 8 * fq;
#pragma unroll
        for (int ai = 0; ai < 2; ++ai)
#pragma unroll
            for (int m = 0; m < 4; ++m) { bf16_t* rowp = C + (size_t)(row0 + ai * 128 + m * 16) * ldc + col0;
#pragma unroll
                for (int bj = 0; bj < 2; ++bj) { const accq v0 = acc[ai][bj][m][0], v1 = acc[ai][bj][m][1];
                    u32x4 w; w.x = cvt_pk_bf16(v0[0], v0[1]); w.y = cvt_pk_bf16(v0[2], v0[3]); w.z = cvt_pk_bf16(v1[0], v1[1]); w.w = cvt_pk_bf16(v1[2], v1[3]);
                    *(u32x4*)(rowp + bj * 128) = w; } }
    }
};
struct EpiResid {
    static constexpr bool PERM = false, AFTER_DRAIN = false;
    float* X; const float* modl; float* SSP;
    __device__ __forceinline__ void operator()(const accq (&acc)[2][2][4][2], const pg8::Unit& u, int wr, int wc, int fr, int fq) const {
        const int row0 = u.pm * 256 + wr * 64 + fr, col0 = u.pn * 256 + wc * 32 + 4 * fq;
#pragma unroll
        for (int ai = 0; ai < 2; ++ai)
#pragma unroll
            for (int m = 0; m < 4; ++m) { const int row = row0 + ai * 128 + m * 16; float* rowp = X + (size_t)row * D + col0; const float* gp = modl + (size_t)mod_row(row) * 6 * D + 2 * D + col0;
                float ss = 0.f;
#pragma unroll
                for (int bj = 0; bj < 2; ++bj)
#pragma unroll
                    for (int n = 0; n < 2; ++n) { const accq gv = *(const accq*)(gp + bj * 128 + n * 16); accq xv = *(accq*)(rowp + bj * 128 + n * 16); xv = xv + gv * acc[ai][bj][m][n]; *(accq*)(rowp + bj * 128 + n * 16) = xv;
                        ss += (xv[0] * xv[0] + xv[1] * xv[1]) + (xv[2] * xv[2] + xv[3] * xv[3]); }
                SSP[(size_t)row * 64 + (u.pn * 4 + wc) * 4 + fq] = ss; }
    }
};
struct EpiSwiglu {
    static constexpr bool PERM = true, AFTER_DRAIN = false;
    bf16_t* ACT; const float* bgu;
    __device__ __forceinline__ void operator()(const accq (&acc)[2][2][4][2], const pg8::Unit& u, int wr, int wc, int fr, int fq) const {
        constexpr int nN = 2 * D / 256;
        const int e = u.pn / nN, ln = u.pn % nN;
        const int row0 = u.pm * 256 + wr * 64 + fr, cl = 128 * ln + wc * 32 + 8 * fq;
        const float* bg = bgu + (size_t)e * 2 * D + cl;
        accq bgl[2], bli[2];
#pragma unroll
        for (int n = 0; n < 2; ++n) { bgl[n] = *(const accq*)(bg + 4 * n); bli[n] = *(const accq*)(bg + D + 4 * n); }
#pragma unroll
        for (int ai = 0; ai < 2; ++ai)
#pragma unroll
            for (int m = 0; m < 4; ++m) {
                float a[8];
#pragma unroll
                for (int n = 0; n < 2; ++n)
#pragma unroll
                    for (int j = 0; j < 4; ++j) {
                        float glu = acc[ai][0][m][n][j] + bgl[n][j], lin = acc[ai][1][m][n][j] + bli[n][j];
                        glu = fminf(glu, 7.0f); lin = fminf(fmaxf(lin, -7.0f), 7.0f);
                        a[4 * n + j] = glu * FRCP(1.0f + __expf(-1.702f * glu)) * (lin + 1.0f);
                    }
                u32x4 w; w.x = cvt_pk_bf16(a[0], a[1]); w.y = cvt_pk_bf16(a[2], a[3]); w.z = cvt_pk_bf16(a[4], a[5]); w.w = cvt_pk_bf16(a[6], a[7]);
                *(u32x4*)(ACT + (size_t)(row0 + ai * 128 + m * 16) * D + cl) = w;
            }
    }
};
struct EpiDown {
    static constexpr bool PERM = true, AFTER_DRAIN = false;
    bf16_t* YB; const float* bdn;
    __device__ __forceinline__ void operator()(const accq (&acc)[2][2][4][2], const pg8::Unit& u, int wr, int wc, int fr, int fq) const {
        constexpr int nN = D / 256;
        const int e = u.pn / nN, ln = u.pn % nN;
        const int row0 = u.pm * 256 + wr * 64 + fr, col0 = ln * 256 + wc * 32 + 8 * fq;
        const float* bp = bdn + (size_t)e * D + col0;
        accq bv[2][2];
#pragma unroll
        for (int bj = 0; bj < 2; ++bj)
#pragma unroll
            for (int n = 0; n < 2; ++n) bv[bj][n] = *(const accq*)(bp + bj * 128 + 4 * n);
#pragma unroll
        for (int ai = 0; ai < 2; ++ai)
#pragma unroll
            for (int m = 0; m < 4; ++m) { bf16_t* rowp = YB + (size_t)(row0 + ai * 128 + m * 16) * D + col0;
#pragma unroll
                for (int bj = 0; bj < 2; ++bj) { const accq v0 = acc[ai][bj][m][0] + bv[bj][0], v1 = acc[ai][bj][m][1] + bv[bj][1];
                    u32x4 w; w.x = cvt_pk_bf16(v0[0], v0[1]); w.y = cvt_pk_bf16(v0[2], v0[3]); w.z = cvt_pk_bf16(v1[0], v1[1]); w.w = cvt_pk_bf16(v1[2], v1[3]);
                    *(u32x4*)(rowp + bj * 128) = w; } }
    }
};
__host__ __device__ __forceinline__ int gu_row_of_col(int n) { return n < D ? 256 * (n / 128) + n % 128 : 256 * ((n - D) / 128) + 128 + (n - D) % 128; }

#ifndef CPU_TEST
__device__ __forceinline__ int lane_now() { int l; asm volatile("v_mbcnt_lo_u32_b32 %0, -1, 0\n\tv_mbcnt_hi_u32_b32 %0, -1, %0" : "=v"(l)); return l; }
#define SHFL_XOR_F(v, m) __builtin_bit_cast(float, __builtin_amdgcn_ds_bpermute((lane_now() ^ (m)) << 2, __builtin_bit_cast(int, (float)(v))))
template <int CTRL> __device__ __forceinline__ float dppf(float v) { return __builtin_bit_cast(float, __builtin_amdgcn_update_dpp(0, __builtin_bit_cast(int, v), CTRL, 0xF, 0xF, true)); }
#define RED1(v) dppf<0xB1>(v)
#define RED2(v) dppf<0x4E>(v)
#define RED4(v) dppf<0x141>(v)
#define RED8(v) dppf<0x140>(v)
#define RFL(x) __builtin_amdgcn_readfirstlane(x)
#define WAVE_SYNC() __builtin_amdgcn_wave_barrier()
#else
#define SHFL_XOR_F(v, m) shfl_xor_f((v), (m))
#define RED1(v) shfl_xor_f((v), 1)
#define RED2(v) shfl_xor_f((v), 2)
#define RED4(v) shfl_xor_f((v), 4)
#define RED8(v) shfl_xor_f((v), 8)
#define RFL(x) rfl_i(x)
#define LAS
#define WAVE_SYNC() simt::wave_sync()
#endif
__device__ __forceinline__ float wave_sum(float v) {
    v += RED1(v); v += RED2(v); v += RED4(v); v += RED8(v); v += SHFL_XOR_F(v, 16); v += SHFL_XOR_F(v, 32);
    return v;
}
static_assert(D % 256 == 0, "row layout: lane l holds float4 j at element 4l + 256j");
constexpr int RJ = D / 256;
__device__ __forceinline__ float row_rms(const f32x4 (&v)[RJ]) {
    float s = 0.f;
#pragma unroll
    for (int j = 0; j < RJ; ++j) s += (v[j][0] * v[j][0] + v[j][1] * v[j][1]) + (v[j][2] * v[j][2] + v[j][3] * v[j][3]);
    return 1.0f / sqrtf(wave_sum(s) * (1.0f / D) + EPS);
}
__device__ __forceinline__ void row_modulate_store(f32x4 (&v)[RJ], float r, const float* g, const float* shift, const float* scale, bf16_t* o, int lane) {
#pragma unroll
    for (int j = 0; j < RJ; ++j) {
        const int e0 = 4 * lane + 256 * j;
        const f32x4 gv = *(const f32x4*)(g + e0), sh = *(const f32x4*)(shift + e0), sc = *(const f32x4*)(scale + e0);
        v[j] = (v[j] * r * gv) * (sc + 1.0f) + sh;
        unsigned lo = pk2(v[j][0], v[j][1]), hi = pk2(v[j][2], v[j][3]);
        *(unsigned long long*)(o + e0) = (unsigned long long)lo | ((unsigned long long)hi << 32);
    }
}
__device__ __forceinline__ void ph_xinit_w(const Ctx& c, int gw, int ngw, int lane) {
    for (int row = gw; row < NTOK; row += ngw) {
        const float* src = row < NLAT ? c.in[I_X] + (size_t)row * D : c.in[I_CTX] + (size_t)(row - NLAT) * D;
        float* dst = c.x() + (size_t)row * D;
#pragma unroll
        for (int j = 0; j < RJ; ++j) *(f32x4*)(dst + 4 * lane + 256 * j) = *(const f32x4*)(src + 4 * lane + 256 * j);
    }
}
__device__ __forceinline__ void ph_norm1_w(const Ctx& c, int l, int gw, int ngw, int lane) {
    for (int row = gw; row < NTOK; row += ngw) {
        const float* xr = row < NLAT ? c.in[I_X] + (size_t)row * D : c.in[I_CTX] + (size_t)(row - NLAT) * D;
        float* dst = c.x() + (size_t)row * D;
        f32x4 v[RJ];
#pragma unroll
        for (int j = 0; j < RJ; ++j) { v[j] = *(const f32x4*)(xr + 4 * lane + 256 * j); *(f32x4*)(dst + 4 * lane + 256 * j) = v[j]; }
        const float r = row_rms(v);
        const float* m = c.mod(l, mod_row(row));
        row_modulate_store(v, r, c.in[I_N1G] + l * D, m, m + D, c.h() + (size_t)row * D, lane);
    }
}
__device__ __forceinline__ void ph_finish_w(const Ctx& c, int l, int nrows, int gw, int ngw, int lane) {
    const bf16_t* U = c.u();
    const bf16_t* OD = c.odir();
    for (int grp = gw; grp < nrows / 4; grp += ngw) {
        const int row0 = 4 * grp;
        int base, pos, len; seg_of(row0, base, pos, len);
        const int is_lat = row0 < NLAT ? 1 : 0, b = is_lat ? row0 / SEQ : (row0 - NLAT) / CTX;
        const int unit = lane >> 3, sub = lane & 7, hd = unit & 3, col0 = unit * 128 + sub * 16;
        float o[4][16];
#pragma unroll
        for (int d = 0; d < 2; ++d) {
            const int q = d == 0 ? pos : len - 1 - pos, n = chunk_of(is_lat, q), qi = q % 64;
            const bf16_t* fp = OD + (unit < 4 ? OF_G : OF_M) + ((((size_t)((b * 4 + hd) * 2 + d) * NCH + n) * 4 + qi / 16) * 8 + sub) * 256 + ((qi % 16) / 4) * 64;
#pragma unroll
            for (int e = 0; e < 16; ++e) { const f32x4 v = ldb4(fp + e * 4);
#pragma unroll
                for (int j = 0; j < 4; ++j) o[j][e] = d == 0 ? v[j] : o[j][e] + v[3 - j]; }
        }
        const int hc = sub * 16;
        const float* gw_ = unit < 4 ? c.in[I_GNG] + l * 128 + hc : c.in[I_MNG] + l * 512 + (unit - 4) * 128 + hc;
        f32x4 gv[4];
#pragma unroll
        for (int q = 0; q < 4; ++q) gv[q] = *(const f32x4*)(gw_ + 4 * q);
#pragma unroll
        for (int j = 0; j < 4; ++j) {
            float ss = 0.f;
#pragma unroll
            for (int e = 0; e < 16; ++e) ss += o[j][e] * o[j][e];
            ss += RED1(ss); ss += RED2(ss); ss += RED4(ss);
            const float r = 1.0f / sqrtf(ss * (1.0f / 128.f) + EPS);
            const bf16_t* ur = U + (size_t)(row0 + j) * INP;
            const bf16_t* gate = unit < 4 ? ur + U_GG + unit * 128 + hc : ur + U_MO + (unit - 4) * 128 + hc;
            unsigned w[8];
#pragma unroll
            for (int q = 0; q < 4; ++q) { const f32x4 ga = ldb4(gate + 4 * q); float t[4];
#pragma unroll
                for (int e = 0; e < 4; ++e) t[e] = o[j][4 * q + e] * r * gv[q][e] * (unit < 4 ? siluf_(ga[e]) : sigmoidf_(ga[e]));
                w[2 * q] = pk2(t[0], t[1]); w[2 * q + 1] = pk2(t[2], t[3]); }
            bf16_t* yr = c.y() + (size_t)(row0 + j) * MIXW + col0;
            *(u32x4*)yr = (u32x4){w[0], w[1], w[2], w[3]}; *(u32x4*)(yr + 8) = (u32x4){w[4], w[5], w[6], w[7]};
            CBAR();
        }
    }
    for (int grp = gw; grp < nrows / 4; grp += ngw) {
        const int srow0 = 4 * grp;
        int base, spos, len; seg_of(srow0, base, spos, len);
        const int is_lat = srow0 < NLAT ? 1 : 0, b = is_lat ? srow0 / SEQ : (srow0 - NLAT) / CTX;
        const int ch0 = 8 * lane, hd = ch0 / 64, wc = (ch0 % 64) / 16, cc0 = ch0 % 16;
        const float dsk = c.in[I_2D][l * 8 + hd];
        float acc[4][8];
#pragma unroll
        for (int d = 0; d < 2; ++d) {
            const int q = d == 0 ? spos : len - 1 - spos, n = chunk_of(is_lat, q), qi = q % 64;
            const bf16_t* fp = OD + OF_S + ((((size_t)((b * 8 + hd) * 2 + d) * NCH + n) * 4 + qi / 16) * 4 + wc) * 256 + ((qi % 16) / 4) * 64 + cc0 * 4;
#pragma unroll
            for (int e = 0; e < 8; ++e) { const f32x4 v = ldb4(fp + e * 4);
#pragma unroll
                for (int j = 0; j < 4; ++j) acc[j][e] = d == 0 ? v[j] : acc[j][e] + v[3 - j]; }
        }
        const float* ng = c.in[I_2NG] + l * 512 + ch0;
        const f32x4 g0 = *(const f32x4*)ng, g1 = *(const f32x4*)(ng + 4);
#pragma unroll
        for (int j = 0; j < 4; ++j) {
            const int srow = srow0 + j, row = tokrow_of_srow(srow);
            const bf16_t* xr = c.xbc() + (size_t)srow * 512 + ch0;
            const bf16_t* ur = U + (size_t)row * INP;
            float yv[8]; float ss = 0.f;
#pragma unroll
            for (int q = 0; q < 2; ++q) { const f32x4 xs = ldb4(xr + 4 * q), z = ldb4(ur + U_Z + ch0 + 4 * q);
#pragma unroll
                for (int e = 0; e < 4; ++e) { const float t = (acc[j][4 * q + e] + dsk * xs[e]) * siluf_(z[e]); yv[4 * q + e] = t; ss += t * t; } }
            ss += RED1(ss); ss += RED2(ss); ss += RED4(ss); ss += RED8(ss); ss += SHFL_XOR_F(ss, 16);
            const float r = 1.0f / sqrtf(ss * (1.0f / 256.f) + EPS);
            *(u32x4*)(c.y() + (size_t)row * MIXW + 1024 + ch0) = (u32x4){pk2(yv[0] * r * g0[0], yv[1] * r * g0[1]), pk2(yv[2] * r * g0[2], yv[3] * r * g0[3]), pk2(yv[4] * r * g1[0], yv[5] * r * g1[1]), pk2(yv[6] * r * g1[2], yv[7] * r * g1[3])};
            CBAR();
        }
    }
}
constexpr int ROUTE_R = 4, ROUTE_LDS = (ROUTE_R * D + ROUTE_R * NE) * 4;
__device__ __forceinline__ void ph_route_w(const Ctx& c, int l, int nrows, LAS float* wlds, int gw, int ngw, int lane, bool dummy = false) {
    LAS float* hv = wlds; LAS float* lgs = wlds + ROUTE_R * D;
    const float* rw = c.in[I_RW] + (size_t)l * D * NE;
    for (int r0 = gw * ROUTE_R; r0 < nrows; r0 += ngw * ROUTE_R) {
#pragma unroll
        for (int q = 0; q < ROUTE_R; ++q) {
            const int row = r0 + q;
            const float* xr = c.x() + (size_t)row * D;
            f32x4 v[RJ];
#pragma unroll
            for (int j = 0; j < RJ; ++j) v[j] = *(const f32x4*)(xr + 4 * lane + 256 * j);
            const float r = row_rms(v);
            const float* m = c.mod(l, mod_row(row));
            row_modulate_store(v, r, c.in[I_N2G] + l * D, m + 3 * D, m + 4 * D, c.h() + (size_t)row * D, lane);
#pragma unroll
            for (int j = 0; j < RJ; ++j) *(LAS f32x4*)(hv + q * D + 4 * lane + 256 * j) = v[j];
        }
        WAVE_SYNC();
        const int e = lane & 31, kh = lane >> 5;
        float acc[ROUTE_R];
#pragma unroll
        for (int q = 0; q < ROUTE_R; ++q) acc[q] = 0.f;
        for (int k = kh * (D / 2); k < (kh + 1) * (D / 2); k += 4) {
            const float w0 = rw[(size_t)(k + 0) * NE + e], w1 = rw[(size_t)(k + 1) * NE + e], w2 = rw[(size_t)(k + 2) * NE + e], w3 = rw[(size_t)(k + 3) * NE + e];
#pragma unroll
            for (int q = 0; q < ROUTE_R; ++q) { const f32x4 hq = *(const LAS f32x4*)(hv + q * D + k); acc[q] += (hq[0] * w0 + hq[1] * w1) + (hq[2] * w2 + hq[3] * w3); }
        }
#pragma unroll
        for (int q = 0; q < ROUTE_R; ++q) { acc[q] += SHFL_XOR_F(acc[q], 32); if (kh == 0) lgs[q * NE + e] = acc[q] + c.in[I_RB][l * NE + e]; }
        WAVE_SYNC();
        if (lane < ROUTE_R) {
            const int row = r0 + lane;
            float lg[NE];
#pragma unroll
            for (int i = 0; i < NE; ++i) lg[i] = lgs[lane * NE + i];
            int te[TOPK]; float tv[TOPK];
#pragma unroll
            for (int kk = 0; kk < TOPK; ++kk) {
                int best = -1; float bv = 0.f;
#pragma unroll
                for (int i = 0; i < NE; ++i) {
                    bool taken = false;
#pragma unroll
                    for (int j = 0; j < kk; ++j) taken = taken || (te[j] == i);
                    if (!taken && (best < 0 || lg[i] > bv)) { best = i; bv = lg[i]; }
                }
                te[kk] = best; tv[kk] = bv;
            }
            float se = 0.f, ex[TOPK];
#pragma unroll
            for (int kk = 0; kk < TOPK; ++kk) { ex[kk] = expf(tv[kk] - tv[0]); se += ex[kk]; }
#pragma unroll
            for (int kk = 0; kk < TOPK; ++kk) {
                c.tope()[row * TOPK + kk] = te[kk];
                c.topg()[row * TOPK + kk] = ex[kk] / se;
                c.pos()[row * TOPK + kk] = atomicAdd(c.cnt(l) + (dummy ? DEPTH * NE * CNTS : 0) + te[kk] * CNTS, 1);
            }
        }
        WAVE_SYNC();
    }
}
template <class TB> __device__ __forceinline__ void ph_rowtok_w(const Ctx& c, int l, int nrows, TB tb, int gt, int gs) {
    for (int it = gt; it < nrows * TOPK; it += gs) {
        const int d = tb[c.tope()[it]] * 256 + c.pos()[it];
        c.dest()[it] = d; c.rtok()[d] = it / TOPK;
    }
    const int* cn = c.cnt(l);
    for (int it = gt; it < NE * 256; it += gs) {
        const int e = it / 256, p = it % 256, n = cn[e * CNTS], nt = (n + 255) / 256;
        if (nt > 0 && (nt - 1) * 256 + p >= n) c.rtok()[tb[e] * 256 + (nt - 1) * 256 + p] = 0;
    }
}
template <int NR> __device__ __forceinline__ void comb_rows(const Ctx& c, int l, const int (&rows)[NR], int lane, bool dummy) {
    typedef int i32x4 __attribute__((ext_vector_type(4)));
    const bool last = (l == DEPTH - 1);
    i32x4 dd[NR]; f32x4 gk[NR];
#pragma unroll
    for (int a = 0; a < NR; ++a) { dd[a] = *(const i32x4*)(c.dest() + rows[a] * TOPK); gk[a] = *(const f32x4*)(c.topg() + rows[a] * TOPK); }
    f32x4 v[NR][RJ];
#pragma unroll
    for (int a = 0; a < NR; ++a) {
        const float* xr = c.x() + (size_t)rows[a] * D;
        const float* m = c.mod(l, mod_row(rows[a])) + 5 * D;
        const bf16_t* y0 = c.yb() + (size_t)dd[a][0] * D; const bf16_t* y1 = c.yb() + (size_t)dd[a][1] * D; const bf16_t* y2 = c.yb() + (size_t)dd[a][2] * D; const bf16_t* y3 = c.yb() + (size_t)dd[a][3] * D;
#pragma unroll
        for (int j = 0; j < RJ; ++j) { const int e0 = 4 * lane + 256 * j;
            const f32x4 s = (ldb4(y0 + e0) * gk[a][0] + ldb4(y1 + e0) * gk[a][1]) + (ldb4(y2 + e0) * gk[a][2] + ldb4(y3 + e0) * gk[a][3]);
            v[a][j] = *(const f32x4*)(xr + e0) + *(const f32x4*)(m + e0) * s; }
    }
#pragma unroll
    for (int a = 0; a < NR; ++a) {
        const int row = rows[a];
        const float r = row_rms(v[a]);
        if (last) {
#pragma unroll
            for (int j = 0; j < RJ; ++j) { const int e0 = 4 * lane + 256 * j; *(f32x4*)(c.out + (size_t)row * D + e0) = v[a][j] * r * *(const f32x4*)(c.in[I_FNG] + e0); }
        } else {
            float* xr = c.x() + (size_t)row * D;
#pragma unroll
            for (int j = 0; j < RJ; ++j) *(f32x4*)((dummy ? c.od2() + (size_t)row * D : xr) + 4 * lane + 256 * j) = v[a][j];
            const float* mn = c.mod(l + 1, mod_row(row));
            row_modulate_store(v[a], r, c.in[I_N1G] + (l + 1) * D, mn, mn + D, c.h() + (size_t)row * D, lane);
        }
    }
}
__device__ __forceinline__ void ph_combine_w(const Ctx& c, int l, int nrows, int gw, int ngw, int lane, bool dummy = false) {
    int row = gw;
    for (; row + 2 * ngw < nrows; row += 3 * ngw) { const int rows[3] = {row, row + ngw, row + 2 * ngw}; comb_rows<3>(c, l, rows, lane, dummy); }
    if (row + ngw < nrows) { const int rows[2] = {row, row + ngw}; comb_rows<2>(c, l, rows, lane, dummy); }
    else if (row < nrows) { const int rows[1] = {row}; comb_rows<1>(c, l, rows, lane, dummy); }
}
__device__ __forceinline__ void ph_mod_w(const Ctx& c, LAS float* tab, int tid, int blk, int G) {
    LAS float* part = tab + (NB + 1) * D;
    for (int i = tid; i < (NB + 1) * D; i += 512) { const int r = i / D, k = i % D; tab[i] = siluf_(r < NB ? c.in[I_C][r * D + k] : c.in[I_CCTX][k]); }
    __syncthreads();
    const int lane = tid & 63, w = tid >> 6;
    for (int cbk = blk; cbk < DEPTH * 6 * D / 64; cbk += G) {
        const int l = cbk / (6 * D / 64), col = (cbk % (6 * D / 64)) * 64 + lane;
        const float* wp = c.in[I_WMOD] + (size_t)l * D * 6 * D + col + (size_t)(w * (D / 8)) * 6 * D;
        float acc[NB + 1];
#pragma unroll
        for (int r = 0; r <= NB; ++r) acc[r] = 0.f;
        for (int k0 = 0; k0 < D / 8; k0 += 16) { float wv[16];
#pragma unroll
            for (int e = 0; e < 16; ++e) wv[e] = wp[(size_t)(k0 + e) * 6 * D];
#pragma unroll
            for (int e = 0; e < 16; ++e)
#pragma unroll
                for (int r = 0; r <= NB; ++r) acc[r] += tab[r * D + w * (D / 8) + k0 + e] * wv[e]; }
#pragma unroll
        for (int r = 0; r <= NB; ++r) part[(w * (NB + 1) + r) * 64 + lane] = acc[r];
        __syncthreads();
        for (int i = tid; i < (NB + 1) * 64; i += 512) { const int r = i / 64, cc = i % 64; float s = 0.f;
#pragma unroll
            for (int ww = 0; ww < 8; ++ww) s += part[(ww * (NB + 1) + r) * 64 + cc];
            const int colo = (cbk % (6 * D / 64)) * 64 + cc;
            c.mod(l, r)[colo] = s + c.in[I_BMOD][l * 6 * D + colo]; }
        __syncthreads();
    }
}
__host__ __device__ __forceinline__ void ph_foldgate(const Ctx& c, int gt, int gs) {
    for (int it = gt; it < DEPTH * (D / 8) * 512; it += gs) {
        const int col = it % 512, k0 = ((it / 512) % (D / 8)) * 8, l = it / (512 * (D / 8)), d = col / 256, cc = col % 256;
        const float* w2 = c.in[I_GW2] + ((size_t)(l * 2 + d) * 16) * 256 + cc;
        float w2r[16];
#pragma unroll
        for (int r = 0; r < 16; ++r) w2r[r] = w2[r * 256];
        float a[8];
#pragma unroll
        for (int e = 0; e < 8; ++e) { const float* wi = c.in[I_WIN] + ((size_t)l * D + k0 + e) * INW + U_GLR + 16 * d; float s = 0.f;
#pragma unroll
            for (int q = 0; q < 4; ++q) { const f32x4 t = *(const f32x4*)(wi + 4 * q); s += t[0] * w2r[4 * q] + t[1] * w2r[4 * q + 1] + t[2] * w2r[4 * q + 2] + t[3] * w2r[4 * q + 3]; }
            a[e] = s; }
        *(u32x4*)(c.win(l) + (size_t)(INW + col) * D + k0) = (u32x4){pk2(a[0], a[1]), pk2(a[2], a[3]), pk2(a[4], a[5]), pk2(a[6], a[7])};
    }
}

__host__ __device__ __forceinline__ void ph_rwsplit(const Ctx& c, int gt, int gs) {
    for (int it = gt; it < DEPTH * NE * D; it += gs) {
        const int e = it % NE, k = (it / NE) % D, l = it / (NE * D);
        const float w = c.in[I_RW][((size_t)l * D + k) * NE + e];
        const unsigned hi = f2bf(w); const float lo = w - bf2f((bf16_t)hi);
        bf16_t* T = c.wsb(WS_RWT) + (size_t)l * 2 * NE * D;
        T[(size_t)e * D + k] = (bf16_t)hi; T[(size_t)(NE + e) * D + k] = (bf16_t)f2bf(lo);
    }
}

__host__ __device__ __forceinline__ u32x4 pack8(const float* v) { return (u32x4){pk2(v[0], v[1]), pk2(v[2], v[3]), pk2(v[4], v[5]), pk2(v[6], v[7])}; }

struct SegC { int base, len, q0; };
__host__ __device__ __forceinline__ SegC seg_of_chunk(int b, int n) { SegC s; if (n < CTX / 64) { s.base = NLAT + b * CTX; s.len = CTX; s.q0 = 64 * n; } else { s.base = b * SEQ; s.len = SEQ; s.q0 = 64 * (n - CTX / 64); } return s; }
__host__ __device__ __forceinline__ int seg_row(const SegC& s, int dir, int q) { return s.base + (dir == 0 ? q : s.len - 1 - q); }
__host__ __device__ __forceinline__ float tap_at(const bf16_t* U, const SegC& s, int dir, int q, int ucol, bool colmajor) {
    const bool ok = q >= 0 && q < s.len; const int qc = q < 0 ? 0 : (q >= s.len ? s.len - 1 : q);
    const int r = seg_row(s, dir, qc);
    const float v = bf2f(U[(size_t)(colmajor ? tokrow_of_srow(r) : r) * INP + ucol]);
    return ok ? v : 0.f;
}

#ifndef CPU_TEST
#define MFMA16(a, b, c) __builtin_amdgcn_mfma_f32_16x16x32_bf16((a), (b), (c), 0, 0, 0)
#else
#define MFMA16(a, b, c) mfma16_emul((a), (b), (c))
#endif
#ifndef CPU_TEST
#define LDS_BAR() do { asm volatile("s_waitcnt lgkmcnt(0)" ::: "memory"); __builtin_amdgcn_s_barrier(); asm volatile("" ::: "memory"); } while (0)
#else
#define LDS_BAR() __syncthreads()
#endif
typedef LAS unsigned char* ldsp_t;
typedef unsigned long long u64_t;
__device__ __forceinline__ bf16x8 lds_rd16(ldsp_t p) { return *(const LAS bf16x8*)p; }
__device__ __forceinline__ bf16x8 lds_rd8x2(ldsp_t p0, ldsp_t p1) { const u64_t a = *(const LAS u64_t*)p0, b = *(const LAS u64_t*)p1; u32x4 v = {(unsigned)a, (unsigned)(a >> 32), (unsigned)b, (unsigned)(b >> 32)}; return __builtin_bit_cast(bf16x8, v); }
template <int KIND> struct ChainCfg {
    static constexpr int DK = KIND == 2 ? 128 : 64, DV = KIND == 2 ? 64 : 128, NCW = DV / 16, KSPLIT = 8 / NCW, KS = DK / 32, KT = DK / 16, KSL = KS / KSPLIT, KTL = KT / KSPLIT, NPC = DK / 64;
    static constexpr int RS_T = DK * 2 + 16, RS_F = 144, OFF_KB = 64 * RS_T, OFF_KDT = 128 * RS_T, OFF_SC = OFF_KDT + DK * RS_F, BUFSZ = OFF_SC + 1024;
    static constexpr int OFF_P = 2 * BUFSZ, OFF_N = OFF_P + 64 * 144, OFF_DEN = OFF_N + 256, OFF_V = OFF_DEN + 1280, RS_V = DV * 2 + 16;
    static constexpr int LDS_NEED = OFF_V + (KIND == 2 ? 4 * 16 * 64 * 4 : 2 * 64 * RS_V);
    static constexpr int SCB = KIND == 0 ? 256 : KIND == 1 ? 1024 : 512;
    static_assert(LDS_NEED <= 139264, "chain LDS");
};
#ifndef CPU_TEST
#define LDS_ADDF(p, v) (void)__hip_atomic_fetch_add((p), (v), __ATOMIC_RELAXED, __HIP_MEMORY_SCOPE_WORKGROUP)
#else
#define LDS_ADDF(p, v) (*(p) += (v))
#endif
template <int KIND> __device__ __forceinline__ void chain_run(const Ctx& c, ldsp_t lds, int cid, int tid, bool noload = false, bool nostore = false) {
    typedef ChainCfg<KIND> CF;
    constexpr int DK = CF::DK, DV = CF::DV, NCW = CF::NCW, KS = CF::KS, KSL = CF::KSL, KTL = CF::KTL, NPC = CF::NPC, RS_T = CF::RS_T, RS_F = CF::RS_F;
    const int lane = tid & 63, w = RFL(tid >> 6), cc = lane & 15, g = lane >> 4;
    const int wc = w % NCW, kh = w / NCW;
    const bool outw = kh == 0;
    const int dir = cid % 2, hh = KIND == 2 ? (cid / 2) % 8 : (cid / 2) % 4, b = KIND == 2 ? cid / 16 : cid / 8;
    constexpr bool SHQ = KIND != 0, SHD = KIND == 2;
    const bool mir = dir == 1;
    const size_t opc = KIND == 2 ? (size_t)((b * 2 + hh / 4) * 2 + (SHQ ? 0 : dir)) * NCH : (size_t)(SHQ ? cid - dir : cid) * NCH;
    const size_t opd = KIND == 2 ? opc : (size_t)cid * NCH;
    const size_t vpc = (size_t)cid * NCH;
    const bf16_t* gQA = c.wsb(KIND == 0 ? WS_GQA : KIND == 1 ? WS_MQA : WS_SQA) + opc * (64 * DK);
    const bf16_t* gKB = c.wsb(KIND == 0 ? WS_GKB : KIND == 1 ? WS_MKB : WS_SKB) + opc * (64 * DK);
    const bf16_t* gKDT = c.wsb(KIND == 0 ? WS_GKDT : KIND == 1 ? WS_MKDT : WS_SKDT) + opd * (64 * DK);
    const bf16_t* gVT = c.wsb(WS_SVT) + vpc * (64 * DV);
    const bf16_t* gU = c.u() + (KIND == 0 ? U_GV : U_MV) + hh * 128;
    const bf16_t* gVHT = c.wsb(WS_SVHT) + vpc * (64 * DV);
    const unsigned char* gSC = (const unsigned char*)(KIND == 0 ? c.wsf(WS_GAL) + vpc * 64 : KIND == 1 ? c.wsf(WS_MMS) + vpc * 256 : c.wsf(WS_SCS) + vpc * 128);
    bf16_t* Og = c.odir() + (KIND == 0 ? OF_G : KIND == 1 ? OF_M : OF_S) + (size_t)cid * NCH * (4 * NCW * 256) + (wc * 64 + lane) * 4;
    LAS float* DEN = (LAS float*)(lds + CF::OFF_DEN);
    LAS float* XR = (LAS float*)(lds + CF::OFF_V);

    f32x4 S[KTL];
#pragma unroll
    for (int kt = 0; kt < KTL; ++kt) S[kt] = (f32x4){0.f, 0.f, 0.f, 0.f};
    float m0 = -1e30f;
    if (KIND == 1 && tid < 64) ((LAS float*)(lds + CF::OFF_N))[tid] = 0.f;

    u32x4 sq[NPC], sk[NPC], sd[NPC], ssc = {0u, 0u, 0u, 0u}, sv[2]; bf16x8 vf[2], vh[2], vfn[2], vhn[2];
#define CHAIN_LOAD(n_) do { const size_t cb_ = (size_t)(n_); const int nm_ = (int)cb_ < CTX / 64 ? CTX / 64 - 1 - (int)cb_ : CTX / 64 + NCH - 1 - (int)cb_; const size_t cq_ = (SHQ && mir) ? (size_t)nm_ : cb_, cd_ = (SHD && mir) ? (size_t)nm_ : cb_; \
        _Pragma("unroll") for (int q = 0; q < NPC; ++q) { const int p = tid + 512 * q; sq[q] = *(const u32x4*)(gQA + cq_ * (64 * DK) + p * 8); sk[q] = *(const u32x4*)(gKB + cq_ * (64 * DK) + p * 8); if (KIND == 1) sd[q] = *(const u32x4*)(gKDT + cd_ * (64 * DK) + p * 8); } \
        if (tid < CF::SCB / 16) ssc = *(const u32x4*)(gSC + cb_ * CF::SCB + tid * 16); \
        if (KIND == 2) { _Pragma("unroll") for (int s = 0; s < 2; ++s) { if (outw) vfn[s] = *(const bf16x8*)(gVT + cb_ * (64 * DV) + (16 * wc + cc) * 64 + 32 * s + 8 * g); vhn[s] = *(const bf16x8*)(gVHT + cb_ * (64 * DV) + (16 * wc + cc) * 64 + 32 * s + 8 * g); } } \
        else { _Pragma("unroll") for (int q = 0; q < 2; ++q) { const int p = tid + 512 * q; sv[q] = *(const u32x4*)(gU + (size_t)scan_row(b, dir, 64 * (int)cb_ + p / 16) * INP + (p % 16) * 8); } } } while (0)
#define CHAIN_STAGE(buf_) do { ldsp_t d_ = lds + (buf_) * CF::BUFSZ; \
        _Pragma("unroll") for (int q = 0; q < NPC; ++q) { const int p = tid + 512 * q; const int rt0 = p / (DK / 8), ct = p % (DK / 8), rt = (SHQ && mir) ? 63 - rt0 : rt0; *(LAS u32x4*)(d_ + rt * RS_T + ct * 16) = sq[q]; *(LAS u32x4*)(d_ + CF::OFF_KB + rt * RS_T + ct * 16) = sk[q]; \
            if (KIND == 1) *(LAS u32x4*)(d_ + CF::OFF_KDT + (p / 8) * RS_F + (p % 8) * 16) = sd[q]; } \
        if (tid < CF::SCB / 16) *(LAS u32x4*)(d_ + CF::OFF_SC + tid * 16) = ssc; \
        if (KIND == 2) { vf[0] = vfn[0]; vf[1] = vfn[1]; vh[0] = vhn[0]; vh[1] = vhn[1]; } \
        else { _Pragma("unroll") for (int q = 0; q < 2; ++q) { const int p = tid + 512 * q; *(LAS u32x4*)(lds + CF::OFF_V + (buf_) * (64 * CF::RS_V) + (p / 16) * CF::RS_V + (p % 16) * 16) = sv[q]; } } } while (0)
    CHAIN_LOAD(0); CHAIN_STAGE(0);
    LDS_BAR();

    for (int n = 0; n < NCH; ++n) {
        ldsp_t cur = lds + (n & 1) * CF::BUFSZ;
        const LAS float* SC = (const LAS float*)(cur + CF::OFF_SC);
        if (n + 1 < NCH && !noload) CHAIN_LOAD(n + 1);
#pragma unroll
        for (int tt = 0; tt < 2; ++tt) {
            const int t = 2 * w + tt, jt = t >> 2, it = t & 3;
            f32x4 acc = {0.f, 0.f, 0.f, 0.f};
#pragma unroll
            for (int s = 0; s < KS; ++s) acc = MFMA16(lds_rd16(cur + CF::OFF_KB + (16 * jt + cc) * RS_T + (32 * s + 8 * g) * 2), lds_rd16(cur + (16 * it + cc) * RS_T + (32 * s + 8 * g) * 2), acc);
            const int i = 16 * it + cc, j0 = 16 * jt + 4 * g;
            float pi = 0.f;
            if (KIND == 1) pi = fmaxf(m0, SC[i * 4 + 2]);
            if (KIND == 2) pi = SC[i * 2];
            float pv[4];
#pragma unroll
            for (int r = 0; r < 4; ++r) { const int j = j0 + r; float d = 1.f;
                if (KIND == 1) d = __expf(SC[j * 4 + 1] - pi);
                if (KIND == 2) d = __expf(pi - SC[j * 2]);
                pv[r] = j <= i ? acc[r] * d : 0.f; }
            const unsigned p01 = pk2(pv[0], pv[1]), p23 = pk2(pv[2], pv[3]);
            *(LAS u64_t*)(lds + CF::OFF_P + i * 144 + j0 * 2) = (u64_t)p01 | ((u64_t)p23 << 32);
            if (KIND == 1) {
                float unp[4]; { unsigned t0 = p01 << 16, t1 = p01 & 0xffff0000u, t2 = p23 << 16, t3 = p23 & 0xffff0000u; __builtin_memcpy(&unp[0], &t0, 4); __builtin_memcpy(&unp[1], &t1, 4); __builtin_memcpy(&unp[2], &t2, 4); __builtin_memcpy(&unp[3], &t3, 4); }
                float rs_ = (unp[0] + unp[1]) + (unp[2] + unp[3]);
                rs_ += SHFL_XOR_F(rs_, 16); rs_ += SHFL_XOR_F(rs_, 32);
                if (g == 0) DEN[jt * 64 + i] = jt <= it ? rs_ : 0.f;
            }
        }
        f32x4 ai[4], ap[4];
        {
            bf16x8 sf[KSL];
#pragma unroll
            for (int s = 0; s < KSL; ++s) { u32x4 v = {pk2(S[2 * s][0], S[2 * s][1]), pk2(S[2 * s][2], S[2 * s][3]), pk2(S[2 * s + 1][0], S[2 * s + 1][1]), pk2(S[2 * s + 1][2], S[2 * s + 1][3])}; sf[s] = __builtin_bit_cast(bf16x8, v); }
#pragma unroll
            for (int it = 0; it < 4; ++it) {
                ai[it] = (f32x4){0.f, 0.f, 0.f, 0.f};
#pragma unroll
                for (int s = 0; s < KSL; ++s) { ldsp_t qa = cur + (16 * it + cc) * RS_T + (32 * (kh * KSL + s) + 4 * g) * 2; ai[it] = MFMA16(lds_rd8x2(qa, qa + 32), sf[s], ai[it]); }
            }
            if (KIND == 2 && !outw) {
#pragma unroll
                for (int it = 0; it < 4; ++it) *(LAS f32x4*)(XR + ((wc * 4 + it) * 64 + lane) * 4) = ai[it];
            }
        }
        if (KIND == 1) {
            const int row = tid >> 3, part = tid & 7;
            const bf16x8 qr = lds_rd16(cur + row * RS_T + part * 16);
            const LAS float* n0 = (const LAS float*)(lds + CF::OFF_N) + part * 8;
            float sqn = 0.f;
#pragma unroll
            for (int e = 0; e < 8; ++e) sqn += bf2f((bf16_t)qr[e]) * n0[e];
            sqn += RED1(sqn); sqn += RED2(sqn); sqn += RED4(sqn);
            if (part == 0) DEN[4 * 64 + row] = __expf(m0 - fmaxf(m0, SC[row * 4 + 2])) * sqn;
        }
        LDS_BAR();
        float c0 = 1.f, c1 = 1.f;
        if (KIND == 1) { const float rL = SC[63 * 4 + 2], ML = fmaxf(m0, rL); c0 = __expf(m0 - ML); c1 = __expf(rL - ML); }
        if (KIND == 2) c0 = __expf(SC[63 * 2]);
        if (KIND == 1) {
            const int krow = tid >> 3, part = tid & 7;
            const bf16x8 kr = lds_rd16(cur + CF::OFF_KDT + krow * RS_F + part * 16);
            float s = 0.f;
#pragma unroll
            for (int e = 0; e < 8; ++e) s += bf2f((bf16_t)kr[e]);
            s += RED1(s); s += RED2(s); s += RED4(s);
            if (part == 0) { LAS float* np = (LAS float*)(lds + CF::OFF_N) + krow; *np = c0 * *np + c1 * s; }
        }
        if (KIND != 2) {
            const LAS bf16_t* vi = (const LAS bf16_t*)(lds + CF::OFF_V + (n & 1) * (64 * CF::RS_V)) + 16 * wc + cc;
#pragma unroll
            for (int s = 0; s < 2; ++s) { unsigned pkd[4];
#pragma unroll
                for (int e = 0; e < 4; ++e) { const unsigned lo_ = vi[(32 * s + 8 * g + 2 * e) * (CF::RS_V / 2)], hi_ = vi[(32 * s + 8 * g + 2 * e + 1) * (CF::RS_V / 2)]; pkd[e] = lo_ | (hi_ << 16); }
                const u32x4 pv_ = {pkd[0], pkd[1], pkd[2], pkd[3]}; vf[s] = __builtin_bit_cast(bf16x8, pv_); }
        }
        if (outw) {
#pragma unroll
            for (int it = 0; it < 4; ++it) {
                if (KIND == 2) ai[it] = ai[it] + *(const LAS f32x4*)(XR + ((wc * 4 + it) * 64 + lane) * 4);
                ap[it] = KIND == 0 ? ai[it] : (f32x4){0.f, 0.f, 0.f, 0.f};
#pragma unroll
                for (int s = 0; s < 2; ++s) ap[it] = MFMA16(lds_rd16(lds + CF::OFF_P + (16 * it + cc) * 144 + (32 * s + 8 * g) * 2), vf[s], ap[it]);
            }
#pragma unroll
            for (int it = 0; it < 4; ++it) {
                f32x4 ov;
                const int i0 = 16 * it + 4 * g;
                if (KIND == 1) {
                    const f32x4 d0 = *(const LAS f32x4*)(DEN + i0), d1 = *(const LAS f32x4*)(DEN + 64 + i0), d2 = *(const LAS f32x4*)(DEN + 128 + i0), d3 = *(const LAS f32x4*)(DEN + 192 + i0), d4 = *(const LAS f32x4*)(DEN + 256 + i0);
                    const f32x4 den4 = ((d0 + d1) + (d2 + d3)) + d4;
#pragma unroll
                    for (int r = 0; r < 4; ++r) { const f32x4 sc = *(const LAS f32x4*)(SC + (i0 + r) * 4);
                        const float Mi = fmaxf(m0, sc[2]);
                        ov[r] = (ap[it][r] + __expf(m0 - Mi) * ai[it][r]) * FRCP(fmaxf(fabsf(den4[r]), __expf(-sc[0] - Mi))); }
                } else {
#pragma unroll
                    for (int r = 0; r < 4; ++r) { float o = ap[it][r]; if (KIND == 2) o = o + __expf(SC[(i0 + r) * 2]) * ai[it][r]; ov[r] = o; }
                }
                if (!nostore) *(u64_t*)(Og + (size_t)((n * 4 + it) * NCW) * 256) = (u64_t)pk2(ov[0], ov[1]) | ((u64_t)pk2(ov[2], ov[3]) << 32);
            }
        }
#pragma unroll
        for (int kt = 0; kt < KTL; ++kt) {
            const int ktg = kh * KTL + kt;
            if (KIND == 2) S[kt] = S[kt] * c0;
            f32x4 T = KIND == 1 ? (f32x4){0.f, 0.f, 0.f, 0.f} : S[kt];
#pragma unroll
            for (int s = 0; s < 2; ++s) {
                bf16x8 ka;
                if (KIND == 1) ka = lds_rd16(cur + CF::OFF_KDT + (16 * ktg + cc) * RS_F + (32 * s + 8 * g) * 2);
                else {
                    const LAS bf16_t* kb = (const LAS bf16_t*)(cur + CF::OFF_KB) + 16 * ktg + cc; unsigned pk_[4];
#pragma unroll
                    for (int e = 0; e < 4; ++e) { const unsigned lo_ = kb[(32 * s + 8 * g + 2 * e) * (RS_T / 2)], hi_ = kb[(32 * s + 8 * g + 2 * e + 1) * (RS_T / 2)]; pk_[e] = lo_ | (hi_ << 16); }
                    const u32x4 kv_ = {pk_[0], pk_[1], pk_[2], pk_[3]}; ka = __builtin_bit_cast(bf16x8, kv_); }
                T = MFMA16(ka, KIND == 2 ? vh[s] : vf[s], T);
            }
            S[kt] = KIND == 1 ? S[kt] * c0 + T * c1 : T;
            if (KIND == 0) { const f32x4 al = *(const LAS f32x4*)(SC + 16 * ktg + 4 * g); S[kt] = S[kt] * al; }
            if (kt & 1) CBAR();
        }
        if (KIND == 1) m0 = SC[63 * 4] + fmaxf(m0, SC[63 * 4 + 2]);
        if (n + 1 < NCH) CHAIN_STAGE((n + 1) & 1);
        LDS_BAR();
    }
#undef CHAIN_LOAD
#undef CHAIN_STAGE
}
__device__ __forceinline__ void ph_chain(const Ctx& c, ldsp_t lds, int blk, int G, int tid, int kmask = 7) {
    const bool noload = false, nostore = (kmask & 8) != 0;
    (void)G;
    const int ch = blk;
    if (ch < NB * 8) { if (kmask & 1) chain_run<0>(c, lds, ch, tid, noload, nostore); }
    else if (ch < NB * 16) { if (kmask & 2) chain_run<1>(c, lds, ch - NB * 8, tid, noload, nostore); }
    else if (ch < NB * 32) { if (kmask & 4) chain_run<2>(c, lds, ch - NB * 16, tid, noload, nostore); }
}

constexpr int ROUTE_M_LDS = 16 * 33 * 4;
__device__ __forceinline__ void ph_route_m(const Ctx& c, int l, int nrows, LAS float* wl, int gw, int ngw, int lane) {
    const int rr = lane & 15, g = lane >> 4;
    const bf16_t* T = c.wsb(WS_RWT) + (size_t)l * 2 * NE * D;
    for (int tile = gw; tile < nrows / 16; tile += ngw) {
        const int row = 16 * tile + rr;
        const float* xr = c.x() + (size_t)row * D + 8 * g;
        const float* m = c.mod(l, mod_row(16 * tile));
        const float* gp = c.in[I_N2G] + l * D + 8 * g; const float* shp = m + 3 * D + 8 * g; const float* scp = m + 4 * D + 8 * g;
        float ss = 0.f;
        { const float* sp = c.wsf(WS_SSP) + (size_t)row * 64 + 16 * g;
#pragma unroll
          for (int q = 0; q < 16; q += 4) { if (16 * g + q < (D / 256) * 16) { const f32x4 t = *(const f32x4*)(sp + q); ss += (t[0] + t[1]) + (t[2] + t[3]); } } }
        ss += SHFL_XOR_F(ss, 16); ss += SHFL_XOR_F(ss, 32);
        const float r = 1.0f / sqrtf(ss * (1.0f / D) + EPS);
        f32x4 acc0 = {0.f, 0.f, 0.f, 0.f}, acc1 = {0.f, 0.f, 0.f, 0.f};
        bf16_t* hr = c.h() + (size_t)row * D + 8 * g;
        for (int s2 = 0; s2 < D / 32; s2 += 2) {
            f32x4 xv[2][2], gv[2][2], hv[2][2], cv[2][2]; bf16x8 bh[2][2], bl[2][2];
#pragma unroll
            for (int u = 0; u < 2; ++u) { const int s = s2 + u;
                xv[u][0] = *(const f32x4*)(xr + 32 * s); xv[u][1] = *(const f32x4*)(xr + 32 * s + 4); gv[u][0] = *(const f32x4*)(gp + 32 * s); gv[u][1] = *(const f32x4*)(gp + 32 * s + 4);
                hv[u][0] = *(const f32x4*)(shp + 32 * s); hv[u][1] = *(const f32x4*)(shp + 32 * s + 4); cv[u][0] = *(const f32x4*)(scp + 32 * s); cv[u][1] = *(const f32x4*)(scp + 32 * s + 4);
                bh[u][0] = *(const bf16x8*)(T + (size_t)rr * D + 32 * s + 8 * g); bh[u][1] = *(const bf16x8*)(T + (size_t)(16 + rr) * D + 32 * s + 8 * g);
                bl[u][0] = *(const bf16x8*)(T + (size_t)(NE + rr) * D + 32 * s + 8 * g); bl[u][1] = *(const bf16x8*)(T + (size_t)(NE + 16 + rr) * D + 32 * s + 8 * g); }
#pragma unroll
            for (int u = 0; u < 2; ++u) { const int s = s2 + u;
                const f32x4 v0 = (xv[u][0] * r * gv[u][0]) * (cv[u][0] + 1.0f) + hv[u][0], v1 = (xv[u][1] * r * gv[u][1]) * (cv[u][1] + 1.0f) + hv[u][1];
                const u32x4 hi = {pk2(v0[0], v0[1]), pk2(v0[2], v0[3]), pk2(v1[0], v1[1]), pk2(v1[2], v1[3])};
                *(u32x4*)(hr + 32 * s) = hi;
                float lo[8];
#pragma unroll
                for (int e = 0; e < 4; ++e) { const unsigned wv = hi[e]; float fl, fh; unsigned t = wv << 16; __builtin_memcpy(&fl, &t, 4); t = wv & 0xffff0000u; __builtin_memcpy(&fh, &t, 4);
                    lo[2 * e] = (e < 2 ? v0[2 * e] : v1[2 * e - 4]) - fl; lo[2 * e + 1] = (e < 2 ? v0[2 * e + 1] : v1[2 * e - 3]) - fh; }
                const u32x4 lov = {pk2(lo[0], lo[1]), pk2(lo[2], lo[3]), pk2(lo[4], lo[5]), pk2(lo[6], lo[7])};
                const bf16x8 ahi = __builtin_bit_cast(bf16x8, hi), alo = __builtin_bit_cast(bf16x8, lov);
                acc0 = MFMA16(ahi, bh[u][0], acc0); acc0 = MFMA16(alo, bh[u][0], acc0); acc0 = MFMA16(ahi, bl[u][0], acc0);
                acc1 = MFMA16(ahi, bh[u][1], acc1); acc1 = MFMA16(alo, bh[u][1], acc1); acc1 = MFMA16(ahi, bl[u][1], acc1); }
            CBAR();
        }
#pragma unroll
        for (int q = 0; q < 4; ++q) { wl[(4 * g + q) * 33 + rr] = acc0[q] + c.in[I_RB][l * NE + rr]; wl[(4 * g + q) * 33 + 16 + rr] = acc1[q] + c.in[I_RB][l * NE + 16 + rr]; }
        WAVE_SYNC();
        if (lane < 16) {
            const int orow = 16 * tile + lane;
            float lg[NE];
#pragma unroll
            for (int i = 0; i < NE; ++i) lg[i] = wl[lane * 33 + i];
            int te[TOPK]; float tv[TOPK];
#pragma unroll
            for (int kk = 0; kk < TOPK; ++kk) {
                int best = -1; float bv = 0.f;
#pragma unroll
                for (int i = 0; i < NE; ++i) {
                    bool taken = false;
#pragma unroll
                    for (int j = 0; j < kk; ++j) taken = taken || (te[j] == i);
                    if (!taken && (best < 0 || lg[i] > bv)) { best = i; bv = lg[i]; }
                }
                te[kk] = best; tv[kk] = bv;
            }
            float se = 0.f, ex[TOPK];
#pragma unroll
            for (int kk = 0; kk < TOPK; ++kk) { ex[kk] = expf(tv[kk] - tv[0]); se += ex[kk]; }
#pragma unroll
            for (int kk = 0; kk < TOPK; ++kk) {
                c.tope()[orow * TOPK + kk] = te[kk];
                c.topg()[orow * TOPK + kk] = ex[kk] / se;
                c.pos()[orow * TOPK + kk] = atomicAdd(c.cnt(l) + te[kk] * CNTS, 1);
            }
        }
        WAVE_SYNC();
    }
}

constexpr int ROUTE_B_LDS = (8 * 16 * 32 + 16 * 33) * 4;
#ifndef CPU_TEST
__device__ __forceinline__ int lds_fetch_inc(LAS int* p) { return __hip_atomic_fetch_add(p, 1, __ATOMIC_RELAXED, __HIP_MEMORY_SCOPE_WORKGROUP); }
#else
static inline int lds_fetch_inc(int* p) { const int o = *p; *p = o + 1; return o; }
#endif
static_assert(TOPK == 4 && 4640 * 4 >= ROUTE_B_LDS, "route LDS map");
__device__ __forceinline__ void ph_route_b(const Ctx& c, int l, int nrows, LAS float* bl, int blk, int G, int tid, bool dummy = false) {
    constexpr int SPW = D / 256, BATCH = SPW >= 4 ? 4 : (SPW >= 2 ? 2 : 1);
    const int lane = tid & 63, w = RFL(tid >> 6), rr = lane & 15, g = lane >> 4;
    const bf16_t* T = c.wsb(WS_RWT) + (size_t)l * 2 * NE * D;
    LAS float* part = bl; LAS float* lgs = bl + 8 * 16 * 32;
    LAS int* sel_e = (LAS int*)(bl + 4640); LAS float* sel_v = bl + 4704;
    LAS int* lcnt = (LAS int*)(bl + 4768); LAS int* lbase = lcnt + 32; LAS unsigned* lrec = (LAS unsigned*)(lbase + 32);
    if (tid < 32) lcnt[tid] = 0;
    int nit = 0;
    for (int tile = blk; tile < nrows / 16; tile += G, ++nit) {
        const int row = 16 * tile + rr;
        const float* xr = c.x() + (size_t)row * D + 8 * g;
        const float* m = c.mod(l, mod_row(16 * tile));
        const float* gp = c.in[I_N2G] + l * D + 8 * g; const float* shp = m + 3 * D + 8 * g; const float* scp = m + 4 * D + 8 * g;
        float ss = 0.f;
        { const float* sp = c.wsf(WS_SSP) + (size_t)row * 64 + 16 * g;
#pragma unroll
          for (int q = 0; q < 16; q += 4) { if (16 * g + q < (D / 256) * 16) { const f32x4 t = *(const f32x4*)(sp + q); ss += (t[0] + t[1]) + (t[2] + t[3]); } } }
        ss += SHFL_XOR_F(ss, 16); ss += SHFL_XOR_F(ss, 32);
        const float r = 1.0f / sqrtf(ss * (1.0f / D) + EPS);
        f32x4 acc0 = {0.f, 0.f, 0.f, 0.f}, acc1 = {0.f, 0.f, 0.f, 0.f};
        bf16_t* hr = c.h() + (size_t)row * D + 8 * g;
        for (int s2 = w * SPW; s2 < (w + 1) * SPW; s2 += BATCH) {
            f32x4 xv[BATCH][2], gv[BATCH][2], hv[BATCH][2], cv[BATCH][2]; bf16x8 bh[BATCH][2], bw[BATCH][2];
#pragma unroll
            for (int u = 0; u < BATCH; ++u) { const int s = s2 + u;
                xv[u][0] = *(const f32x4*)(xr + 32 * s); xv[u][1] = *(const f32x4*)(xr + 32 * s + 4); gv[u][0] = *(const f32x4*)(gp + 32 * s); gv[u][1] = *(const f32x4*)(gp + 32 * s + 4);
                hv[u][0] = *(const f32x4*)(shp + 32 * s); hv[u][1] = *(const f32x4*)(shp + 32 * s + 4); cv[u][0] = *(const f32x4*)(scp + 32 * s); cv[u][1] = *(const f32x4*)(scp + 32 * s + 4);
                bh[u][0] = *(const bf16x8*)(T + (size_t)rr * D + 32 * s + 8 * g); bh[u][1] = *(const bf16x8*)(T + (size_t)(16 + rr) * D + 32 * s + 8 * g);
                bw[u][0] = *(const bf16x8*)(T + (size_t)(NE + rr) * D + 32 * s + 8 * g); bw[u][1] = *(const bf16x8*)(T + (size_t)(NE + 16 + rr) * D + 32 * s + 8 * g); }
#pragma unroll
            for (int u = 0; u < BATCH; ++u) { const int s = s2 + u;
                const f32x4 v0 = (xv[u][0] * r * gv[u][0]) * (cv[u][0] + 1.0f) + hv[u][0], v1 = (xv[u][1] * r * gv[u][1]) * (cv[u][1] + 1.0f) + hv[u][1];
                const u32x4 hi = {pk2(v0[0], v0[1]), pk2(v0[2], v0[3]), pk2(v1[0], v1[1]), pk2(v1[2], v1[3])};
                *(u32x4*)(hr + 32 * s) = hi;
                float lo[8];
#pragma unroll
                for (int e = 0; e < 4; ++e) { const unsigned wv = hi[e]; float fl, fh; unsigned t = wv << 16; __builtin_memcpy(&fl, &t, 4); t = wv & 0xffff0000u; __builtin_memcpy(&fh, &t, 4);
                    lo[2 * e] = (e < 2 ? v0[2 * e] : v1[2 * e - 4]) - fl; lo[2 * e + 1] = (e < 2 ? v0[2 * e + 1] : v1[2 * e - 3]) - fh; }
                const u32x4 lov = {pk2(lo[0], lo[1]), pk2(lo[2], lo[3]), pk2(lo[4], lo[5]), pk2(lo[6], lo[7])};
                const bf16x8 ahi = __builtin_bit_cast(bf16x8, hi), alo = __builtin_bit_cast(bf16x8, lov);
                acc0 = MFMA16(ahi, bh[u][0], acc0); acc0 = MFMA16(alo, bh[u][0], acc0); acc0 = MFMA16(ahi, bw[u][0], acc0);
                acc1 = MFMA16(ahi, bh[u][1], acc1); acc1 = MFMA16(alo, bh[u][1], acc1); acc1 = MFMA16(ahi, bw[u][1], acc1); }
        }
#pragma unroll
        for (int q = 0; q < 4; ++q) { part[(w * 16 + 4 * g + q) * 32 + rr] = acc0[q]; part[(w * 16 + 4 * g + q) * 32 + 16 + rr] = acc1[q]; }
        LDS_BAR();
        { const int prow = tid >> 5, e = tid & 31; float s = c.in[I_RB][l * NE + e];
#pragma unroll
          for (int ww = 0; ww < 8; ++ww) s += part[(ww * 16 + prow) * 32 + e];
          lgs[prow * 33 + e] = s;
          LDS_BAR();
          int rank = 0;
#pragma unroll
          for (int j = 0; j < NE; ++j) { const float v = lgs[prow * 33 + j]; rank += (v > s || (v == s && j < e)) ? 1 : 0; }
          if (rank < TOPK) { sel_e[prow * TOPK + rank] = e; sel_v[prow * TOPK + rank] = s; } }
        LDS_BAR();
        if (tid < 16 * TOPK) {
            const int prow = tid >> 2, kk = tid & 3;
            const float v0 = sel_v[prow * TOPK];
            float se = 0.f;
#pragma unroll
            for (int k2 = 0; k2 < TOPK; ++k2) se += expf(sel_v[prow * TOPK + k2] - v0);
            const int te = sel_e[tid];
            c.tope()[64 * tile + tid] = te;
            c.topg()[64 * tile + tid] = expf(sel_v[tid] - v0) / se;
            lrec[nit * 64 + tid] = ((unsigned)te << 16) | (unsigned)lds_fetch_inc(lcnt + te);
        }
    }
    LDS_BAR();
    if (tid < 32) { const int n = lcnt[tid]; lbase[tid] = n ? atomicAdd(c.cnt(l) + (dummy ? DEPTH * NE * CNTS : 0) + tid * CNTS, n) : 0; }
    LDS_BAR();
    for (int i = tid; i < nit * 64; i += 512) { const int tile = blk + (i >> 6) * G; const unsigned rec = lrec[i]; c.pos()[64 * tile + (i & 63)] = lbase[rec >> 16] + (int)(rec & 0xffffu); }
}

__device__ __forceinline__ void ph_gin_tail(const Ctx& c, int l, LAS float* part, int blk, int G, int tid) {
    constexpr int SPW = D / 256;
    const int lane = tid & 63, w = RFL(tid >> 6), rr = lane & 15, g = lane >> 4;
    const bf16_t* W = c.win(l) + (size_t)GIN_CT * D + 32 * (w * SPW) + 8 * g;
    for (int t0 = blk * 4; t0 < NTOK / 16; t0 += G * 4) {
        const bf16_t* A = c.h() + (size_t)(16 * t0 + rr) * D + 32 * (w * SPW) + 8 * g;
        bf16x8 bv[SPW][2], av[4][SPW];
#pragma unroll
        for (int s = 0; s < SPW; ++s) { bv[s][0] = *(const bf16x8*)(W + (size_t)rr * D + 32 * s); bv[s][1] = *(const bf16x8*)(W + (size_t)(16 + rr) * D + 32 * s); }
#pragma unroll
        for (int t = 0; t < 4; ++t)
#pragma unroll
            for (int s = 0; s < SPW; ++s) av[t][s] = *(const bf16x8*)(A + (size_t)(16 * t) * D + 32 * s);
#pragma unroll
        for (int t = 0; t < 4; ++t) {
            f32x4 a0 = {0.f, 0.f, 0.f, 0.f}, a1 = {0.f, 0.f, 0.f, 0.f};
#pragma unroll
            for (int s = 0; s < SPW; ++s) { a0 = MFMA16(av[t][s], bv[s][0], a0); a1 = MFMA16(av[t][s], bv[s][1], a1); }
#pragma unroll
            for (int q = 0; q < 4; ++q) { part[((w * 4 + t) * 16 + 4 * g + q) * 32 + rr] = a0[q]; part[((w * 4 + t) * 16 + 4 * g + q) * 32 + 16 + rr] = a1[q]; }
        }
        LDS_BAR();
        { const int o = tid * 4, t = o >> 9, row = (o >> 5) & 15, col = o & 31;
          f32x4 s = {0.f, 0.f, 0.f, 0.f};
#pragma unroll
          for (int ww = 0; ww < 8; ++ww) s += *(const LAS f32x4*)(part + ((ww * 4 + t) * 16 + row) * 32 + col);
          u32x2 o2; o2.x = pk2(s[0], s[1]); o2.y = pk2(s[2], s[3]);
          *(u32x2*)(c.u() + (size_t)(16 * (t0 + t) + row) * INP + GIN_CT + col) = o2; }
        LDS_BAR();
    }
}

__host__ __device__ __forceinline__ f32x4 silu4(f32x4 x) { return (f32x4){siluf_(x[0]), siluf_(x[1]), siluf_(x[2]), siluf_(x[3])}; }
__host__ __device__ __forceinline__ f32x4 exp4(f32x4 x) { return (f32x4){FEXP(x[0]), FEXP(x[1]), FEXP(x[2]), FEXP(x[3])}; }
__host__ __device__ __forceinline__ f32x4 logsig4(f32x4 x) { return (f32x4){logsigmoidf_(x[0]), logsigmoidf_(x[1]), logsigmoidf_(x[2]), logsigmoidf_(x[3])}; }
__host__ __device__ __forceinline__ f32x4 min4(f32x4 x, float m) { return (f32x4){fminf(x[0], m), fminf(x[1], m), fminf(x[2], m), fminf(x[3], m)}; }
__host__ __device__ __forceinline__ u64_t pk4(f32x4 v) { return (u64_t)pk2(v[0], v[1]) | ((u64_t)pk2(v[2], v[3]) << 32); }
__host__ __device__ __forceinline__ f32x4 tap4_at(const bf16_t* U, const SegC& s, int dir, int q, int ucol, bool colmajor) {
    const bool ok = q >= 0 && q < s.len; const int qc = q < 0 ? 0 : (q >= s.len ? s.len - 1 : q);
    const int r = seg_row(s, dir, qc);
    const f32x4 v = ldb4(U + (size_t)(colmajor ? tokrow_of_srow(r) : r) * INP + ucol);
    return ok ? v : (f32x4){0.f, 0.f, 0.f, 0.f};
}
__host__ __device__ __forceinline__ void store_t8(bf16_t* base, int t0, const f32x4 (&x)[8]) {
#pragma unroll
    for (int cc = 0; cc < 4; ++cc) *(u32x4*)(base + cc * 64 + t0) = (u32x4){pk2(x[0][cc], x[1][cc]), pk2(x[2][cc], x[3][cc]), pk2(x[4][cc], x[5][cc]), pk2(x[6][cc], x[7][cc])};
}
__host__ __device__ __forceinline__ u64_t tapraw4_at(const bf16_t* U, const SegC& s, int dir, int q, int ucol, bool colmajor) {
    const int qc = q < 0 ? 0 : (q >= s.len ? s.len - 1 : q); const int r = seg_row(s, dir, qc);
    return *(const u64_t*)(U + (size_t)(colmajor ? tokrow_of_srow(r) : r) * INP + ucol);
}
__host__ __device__ __forceinline__ bf16_t tapraw1_at(const bf16_t* U, const SegC& s, int dir, int q, int ucol, bool colmajor) {
    const int qc = q < 0 ? 0 : (q >= s.len ? s.len - 1 : q); const int r = seg_row(s, dir, qc);
    return U[(size_t)(colmajor ? tokrow_of_srow(r) : r) * INP + ucol];
}
__host__ __device__ __forceinline__ f32x4 tapcvt4(u64_t raw, const SegC& s, int q) { return (q >= 0 && q < s.len) ? cvtb4(raw) : (f32x4){0.f, 0.f, 0.f, 0.f}; }
__host__ __device__ __forceinline__ void ph_prep4(const Ctx& c, int l, int gt, int gs, int sel = 31) {
    const bf16_t* U = c.u();
    const int rot = (int)CH_G * 16;
    const int gt1 = gt, gt2 = (gt + gs - rot % gs) % gs, gt3 = (gt + gs - (3 * rot) % gs) % gs, gt4 = (gt + gs - (5 * rot) % gs) % gs;
    if (sel & 1) for (int it = gt1; it < (int)CH_G * 16; it += gs) {
        const int k = 4 * (it % 16), hh = (it / 16) % 4, n = (it / 64) % NCH, dir = (it / (64 * NCH)) % 2, b = it / (128 * NCH), cid = (b * 4 + hh) * 2 + dir;
        const SegC sg = seg_of_chunk(b, n);
        const int row0 = seg_row(sg, dir, sg.q0), rs = dir == 0 ? 1 : -1;
        const f32x4 bg = *(const f32x4*)(c.in[I_GBG] + (l * 2 + dir) * 256 + hh * 64 + k);
        const size_t cb = ((size_t)cid * NCH + n);
        bf16_t* QA = c.wsb(WS_GQA) + cb * 4096 + k; bf16_t* KB = c.wsb(WS_GKB) + cb * 4096 + k; bf16_t* KDT = c.wsb(WS_GKDT) + cb * 4096 + k * 64;
        const bf16_t* uq = U + (size_t)row0 * INP + U_GQ + hh * 64 + k; const bf16_t* uk = U + (size_t)row0 * INP + U_GK + hh * 64 + k; const bf16_t* ug = U + (size_t)row0 * INP + U_GGK + dir * 256 + hh * 64 + k;
        f32x4 crun = {0.f, 0.f, 0.f, 0.f};
        u64_t nq[8], nk[8], ng[8];
#pragma unroll
        for (int e = 0; e < 8; ++e) { nq[e] = *(const u64_t*)(uq + (long)rs * e * INP); nk[e] = *(const u64_t*)(uk + (long)rs * e * INP); ng[e] = *(const u64_t*)(ug + (long)rs * e * INP); }
        for (int i0 = 0; i0 < 64; i0 += 8) { const int nb = i0 + 8 < 64 ? i0 + 8 : i0;
            u64_t cq[8], ck[8], cg[8]; f32x4 kd[8];
#pragma unroll
            for (int e = 0; e < 8; ++e) { cq[e] = nq[e]; ck[e] = nk[e]; cg[e] = ng[e]; }
#pragma unroll
            for (int e = 0; e < 8; ++e) { nq[e] = *(const u64_t*)(uq + (long)rs * (nb + e) * INP); nk[e] = *(const u64_t*)(uk + (long)rs * (nb + e) * INP); ng[e] = *(const u64_t*)(ug + (long)rs * (nb + e) * INP); }
            CBAR();
#pragma unroll
            for (int e = 0; e < 8; ++e) { crun = crun + logsig4(cvtb4(cg[e]) + bg) * (1.0f / 16.0f);
                kd[e] = cvtb4(ck[e]) * exp4(min4(-crun, 60.f));
                *(u64_t*)(QA + (i0 + e) * 64) = pk4(cvtb4(cq[e]) * 0.125f * exp4(crun)); *(u64_t*)(KB + (i0 + e) * 64) = pk4(kd[e]); }
        }
        *(f32x4*)(c.wsf(WS_GAL) + cb * 64 + k) = exp4(crun);
    }
    if (sel & 4) for (int it = gt2; it < (int)CH_G * 32; it += gs) {
        const int k = 4 * (it % 16), hh = (it / 16) % 4, which = (it / 64) % 2, n = (it / 128) % NCH, dir = (it / (128 * NCH)) % 2, b = it / (256 * NCH), cid = (b * 4 + hh) * 2 + dir;
        if (which == 0 && dir == 1) continue;
        const SegC sg = seg_of_chunk(b, n);
        const int row0 = seg_row(sg, dir, sg.q0), rs = dir == 0 ? 1 : -1;
        const float bi = c.in[I_MBI][l * 8 + dir * 4 + hh], bf = c.in[I_MBF][l * 8 + dir * 4 + hh];
        const bf16_t* MG = U + (size_t)row0 * INP + U_MG + dir * 4 + hh;
        const size_t cb = ((size_t)cid * NCH + n);
        float rmaxL = 0.f;
        if (which == 1) {
            float F = 0.f, rmax = -1e30f; float* MS = c.wsf(WS_MMS) + cb * 256;
            for (int i0 = 0; i0 < 64; i0 += 16) { float ig[16], lf[16];
#pragma unroll
                for (int e = 0; e < 16; ++e) { ig[e] = bf2f(MG[(long)rs * (i0 + e) * INP]); lf[e] = bf2f(MG[(long)rs * (i0 + e) * INP + 8]); }
#pragma unroll
                for (int e = 0; e < 16; ++e) { F += logsigmoidf_(lf[e] + bf); const float bjv = ig[e] + bi - F; rmax = fmaxf(rmax, bjv); if (k == 0) *(f32x4*)(MS + (i0 + e) * 4) = (f32x4){F, bjv, rmax, 0.f}; } }
            rmaxL = rmax;
        }
        bf16_t* OT = c.wsb(which == 0 ? WS_MQA : WS_MKB) + cb * 4096 + k; bf16_t* KDT = c.wsb(WS_MKDT) + cb * 4096 + k * 64;
        const int cch = which * 256 + hh * 64 + k;
        f32x4 w[7];
#pragma unroll
        for (int j = 0; j < 7; ++j) w[j] = *(const f32x4*)(c.in[I_MCW] + ((size_t)l * 7 + (dir == 0 ? j : 6 - j)) * 512 + cch);
        const f32x4 bc = *(const f32x4*)(c.in[I_MCB] + l * 512 + cch);
        f32x4 win[14];
#pragma unroll
        for (int t = 0; t < 6; ++t) win[t] = tap4_at(U, sg, dir, sg.q0 + t - 3, U_MQK + cch, false);
        float F = 0.f;
        u64_t nt[8]; bf16_t ni[8], nf[8];
#pragma unroll
        for (int e = 0; e < 8; ++e) { nt[e] = tapraw4_at(U, sg, dir, sg.q0 + e + 3, U_MQK + cch, false); ni[e] = MG[(long)rs * e * INP]; nf[e] = MG[(long)rs * e * INP + 8]; }
        for (int i0 = 0; i0 < 64; i0 += 8) { const int nb = i0 + 8 < 64 ? i0 + 8 : i0; f32x4 kd[8]; float ig[8], lf[8];
#pragma unroll
            for (int e = 0; e < 8; ++e) { win[6 + e] = tapcvt4(nt[e], sg, sg.q0 + i0 + e + 3); ig[e] = bf2f(ni[e]); lf[e] = bf2f(nf[e]); }
#pragma unroll
            for (int e = 0; e < 8; ++e) { nt[e] = tapraw4_at(U, sg, dir, sg.q0 + nb + e + 3, U_MQK + cch, false); ni[e] = MG[(long)rs * (nb + e) * INP]; nf[e] = MG[(long)rs * (nb + e) * INP + 8]; }
            CBAR();
#pragma unroll
            for (int e = 0; e < 8; ++e) { f32x4 a = bc;
#pragma unroll
                for (int j = 0; j < 7; ++j) a = a + w[j] * win[e + j];
                f32x4 v = silu4(a); if (which == 1) v = v * 0.125f;
                F += logsigmoidf_(lf[e] + bf);
                if (dir == 0) *(u64_t*)(OT + (i0 + e) * 64) = pk4(v);
                kd[e] = v * FEXP(ig[e] + bi - F - rmaxL); }
            if (which == 1) store_t8(KDT, i0, kd);
#pragma unroll
            for (int t = 0; t < 6; ++t) win[t] = win[t + 8]; }
    }
    if (sel & 8) for (int it = gt3; it < (int)CH_SG * 32; it += gs) {
        const int s = 4 * (it % 32), g = (it / 32) % 2, which = (it / 64) % 2, n = (it / 128) % NCH, dir = 0, b = it / (128 * NCH), gid = (b * 2 + g) * 2 + dir;
        const SegC sg = seg_of_chunk(b, n);
        const size_t cb = ((size_t)gid * NCH + n);
        bf16_t* OT = c.wsb(which == 0 ? WS_SKB : WS_SQA) + cb * 8192 + s; bf16_t* KDT = c.wsb(WS_SKDT) + cb * 8192 + s * 64;
        const int cch = 512 + which * 256 + g * 128 + s;
        f32x4 w[7];
#pragma unroll
        for (int j = 0; j < 7; ++j) w[j] = *(const f32x4*)(c.in[I_2CW] + ((size_t)l * 7 + (dir == 0 ? j : 6 - j)) * 1024 + cch);
        const f32x4 bc = *(const f32x4*)(c.in[I_2CB] + l * 1024 + cch);
        f32x4 win[14];
#pragma unroll
        for (int t = 0; t < 6; ++t) win[t] = tap4_at(U, sg, dir, sg.q0 + t - 3, U_XBC + cch, true);
        u64_t nt[8];
#pragma unroll
        for (int e = 0; e < 8; ++e) nt[e] = tapraw4_at(U, sg, dir, sg.q0 + e + 3, U_XBC + cch, true);
        for (int i0 = 0; i0 < 64; i0 += 8) { const int nb = i0 + 8 < 64 ? i0 + 8 : i0; f32x4 v[8];
#pragma unroll
            for (int e = 0; e < 8; ++e) win[6 + e] = tapcvt4(nt[e], sg, sg.q0 + i0 + e + 3);
#pragma unroll
            for (int e = 0; e < 8; ++e) nt[e] = tapraw4_at(U, sg, dir, sg.q0 + nb + e + 3, U_XBC + cch, true);
            CBAR();
#pragma unroll
            for (int e = 0; e < 8; ++e) { f32x4 a = bc;
#pragma unroll
                for (int j = 0; j < 7; ++j) a = a + w[j] * win[e + j];
                v[e] = silu4(a); *(u64_t*)(OT + (i0 + e) * 128) = pk4(v[e]); }
#pragma unroll
            for (int t = 0; t < 6; ++t) win[t] = win[t + 8]; }
    }
    if (sel & 16) for (int it = gt4; it < (int)CH_S * 16; it += gs) {
        const int p = 4 * (it % 16), hh = (it / 16) % 8, n = (it / 128) % NCH, dir = (it / (128 * NCH)) % 2, b = it / (256 * NCH), cid = (b * 8 + hh) * 2 + dir;
        const SegC sg = seg_of_chunk(b, n);
        const float Ah = -expf(c.in[I_2AL][l * 16 + dir * 8 + hh]), dtb = c.in[I_2DTB][l * 16 + dir * 8 + hh];
        const int cdt = U_DT + dir * 8 + hh;
        float cumL = 0.f;
        for (int i0 = 0; i0 < 64; i0 += 16) { float t[16];
#pragma unroll
            for (int e = 0; e < 16; ++e) t[e] = tap_at(U, sg, dir, sg.q0 + i0 + e, cdt, true);
#pragma unroll
            for (int e = 0; e < 16; ++e) cumL += softplusf_(t[e] + dtb) * Ah; }
        const size_t cb = ((size_t)cid * NCH + n);
        bf16_t* VT = c.wsb(WS_SVT) + cb * 4096 + p * 64; bf16_t* VHT = c.wsb(WS_SVHT) + cb * 4096 + p * 64; float* CS = c.wsf(WS_SCS) + cb * 128;
        const int cx = hh * 64 + p;
        f32x4 wx[7];
#pragma unroll
        for (int j = 0; j < 7; ++j) wx[j] = *(const f32x4*)(c.in[I_2CW] + ((size_t)l * 7 + (dir == 0 ? j : 6 - j)) * 1024 + cx);
        const f32x4 bx = *(const f32x4*)(c.in[I_2CB] + l * 1024 + cx);
        f32x4 win[14];
#pragma unroll
        for (int t = 0; t < 6; ++t) win[t] = tap4_at(U, sg, dir, sg.q0 + t - 3, U_XBC + cx, true);
        float crun = 0.f;
        u64_t nt[8]; bf16_t nd[8];
#pragma unroll
        for (int e = 0; e < 8; ++e) { nt[e] = tapraw4_at(U, sg, dir, sg.q0 + e + 3, U_XBC + cx, true); nd[e] = tapraw1_at(U, sg, dir, sg.q0 + e, cdt, true); }
        for (int i0 = 0; i0 < 64; i0 += 8) { const int nb = i0 + 8 < 64 ? i0 + 8 : i0; float dv[8]; f32x4 a[8], h[8];
#pragma unroll
            for (int e = 0; e < 8; ++e) { win[6 + e] = tapcvt4(nt[e], sg, sg.q0 + i0 + e + 3); dv[e] = bf2f(nd[e]); }
#pragma unroll
            for (int e = 0; e < 8; ++e) { nt[e] = tapraw4_at(U, sg, dir, sg.q0 + nb + e + 3, U_XBC + cx, true); nd[e] = tapraw1_at(U, sg, dir, sg.q0 + nb + e, cdt, true); }
            CBAR();
#pragma unroll
            for (int e = 0; e < 8; ++e) { f32x4 ax = bx;
#pragma unroll
                for (int j = 0; j < 7; ++j) ax = ax + wx[j] * win[e + j];
                const f32x4 xs = silu4(ax); const float dtv = softplusf_(dv[e] + dtb);
                crun += dtv * Ah; a[e] = xs * dtv; h[e] = a[e] * FEXP(cumL - crun);
                if (dir == 0) *(u64_t*)(c.xbc() + (size_t)seg_row(sg, 0, sg.q0 + i0 + e) * 512 + cx) = pk4(xs);
                if (p == 0) { CS[(i0 + e) * 2] = crun; CS[(i0 + e) * 2 + 1] = dtv; } }
            store_t8(VT, i0, a); store_t8(VHT, i0, h);
#pragma unroll
            for (int t = 0; t < 6; ++t) win[t] = win[t + 8]; }
    }
}

constexpr int NPH = 11, NSTEPS = 1 + DEPTH * NPH;
enum { PH_NORM1 = 0, PH_GIN, PH_PREP, PH_SCAN, PH_FIN, PH_GOUT, PH_ROUTE, PH_SCAT, PH_G1, PH_G2, PH_COMB };
constexpr int IT_IN = (D / 64) * (INW / 32), IT_OUT = (MIXW / 64) * (D / 32), IT_GU = (D / 64) * (2 * D / 32), IT_DN = (D / 64) * (D / 32);

#ifndef CPU_TEST
constexpr int LDS_BYTES = 147456, LDS_CTL = 139264;
#define LDS_WAIT() asm volatile("s_waitcnt lgkmcnt(0)" ::: "memory")
typedef __attribute__((address_space(1))) u32x4 g_u32x4;

struct TItem { const float* W; bf16_t* WT; int K, N, mode, item; };
constexpr int IT_DENSE = IT_IN + IT_OUT, IT_MOE = NE * (IT_GU + IT_DN);
__device__ __forceinline__ TItem titem_of(const Ctx& c, int layer, int it) {
    TItem t;
    if (layer < 0) { const int l = it / IT_DENSE; int r = it % IT_DENSE;
        if (r < IT_IN) { t.W = c.in[I_WIN] + (size_t)l * D * INW; t.K = D; t.N = INW; t.WT = c.win(l); t.mode = 0; t.item = r; return t; } r -= IT_IN;
        t.W = c.in[I_WOUT] + (size_t)l * MIXW * D; t.K = MIXW; t.N = D; t.WT = c.wout(l); t.mode = 0; t.item = r; return t; }
    const int l = layer, e = it / (IT_GU + IT_DN); int r = it % (IT_GU + IT_DN);
    if (r < IT_GU) { t.W = c.in[I_WGU] + ((size_t)l * NE + e) * D * 2 * D; t.K = D; t.N = 2 * D; t.WT = c.wgu(l) + (size_t)e * 2 * D * D; t.mode = 1; t.item = r; }
    else { t.W = c.in[I_WDN] + ((size_t)l * NE + e) * D * D; t.K = D; t.N = D; t.WT = c.wdn(l) + (size_t)e * D * D; t.mode = 0; t.item = r - IT_GU; }
    return t;
}
__device__ __forceinline__ void titem_load(const TItem& t, float (&v)[32], int lane) {
    const int nblk = t.N / 32, kb = t.item / nblk, nb = t.item % nblk;
    const float* src = t.W + (size_t)(64 * kb + (lane >> 5)) * t.N + 32 * nb + (lane & 31);
#pragma unroll
    for (int i = 0; i < 32; ++i) v[i] = __builtin_nontemporal_load(src + (size_t)(2 * i) * t.N);
}
__device__ __forceinline__ void titem_store(const TItem& t, const float (&v)[32], LAS float* scr, int lane) {
    const int nblk = t.N / 32, kb = t.item / nblk, nb = t.item % nblk, k0 = 64 * kb, n0 = 32 * nb;
#pragma unroll
    for (int i = 0; i < 32; ++i) scr[(2 * i + (lane >> 5)) * 33 + (lane & 31)] = v[i];
    LDS_WAIT(); asm volatile("" ::: "memory");
    const int c = lane & 7;
    const int r0 = t.mode ? gu_row_of_col(n0) : n0;
#pragma unroll
    for (int j = 0; j < 4; ++j) { const int n = (lane >> 3) + 8 * j; const LAS float* s = scr + (8 * c) * 33 + n;
        u32x4 o; o.x = pk2(s[0 * 33], s[1 * 33]); o.y = pk2(s[2 * 33], s[3 * 33]); o.z = pk2(s[4 * 33], s[5 * 33]); o.w = pk2(s[6 * 33], s[7 * 33]);
        __builtin_nontemporal_store(o, (u32x4*)(t.WT + (size_t)(r0 + n) * t.K + k0 + 8 * c)); }
    LDS_WAIT(); asm volatile("" ::: "memory");
}
__device__ __forceinline__ void ph_transposes(const Ctx& c, LAS unsigned char* lds, int layer, int gw, int ngw, int wave, int lane) {
    LAS float* scr = (LAS float*)(lds + wave * 16384);
    const int nit = layer < 0 ? DEPTH * IT_DENSE : IT_MOE;
    int it = gw;
    if (it >= nit) return;
    TItem cur = titem_of(c, layer, it); float va[32], vb[32];
    titem_load(cur, va, lane);
    for (;;) {
        const int nx = it + ngw; const bool more = nx < nit;
        TItem nxt = cur;
        if (more) { nxt = titem_of(c, layer, nx); titem_load(nxt, vb, lane); }
        titem_store(cur, va, scr, lane);
        if (!more) break;
#pragma unroll
        for (int i = 0; i < 32; ++i) va[i] = vb[i];
        cur = nxt; it = nx;
    }
}

#define FRESH() Ctx c; { const KAS Args* kp_ = (const KAS Args*)__builtin_amdgcn_kernarg_segment_ptr(); asm volatile("" : "+s"(kp_)); c.in = kp_->in; c.out = kp_->out; c.ws = kp_->ws; } \
    int lane; asm volatile("v_mbcnt_lo_u32_b32 %0, -1, 0\n\tv_mbcnt_hi_u32_b32 %0, -1, %0" : "=v"(lane)); const int wave = wave_s, tid = wave * 64 + lane, gt = blk * 512 + tid, gs = G * 512; (void)gt; (void)gs;
__global__ void __launch_bounds__(512, 2) mega_fwd(Args args) {
    extern __shared__ __attribute__((aligned(16))) unsigned char lds_raw[];
    LAS unsigned char* lds = (LAS unsigned char*)lds_raw;
    const int G = gridDim.x, blk = blockIdx.x;
    const int wave_s = __builtin_amdgcn_readfirstlane((int)threadIdx.x >> 6);
    const int lo = args.lo, hi = args.hi;
    for (int u = threadIdx.x; u < (LDS_BYTES - LDS_CTL) / 4; u += 512) ((LAS unsigned*)(lds + LDS_CTL))[u] = 0u;
    __syncthreads();
    volatile LAS unsigned* xbw = (volatile LAS unsigned*)(lds + LDS_CTL + 1024);
    unsigned* barw = (unsigned*)(args.ws + WS_CTL) + CW_BAR + args.li * XCD_BAR_WORDS;
    XcdBarrier bar; bar.bar = barw; bar.x = 0; bar.st = xbw;
    if (hi - lo > 1) bar = xcd_barrier_post(barw, xbw);
    LAS int* tb = (LAS int*)(lds + LDS_CTL + 2048);
    static_assert(2048 + TB_WORDS * 4 <= 4096 && 4096 + NE * 4 <= LDS_BYTES - LDS_CTL, "LDS control region");
#ifndef PHASE_MASK
#define PHASE_MASK 0xFFFFu
#endif
#define EN(p) (((PHASE_MASK) >> (p)) & 1u)
#ifndef DUP_MASK
#define DUP_MASK 0u
#endif
#define DUP(p) (((DUP_MASK) >> (p)) & 1u)
#define IN(s) (lo <= (s) && (s) < hi)
#define SEAM(s) do { if (IN(s) && IN((s) + 1)) xcd_barrier(bar); } while (0)

    if (EN(12) && IN(0)) {
        FRESH();
        const int psel = (hi == 1) ? args.pad : 15;
        if (psel & 1) ph_transposes(c, lds, -1, blk * 8 + wave, G * 8, wave, lane);
        __syncthreads();
        if (psel & 2) ph_mod_w(c, (LAS float*)lds, tid, blk, G);
        if (psel & 8) { ph_foldgate(c, gt, gs); ph_rwsplit(c, gt, gs); }
    }
    SEAM(0);
    for (int l = 0; l < DEPTH; ++l) {
        const int s0 = 1 + l * NPH;
        const bool last = (l == DEPTH - 1);
        const int nrows = last ? NLAT : NTOK;
        if (l == 0) {
            if (EN(PH_NORM1) && IN(s0 + PH_NORM1)) { FRESH(); ph_norm1_w(c, l, blk * 8 + wave, G * 8, lane); }
            SEAM(s0 + PH_NORM1);
        }
        if (EN(PH_GIN) && IN(s0 + PH_GIN)) {
            FRESH();
            { pg8::Gemm g{c.h(), c.win(l), NTOK, GIN_N1, D}; DenseOrder S; S.init(NTOK, GIN_N1, G, blk);
              EpiU E{c.u(), INP};
              pg8::gemm_phase<EpiU, DenseOrder, true, true>(lds, g, S, E, tid); }
            __syncthreads();
            { pg8::Gemm g{c.h(), c.win(l) + (size_t)GIN_C2 * D, NTOK, GIN_N2, D}; DenseOrder S; S.init(NTOK, GIN_N2, G, (blk + G / 2) % G);
              EpiU E{c.u() + GIN_C2, INP};
              pg8::gemm_phase<EpiU, DenseOrder, true, true>(lds, g, S, E, tid); }
            __syncthreads();
            ph_gin_tail(c, l, (LAS float*)lds, blk, G, tid);
        }
        SEAM(s0 + PH_GIN);
        if (EN(PH_PREP) && IN(s0 + PH_PREP)) { FRESH(); ph_prep4(c, l, gt, gs, (args.li > 0 && s0 + PH_PREP == lo) ? args.pad : 31); }
        SEAM(s0 + PH_PREP);
        if (EN(PH_SCAN) && IN(s0 + PH_SCAN)) { FRESH(); ph_chain(c, lds, blk, G, tid, (hi == s0 + PH_SCAN + 1 && args.pad >= 64) ? (args.pad & 15) : 7); }
        SEAM(s0 + PH_SCAN);
        if (EN(PH_FIN) && IN(s0 + PH_FIN)) { FRESH(); ph_finish_w(c, l, nrows, blk * 8 + wave, G * 8, lane); if (DUP(PH_FIN)) ph_finish_w(c, l, nrows, blk * 8 + wave, G * 8, lane); }
        SEAM(s0 + PH_FIN);
        if (EN(PH_GOUT) && IN(s0 + PH_GOUT)) {
            FRESH();
            pg8::Gemm g{c.y(), c.wout(l), nrows, D, MIXW}; DenseOrder S; S.init(nrows, D, G, blk);
            EpiResid E{c.x(), c.mod(l, 0), c.wsf(WS_SSP)};
            pg8::gemm_phase<EpiResid, DenseOrder, true, true>(lds, g, S, E, tid);
        }
        SEAM(s0 + PH_GOUT);
        if (EN(PH_ROUTE) && IN(s0 + PH_ROUTE)) { FRESH(); if (DUP(PH_ROUTE)) { ph_route_b(c, l, nrows, (LAS float*)lds, blk, G, tid, true); __syncthreads(); } ph_route_b(c, l, nrows, (LAS float*)lds, blk, G, tid); }
        SEAM(s0 + PH_ROUTE);
        if (IN(s0 + PH_SCAT) || IN(s0 + PH_G1) || IN(s0 + PH_G2)) {
            FRESH();
            LAS int* ntl = (LAS int*)(lds + LDS_CTL + 4096);
            if (tid < NE) ntl[tid] = (c.cnt(l)[tid * CNTS] + 255) / 256;
            __syncthreads();
            if (tid < NE) { int a = 0; for (int e = 0; e < NE; ++e) a += (e < tid) ? ntl[e] : 0; tb[tid] = a; const int nt = ntl[tid]; for (int t = 0; t < nt; ++t) tb[NE + 1 + a + t] = tid; if (tid == NE - 1) tb[NE] = a + nt; }
            __syncthreads();
        }
        if (EN(PH_SCAT) && IN(s0 + PH_SCAT)) { FRESH(); ph_rowtok_w(c, l, nrows, (const LAS int*)tb, gt, gs); ph_transposes(c, lds, l, blk * 8 + wave, G * 8, wave, lane); }
        SEAM(s0 + PH_SCAT);
        if (EN(PH_G1) && IN(s0 + PH_G1)) {
            FRESH();
            LAS unsigned short* gtab = (LAS unsigned short*)(lds + 131072);
            MoeOrderG<const LAS int*, const LAS unsigned short*> S(tb, 2 * D / 256, G, blk, gtab, c.rtok());
            { pg8::Unit uu; const int* rt_ = c.rtok(); for (int i = 0; i < 16 && S.next(i, uu); ++i) if ((i & 7) == wave) {
                  const int* rp = rt_ + uu.pm * 256 + lane; const int v0 = rp[0], v1 = rp[64], v2 = rp[128], v3 = rp[192];
                  LAS unsigned short* gp = gtab + i * 256 + lane; gp[0] = (unsigned short)v0; gp[64] = (unsigned short)v1; gp[128] = (unsigned short)v2; gp[192] = (unsigned short)v3; } }
            __syncthreads();
            pg8::Gemm g{c.h(), c.wgu(l), NTOK, NE * 2 * D, D};
            EpiSwiglu E{c.act(), c.in[I_BGU] + (size_t)l * NE * 2 * D};
            pg8::gemm_phase<EpiSwiglu, MoeOrderG<const LAS int*, const LAS unsigned short*>, true, true>(lds, g, S, E, tid);
        }
        SEAM(s0 + PH_G1);
        if (EN(PH_G2) && IN(s0 + PH_G2)) {
            FRESH();
            pg8::Gemm g{c.act(), c.wdn(l), MAXROWS, NE * D, D}; MoeOrder<const LAS int*> S{tb, D / 256, G, blk, 8, 0};
            EpiDown E{c.yb(), c.in[I_BDN] + (size_t)l * NE * D};
            pg8::gemm_phase<EpiDown, MoeOrder<const LAS int*>, true, true>(lds, g, S, E, tid);
            if (DUP(PH_G2)) pg8::gemm_phase<EpiDown, MoeOrder<const LAS int*>, true, true>(lds, g, S, E, tid);
        }
        SEAM(s0 + PH_G2);
        if (EN(PH_COMB) && IN(s0 + PH_COMB)) { FRESH(); if (DUP(PH_COMB) && l < DEPTH - 1) ph_combine_w(c, l, nrows, blk * 8 + wave, G * 8, lane, true); ph_combine_w(c, l, nrows, blk * 8 + wave, G * 8, lane); }
        SEAM(s0 + PH_COMB);
    }
#undef IN
#undef SEAM
}

#ifndef MK_MULTI
#define MK_MULTI 0
#endif
extern "C" void kernel_launch(void* const* d_in, const int* in_sizes, int n_in, void* d_out, int out_size, void* d_ws, size_t ws_size, hipStream_t stream) {
    static int grid = 0;
    if (grid == 0) {
        if (n_in != N_IN || out_size != NLAT * D || ws_size < WS_END) { fprintf(stderr, "kernel_launch: unexpected shapes (n_in %d out %d ws %zu need %zu)\n", n_in, out_size, ws_size, (size_t)WS_END); grid = -1; return; }
        int dev = 0, cus = 0;
        if (hipGetDevice(&dev) != hipSuccess || hipDeviceGetAttribute(&cus, hipDeviceAttributeMultiprocessorCount, dev) != hipSuccess) { grid = -1; return; }
        if (hipFuncSetAttribute((const void*)mega_fwd, hipFuncAttributeMaxDynamicSharedMemorySize, LDS_BYTES) != hipSuccess) { fprintf(stderr, "kernel_launch: hipFuncSetAttribute failed\n"); grid = -1; return; }
        int per_cu = 0;
        (void)hipOccupancyMaxActiveBlocksPerMultiprocessor(&per_cu, (const void*)mega_fwd, 512, LDS_BYTES);
        (void)hipGetLastError();
        grid = cus;
        if (grid < NB * 32) { fprintf(stderr, "kernel_launch: needs at least %d CUs (one scan chain per workgroup), device has %d\n", NB * 32, cus); grid = -1; return; }
    }
    if (grid < 0) return;
    (void)hipMemsetAsync((char*)d_ws + WS_CTL, 0, CTL_BYTES, stream);
    Args a{};
    for (int i = 0; i < N_IN; ++i) a.in[i] = (const float*)d_in[i];
    a.out = (float*)d_out; a.ws = (unsigned char*)d_ws;
#if MK_MULTI
    for (int s = 0; s < NSTEPS; ++s) { a.lo = s; a.hi = s + 1; hipLaunchKernelGGL(mega_fwd, dim3(grid), dim3(512), LDS_BYTES, stream, a); }
#elif defined(PROBE_PRO)
    a.lo = 0; a.hi = 1; a.li = 0; a.pad = PROBE_PRO; hipLaunchKernelGGL(mega_fwd, dim3(grid), dim3(512), LDS_BYTES, stream, a);
    a.lo = 0; a.hi = NSTEPS; a.li = 1; a.pad = 0; hipLaunchKernelGGL(mega_fwd, dim3(grid), dim3(512), LDS_BYTES, stream, a);
#elif defined(PROBE_PH)
    { int lo = 0; for (int l = 0; l <= DEPTH; ++l) { const int s = 1 + l * NPH + PROBE_PH; a.lo = lo; a.hi = l < DEPTH ? s + 1 : NSTEPS; a.li = l; a.pad = PROBE_SEL; hipLaunchKernelGGL(mega_fwd, dim3(grid), dim3(512), LDS_BYTES, stream, a); lo = s; } }
#else
    a.lo = 0; a.hi = NSTEPS;
    hipLaunchKernelGGL(mega_fwd, dim3(grid), dim3(512), LDS_BYTES, stream, a);
#endif
}

#else
static void transposes_cpu(const Ctx& c) {
    for (int l = 0; l < DEPTH; ++l) {
        for (int k = 0; k < D; ++k) for (int n = 0; n < INW; ++n) c.win(l)[(size_t)n * D + k] = (bf16_t)f2bf(c.in[I_WIN][((size_t)l * D + k) * INW + n]);
        for (int k = 0; k < MIXW; ++k) for (int n = 0; n < D; ++n) c.wout(l)[(size_t)n * MIXW + k] = (bf16_t)f2bf(c.in[I_WOUT][((size_t)l * MIXW + k) * D + n]);
        for (int e = 0; e < NE; ++e) {
            for (int k = 0; k < D; ++k) for (int n = 0; n < 2 * D; ++n) c.wgu(l)[((size_t)e * 2 * D + gu_row_of_col(n)) * D + k] = (bf16_t)f2bf(c.in[I_WGU][(((size_t)l * NE + e) * D + k) * 2 * D + n]);
            for (int k = 0; k < D; ++k) for (int n = 0; n < D; ++n) c.wdn(l)[((size_t)e * D + n) * D + k] = (bf16_t)f2bf(c.in[I_WDN][(((size_t)l * NE + e) * D + k) * D + n]);
        }
    }
}
template <class Sched> static int gemm_cpu_arow(const Sched& S, const pg8::Unit& u, int r) { if constexpr (Sched::GATHER) return S.rowtok[u.pm * 256 + r]; else return u.pm * 256 + r; }
template <class Epi, class Sched> static void gemm_cpu(const pg8::Gemm& g, Sched S, const Epi& E, int G) {
    static float T[256][256];
    for (int cblk = 0; cblk < G; ++cblk) {
        S.c = cblk;
        for (int i = 0;; ++i) {
            pg8::Unit u; if (!S.next(i, u)) break;
            for (int r = 0; r < 256; ++r) for (int cc = 0; cc < 256; ++cc) {
                const bf16_t* a = g.A + (size_t)gemm_cpu_arow(S, u, r) * g.K; const bf16_t* b = g.Bt + (size_t)(u.pn * 256 + cc) * g.K;
                float s = 0.f; for (int k = 0; k < g.K; ++k) s += bf2f(a[k]) * bf2f(b[k]);
                T[r][cc] = s;
            }
            for (int wid = 0; wid < 8; ++wid) for (int lane = 0; lane < 64; ++lane) {
                const int wr = wid >> 2, wc = wid & 3, fr = lane & 15, fq = lane >> 4;
                accq acc[2][2][4][2];
                for (int ai = 0; ai < 2; ++ai) for (int bj = 0; bj < 2; ++bj) for (int m = 0; m < 4; ++m) for (int n = 0; n < 2; ++n) for (int j = 0; j < 4; ++j) {
                    const int r = 128 * ai + 64 * wr + 16 * m + fr;
                    const int cc = Epi::PERM ? 128 * bj + 32 * wc + 8 * fq + 4 * n + j : 128 * bj + 32 * wc + 16 * n + 4 * fq + j;
                    acc[ai][bj][m][n][j] = T[r][cc];
                }
                E(acc, u, wr, wc, fr, fq);
            }
        }
    }
}
constexpr int LDS_BYTES = 147456;
#define COOP(G_, body_) simt::launch(G_, 512, LDS_BYTES, [&]() { const int tid = threadIdx.x, lane = tid & 63, wave = tid >> 6, blk = blockIdx.x, G = gridDim.x; unsigned char* lds = simt::lds_base; (void)lane; (void)wave; (void)blk; (void)G; (void)lds; body_; })
extern "C" void kernel_launch(void* const* d_in, const int* in_sizes, int n_in, void* d_out, int out_size, void* d_ws, size_t ws_size, hipStream_t stream) {
    Ctx c; c.in = (const float* const*)d_in; c.out = (float*)d_out; c.ws = (unsigned char*)d_ws;
    memset((char*)d_ws + WS_CTL, 0, CTL_BYTES);
    const int G = 256, GC = 8;
    transposes_cpu(c);
    COOP(GC, { ph_mod_w(c, (float*)lds, tid, blk, G); });
    ph_foldgate(c, 0, 1); ph_rwsplit(c, 0, 1);
    for (int l = 0; l < DEPTH; ++l) {
        const bool last = (l == DEPTH - 1); const int nrows = last ? NLAT : NTOK;
        if (l == 0) COOP(GC, ph_norm1_w(c, l, blk * 8 + wave, G * 8, lane));
        { pg8::Gemm g{c.h(), c.win(l), NTOK, GIN_N1, D}; DenseOrder S; S.init(NTOK, GIN_N1, G, 0); EpiU E{c.u(), INP}; gemm_cpu(g, S, E, G); }
        { pg8::Gemm g{c.h(), c.win(l) + (size_t)GIN_C2 * D, NTOK, GIN_N2, D}; DenseOrder S; S.init(NTOK, GIN_N2, G, 0); EpiU E{c.u() + GIN_C2, INP}; gemm_cpu(g, S, E, G); }
        COOP(GC, ph_gin_tail(c, l, (float*)lds, blk, G, tid));
        ph_prep4(c, l, 0, 1);
        COOP(NB * 32, ph_chain(c, lds, blk, G, tid));
        COOP(GC, ph_finish_w(c, l, nrows, blk * 8 + wave, G * 8, lane));
        { pg8::Gemm g{c.y(), c.wout(l), nrows, D, MIXW}; DenseOrder S; S.init(nrows, D, G, 0); EpiResid E{c.x(), c.mod(l, 0), c.wsf(WS_SSP)}; gemm_cpu(g, S, E, G); }
        COOP(GC, ph_route_b(c, l, nrows, (float*)lds, blk, G, tid));
        int tb[TB_WORDS]; expert_tile_base(c.cnt(l), tb);
        COOP(GC, ph_rowtok_w(c, l, nrows, (const int*)tb, blk * 512 + tid, G * 512));
        { pg8::Gemm g{c.h(), c.wgu(l), NTOK, NE * 2 * D, D}; MoeOrderG<const int*, const unsigned short*> S(tb, 2 * D / 256, G, 0, nullptr, c.rtok()); EpiSwiglu E{c.act(), c.in[I_BGU] + (size_t)l * NE * 2 * D}; gemm_cpu(g, S, E, G); }
        { pg8::Gemm g{c.act(), c.wdn(l), MAXROWS, NE * D, D}; MoeOrder<const int*> S{tb, D / 256, G, 0}; EpiDown E{c.yb(), c.in[I_BDN] + (size_t)l * NE * D}; gemm_cpu(g, S, E, G); }
        COOP(GC, ph_combine_w(c, l, nrows, blk * 8 + wave, G * 8, lane));
    }
}
#endif
```

```cpp
#ifndef CPU_TEST
#include <hip/hip_runtime.h>
#else
#include "cpu_shim.h"
#endif
#include <cstdio>
#include <cstdint>
#include <cmath>

#ifndef CFG_D
#define CFG_D 1024
#define CFG_B 8
#define CFG_SEQ 2048
#define CFG_DEPTH 4
#define CFG_CTX 256
#endif
constexpr int D = CFG_D, NB = CFG_B, SEQ = CFG_SEQ, DEPTH = CFG_DEPTH, CTX = CFG_CTX;
constexpr int GRID_W = 64, ROWS = SEQ / GRID_W;
constexpr int NLAT = NB * SEQ, NCTX = NB * CTX, NTOK = NLAT + NCTX;
constexpr int INW = 4672, INWX = 5184, INP = 5376, MIXW = 1536, NE = 32, TOPK = 4;
constexpr int U_GQ = 0, U_GK = 256, U_GV = 512, U_GG = 1024, U_GLR = 1536;
constexpr int U_MQK = 1568, U_MV = 2080, U_MO = 2592, U_MG = 3104;
constexpr int U_Z = 3120, U_XBC = 3632, U_DT = 4656, U_GGK = 4672;
constexpr float EPS = 1e-6f;
constexpr int GIN_CT = 5120, GIN_TW = 64;
static_assert(GIN_CT + GIN_TW == INWX && GIN_CT % 256 == 0 && GIN_CT >= INW && NTOK % 64 == 0, "w_in column split");
constexpr int MAXROWS = NTOK * TOPK + NE * 256;
static_assert(NTOK % 256 == 0 && NLAT % 256 == 0 && D % 128 == 0 && D >= 256, "shape");

constexpr size_t al256(size_t x) { return (x + 255) & ~(size_t)255; }
constexpr size_t WS_CTL = 0, CTL_BYTES = 1u << 20;
constexpr size_t WS_MOD = WS_CTL + CTL_BYTES;
constexpr size_t WS_WIN = al256(WS_MOD + (size_t)DEPTH * (NB + 1) * 6 * D * 4);
constexpr size_t WS_WOUT = al256(WS_WIN + (size_t)DEPTH * INP * D * 2);
constexpr size_t WS_WGU = al256(WS_WOUT + (size_t)DEPTH * D * MIXW * 2);
constexpr size_t WS_WDN = al256(WS_WGU + (size_t)DEPTH * NE * 2 * D * D * 2);
constexpr size_t WS_X = al256(WS_WDN + (size_t)DEPTH * NE * D * D * 2);
constexpr size_t WS_H = al256(WS_X + (size_t)NTOK * D * 4);
constexpr size_t WS_U = al256(WS_H + (size_t)NTOK * D * 2);
constexpr size_t WS_GLA_A = al256(WS_U + (size_t)NTOK * INP * 4);
constexpr size_t WS_ML_QK = al256(WS_GLA_A + (size_t)2 * NTOK * 256 * 4);
constexpr size_t WS_ML_G = al256(WS_ML_QK + (size_t)NTOK * 512 * 4);
constexpr size_t WS_XBC = al256(WS_ML_G + (size_t)NTOK * 16 * 4);
constexpr size_t WS_DT = al256(WS_XBC + (size_t)NTOK * 1024 * 4);
constexpr size_t WS_ODIR = al256(WS_DT + (size_t)NTOK * 16 * 4);
constexpr size_t WS_OD2 = al256(WS_ODIR + (size_t)2 * NTOK * MIXW * 4);
constexpr size_t WS_Y = al256(WS_OD2 + (size_t)2 * NTOK * 512 * 4);
constexpr size_t WS_TOPE = al256(WS_Y + (size_t)NTOK * MIXW * 2);
constexpr size_t WS_TOPG = al256(WS_TOPE + (size_t)NTOK * 4 * 4);
constexpr size_t WS_POS = al256(WS_TOPG + (size_t)NTOK * 4 * 4);
constexpr size_t WS_DEST = al256(WS_POS + (size_t)NTOK * 4 * 4);
constexpr size_t WS_XS = al256(WS_DEST + (size_t)NTOK * 4 * 4);
constexpr size_t WS_ACT = al256(WS_XS + (size_t)MAXROWS * D * 2);
constexpr size_t WS_YB = al256(WS_ACT + (size_t)MAXROWS * D * 2);
constexpr int NCH = (CTX + SEQ) / 64;
static_assert(CTX % 64 == 0 && SEQ % 64 == 0, "chunking");
constexpr size_t CH_G = (size_t)NB * 4 * 2 * NCH, CH_S = (size_t)NB * 8 * 2 * NCH, CH_SG = (size_t)NB * 2 * 2 * NCH;
constexpr size_t WS_GQA = al256(WS_YB + (size_t)MAXROWS * D * 4);
constexpr size_t WS_GKB = al256(WS_GQA + CH_G * 4096 * 2);
constexpr size_t WS_GKDT = al256(WS_GKB + CH_G * 4096 * 2);
constexpr size_t WS_GVT = al256(WS_GKDT + CH_G * 4096 * 2);
constexpr size_t WS_GAL = al256(WS_GVT + CH_G * 8192 * 2);
constexpr size_t WS_MQA = al256(WS_GAL + CH_G * 64 * 4);
constexpr size_t WS_MKB = al256(WS_MQA + CH_G * 4096 * 2);
constexpr size_t WS_MKDT = al256(WS_MKB + CH_G * 4096 * 2);
constexpr size_t WS_MVT = al256(WS_MKDT + CH_G * 4096 * 2);
constexpr size_t WS_MMS = al256(WS_MVT + CH_G * 8192 * 2);
constexpr size_t WS_SQA = al256(WS_MMS + CH_G * 256 * 4);
constexpr size_t WS_SKB = al256(WS_SQA + CH_SG * 8192 * 2);
constexpr size_t WS_SKDT = al256(WS_SKB + CH_SG * 8192 * 2);
constexpr size_t WS_SVT = al256(WS_SKDT + CH_SG * 8192 * 2);
constexpr size_t WS_SVHT = al256(WS_SVT + CH_S * 4096 * 2);
constexpr size_t WS_SCS = al256(WS_SVHT + CH_S * 4096 * 2);
constexpr size_t WS_RWT = al256(WS_SCS + CH_S * 128 * 4);
constexpr size_t WS_SSP = al256(WS_RWT + (size_t)DEPTH * 2 * NE * D * 2);
constexpr size_t WS_RTOK = al256(WS_SSP + (size_t)NTOK * 64 * 4);
constexpr size_t WS_END = al256(WS_RTOK + (size_t)MAXROWS * 4);
static_assert(D == 1024 || D == 256, "ssp slots assume D / 256 <= 4 column tiles");
constexpr int CW_BAR = 4096;
constexpr int CW_CNT = 131072, CNTS = 256;

enum { I_X = 0, I_C, I_CTX, I_CCTX, I_WMOD, I_BMOD, I_N1G, I_WIN, I_GW2, I_GBG, I_GNG, I_MCW, I_MCB, I_MBI, I_MBF, I_MNG,
       I_2CW, I_2CB, I_2DTB, I_2AL, I_2D, I_2NG, I_WOUT, I_N2G, I_RW, I_RB, I_WGU, I_BGU, I_WDN, I_BDN, I_FNG, N_IN };

struct Args { const float* in[N_IN]; float* out; unsigned char* ws; int lo, hi, li, pad; };

#ifndef CPU_TEST
#define KAS __attribute__((address_space(4)))
#else
#define KAS
#endif
typedef unsigned short bf16_t;
typedef float f32x4 __attribute__((ext_vector_type(4)));
typedef unsigned u32x4 __attribute__((ext_vector_type(4)));
typedef unsigned u32x2 __attribute__((ext_vector_type(2)));
typedef short bf16x8 __attribute__((ext_vector_type(8)));

__host__ __device__ __forceinline__ unsigned f2bf(float f) { unsigned u; __builtin_memcpy(&u, &f, 4); return (u + 0x7fffu + ((u >> 16) & 1u)) >> 16; }
#ifndef CPU_TEST
__device__ __forceinline__ unsigned pk2(float lo, float hi) { unsigned r; asm("v_cvt_pk_bf16_f32 %0, %1, %2" : "=v"(r) : "v"(lo), "v"(hi)); return r; }
#else
__host__ __device__ __forceinline__ unsigned pk2(float lo, float hi) { return f2bf(lo) | (f2bf(hi) << 16); }
#endif
__host__ __device__ __forceinline__ float bf2f(bf16_t b) { unsigned u = ((unsigned)b) << 16; float f; __builtin_memcpy(&f, &u, 4); return f; }
#ifndef CPU_TEST
#define FEXP(x) __expf(x)
#define FLOG(x) __logf(x)
#define FRCP(x) __builtin_amdgcn_rcpf(x)
#else
#define FEXP(x) expf(x)
#define FLOG(x) logf(x)
#define FRCP(x) (1.0f / (x))
#endif
__host__ __device__ __forceinline__ float sigmoidf_(float x) { return FRCP(1.0f + FEXP(-x)); }
__host__ __device__ __forceinline__ float siluf_(float x) { return x * sigmoidf_(x); }
__host__ __device__ __forceinline__ float logsigmoidf_(float x) { return fminf(x, 0.f) - FLOG(1.0f + FEXP(-fabsf(x))); }
__host__ __device__ __forceinline__ float softplusf_(float x) { return fmaxf(x, 0.f) + FLOG(1.0f + FEXP(-fabsf(x))); }

__host__ __device__ __forceinline__ f32x4 cvtb4(unsigned long long w) { const unsigned lo = (unsigned)w, hi = (unsigned)(w >> 32); f32x4 r;
    unsigned t; float f; t = lo << 16; __builtin_memcpy(&f, &t, 4); r[0] = f; t = lo & 0xffff0000u; __builtin_memcpy(&f, &t, 4); r[1] = f; t = hi << 16; __builtin_memcpy(&f, &t, 4); r[2] = f; t = hi & 0xffff0000u; __builtin_memcpy(&f, &t, 4); r[3] = f; return r; }
__host__ __device__ __forceinline__ f32x4 ldb4(const bf16_t* p) { const unsigned long long w = *(const unsigned long long*)p; const unsigned lo = (unsigned)w, hi = (unsigned)(w >> 32); f32x4 r;
    unsigned t; float f; t = lo << 16; __builtin_memcpy(&f, &t, 4); r[0] = f; t = lo & 0xffff0000u; __builtin_memcpy(&f, &t, 4); r[1] = f; t = hi << 16; __builtin_memcpy(&f, &t, 4); r[2] = f; t = hi & 0xffff0000u; __builtin_memcpy(&f, &t, 4); r[3] = f; return r; }
struct Ctx {
    const float* const KAS* in; float* out; unsigned char* ws;
    __host__ __device__ float* mod(int l, int r) const { return (float*)(ws + WS_MOD) + ((size_t)l * (NB + 1) + r) * 6 * D; }
    __host__ __device__ bf16_t* win(int l) const { return (bf16_t*)(ws + WS_WIN) + (size_t)l * INP * D; }
    __host__ __device__ bf16_t* wout(int l) const { return (bf16_t*)(ws + WS_WOUT) + (size_t)l * D * MIXW; }
    __host__ __device__ bf16_t* wgu(int l) const { return (bf16_t*)(ws + WS_WGU) + (size_t)l * NE * 2 * D * D; }
    __host__ __device__ bf16_t* wdn(int l) const { return (bf16_t*)(ws + WS_WDN) + (size_t)l * NE * D * D; }
    __host__ __device__ float* x() const { return (float*)(ws + WS_X); }
    __host__ __device__ bf16_t* h() const { return (bf16_t*)(ws + WS_H); }
    __host__ __device__ bf16_t* u() const { return (bf16_t*)(ws + WS_U); }
    __host__ __device__ float* gla_a() const { return (float*)(ws + WS_GLA_A); }
    __host__ __device__ float* ml_qk() const { return (float*)(ws + WS_ML_QK); }
    __host__ __device__ float* ml_g() const { return (float*)(ws + WS_ML_G); }
    __host__ __device__ bf16_t* xbc() const { return (bf16_t*)(ws + WS_XBC); }
    __host__ __device__ float* dt() const { return (float*)(ws + WS_DT); }
    __host__ __device__ bf16_t* odir() const { return (bf16_t*)(ws + WS_ODIR); }
    __host__ __device__ float* od2() const { return (float*)(ws + WS_OD2); }
    __host__ __device__ bf16_t* y() const { return (bf16_t*)(ws + WS_Y); }
    __host__ __device__ int* tope() const { return (int*)(ws + WS_TOPE); }
    __host__ __device__ float* topg() const { return (float*)(ws + WS_TOPG); }
    __host__ __device__ int* pos() const { return (int*)(ws + WS_POS); }
    __host__ __device__ int* dest() const { return (int*)(ws + WS_DEST); }
    __host__ __device__ bf16_t* xs() const { return (bf16_t*)(ws + WS_XS); }
    __host__ __device__ bf16_t* act() const { return (bf16_t*)(ws + WS_ACT); }
    __host__ __device__ bf16_t* yb() const { return (bf16_t*)(ws + WS_YB); }
    __host__ __device__ bf16_t* wsb(size_t off) const { return (bf16_t*)(ws + off); }
    __host__ __device__ float* wsf(size_t off) const { return (float*)(ws + off); }
    __host__ __device__ int* rtok() const { return (int*)(ws + WS_RTOK); }
    __host__ __device__ unsigned* ctl() const { return (unsigned*)(ws + WS_CTL); }
    static_assert((size_t)(CW_CNT + 2 * DEPTH * NE * CNTS) * 4 <= CTL_BYTES, "expert counters fit the zeroed control area");
    __host__ __device__ int* cnt(int l) const { return (int*)(ws + WS_CTL) + CW_CNT + l * NE * CNTS; }
};

constexpr size_t OF_G = 0, OF_M = (size_t)NB * 8 * NCH * 8192, OF_S = 2 * OF_M;
static_assert(OF_S + (size_t)NB * 16 * NCH * 4096 == (size_t)2 * NTOK * MIXW, "fragment layout fills the old [2][NTOK][MIXW] buffer exactly");
__host__ __device__ __forceinline__ int chunk_of(int is_lat, int q) { return (is_lat ? CTX / 64 : 0) + q / 64; }
__host__ __device__ __forceinline__ int mod_row(int row) { return row < NLAT ? row / SEQ : NB; }
__host__ __device__ __forceinline__ void seg_of(int row, int& base, int& pos, int& len) {
    if (row < NLAT) { base = (row / SEQ) * SEQ; pos = row - base; len = SEQ; } else { const int r = row - NLAT; base = NLAT + (r / CTX) * CTX; pos = row - base; len = CTX; }
}
__host__ __device__ __forceinline__ int tok_of_scan(int s) { return (s % ROWS) * GRID_W + s / ROWS; }
__host__ __device__ __forceinline__ int scan_of_tok(int t) { return (t % GRID_W) * ROWS + t / GRID_W; }
__host__ __device__ __forceinline__ int tokrow_of_srow(int srow) { if (srow >= NLAT) return srow; const int b = srow / SEQ; return b * SEQ + tok_of_scan(srow - b * SEQ); }
__host__ __device__ __forceinline__ int srow_of_tokrow(int row) { if (row >= NLAT) return row; const int b = row / SEQ; return b * SEQ + scan_of_tok(row - b * SEQ); }

#ifndef CPU_TEST
#define UNI(x) __builtin_amdgcn_readfirstlane(x)
#define CBAR() __builtin_amdgcn_sched_barrier(0)
#define LAS __attribute__((address_space(3)))
namespace pg8 {
#define PG8_LAS __attribute__((address_space(3)))
typedef unsigned short bf16_t;
typedef short bf16x8 __attribute__((ext_vector_type(8)));
typedef float f32x4 __attribute__((ext_vector_type(4)));
typedef unsigned u32x4 __attribute__((ext_vector_type(4)));
constexpr int BM = 256, BK = 64, HALF = 128, HTB = HALF * BK * 2  , STAGE_BYTES = 8 * HTB, NXCD = 8, WGM = 8;

__host__ __device__ __forceinline__ int lds_byte(int r, int c) { const int st = (r >> 4) * 2 + (c >> 5), rr = r & 15, cc = c & 31, ob = rr * 64 + cc * 2; return st * 1024 + (ob ^ (((ob >> 9) & 1) << 5)); }
__host__ __device__ __forceinline__ void stage_rc(int b, int& R, int& C) { const int st = b / 1024, sb = b % 1024, swz = sb ^ (((sb >> 9) & 1) << 5); R = (st >> 1) * 16 + swz / 64; C = (st & 1) * 32 + (swz % 64) / 2; }
__host__ __device__ __forceinline__ int perm32(int rho) { const int n = rho >> 4, i = rho & 15; return 8 * (i >> 2) + 4 * n + (i & 3); }

struct Unit { int pm, pn; };
struct Gemm { const bf16_t* A; const bf16_t* Bt; int M, N, K; };

struct StaticOrder {
    int nM, nN, nwg, G, c;
    __host__ __device__ void init(int M, int N, int G_, int c_) { nM = M / BM; nN = N / BM; nwg = nM * nN; G = G_; c = c_; }
    __host__ __device__ bool next(int i, Unit& u) const {
        const long L = (long)i * G + c; if (L >= nwg) return false;
        int wgid = (int)L; { const int q = nwg / NXCD, r = nwg % NXCD, xcd = wgid % NXCD, off = wgid / NXCD; wgid = (xcd < r ? xcd * (q + 1) : r * (q + 1) + (xcd - r) * q) + off; }
        const int nig = WGM * nN, gid = wgid / nig, fm = gid * WGM, gsz = (nM - fm) < WGM ? (nM - fm) : WGM;
        u.pm = fm + ((wgid % nig) % gsz); u.pn = (wgid % nig) / gsz; return true;
    }
    __device__ __forceinline__ void a_ready(const Unit&) const {}
    __device__ __forceinline__ void done(const Unit&) const {}
};
__device__ __forceinline__ unsigned cvt_pk_bf16(float lo, float hi) { unsigned r; asm volatile("v_cvt_pk_bf16_f32 %0, %1, %2" : "=v"(r) : "v"(lo), "v"(hi)); return r; }
typedef float f32x2 __attribute__((ext_vector_type(2)));
template <class Epi, class Sched, bool ALIGN_EPI = false, bool SP2 = false>
__device__ __forceinline__ void gemm_phase(PG8_LAS unsigned char* lds, const Gemm g, const Sched& S, const Epi& E, const int tid_in) {
    const int tid = tid_in, wid = __builtin_amdgcn_readfirstlane(tid >> 6), lane = tid & 63, wr = wid >> 2, wc = wid & 3, fr = lane & 15, fq = lane >> 4;
    const int K = g.K, nt = K / BK;
    static_assert(!Sched::GATHER || SP2, "the gathered A operand is wired into the SP2 loop only");
    unsigned voffA[2], voffB[2];
#pragma unroll
    for (int i = 0; i < 2; ++i) { int R, C; stage_rc(tid * 16 + i * 8192, R, C); const int Rb = Epi::PERM ? ((R & ~31) + perm32(R & 31)) : R;
        voffA[i] = (unsigned)(R * K + C) * 2u; voffB[i] = (unsigned)(Rb * K + C) * 2u; }
    unsigned gc00 = 0u, gc01 = 0u, gc10 = 0u, gc11 = 0u, gn00 = 0u, gn01 = 0u, gn10 = 0u, gn11 = 0u;
#define PG8_GOFS(d00, d01, d10, d11, uidx) do { int R0_, C0_, R1_, C1_; stage_rc(tid * 16, R0_, C0_); stage_rc(tid * 16 + 8192, R1_, C1_); \
        d00 = ((unsigned)S.grow((uidx), R0_) * (unsigned)K + (unsigned)C0_) * 2u; d01 = ((unsigned)S.grow((uidx), R1_) * (unsigned)K + (unsigned)C1_) * 2u; \
        d10 = ((unsigned)S.grow((uidx), 128 + R0_) * (unsigned)K + (unsigned)C0_) * 2u; d11 = ((unsigned)S.grow((uidx), 128 + R1_) * (unsigned)K + (unsigned)C1_) * 2u; } while (0)
#define PG8_STAGE2(bufoff, gbase, o0, o1) do { \
        __builtin_amdgcn_global_load_lds((const unsigned*)((const char*)(gbase) + (o0)), (PG8_LAS unsigned*)(lds + (bufoff) + ldsw), 16, 0, 0); \
        __builtin_amdgcn_global_load_lds((const unsigned*)((const char*)(gbase) + (o1)), (PG8_LAS unsigned*)(lds + (bufoff) + ldsw + 8192), 16, 0, 0); } while (0)
#define PG8_STAGE_A(bufoff, base, H, NX) do { if constexpr (Sched::GATHER) { const unsigned o0_ = (NX) ? ((H) ? gn10 : gn00) : ((H) ? gc10 : gc00), o1_ = (NX) ? ((H) ? gn11 : gn01) : ((H) ? gc11 : gc01); PG8_STAGE2(bufoff, base, o0_, o1_); } \
        else { PG8_STAGE(bufoff, (base) + (H) * hstep, voffA); } } while (0)
    const size_t kstep = (size_t)(BK * 2);
    const size_t hstep = (size_t)HALF * K * 2;
    const size_t tstep = 2 * hstep;
    const unsigned ldsw = (unsigned)wid * 1024u;
    const int aoff = lds_byte(wr * 64 + fr, fq * 8), boff = lds_byte(wc * 32 + fr, fq * 8);
#define PG8_SA(b, h) (((b) * 2 + (h)) * HTB)
#define PG8_SB(b, h) ((4 + (b) * 2 + (h)) * HTB)
#define PG8_STAGE(bufoff, gbase, voff) do { _Pragma("unroll") for (int _i = 0; _i < 2; ++_i) \
        __builtin_amdgcn_global_load_lds((const unsigned*)((const char*)(gbase) + (voff)[_i]), (PG8_LAS unsigned*)(lds + (bufoff) + ldsw + _i * 8192), 16, 0, 0); } while (0)
#define PG8_LDA(dst, b, h) do { _Pragma("unroll") for (int m = 0; m < 4; ++m) _Pragma("unroll") for (int k = 0; k < 2; ++k) dst[m][k] = *(const PG8_LAS bf16x8*)(lds + PG8_SA(b, h) + aoff + m * 2048 + k * 1024); } while (0)
#define PG8_LDB(dst, b, h) do { _Pragma("unroll") for (int n = 0; n < 2; ++n) _Pragma("unroll") for (int k = 0; k < 2; ++k) dst[n][k] = *(const PG8_LAS bf16x8*)(lds + PG8_SB(b, h) + boff + n * 2048 + k * 1024); } while (0)
#define PG8_MMA(ai, bj, At, Bt) do { __builtin_amdgcn_s_setprio(1); _Pragma("unroll") for (int m = 0; m < 4; ++m) _Pragma("unroll") for (int n = 0; n < 2; ++n) _Pragma("unroll") for (int k = 0; k < 2; ++k) \
        acc[ai][bj][m][n] = __builtin_amdgcn_mfma_f32_16x16x32_bf16(Bt[n][k], At[m][k], acc[ai][bj][m][n], 0, 0, 0); __builtin_amdgcn_s_setprio(0); } while (0)
#define PG8_WAIT_V(n) asm volatile("s_waitcnt vmcnt(" #n ")" ::: "memory")
#define PG8_WAIT_L(n) asm volatile("s_waitcnt lgkmcnt(" #n ")" ::: "memory")
#define PG8_BAR __builtin_amdgcn_s_barrier()
#define PG8_SCHED __builtin_amdgcn_sched_barrier(0)
    Unit cur, nxt; int ui = 0;
    if (!S.next(0, cur)) return;
    f32x4 acc[2][2][4][2];
#pragma unroll
    for (int a = 0; a < 2; ++a)
#pragma unroll
        for (int b = 0; b < 2; ++b)
#pragma unroll
            for (int m = 0; m < 4; ++m)
#pragma unroll
                for (int n = 0; n < 2; ++n) acc[a][b][m][n] = (f32x4){0.f, 0.f, 0.f, 0.f};
    bf16x8 At[4][2], B0[2][2], B1[2][2];
    const char* cA = (const char*)g.A + (Sched::GATHER ? (size_t)0 : (size_t)cur.pm * tstep); const char* cB = (const char*)g.Bt + (size_t)cur.pn * tstep;
    if constexpr (Sched::GATHER) PG8_GOFS(gc00, gc01, gc10, gc11, 0);
    S.a_ready(cur);
    if constexpr (SP2) {
        PG8_STAGE(PG8_SB(0, 0), cB, voffB); PG8_STAGE(PG8_SB(0, 1), cB + hstep, voffB); PG8_STAGE_A(PG8_SA(0, 0), cA, 0, false); PG8_STAGE_A(PG8_SA(0, 1), cA, 1, false);
        if (wr == 1) PG8_BAR;
        PG8_WAIT_V(2); PG8_BAR;
        PG8_STAGE(PG8_SB(1, 0), cB + kstep, voffB); PG8_STAGE_A(PG8_SA(1, 0), cA + kstep, 0, false); PG8_STAGE(PG8_SB(1, 1), cB + hstep + kstep, voffB);
        PG8_WAIT_V(6); PG8_BAR;
    } else {
        PG8_STAGE(PG8_SB(0, 0), cB, voffB); PG8_STAGE(PG8_SA(0, 0), cA, voffA); PG8_STAGE(PG8_SB(0, 1), cB + hstep, voffB); PG8_STAGE(PG8_SA(0, 1), cA + hstep, voffA);
        if (wr == 1) PG8_BAR;
        PG8_WAIT_V(4); PG8_BAR;
        PG8_STAGE(PG8_SB(1, 0), cB + kstep, voffB); PG8_STAGE(PG8_SA(1, 0), cA + kstep, voffA); PG8_STAGE(PG8_SB(1, 1), cB + hstep + kstep, voffB);
        PG8_WAIT_V(6); PG8_BAR;
    }
    for (;;) {
        const bool has_next = S.next(ui + 1, nxt);
        const char* nA = (has_next && !Sched::GATHER) ? (const char*)g.A + (size_t)nxt.pm * tstep : cA; const char* nB = has_next ? (const char*)g.Bt + (size_t)nxt.pn * tstep : cB;
        if constexpr (Sched::GATHER) { if (has_next) PG8_GOFS(gn00, gn01, gn10, gn11, ui + 1); else { gn00 = gc00; gn01 = gc01; gn10 = gc10; gn11 = gc11; } }
        for (int t = 0; t < nt; t += 2) {
            const bool last = (t == nt - 2);
            const char* a1 = cA + (size_t)(t + 1) * kstep;
            const char* a2 = last ? nA : cA + (size_t)(t + 2) * kstep; const char* b2 = last ? nB : cB + (size_t)(t + 2) * kstep;
            const char* a3 = a2 + kstep; const char* b3 = b2 + kstep;
            if (last && has_next) S.a_ready(nxt);
            if constexpr (SP2) {
            PG8_LDB(B0, 0, 0); PG8_LDB(B1, 0, 1); PG8_SCHED; PG8_LDA(At, 0, 0); PG8_STAGE_A(PG8_SA(1, 1), a1, 1, false);
            PG8_WAIT_V(8); PG8_WAIT_L(0); PG8_BAR; PG8_MMA(0, 0, At, B0); PG8_MMA(0, 1, At, B1); PG8_BAR; PG8_SCHED;
            PG8_LDA(At, 0, 1); PG8_STAGE(PG8_SB(0, 0), b2, voffB); PG8_STAGE(PG8_SB(0, 1), b2 + hstep, voffB); PG8_STAGE_A(PG8_SA(0, 0), a2, 0, last);
            PG8_WAIT_V(8); PG8_WAIT_L(0); PG8_BAR; PG8_MMA(1, 0, At, B0); PG8_MMA(1, 1, At, B1); PG8_BAR; PG8_SCHED;
            PG8_LDB(B0, 1, 0); PG8_LDB(B1, 1, 1); PG8_SCHED; PG8_LDA(At, 1, 0); PG8_STAGE_A(PG8_SA(0, 1), a2, 1, last);
            PG8_WAIT_V(8); PG8_WAIT_L(0); PG8_BAR; PG8_MMA(0, 0, At, B0); PG8_MMA(0, 1, At, B1); PG8_BAR; PG8_SCHED;
            PG8_LDA(At, 1, 1); PG8_STAGE(PG8_SB(1, 0), b3, voffB); PG8_STAGE(PG8_SB(1, 1), b3 + hstep, voffB); PG8_STAGE_A(PG8_SA(1, 0), a3, 0, last);
            PG8_WAIT_V(8); PG8_WAIT_L(0); PG8_BAR; PG8_MMA(1, 0, At, B0); PG8_MMA(1, 1, At, B1); PG8_BAR; PG8_SCHED;
            } else {
            PG8_LDB(B0, 0, 0); PG8_SCHED; PG8_LDA(At, 0, 0); PG8_STAGE(PG8_SA(1, 1), a1 + hstep, voffA);
            PG8_WAIT_L(8); PG8_BAR; PG8_WAIT_L(0); PG8_MMA(0, 0, At, B0); PG8_BAR; PG8_SCHED;
            PG8_LDB(B1, 0, 1); PG8_STAGE(PG8_SB(0, 0), b2, voffB);
            PG8_BAR; PG8_WAIT_L(0); PG8_MMA(0, 1, At, B1); PG8_BAR;
            PG8_LDA(At, 0, 1); PG8_STAGE(PG8_SA(0, 0), a2, voffA);
            PG8_BAR; PG8_WAIT_L(0); PG8_MMA(1, 0, At, B0); PG8_BAR; PG8_SCHED;
            PG8_STAGE(PG8_SB(0, 1), b2 + hstep, voffB);
            PG8_WAIT_V(6); PG8_BAR; PG8_MMA(1, 1, At, B1); PG8_BAR;
            PG8_LDB(B0, 1, 0); PG8_SCHED; PG8_LDA(At, 1, 0); PG8_STAGE(PG8_SA(0, 1), a2 + hstep, voffA);
            PG8_WAIT_L(8); PG8_BAR; PG8_WAIT_L(0); PG8_MMA(0, 0, At, B0); PG8_BAR; PG8_SCHED;
            PG8_LDB(B1, 1, 1); PG8_STAGE(PG8_SB(1, 0), b3, voffB);
            PG8_BAR; PG8_WAIT_L(0); PG8_MMA(0, 1, At, B1); PG8_BAR;
            PG8_LDA(At, 1, 1); PG8_STAGE(PG8_SA(1, 0), a3, voffA);
            PG8_BAR; PG8_WAIT_L(0); PG8_MMA(1, 0, At, B0); PG8_BAR; PG8_SCHED;
            PG8_STAGE(PG8_SB(1, 1), b3 + hstep, voffB);
            PG8_WAIT_V(6); PG8_BAR; PG8_MMA(1, 1, At, B1); PG8_BAR;
            }
        }
        if constexpr (ALIGN_EPI) { if (wr == 0) PG8_BAR; }
        if constexpr (!Epi::AFTER_DRAIN) { E(acc, cur, wr, wc, fr, fq); S.done(cur); }
        if (!has_next) break;
#pragma unroll
        for (int a = 0; a < 2; ++a)
#pragma unroll
            for (int b = 0; b < 2; ++b)
#pragma unroll
                for (int m = 0; m < 4; ++m)
#pragma unroll
                    for (int n = 0; n < 2; ++n) acc[a][b][m][n] = (f32x4){0.f, 0.f, 0.f, 0.f};
        cur = nxt; cA = nA; cB = nB; ++ui;
        if constexpr (Sched::GATHER) { gc00 = gn00; gc01 = gn01; gc10 = gn10; gc11 = gn11; }
        if constexpr (ALIGN_EPI) { if (wr == 1) PG8_BAR; }
    }
    PG8_WAIT_V(0);
    if constexpr (!ALIGN_EPI) { if (wr == 0) PG8_BAR; }
    PG8_BAR;
    if constexpr (Epi::AFTER_DRAIN) { E.fused(acc, cur, wr, wc, fr, fq, lds, wid, lane); S.done(cur); }
#undef PG8_SA
#undef PG8_SB
#undef PG8_STAGE
#undef PG8_LDA
#undef PG8_LDB
#undef PG8_MMA
#undef PG8_WAIT_V
#undef PG8_WAIT_L
#undef PG8_BAR
#undef PG8_SCHED
#undef PG8_GOFS
#undef PG8_STAGE_A
#undef PG8_STAGE2
}
}
#define XB_TMO      128
#define XB_XCNT(j)  (256  + 64 * (j))
#define XB_XSUB(j)  (1280 + 64 * (j))
#define XB_XGEN(j)  (2304 + 64 * (j))
#define XB_TOP      3328
#define XB_TOPGEN   3392
#define XCD_BAR_WORDS 3456
#define XB_SPIN_CAP (1u << 22)

__device__ __forceinline__ unsigned xb_ld(unsigned* p)              { return __hip_atomic_load(p, __ATOMIC_RELAXED, __HIP_MEMORY_SCOPE_AGENT); }
__device__ __forceinline__ unsigned xb_add(unsigned* p, unsigned v) { return __hip_atomic_fetch_add(p, v, __ATOMIC_RELAXED, __HIP_MEMORY_SCOPE_AGENT); }
__device__ __forceinline__ unsigned xb_xcc_id() { return (unsigned)__builtin_amdgcn_s_getreg((3 << 11) | 20) & 0xFu; }
#define XB_SPIN(cond, bar) do { unsigned _sp = 0; while (cond) { __builtin_amdgcn_s_sleep(1); \
    if ((++_sp & 255u) == 0u) { if (xb_ld(&(bar)[XB_TMO])) break; if (_sp > XB_SPIN_CAP) { atomicAdd(&(bar)[XB_TMO], 1u); break; } } } } while (0)

struct XcdBarrier {
    unsigned* bar; unsigned x;
    volatile LAS unsigned* st;
};

__device__ __forceinline__ XcdBarrier xcd_barrier_post(unsigned* bar, volatile LAS unsigned* st) {
    XcdBarrier b; b.bar = bar; b.x = xb_xcc_id(); b.st = st;
    if (threadIdx.x == 0) (void)xb_add(&bar[XB_XCNT(b.x)], 1u);
    return b;
}
__device__ __forceinline__ void xcd_barrier_complete(unsigned* bar, unsigned x, unsigned& nloc, unsigned& nx) {
    const unsigned G = gridDim.x * gridDim.y * gridDim.z;
    unsigned sum, cnt, mine, sp = 0u;
    for (;;) {
        sum = 0u; cnt = 0u; mine = 0u;
#pragma unroll
        for (unsigned j = 0; j < 16; ++j) { const unsigned c = xb_ld(&bar[XB_XCNT(j)]); sum += c; cnt += (c > 0u) ? 1u : 0u; mine = (j == x) ? c : mine; }
        if (sum == G) break;
        __builtin_amdgcn_s_sleep(1);
        if ((++sp & 255u) == 0u) { if (xb_ld(&bar[XB_TMO])) break; if (sp > XB_SPIN_CAP) { atomicAdd(&bar[XB_TMO], 1u); break; } }
    }
    nloc = mine > 0u ? mine : 1u; nx = cnt > 0u ? cnt : 1u;
}

__device__ __forceinline__ void xcd_barrier(const XcdBarrier& b) {
    asm volatile("s_waitcnt vmcnt(0)" ::: "memory");
    __syncthreads();
    if (threadIdx.x == 0) {
        unsigned* bar = b.bar;
        __builtin_amdgcn_s_waitcnt(0);
        unsigned nloc = b.st[0], nx = b.st[1];
        if (nloc == 0u) { xcd_barrier_complete(bar, b.x, nloc, nx); b.st[0] = nloc; b.st[1] = nx; }
        const unsigned old = xb_add(&bar[XB_XSUB(b.x)], 1u);
        const unsigned gen = old / nloc;
        if (old + 1u == (gen + 1u) * nloc) {
            __builtin_amdgcn_fence(__ATOMIC_RELEASE, "agent");
            asm volatile("s_waitcnt vmcnt(0)" ::: "memory");
            const unsigned og = xb_add(&bar[XB_TOP], 1u);
            const unsigned tg = og / nx;
            if (og + 1u == (tg + 1u) * nx) xb_add(&bar[XB_TOPGEN], 1u);
            else XB_SPIN(xb_ld(&bar[XB_TOPGEN]) == tg, bar);
            __builtin_amdgcn_fence(__ATOMIC_ACQUIRE, "agent");
            xb_add(&bar[XB_XGEN(b.x)], 1u);
            asm volatile("s_waitcnt vmcnt(0)" ::: "memory");
        } else {
            XB_SPIN(xb_ld(&bar[XB_XGEN(b.x)]) == gen, bar);
            __builtin_amdgcn_fence(__ATOMIC_ACQUIRE, "agent");
            asm volatile("s_waitcnt vmcnt(0)" ::: "memory");
        }
    }
    __syncthreads();
}
#else
#define UNI(x) (x)
#define CBAR()
namespace pg8 { typedef float f32x4 __attribute__((ext_vector_type(4))); struct Unit { int pm, pn; }; struct Gemm { const unsigned short* A; const unsigned short* Bt; int M, N, K; }; }
#endif

__host__ __device__ __forceinline__ int scan_row(int b, int dir, int st) {
    return st < CTX ? NLAT + b * CTX + (dir == 0 ? st : CTX - 1 - st) : b * SEQ + (dir == 0 ? st - CTX : SEQ - 1 - (st - CTX));
}
__host__ __device__ __forceinline__ void expert_tile_base(const int* cnt, int* tb) { int a = 0; for (int e = 0; e < NE; ++e) { tb[e] = a; const int nt = (cnt[e * CNTS] + 255) / 256; for (int t = 0; t < nt; ++t) tb[NE + 1 + a + t] = e; a += nt; } tb[NE] = a; }
constexpr int TB_WORDS = NE + 1 + MAXROWS / 256;
struct DenseOrder {
    static constexpr bool GATHER = false;
    __device__ __forceinline__ int grow(int, int) const { return 0; }
    int nM, nN, nwg, G, c;
    __host__ __device__ void init(int M, int N, int G_, int c_) { nM = M / 256; nN = N / 256; nwg = nM * nN; G = G_; c = c_; }
    __host__ __device__ __forceinline__ bool next(int i, pg8::Unit& u) const {
        const long L = (long)i * G + c; if (L >= nwg) return false;
        int wgid = (int)L; { const int q = nwg / 8, r = nwg % 8, xcd = wgid % 8, off = wgid / 8; wgid = (xcd < r ? xcd * (q + 1) : r * (q + 1) + (xcd - r) * q) + off; }
        const int nig = 8 * nN, gid = wgid / nig, fm = gid * 8, gsz = (nM - fm) < 8 ? (nM - fm) : 8;
        u.pm = fm + ((wgid % nig) % gsz); u.pn = (wgid % nig) / gsz; return true;
    }
    __device__ __forceinline__ void a_ready(const pg8::Unit&) const {}
    __device__ __forceinline__ void done(const pg8::Unit&) const {}
};
template <class TB> struct MoeOrder {
    static constexpr bool GATHER = false;
    __device__ __forceinline__ int grow(int, int) const { return 0; }
    TB tb; int nN, G, c; int wgm = 8; int rev = 0;
    __host__ __device__ __forceinline__ bool next(int i, pg8::Unit& u) const {
        const int nRT = tb[NE], nwg = nRT * nN;
        const long L = (long)i * G + c; if (L >= nwg) return false;
        int wgid = (int)L; { const int q = nwg / 8, r = nwg % 8, xcd = wgid % 8, off = wgid / 8; wgid = (xcd < r ? xcd * (q + 1) : r * (q + 1) + (xcd - r) * q) + off; }
        if (rev) wgid = nwg - 1 - wgid;
        const int nig = wgm * nN, gid = wgid / nig, fm = gid * wgm, gsz = (nRT - fm) < wgm ? (nRT - fm) : wgm;
        const int rt = fm + ((wgid % nig) % gsz), ln = (wgid % nig) / gsz;
        const int e = tb[NE + 1 + rt];
#ifndef CPU_TEST
        u.pm = __builtin_amdgcn_readfirstlane(rt); u.pn = __builtin_amdgcn_readfirstlane(e * nN + ln);
#else
        u.pm = rt; u.pn = e * nN + ln;
#endif
        return true;
    }
    __device__ __forceinline__ void a_ready(const pg8::Unit&) const {}
    __device__ __forceinline__ void done(const pg8::Unit&) const {}
};
template <class TB, class GT> struct MoeOrderG : MoeOrder<TB> {
    static constexpr bool GATHER = true;
    GT gtab; const int* rowtok;
    __host__ __device__ MoeOrderG(TB tb_, int nN_, int G_, int c_, GT gt_, const int* rt_) { this->tb = tb_; this->nN = nN_; this->G = G_; this->c = c_; this->wgm = 8; gtab = gt_; rowtok = rt_; }
    __device__ __forceinline__ int grow(int ui, int r) const { return (int)gtab[ui * 256 + r]; }
};
#ifdef CPU_TEST
static inline unsigned cvt_pk_bf16(float lo, float hi) { return pk2(lo, hi); }
#else
using pg8::cvt_pk_bf16;
#endif
typedef pg8::f32x4 accq;
struct EpiU {
    static constexpr bool PERM = true, AFTER_DRAIN = false;
    bf16_t* C; int ldc;
    __device__ __forceinline__ void operator()(const accq (&acc)[2][2][4][2], const pg8::Unit& u, int wr, int wc, int fr, int fq) const {
        const int row0 = u.pm * 256 + wr * 64 + fr, col0 = u.pn * 256 + wc * 32 + 8 * fq;
#pragma unroll
        for (int ai = 0; ai < 2; ++ai)
#pragma unroll
            for (int m = 0; m < 4; ++m) { bf16_t* rowp = C + (size_t)(row0 + ai * 128 + m * 16) * ldc + col0;
#pragma unroll
                for (int bj = 0; bj < 2; ++bj) { const accq v0 = acc[ai][bj][m][0], v1 = acc[ai][bj][m][1];
                    u32x4 w; w.x = cvt_pk_bf16(v0[0], v0[1]); w.y = cvt_pk_bf16(v0[2], v0[3]); w.z = cvt_pk_bf16(v1[0], v1[1]); w.w = cvt_pk_bf16(v1[2], v1[3]);
                    *(u32x4*)(rowp + bj * 128) = w; } }
    }
};
struct EpiResid {
    static constexpr bool PERM = false, AFTER_DRAIN = false;
    float* X; const float* modl; float* SSP;
    __device__ __forceinline__ void operator()(const accq (&acc)[2][2][4][2], const pg8::Unit& u, int wr, int wc, int fr, int fq) const {
        const int row0 = u.pm * 256 + wr * 64 + fr, col0 = u.pn * 256 + wc * 32 + 4 * fq;
#pragma unroll
        for (int ai = 0; ai < 2; ++ai)
#pragma unroll
            for (int m = 0; m < 4; ++m) { const int row = row0 + ai * 128 + m * 16; float* rowp = X + (size_t)row * D + col0; const float* gp = modl + (size_t)mod_row(row) * 6 * D + 2 * D + col0;
                float ss = 0.f;
#pragma unroll
                for (int bj = 0; bj < 2; ++bj)
#pragma unroll
                    for (int n = 0; n < 2; ++n) { const accq gv = *(const accq*)(gp + bj * 128 + n * 16); accq xv = *(accq*)(rowp + bj * 128 + n * 16); xv = xv + gv * acc[ai][bj][m][n]; *(accq*)(rowp + bj * 128 + n * 16) = xv;
                        ss += (xv[0] * xv[0] + xv[1] * xv[1]) + (xv[2] * xv[2] + xv[3] * xv[3]); }
                SSP[(size_t)row * 64 + (u.pn * 4 + wc) * 4 + fq] = ss; }
    }
};
struct EpiSwiglu {
    static constexpr bool PERM = true, AFTER_DRAIN = false;
    bf16_t* ACT; const float* bgu;
    __device__ __forceinline__ void operator()(const accq (&acc)[2][2][4][2], const pg8::Unit& u, int wr, int wc, int fr, int fq) const {
        constexpr int nN = 2 * D / 256;
        const int e = u.pn / nN, ln = u.pn % nN;
        const int row0 = u.pm * 256 + wr * 64 + fr, cl = 128 * ln + wc * 32 + 8 * fq;
        const float* bg = bgu + (size_t)e * 2 * D + cl;
        accq bgl[2], bli[2];
#pragma unroll
        for (int n = 0; n < 2; ++n) { bgl[n] = *(const accq*)(bg + 4 * n); bli[n] = *(const accq*)(bg + D + 4 * n); }
#pragma unroll
        for (int ai = 0; ai < 2; ++ai)
#pragma unroll
            for (int m = 0; m < 4; ++m) {
                float a[8];
#pragma unroll
                for (int n = 0; n < 2; ++n)
#pragma unroll
                    for (int j = 0; j < 4; ++j) {
                        float glu = acc[ai][0][m][n][j] + bgl[n][j], lin = acc[ai][1][m][n][j] + bli[n][j];
                        glu = fminf(glu, 7.0f); lin = fminf(fmaxf(lin, -7.0f), 7.0f);
                        a[4 * n + j] = glu * FRCP(1.0f + __expf(-1.702f * glu)) * (lin + 1.0f);
                    }
                u32x4 w; w.x = cvt_pk_bf16(a[0], a[1]); w.y = cvt_pk_bf16(a[2], a[3]); w.z = cvt_pk_bf16(a[4], a[5]); w.w = cvt_pk_bf16(a[6], a[7]);
                *(u32x4*)(ACT + (size_t)(row0 + ai * 128 + m * 16) * D + cl) = w;
            }
    }
};
struct EpiDown {
    static constexpr bool PERM = true, AFTER_DRAIN = false;
    bf16_t* YB; const float* bdn;
    __device__ __forceinline__ void operator()(const accq (&acc)[2][2][4][2], const pg8::Unit& u, int wr, int wc, int fr, int fq) const {
        constexpr int nN = D / 256;
        const int e = u.pn / nN, ln = u.pn % nN;
        const int row0 = u.pm * 256 + wr * 64 + fr, col0 = ln * 256 + wc * 32 + 8 * fq;
        const float* bp = bdn + (size_t)e * D + col0;
        accq bv[2][2];
#pragma unroll
        for (int bj = 0; bj < 2; ++bj)
#pragma unroll
            for (int n = 0; n < 2; ++n) bv[bj][n] = *(const accq*)(bp + bj * 128 + 4 * n);
#pragma unroll
        for (int ai = 0; ai < 2; ++ai)
#pragma unroll
            for (int m = 0; m < 4; ++m) { bf16_t* rowp = YB + (size_t)(row0 + ai * 128 + m * 16) * D + col0;
#pragma unroll
                for (int bj = 0; bj < 2; ++bj) { const accq v0 = acc[ai][bj][m][0] + bv[bj][0], v1 = acc[ai][bj][m][1] + bv[bj][1];
                    u32x4 w; w.x = cvt_pk_bf16(v0[0], v0[1]); w.y = cvt_pk_bf16(v0[2], v0[3]); w.z = cvt_pk_bf16(v1[0], v1[1]); w.w = cvt_pk_bf16(v1[2], v1[3]);
                    *(u32x4*)(rowp + bj * 128) = w; } }
    }
};
__host__ __device__ __forceinline__ int gu_row_of_col(int n) { return n < D ? 256 * (n / 128) + n % 128 : 256 * ((n - D) / 128) + 128 + (n - D) % 128; }

#ifndef CPU_TEST
__device__ __forceinline__ int lane_now() { int l; asm volatile("v_mbcnt_lo_u32_b32 %0, -1, 0\n\tv_mbcnt_hi_u32_b32 %0, -1, %0" : "=v"(l)); return l; }
#define SHFL_XOR_F(v, m) __builtin_bit_cast(float, __builtin_amdgcn_ds_bpermute((lane_now() ^ (m)) << 2, __builtin_bit_cast(int, (float)(v))))
template <int CTRL> __device__ __forceinline__ float dppf(float v) { return __builtin_bit_cast(float, __builtin_amdgcn_update_dpp(0, __builtin_bit_cast(int, v), CTRL, 0xF, 0xF, true)); }
#define RED1(v) dppf<0xB1>(v)
#define RED2(v) dppf<0x4E>(v)
#define RED4(v) dppf<0x141>(v)
#define RED8(v) dppf<0x140>(v)
#define RFL(x) __builtin_amdgcn_readfirstlane(x)
#define WAVE_SYNC() __builtin_amdgcn_wave_barrier()
#else
#define SHFL_XOR_F(v, m) shfl_xor_f((v), (m))
#define RED1(v) shfl_xor_f((v), 1)
#define RED2(v) shfl_xor_f((v), 2)
#define RED4(v) shfl_xor_f((v), 4)
#define RED8(v) shfl_xor_f((v), 8)
#define RFL(x) rfl_i(x)
#define LAS
#define WAVE_SYNC() simt::wave_sync()
#endif
__device__ __forceinline__ float wave_sum(float v) {
    v += RED1(v); v += RED2(v); v += RED4(v); v += RED8(v); v += SHFL_XOR_F(v, 16); v += SHFL_XOR_F(v, 32);
    return v;
}
static_assert(D % 256 == 0, "row layout: lane l holds float4 j at element 4l + 256j");
constexpr int RJ = D / 256;
__device__ __forceinline__ float row_rms(const f32x4 (&v)[RJ]) {
    float s = 0.f;
#pragma unroll
    for (int j = 0; j < RJ; ++j) s += (v[j][0] * v[j][0] + v[j][1] * v[j][1]) + (v[j][2] * v[j][2] + v[j][3] * v[j][3]);
    return 1.0f / sqrtf(wave_sum(s) * (1.0f / D) + EPS);
}
__device__ __forceinline__ void row_modulate_store(f32x4 (&v)[RJ], float r, const float* g, const float* shift, const float* scale, bf16_t* o, int lane) {
#pragma unroll
    for (int j = 0; j < RJ; ++j) {
        const int e0 = 4 * lane + 256 * j;
        const f32x4 gv = *(const f32x4*)(g + e0), sh = *(const f32x4*)(shift + e0), sc = *(const f32x4*)(scale + e0);
        v[j] = (v[j] * r * gv) * (sc + 1.0f) + sh;
        unsigned lo = pk2(v[j][0], v[j][1]), hi = pk2(v[j][2], v[j][3]);
        *(unsigned long long*)(o + e0) = (unsigned long long)lo | ((unsigned long long)hi << 32);
    }
}
__device__ __forceinline__ void ph_xinit_w(const Ctx& c, int gw, int ngw, int lane) {
    for (int row = gw; row < NTOK; row += ngw) {
        const float* src = row < NLAT ? c.in[I_X] + (size_t)row * D : c.in[I_CTX] + (size_t)(row - NLAT) * D;
        float* dst = c.x() + (size_t)row * D;
#pragma unroll
        for (int j = 0; j < RJ; ++j) *(f32x4*)(dst + 4 * lane + 256 * j) = *(const f32x4*)(src + 4 * lane + 256 * j);
    }
}
__device__ __forceinline__ void ph_norm1_w(const Ctx& c, int l, int gw, int ngw, int lane) {
    for (int row = gw; row < NTOK; row += ngw) {
        const float* xr = row < NLAT ? c.in[I_X] + (size_t)row * D : c.in[I_CTX] + (size_t)(row - NLAT) * D;
        float* dst = c.x() + (size_t)row * D;
        f32x4 v[RJ];
#pragma unroll
        for (int j = 0; j < RJ; ++j) { v[j] = *(const f32x4*)(xr + 4 * lane + 256 * j); *(f32x4*)(dst + 4 * lane + 256 * j) = v[j]; }
        const float r = row_rms(v);
        const float* m = c.mod(l, mod_row(row));
        row_modulate_store(v, r, c.in[I_N1G] + l * D, m, m + D, c.h() + (size_t)row * D, lane);
    }
}
__device__ __forceinline__ void ph_finish_w(const Ctx& c, int l, int nrows, int gw, int ngw, int lane) {
    const bf16_t* U = c.u();
    const bf16_t* OD = c.odir();
    for (int grp = gw; grp < nrows / 4; grp += ngw) {
        const int row0 = 4 * grp;
        int base, pos, len; seg_of(row0, base, pos, len);
        const int is_lat = row0 < NLAT ? 1 : 0, b = is_lat ? row0 / SEQ : (row0 - NLAT) / CTX;
        const int unit = lane >> 3, sub = lane & 7, hd = unit & 3, col0 = unit * 128 + sub * 16;
        float o[4][16];
#pragma unroll
        for (int d = 0; d < 2; ++d) {
            const int q = d == 0 ? pos : len - 1 - pos, n = chunk_of(is_lat, q), qi = q % 64;
            const bf16_t* fp = OD + (unit < 4 ? OF_G : OF_M) + ((((size_t)((b * 4 + hd) * 2 + d) * NCH + n) * 4 + qi / 16) * 8 + sub) * 256 + ((qi % 16) / 4) * 64;
#pragma unroll
            for (int e = 0; e < 16; ++e) { const f32x4 v = ldb4(fp + e * 4);
#pragma unroll
                for (int j = 0; j < 4; ++j) o[j][e] = d == 0 ? v[j] : o[j][e] + v[3 - j]; }
        }
        const int hc = sub * 16;
        const float* gw_ = unit < 4 ? c.in[I_GNG] + l * 128 + hc : c.in[I_MNG] + l * 512 + (unit - 4) * 128 + hc;
        f32x4 gv[4];
#pragma unroll
        for (int q = 0; q < 4; ++q) gv[q] = *(const f32x4*)(gw_ + 4 * q);
#pragma unroll
        for (int j = 0; j < 4; ++j) {
            float ss = 0.f;
#pragma unroll
            for (int e = 0; e < 16; ++e) ss += o[j][e] * o[j][e];
            ss += RED1(ss); ss += RED2(ss); ss += RED4(ss);
            const float r = 1.0f / sqrtf(ss * (1.0f / 128.f) + EPS);
            const bf16_t* ur = U + (size_t)(row0 + j) * INP;
            const bf16_t* gate = unit < 4 ? ur + U_GG + unit * 128 + hc : ur + U_MO + (unit - 4) * 128 + hc;
            unsigned w[8];
#pragma unroll
            for (int q = 0; q < 4; ++q) { const f32x4 ga = ldb4(gate + 4 * q); float t[4];
#pragma unroll
                for (int e = 0; e < 4; ++e) t[e] = o[j][4 * q + e] * r * gv[q][e] * (unit < 4 ? siluf_(ga[e]) : sigmoidf_(ga[e]));
                w[2 * q] = pk2(t[0], t[1]); w[2 * q + 1] = pk2(t[2], t[3]); }
            bf16_t* yr = c.y() + (size_t)(row0 + j) * MIXW + col0;
            *(u32x4*)yr = (u32x4){w[0], w[1], w[2], w[3]}; *(u32x4*)(yr + 8) = (u32x4){w[4], w[5], w[6], w[7]};
            CBAR();
        }
    }
    for (int grp = gw; grp < nrows / 4; grp += ngw) {
        const int srow0 = 4 * grp;
        int base, spos, len; seg_of(srow0, base, spos, len);
        const int is_lat = srow0 < NLAT ? 1 : 0, b = is_lat ? srow0 / SEQ : (srow0 - NLAT) / CTX;
        const int ch0 = 8 * lane, hd = ch0 / 64, wc = (ch0 % 64) / 16, cc0 = ch0 % 16;
        const float dsk = c.in[I_2D][l * 8 + hd];
        float acc[4][8];
#pragma unroll
        for (int d = 0; d < 2; ++d) {
            const int q = d == 0 ? spos : len - 1 - spos, n = chunk_of(is_lat, q), qi = q % 64;
            const bf16_t* fp = OD + OF_S + ((((size_t)((b * 8 + hd) * 2 + d) * NCH + n) * 4 + qi / 16) * 4 + wc) * 256 + ((qi % 16) / 4) * 64 + cc0 * 4;
#pragma unroll
            for (int e = 0; e < 8; ++e) { const f32x4 v = ldb4(fp + e * 4);
#pragma unroll
                for (int j = 0; j < 4; ++j) acc[j][e] = d == 0 ? v[j] : acc[j][e] + v[3 - j]; }
        }
        const float* ng = c.in[I_2NG] + l * 512 + ch0;
        const f32x4 g0 = *(const f32x4*)ng, g1 = *(const f32x4*)(ng + 4);
#pragma unroll
        for (int j = 0; j < 4; ++j) {
            const int srow = srow0 + j, row = tokrow_of_srow(srow);
            const bf16_t* xr = c.xbc() + (size_t)srow * 512 + ch0;
            const bf16_t* ur = U + (size_t)row * INP;
            float yv[8]; float ss = 0.f;
#pragma unroll
            for (int q = 0; q < 2; ++q) { const f32x4 xs = ldb4(xr + 4 * q), z = ldb4(ur + U_Z + ch0 + 4 * q);
#pragma unroll
                for (int e = 0; e < 4; ++e) { const float t = (acc[j][4 * q + e] + dsk * xs[e]) * siluf_(z[e]); yv[4 * q + e] = t; ss += t * t; } }
            ss += RED1(ss); ss += RED2(ss); ss += RED4(ss); ss += RED8(ss); ss += SHFL_XOR_F(ss, 16);
            const float r = 1.0f / sqrtf(ss * (1.0f / 256.f) + EPS);
            *(u32x4*)(c.y() + (size_t)row * MIXW + 1024 + ch0) = (u32x4){pk2(yv[0] * r * g0[0], yv[1] * r * g0[1]), pk2(yv[2] * r * g0[2], yv[3] * r * g0[3]), pk2(yv[4] * r * g1[0], yv[5] * r * g1[1]), pk2(yv[6] * r * g1[2], yv[7] * r * g1[3])};
            CBAR();
        }
    }
}
constexpr int ROUTE_R = 4, ROUTE_LDS = (ROUTE_R * D + ROUTE_R * NE) * 4;
__device__ __forceinline__ void ph_route_w(const Ctx& c, int l, int nrows, LAS float* wlds, int gw, int ngw, int lane, bool dummy = false) {
    LAS float* hv = wlds; LAS float* lgs = wlds + ROUTE_R * D;
    const float* rw = c.in[I_RW] + (size_t)l * D * NE;
    for (int r0 = gw * ROUTE_R; r0 < nrows; r0 += ngw * ROUTE_R) {
#pragma unroll
        for (int q = 0; q < ROUTE_R; ++q) {
            const int row = r0 + q;
            const float* xr = c.x() + (size_t)row * D;
            f32x4 v[RJ];
#pragma unroll
            for (int j = 0; j < RJ; ++j) v[j] = *(const f32x4*)(xr + 4 * lane + 256 * j);
            const float r = row_rms(v);
            const float* m = c.mod(l, mod_row(row));
            row_modulate_store(v, r, c.in[I_N2G] + l * D, m + 3 * D, m + 4 * D, c.h() + (size_t)row * D, lane);
#pragma unroll
            for (int j = 0; j < RJ; ++j) *(LAS f32x4*)(hv + q * D + 4 * lane + 256 * j) = v[j];
        }
        WAVE_SYNC();
        const int e = lane & 31, kh = lane >> 5;
        float acc[ROUTE_R];
#pragma unroll
        for (int q = 0; q < ROUTE_R; ++q) acc[q] = 0.f;
        for (int k = kh * (D / 2); k < (kh + 1) * (D / 2); k += 4) {
            const float w0 = rw[(size_t)(k + 0) * NE + e], w1 = rw[(size_t)(k + 1) * NE + e], w2 = rw[(size_t)(k + 2) * NE + e], w3 = rw[(size_t)(k + 3) * NE + e];
#pragma unroll
            for (int q = 0; q < ROUTE_R; ++q) { const f32x4 hq = *(const LAS f32x4*)(hv + q * D + k); acc[q] += (hq[0] * w0 + hq[1] * w1) + (hq[2] * w2 + hq[3] * w3); }
        }
#pragma unroll
        for (int q = 0; q < ROUTE_R; ++q) { acc[q] += SHFL_XOR_F(acc[q], 32); if (kh == 0) lgs[q * NE + e] = acc[q] + c.in[I_RB][l * NE + e]; }
        WAVE_SYNC();
        if (lane < ROUTE_R) {
            const int row = r0 + lane;
            float lg[NE];
#pragma unroll
            for (int i = 0; i < NE; ++i) lg[i] = lgs[lane * NE + i];
            int te[TOPK]; float tv[TOPK];
#pragma unroll
            for (int kk = 0; kk < TOPK; ++kk) {
                int best = -1; float bv = 0.f;
#pragma unroll
                for (int i = 0; i < NE; ++i) {
                    bool taken = false;
#pragma unroll
                    for (int j = 0; j < kk; ++j) taken = taken || (te[j] == i);
                    if (!taken && (best < 0 || lg[i] > bv)) { best = i; bv = lg[i]; }
                }
                te[kk] = best; tv[kk] = bv;
            }
            float se = 0.f, ex[TOPK];
#pragma unroll
            for (int kk = 0; kk < TOPK; ++kk) { ex[kk] = expf(tv[kk] - tv[0]); se += ex[kk]; }
#pragma unroll
            for (int kk = 0; kk < TOPK; ++kk) {
                c.tope()[row * TOPK + kk] = te[kk];
                c.topg()[row * TOPK + kk] = ex[kk] / se;
                c.pos()[row * TOPK + kk] = atomicAdd(c.cnt(l) + (dummy ? DEPTH * NE * CNTS : 0) + te[kk] * CNTS, 1);
            }
        }
        WAVE_SYNC();
    }
}
template <class TB> __device__ __forceinline__ void ph_rowtok_w(const Ctx& c, int l, int nrows, TB tb, int gt, int gs) {
    for (int it = gt; it < nrows * TOPK; it += gs) {
        const int d = tb[c.tope()[it]] * 256 + c.pos()[it];
        c.dest()[it] = d; c.rtok()[d] = it / TOPK;
    }
    const int* cn = c.cnt(l);
    for (int it = gt; it < NE * 256; it += gs) {
        const int e = it / 256, p = it % 256, n = cn[e * CNTS], nt = (n + 255) / 256;
        if (nt > 0 && (nt - 1) * 256 + p >= n) c.rtok()[tb[e] * 256 + (nt - 1) * 256 + p] = 0;
    }
}
template <int NR> __device__ __forceinline__ void comb_rows(const Ctx& c, int l, const int (&rows)[NR], int lane, bool dummy) {
    typedef int i32x4 __attribute__((ext_vector_type(4)));
    const bool last = (l == DEPTH - 1);
    i32x4 dd[NR]; f32x4 gk[NR];
#pragma unroll
    for (int a = 0; a < NR; ++a) { dd[a] = *(const i32x4*)(c.dest() + rows[a] * TOPK); gk[a] = *(const f32x4*)(c.topg() + rows[a] * TOPK); }
    f32x4 v[NR][RJ];
#pragma unroll
    for (int a = 0; a < NR; ++a) {
        const float* xr = c.x() + (size_t)rows[a] * D;
        const float* m = c.mod(l, mod_row(rows[a])) + 5 * D;
        const bf16_t* y0 = c.yb() + (size_t)dd[a][0] * D; const bf16_t* y1 = c.yb() + (size_t)dd[a][1] * D; const bf16_t* y2 = c.yb() + (size_t)dd[a][2] * D; const bf16_t* y3 = c.yb() + (size_t)dd[a][3] * D;
#pragma unroll
        for (int j = 0; j < RJ; ++j) { const int e0 = 4 * lane + 256 * j;
            const f32x4 s = (ldb4(y0 + e0) * gk[a][0] + ldb4(y1 + e0) * gk[a][1]) + (ldb4(y2 + e0) * gk[a][2] + ldb4(y3 + e0) * gk[a][3]);
            v[a][j] = *(const f32x4*)(xr + e0) + *(const f32x4*)(m + e0) * s; }
    }
#pragma unroll
    for (int a = 0; a < NR; ++a) {
        const int row = rows[a];
        const float r = row_rms(v[a]);
        if (last) {
#pragma unroll
            for (int j = 0; j < RJ; ++j) { const int e0 = 4 * lane + 256 * j; *(f32x4*)(c.out + (size_t)row * D + e0) = v[a][j] * r * *(const f32x4*)(c.in[I_FNG] + e0); }
        } else {
            float* xr = c.x() + (size_t)row * D;
#pragma unroll
            for (int j = 0; j < RJ; ++j) *(f32x4*)((dummy ? c.od2() + (size_t)row * D : xr) + 4 * lane + 256 * j) = v[a][j];
            const float* mn = c.mod(l + 1, mod_row(row));
            row_modulate_store(v[a], r, c.in[I_N1G] + (l + 1) * D, mn, mn + D, c.h() + (size_t)row * D, lane);
        }
    }
}
__device__ __forceinline__ void ph_combine_w(const Ctx& c, int l, int nrows, int gw, int ngw, int lane, bool dummy = false) {
    int row = gw;
    for (; row + 2 * ngw < nrows; row += 3 * ngw) { const int rows[3] = {row, row + ngw, row + 2 * ngw}; comb_rows<3>(c, l, rows, lane, dummy); }
    if (row + ngw < nrows) { const int rows[2] = {row, row + ngw}; comb_rows<2>(c, l, rows, lane, dummy); }
    else if (row < nrows) { const int rows[1] = {row}; comb_rows<1>(c, l, rows, lane, dummy); }
}
__device__ __forceinline__ void ph_mod_w(const Ctx& c, LAS float* tab, int tid, int blk, int G) {
    LAS float* part = tab + (NB + 1) * D;
    for (int i = tid; i < (NB + 1) * D; i += 512) { const int r = i / D, k = i % D; tab[i] = siluf_(r < NB ? c.in[I_C][r * D + k] : c.in[I_CCTX][k]); }
    __syncthreads();
    const int lane = tid & 63, w = tid >> 6;
    for (int cbk = blk; cbk < DEPTH * 6 * D / 64; cbk += G) {
        const int l = cbk / (6 * D / 64), col = (cbk % (6 * D / 64)) * 64 + lane;
        const float* wp = c.in[I_WMOD] + (size_t)l * D * 6 * D + col + (size_t)(w * (D / 8)) * 6 * D;
        float acc[NB + 1];
#pragma unroll
        for (int r = 0; r <= NB; ++r) acc[r] = 0.f;
        for (int k0 = 0; k0 < D / 8; k0 += 16) { float wv[16];
#pragma unroll
            for (int e = 0; e < 16; ++e) wv[e] = wp[(size_t)(k0 + e) * 6 * D];
#pragma unroll
            for (int e = 0; e < 16; ++e)
#pragma unroll
                for (int r = 0; r <= NB; ++r) acc[r] += tab[r * D + w * (D / 8) + k0 + e] * wv[e]; }
#pragma unroll
        for (int r = 0; r <= NB; ++r) part[(w * (NB + 1) + r) * 64 + lane] = acc[r];
        __syncthreads();
        for (int i = tid; i < (NB + 1) * 64; i += 512) { const int r = i / 64, cc = i % 64; float s = 0.f;
#pragma unroll
            for (int ww = 0; ww < 8; ++ww) s += part[(ww * (NB + 1) + r) * 64 + cc];
            const int colo = (cbk % (6 * D / 64)) * 64 + cc;
            c.mod(l, r)[colo] = s + c.in[I_BMOD][l * 6 * D + colo]; }
        __syncthreads();
    }
}
__host__ __device__ __forceinline__ void ph_foldgate(const Ctx& c, int gt, int gs) {
    for (int it = gt; it < DEPTH * (D / 8) * 512; it += gs) {
        const int col = it % 512, k0 = ((it / 512) % (D / 8)) * 8, l = it / (512 * (D / 8)), d = col / 256, cc = col % 256;
        const float* w2 = c.in[I_GW2] + ((size_t)(l * 2 + d) * 16) * 256 + cc;
        float w2r[16];
#pragma unroll
        for (int r = 0; r < 16; ++r) w2r[r] = w2[r * 256];
        float a[8];
#pragma unroll
        for (int e = 0; e < 8; ++e) { const float* wi = c.in[I_WIN] + ((size_t)l * D + k0 + e) * INW + U_GLR + 16 * d; float s = 0.f;
#pragma unroll
            for (int q = 0; q < 4; ++q) { const f32x4 t = *(const f32x4*)(wi + 4 * q); s += t[0] * w2r[4 * q] + t[1] * w2r[4 * q + 1] + t[2] * w2r[4 * q + 2] + t[3] * w2r[4 * q + 3]; }
            a[e] = s; }
        *(u32x4*)(c.win(l) + (size_t)(INW + col) * D + k0) = (u32x4){pk2(a[0], a[1]), pk2(a[2], a[3]), pk2(a[4], a[5]), pk2(a[6], a[7])};
    }
}

__host__ __device__ __forceinline__ void ph_rwsplit(const Ctx& c, int gt, int gs) {
    for (int it = gt; it < DEPTH * NE * D; it += gs) {
        const int e = it % NE, k = (it / NE) % D, l = it / (NE * D);
        const float w = c.in[I_RW][((size_t)l * D + k) * NE + e];
        const unsigned hi = f2bf(w); const float lo = w - bf2f((bf16_t)hi);
        bf16_t* T = c.wsb(WS_RWT) + (size_t)l * 2 * NE * D;
        T[(size_t)e * D + k] = (bf16_t)hi; T[(size_t)(NE + e) * D + k] = (bf16_t)f2bf(lo);
    }
}

__host__ __device__ __forceinline__ u32x4 pack8(const float* v) { return (u32x4){pk2(v[0], v[1]), pk2(v[2], v[3]), pk2(v[4], v[5]), pk2(v[6], v[7])}; }

struct SegC { int base, len, q0; };
__host__ __device__ __forceinline__ SegC seg_of_chunk(int b, int n) { SegC s; if (n < CTX / 64) { s.base = NLAT + b * CTX; s.len = CTX; s.q0 = 64 * n; } else { s.base = b * SEQ; s.len = SEQ; s.q0 = 64 * (n - CTX / 64); } return s; }
__host__ __device__ __forceinline__ int seg_row(const SegC& s, int dir, int q) { return s.base + (dir == 0 ? q : s.len - 1 - q); }
__host__ __device__ __forceinline__ float tap_at(const bf16_t* U, const SegC& s, int dir, int q, int ucol, bool colmajor) {
    const bool ok = q >= 0 && q < s.len; const int qc = q < 0 ? 0 : (q >= s.len ? s.len - 1 : q);
    const int r = seg_row(s, dir, qc);
    const float v = bf2f(U[(size_t)(colmajor ? tokrow_of_srow(r) : r) * INP + ucol]);
    return ok ? v : 0.f;
}

#ifndef CPU_TEST
#define MFMA16(a, b, c) __builtin_amdgcn_mfma_f32_16x16x32_bf16((a), (b), (c), 0, 0, 0)
#else
#define MFMA16(a, b, c) mfma16_emul((a), (b), (c))
#endif
#ifndef CPU_TEST
#define LDS_BAR() do { asm volatile("s_waitcnt lgkmcnt(0)" ::: "memory"); __builtin_amdgcn_s_barrier(); asm volatile("" ::: "memory"); } while (0)
#else
#define LDS_BAR() __syncthreads()
#endif
typedef LAS unsigned char* ldsp_t;
typedef unsigned long long u64_t;
__device__ __forceinline__ bf16x8 lds_rd16(ldsp_t p) { return *(const LAS bf16x8*)p; }
__device__ __forceinline__ bf16x8 lds_rd8x2(ldsp_t p0, ldsp_t p1) { const u64_t a = *(const LAS u64_t*)p0, b = *(const LAS u64_t*)p1; u32x4 v = {(unsigned)a, (unsigned)(a >> 32), (unsigned)b, (unsigned)(b >> 32)}; return __builtin_bit_cast(bf16x8, v); }
template <int KIND> struct ChainCfg {
    static constexpr int DK = KIND == 2 ? 128 : 64, DV = KIND == 2 ? 64 : 128, NCW = DV / 16, KSPLIT = 8 / NCW, KS = DK / 32, KT = DK / 16, KSL = KS / KSPLIT, KTL = KT / KSPLIT, NPC = DK / 64;
    static constexpr int RS_T = DK * 2 + 16, RS_F = 144, OFF_KB = 64 * RS_T, OFF_KDT = 128 * RS_T, OFF_SC = OFF_KDT + DK * RS_F, BUFSZ = OFF_SC + 1024;
    static constexpr int OFF_P = 2 * BUFSZ, OFF_N = OFF_P + 64 * 144, OFF_DEN = OFF_N + 256, OFF_V = OFF_DEN + 1280, RS_V = DV * 2 + 16;
    static constexpr int LDS_NEED = OFF_V + (KIND == 2 ? 4 * 16 * 64 * 4 : 2 * 64 * RS_V);
    static constexpr int SCB = KIND == 0 ? 256 : KIND == 1 ? 1024 : 512;
    static_assert(LDS_NEED <= 139264, "chain LDS");
};
#ifndef CPU_TEST
#define LDS_ADDF(p, v) (void)__hip_atomic_fetch_add((p), (v), __ATOMIC_RELAXED, __HIP_MEMORY_SCOPE_WORKGROUP)
#else
#define LDS_ADDF(p, v) (*(p) += (v))
#endif
template <int KIND> __device__ __forceinline__ void chain_run(const Ctx& c, ldsp_t lds, int cid, int tid, bool noload = false, bool nostore = false) {
    typedef ChainCfg<KIND> CF;
    constexpr int DK = CF::DK, DV = CF::DV, NCW = CF::NCW, KS = CF::KS, KSL = CF::KSL, KTL = CF::KTL, NPC = CF::NPC, RS_T = CF::RS_T, RS_F = CF::RS_F;
    const int lane = tid & 63, w = RFL(tid >> 6), cc = lane & 15, g = lane >> 4;
    const int wc = w % NCW, kh = w / NCW;
    const bool outw = kh == 0;
    const int dir = cid % 2, hh = KIND == 2 ? (cid / 2) % 8 : (cid / 2) % 4, b = KIND == 2 ? cid / 16 : cid / 8;
    constexpr bool SHQ = KIND != 0, SHD = KIND == 2;
    const bool mir = dir == 1;
    const size_t opc = KIND == 2 ? (size_t)((b * 2 + hh / 4) * 2 + (SHQ ? 0 : dir)) * NCH : (size_t)(SHQ ? cid - dir : cid) * NCH;
    const size_t opd = KIND == 2 ? opc : (size_t)cid * NCH;
    const size_t vpc = (size_t)cid * NCH;
    const bf16_t* gQA = c.wsb(KIND == 0 ? WS_GQA : KIND == 1 ? WS_MQA : WS_SQA) + opc * (64 * DK);
    const bf16_t* gKB = c.wsb(KIND == 0 ? WS_GKB : KIND == 1 ? WS_MKB : WS_SKB) + opc * (64 * DK);
    const bf16_t* gKDT = c.wsb(KIND == 0 ? WS_GKDT : KIND == 1 ? WS_MKDT : WS_SKDT) + opd * (64 * DK);
    const bf16_t* gVT = c.wsb(WS_SVT) + vpc * (64 * DV);
    const bf16_t* gU = c.u() + (KIND == 0 ? U_GV : U_MV) + hh * 128;
    const bf16_t* gVHT = c.wsb(WS_SVHT) + vpc * (64 * DV);
    const unsigned char* gSC = (const unsigned char*)(KIND == 0 ? c.wsf(WS_GAL) + vpc * 64 : KIND == 1 ? c.wsf(WS_MMS) + vpc * 256 : c.wsf(WS_SCS) + vpc * 128);
    bf16_t* Og = c.odir() + (KIND == 0 ? OF_G : KIND == 1 ? OF_M : OF_S) + (size_t)cid * NCH * (4 * NCW * 256) + (wc * 64 + lane) * 4;
    LAS float* DEN = (LAS float*)(lds + CF::OFF_DEN);
    LAS float* XR = (LAS float*)(lds + CF::OFF_V);

    f32x4 S[KTL];
#pragma unroll
    for (int kt = 0; kt < KTL; ++kt) S[kt] = (f32x4){0.f, 0.f, 0.f, 0.f};
    float m0 = -1e30f;
    if (KIND == 1 && tid < 64) ((LAS float*)(lds + CF::OFF_N))[tid] = 0.f;

    u32x4 sq[NPC], sk[NPC], sd[NPC], ssc = {0u, 0u, 0u, 0u}, sv[2]; bf16x8 vf[2], vh[2], vfn[2], vhn[2];
#define CHAIN_LOAD(n_) do { const size_t cb_ = (size_t)(n_); const int nm_ = (int)cb_ < CTX / 64 ? CTX / 64 - 1 - (int)cb_ : CTX / 64 + NCH - 1 - (int)cb_; const size_t cq_ = (SHQ && mir) ? (size_t)nm_ : cb_, cd_ = (SHD && mir) ? (size_t)nm_ : cb_; \
        _Pragma("unroll") for (int q = 0; q < NPC; ++q) { const int p = tid + 512 * q; sq[q] = *(const u32x4*)(gQA + cq_ * (64 * DK) + p * 8); sk[q] = *(const u32x4*)(gKB + cq_ * (64 * DK) + p * 8); if (KIND == 1) sd[q] = *(const u32x4*)(gKDT + cd_ * (64 * DK) + p * 8); } \
        if (tid < CF::SCB / 16) ssc = *(const u32x4*)(gSC + cb_ * CF::SCB + tid * 16); \
        if (KIND == 2) { _Pragma("unroll") for (int s = 0; s < 2; ++s) { if (outw) vfn[s] = *(const bf16x8*)(gVT + cb_ * (64 * DV) + (16 * wc + cc) * 64 + 32 * s + 8 * g); vhn[s] = *(const bf16x8*)(gVHT + cb_ * (64 * DV) + (16 * wc + cc) * 64 + 32 * s + 8 * g); } } \
        else { _Pragma("unroll") for (int q = 0; q < 2; ++q) { const int p = tid + 512 * q; sv[q] = *(const u32x4*)(gU + (size_t)scan_row(b, dir, 64 * (int)cb_ + p / 16) * INP + (p % 16) * 8); } } } while (0)
#define CHAIN_STAGE(buf_) do { ldsp_t d_ = lds + (buf_) * CF::BUFSZ; \
        _Pragma("unroll") for (int q = 0; q < NPC; ++q) { const int p = tid + 512 * q; const int rt0 = p / (DK / 8), ct = p % (DK / 8), rt = (SHQ && mir) ? 63 - rt0 : rt0; *(LAS u32x4*)(d_ + rt * RS_T + ct * 16) = sq[q]; *(LAS u32x4*)(d_ + CF::OFF_KB + rt * RS_T + ct * 16) = sk[q]; \
            if (KIND == 1) *(LAS u32x4*)(d_ + CF::OFF_KDT + (p / 8) * RS_F + (p % 8) * 16) = sd[q]; } \
        if (tid < CF::SCB / 16) *(LAS u32x4*)(d_ + CF::OFF_SC + tid * 16) = ssc; \
        if (KIND == 2) { vf[0] = vfn[0]; vf[1] = vfn[1]; vh[0] = vhn[0]; vh[1] = vhn[1]; } \
        else { _Pragma("unroll") for (int q = 0; q < 2; ++q) { const int p = tid + 512 * q; *(LAS u32x4*)(lds + CF::OFF_V + (buf_) * (64 * CF::RS_V) + (p / 16) * CF::RS_V + (p % 16) * 16) = sv[q]; } } } while (0)
    CHAIN_LOAD(0); CHAIN_STAGE(0);
    LDS_BAR();

    for (int n = 0; n < NCH; ++n) {
        ldsp_t cur = lds + (n & 1) * CF::BUFSZ;
        const LAS float* SC = (const LAS float*)(cur + CF::OFF_SC);
        if (n + 1 < NCH && !noload) CHAIN_LOAD(n + 1);
#pragma unroll
        for (int tt = 0; tt < 2; ++tt) {
            const int t = 2 * w + tt, jt = t >> 2, it = t & 3;
            f32x4 acc = {0.f, 0.f, 0.f, 0.f};
#pragma unroll
            for (int s = 0; s < KS; ++s) acc = MFMA16(lds_rd16(cur + CF::OFF_KB + (16 * jt + cc) * RS_T + (32 * s + 8 * g) * 2), lds_rd16(cur + (16 * it + cc) * RS_T + (32 * s + 8 * g) * 2), acc);
            const int i = 16 * it + cc, j0 = 16 * jt + 4 * g;
            float pi = 0.f;
            if (KIND == 1) pi = fmaxf(m0, SC[i * 4 + 2]);
            if (KIND == 2) pi = SC[i * 2];
            float pv[4];
#pragma unroll
            for (int r = 0; r < 4; ++r) { const int j = j0 + r; float d = 1.f;
                if (KIND == 1) d = __expf(SC[j * 4 + 1] - pi);
                if (KIND == 2) d = __expf(pi - SC[j * 2]);
                pv[r] = j <= i ? acc[r] * d : 0.f; }
            const unsigned p01 = pk2(pv[0], pv[1]), p23 = pk2(pv[2], pv[3]);
            *(LAS u64_t*)(lds + CF::OFF_P + i * 144 + j0 * 2) = (u64_t)p01 | ((u64_t)p23 << 32);
            if (KIND == 1) {
                float unp[4]; { unsigned t0 = p01 << 16, t1 = p01 & 0xffff0000u, t2 = p23 << 16, t3 = p23 & 0xffff0000u; __builtin_memcpy(&unp[0], &t0, 4); __builtin_memcpy(&unp[1], &t1, 4); __builtin_memcpy(&unp[2], &t2, 4); __builtin_memcpy(&unp[3], &t3, 4); }
                float rs_ = (unp[0] + unp[1]) + (unp[2] + unp[3]);
                rs_ += SHFL_XOR_F(rs_, 16); rs_ += SHFL_XOR_F(rs_, 32);
                if (g == 0) DEN[jt * 64 + i] = jt <= it ? rs_ : 0.f;
            }
        }
        f32x4 ai[4], ap[4];
        {
            bf16x8 sf[KSL];
#pragma unroll
            for (int s = 0; s < KSL; ++s) { u32x4 v = {pk2(S[2 * s][0], S[2 * s][1]), pk2(S[2 * s][2], S[2 * s][3]), pk2(S[2 * s + 1][0], S[2 * s + 1][1]), pk2(S[2 * s + 1][2], S[2 * s + 1][3])}; sf[s] = __builtin_bit_cast(bf16x8, v); }
#pragma unroll
            for (int it = 0; it < 4; ++it) {
                ai[it] = (f32x4){0.f, 0.f, 0.f, 0.f};
#pragma unroll
                for (int s = 0; s < KSL; ++s) { ldsp_t qa = cur + (16 * it + cc) * RS_T + (32 * (kh * KSL + s) + 4 * g) * 2; ai[it] = MFMA16(lds_rd8x2(qa, qa + 32), sf[s], ai[it]); }
            }
            if (KIND == 2 && !outw) {
#pragma unroll
                for (int it = 0; it < 4; ++it) *(LAS f32x4*)(XR + ((wc * 4 + it) * 64 + lane) * 4) = ai[it];
            }
        }
        if (KIND == 1) {
            const int row = tid >> 3, part = tid & 7;
            const bf16x8 qr = lds_rd16(cur + row * RS_T + part * 16);
            const LAS float* n0 = (const LAS float*)(lds + CF::OFF_N) + part * 8;
            float sqn = 0.f;
#pragma unroll
            for (int e = 0; e < 8; ++e) sqn += bf2f((bf16_t)qr[e]) * n0[e];
            sqn += RED1(sqn); sqn += RED2(sqn); sqn += RED4(sqn);
            if (part == 0) DEN[4 * 64 + row] = __expf(m0 - fmaxf(m0, SC[row * 4 + 2])) * sqn;
        }
        LDS_BAR();
        float c0 = 1.f, c1 = 1.f;
        if (KIND == 1) { const float rL = SC[63 * 4 + 2], ML = fmaxf(m0, rL); c0 = __expf(m0 - ML); c1 = __expf(rL - ML); }
        if (KIND == 2) c0 = __expf(SC[63 * 2]);
        if (KIND == 1) {
            const int krow = tid >> 3, part = tid & 7;
            const bf16x8 kr = lds_rd16(cur + CF::OFF_KDT + krow * RS_F + part * 16);
            float s = 0.f;
#pragma unroll
            for (int e = 0; e < 8; ++e) s += bf2f((bf16_t)kr[e]);
            s += RED1(s); s += RED2(s); s += RED4(s);
            if (part == 0) { LAS float* np = (LAS float*)(lds + CF::OFF_N) + krow; *np = c0 * *np + c1 * s; }
        }
        if (KIND != 2) {
            const LAS bf16_t* vi = (const LAS bf16_t*)(lds + CF::OFF_V + (n & 1) * (64 * CF::RS_V)) + 16 * wc + cc;
#pragma unroll
            for (int s = 0; s < 2; ++s) { unsigned pkd[4];
#pragma unroll
                for (int e = 0; e < 4; ++e) { const unsigned lo_ = vi[(32 * s + 8 * g + 2 * e) * (CF::RS_V / 2)], hi_ = vi[(32 * s + 8 * g + 2 * e + 1) * (CF::RS_V / 2)]; pkd[e] = lo_ | (hi_ << 16); }
                const u32x4 pv_ = {pkd[0], pkd[1], pkd[2], pkd[3]}; vf[s] = __builtin_bit_cast(bf16x8, pv_); }
        }
        if (outw) {
#pragma unroll
            for (int it = 0; it < 4; ++it) {
                if (KIND == 2) ai[it] = ai[it] + *(const LAS f32x4*)(XR + ((wc * 4 + it) * 64 + lane) * 4);
                ap[it] = KIND == 0 ? ai[it] : (f32x4){0.f, 0.f, 0.f, 0.f};
#pragma unroll
                for (int s = 0; s < 2; ++s) ap[it] = MFMA16(lds_rd16(lds + CF::OFF_P + (16 * it + cc) * 144 + (32 * s + 8 * g) * 2), vf[s], ap[it]);
            }
#pragma unroll
            for (int it = 0; it < 4; ++it) {
                f32x4 ov;
                const int i0 = 16 * it + 4 * g;
                if (KIND == 1) {
                    const f32x4 d0 = *(const LAS f32x4*)(DEN + i0), d1 = *(const LAS f32x4*)(DEN + 64 + i0), d2 = *(const LAS f32x4*)(DEN + 128 + i0), d3 = *(const LAS f32x4*)(DEN + 192 + i0), d4 = *(const LAS f32x4*)(DEN + 256 + i0);
                    const f32x4 den4 = ((d0 + d1) + (d2 + d3)) + d4;
#pragma unroll
                    for (int r = 0; r < 4; ++r) { const f32x4 sc = *(const LAS f32x4*)(SC + (i0 + r) * 4);
                        const float Mi = fmaxf(m0, sc[2]);
                        ov[r] = (ap[it][r] + __expf(m0 - Mi) * ai[it][r]) * FRCP(fmaxf(fabsf(den4[r]), __expf(-sc[0] - Mi))); }
                } else {
#pragma unroll
                    for (int r = 0; r < 4; ++r) { float o = ap[it][r]; if (KIND == 2) o = o + __expf(SC[(i0 + r) * 2]) * ai[it][r]; ov[r] = o; }
                }
                if (!nostore) *(u64_t*)(Og + (size_t)((n * 4 + it) * NCW) * 256) = (u64_t)pk2(ov[0], ov[1]) | ((u64_t)pk2(ov[2], ov[3]) << 32);
            }
        }
#pragma unroll
        for (int kt = 0; kt < KTL; ++kt) {
            const int ktg = kh * KTL + kt;
            if (KIND == 2) S[kt] = S[kt] * c0;
            f32x4 T = KIND == 1 ? (f32x4){0.f, 0.f, 0.f, 0.f} : S[kt];
#pragma unroll
            for (int s = 0; s < 2; ++s) {
                bf16x8 ka;
                if (KIND == 1) ka = lds_rd16(cur + CF::OFF_KDT + (16 * ktg + cc) * RS_F + (32 * s + 8 * g) * 2);
                else {
                    const LAS bf16_t* kb = (const LAS bf16_t*)(cur + CF::OFF_KB) + 16 * ktg + cc; unsigned pk_[4];
#pragma unroll
                    for (int e = 0; e < 4; ++e) { const unsigned lo_ = kb[(32 * s + 8 * g + 2 * e) * (RS_T / 2)], hi_ = kb[(32 * s + 8 * g + 2 * e + 1) * (RS_T / 2)]; pk_[e] = lo_ | (hi_ << 16); }
                    const u32x4 kv_ = {pk_[0], pk_[1], pk_[2], pk_[3]}; ka = __builtin_bit_cast(bf16x8, kv_); }
                T = MFMA16(ka, KIND == 2 ? vh[s] : vf[s], T);
            }
            S[kt] = KIND == 1 ? S[kt] * c0 + T * c1 : T;
            if (KIND == 0) { const f32x4 al = *(const LAS f32x4*)(SC + 16 * ktg + 4 * g); S[kt] = S[kt] * al; }
            if (kt & 1) CBAR();
        }
        if (KIND == 1) m0 = SC[63 * 4] + fmaxf(m0, SC[63 * 4 + 2]);
        if (n + 1 < NCH) CHAIN_STAGE((n + 1) & 1);
        LDS_BAR();
    }
#undef CHAIN_LOAD
#undef CHAIN_STAGE
}
__device__ __forceinline__ void ph_chain(const Ctx& c, ldsp_t lds, int blk, int G, int tid, int kmask = 7) {
    const bool noload = false, nostore = (kmask & 8) != 0;
    (void)G;
    const int ch = blk;
    if (ch < NB * 8) { if (kmask & 1) chain_run<0>(c, lds, ch, tid, noload, nostore); }
    else if (ch < NB * 16) { if (kmask & 2) chain_run<1>(c, lds, ch - NB * 8, tid, noload, nostore); }
    else if (ch < NB * 32) { if (kmask & 4) chain_run<2>(c, lds, ch - NB * 16, tid, noload, nostore); }
}

constexpr int ROUTE_M_LDS = 16 * 33 * 4;
__device__ __forceinline__ void ph_route_m(const Ctx& c, int l, int nrows, LAS float* wl, int gw, int ngw, int lane) {
    const int rr = lane & 15, g = lane >> 4;
    const bf16_t* T = c.wsb(WS_RWT) + (size_t)l * 2 * NE * D;
    for (int tile = gw; tile < nrows / 16; tile += ngw) {
        const int row = 16 * tile + rr;
        const float* xr = c.x() + (size_t)row * D + 8 * g;
        const float* m = c.mod(l, mod_row(16 * tile));
        const float* gp = c.in[I_N2G] + l * D + 8 * g; const float* shp = m + 3 * D + 8 * g; const float* scp = m + 4 * D + 8 * g;
        float ss = 0.f;
        { const float* sp = c.wsf(WS_SSP) + (size_t)row * 64 + 16 * g;
#pragma unroll
          for (int q = 0; q < 16; q += 4) { if (16 * g + q < (D / 256) * 16) { const f32x4 t = *(const f32x4*)(sp + q); ss += (t[0] + t[1]) + (t[2] + t[3]); } } }
        ss += SHFL_XOR_F(ss, 16); ss += SHFL_XOR_F(ss, 32);
        const float r = 1.0f / sqrtf(ss * (1.0f / D) + EPS);
        f32x4 acc0 = {0.f, 0.f, 0.f, 0.f}, acc1 = {0.f, 0.f, 0.f, 0.f};
        bf16_t* hr = c.h() + (size_t)row * D + 8 * g;
        for (int s2 = 0; s2 < D / 32; s2 += 2) {
            f32x4 xv[2][2], gv[2][2], hv[2][2], cv[2][2]; bf16x8 bh[2][2], bl[2][2];
#pragma unroll
            for (int u = 0; u < 2; ++u) { const int s = s2 + u;
                xv[u][0] = *(const f32x4*)(xr + 32 * s); xv[u][1] = *(const f32x4*)(xr + 32 * s + 4); gv[u][0] = *(const f32x4*)(gp + 32 * s); gv[u][1] = *(const f32x4*)(gp + 32 * s + 4);
                hv[u][0] = *(const f32x4*)(shp + 32 * s); hv[u][1] = *(const f32x4*)(shp + 32 * s + 4); cv[u][0] = *(const f32x4*)(scp + 32 * s); cv[u][1] = *(const f32x4*)(scp + 32 * s + 4);
                bh[u][0] = *(const bf16x8*)(T + (size_t)rr * D + 32 * s + 8 * g); bh[u][1] = *(const bf16x8*)(T + (size_t)(16 + rr) * D + 32 * s + 8 * g);
                bl[u][0] = *(const bf16x8*)(T + (size_t)(NE + rr) * D + 32 * s + 8 * g); bl[u][1] = *(const bf16x8*)(T + (size_t)(NE + 16 + rr) * D + 32 * s + 8 * g); }
#pragma unroll
            for (int u = 0; u < 2; ++u) { const int s = s2 + u;
                const f32x4 v0 = (xv[u][0] * r * gv[u][0]) * (cv[u][0] + 1.0f) + hv[u][0], v1 = (xv[u][1] * r * gv[u][1]) * (cv[u][1] + 1.0f) + hv[u][1];
                const u32x4 hi = {pk2(v0[0], v0[1]), pk2(v0[2], v0[3]), pk2(v1[0], v1[1]), pk2(v1[2], v1[3])};
                *(u32x4*)(hr + 32 * s) = hi;
                float lo[8];
#pragma unroll
                for (int e = 0; e < 4; ++e) { const unsigned wv = hi[e]; float fl, fh; unsigned t = wv << 16; __builtin_memcpy(&fl, &t, 4); t = wv & 0xffff0000u; __builtin_memcpy(&fh, &t, 4);
                    lo[2 * e] = (e < 2 ? v0[2 * e] : v1[2 * e - 4]) - fl; lo[2 * e + 1] = (e < 2 ? v0[2 * e + 1] : v1[2 * e - 3]) - fh; }
                const u32x4 lov = {pk2(lo[0], lo[1]), pk2(lo[2], lo[3]), pk2(lo[4], lo[5]), pk2(lo[6], lo[7])};
                const bf16x8 ahi = __builtin_bit_cast(bf16x8, hi), alo = __builtin_bit_cast(bf16x8, lov);
                acc0 = MFMA16(ahi, bh[u][0], acc0); acc0 = MFMA16(alo, bh[u][0], acc0); acc0 = MFMA16(ahi, bl[u][0], acc0);
                acc1 = MFMA16(ahi, bh[u][1], acc1); acc1 = MFMA16(alo, bh[u][1], acc1); acc1 = MFMA16(ahi, bl[u][1], acc1); }
            CBAR();
        }
#pragma unroll
        for (int q = 0; q < 4; ++q) { wl[(4 * g + q) * 33 + rr] = acc0[q] + c.in[I_RB][l * NE + rr]; wl[(4 * g + q) * 33 + 16 + rr] = acc1[q] + c.in[I_RB][l * NE + 16 + rr]; }
        WAVE_SYNC();
        if (lane < 16) {
            const int orow = 16 * tile + lane;
            float lg[NE];
#pragma unroll
            for (int i = 0; i < NE; ++i) lg[i] = wl[lane * 33 + i];
            int te[TOPK]; float tv[TOPK];
#pragma unroll
            for (int kk = 0; kk < TOPK; ++kk) {
                int best = -1; float bv = 0.f;
#pragma unroll
                for (int i = 0; i < NE; ++i) {
                    bool taken = false;
#pragma unroll
                    for (int j = 0; j < kk; ++j) taken = taken || (te[j] == i);
                    if (!taken && (best < 0 || lg[i] > bv)) { best = i; bv = lg[i]; }
                }
                te[kk] = best; tv[kk] = bv;
            }
            float se = 0.f, ex[TOPK];
#pragma unroll
            for (int kk = 0; kk < TOPK; ++kk) { ex[kk] = expf(tv[kk] - tv[0]); se += ex[kk]; }
#pragma unroll
            for (int kk = 0; kk < TOPK; ++kk) {
                c.tope()[orow * TOPK + kk] = te[kk];
                c.topg()[orow * TOPK + kk] = ex[kk] / se;
                c.pos()[orow * TOPK + kk] = atomicAdd(c.cnt(l) + te[kk] * CNTS, 1);
            }
        }
        WAVE_SYNC();
    }
}

constexpr int ROUTE_B_LDS = (8 * 16 * 32 + 16 * 33) * 4;
#ifndef CPU_TEST
__device__ __forceinline__ int lds_fetch_inc(LAS int* p) { return __hip_atomic_fetch_add(p, 1, __ATOMIC_RELAXED, __HIP_MEMORY_SCOPE_WORKGROUP); }
#else
static inline int lds_fetch_inc(int* p) { const int o = *p; *p = o + 1; return o; }
#endif
static_assert(TOPK == 4 && 4640 * 4 >= ROUTE_B_LDS, "route LDS map");
__device__ __forceinline__ void ph_route_b(const Ctx& c, int l, int nrows, LAS float* bl, int blk, int G, int tid, bool dummy = false) {
    constexpr int SPW = D / 256, BATCH = SPW >= 4 ? 4 : (SPW >= 2 ? 2 : 1);
    const int lane = tid & 63, w = RFL(tid >> 6), rr = lane & 15, g = lane >> 4;
    const bf16_t* T = c.wsb(WS_RWT) + (size_t)l * 2 * NE * D;
    LAS float* part = bl; LAS float* lgs = bl + 8 * 16 * 32;
    LAS int* sel_e = (LAS int*)(bl + 4640); LAS float* sel_v = bl + 4704;
    LAS int* lcnt = (LAS int*)(bl + 4768); LAS int* lbase = lcnt + 32; LAS unsigned* lrec = (LAS unsigned*)(lbase + 32);
    if (tid < 32) lcnt[tid] = 0;
    int nit = 0;
    for (int tile = blk; tile < nrows / 16; tile += G, ++nit) {
        const int row = 16 * tile + rr;
        const float* xr = c.x() + (size_t)row * D + 8 * g;
        const float* m = c.mod(l, mod_row(16 * tile));
        const float* gp = c.in[I_N2G] + l * D + 8 * g; const float* shp = m + 3 * D + 8 * g; const float* scp = m + 4 * D + 8 * g;
        float ss = 0.f;
        { const float* sp = c.wsf(WS_SSP) + (size_t)row * 64 + 16 * g;
#pragma unroll
          for (int q = 0; q < 16; q += 4) { if (16 * g + q < (D / 256) * 16) { const f32x4 t = *(const f32x4*)(sp + q); ss += (t[0] + t[1]) + (t[2] + t[3]); } } }
        ss += SHFL_XOR_F(ss, 16); ss += SHFL_XOR_F(ss, 32);
        const float r = 1.0f / sqrtf(ss * (1.0f / D) + EPS);
        f32x4 acc0 = {0.f, 0.f, 0.f, 0.f}, acc1 = {0.f, 0.f, 0.f, 0.f};
        bf16_t* hr = c.h() + (size_t)row * D + 8 * g;
        for (int s2 = w * SPW; s2 < (w + 1) * SPW; s2 += BATCH) {
            f32x4 xv[BATCH][2], gv[BATCH][2], hv[BATCH][2], cv[BATCH][2]; bf16x8 bh[BATCH][2], bw[BATCH][2];
#pragma unroll
            for (int u = 0; u < BATCH; ++u) { const int s = s2 + u;
                xv[u][0] = *(const f32x4*)(xr + 32 * s); xv[u][1] = *(const f32x4*)(xr + 32 * s + 4); gv[u][0] = *(const f32x4*)(gp + 32 * s); gv[u][1] = *(const f32x4*)(gp + 32 * s + 4);
                hv[u][0] = *(const f32x4*)(shp + 32 * s); hv[u][1] = *(const f32x4*)(shp + 32 * s + 4); cv[u][0] = *(const f32x4*)(scp + 32 * s); cv[u][1] = *(const f32x4*)(scp + 32 * s + 4);
                bh[u][0] = *(const bf16x8*)(T + (size_t)rr * D + 32 * s + 8 * g); bh[u][1] = *(const bf16x8*)(T + (size_t)(16 + rr) * D + 32 * s + 8 * g);
                bw[u][0] = *(const bf16x8*)(T + (size_t)(NE + rr) * D + 32 * s + 8 * g); bw[u][1] = *(const bf16x8*)(T + (size_t)(NE + 16 + rr) * D + 32 * s + 8 * g); }
#pragma unroll
            for (int u = 0; u < BATCH; ++u) { const int s = s2 + u;
                const f32x4 v0 = (xv[u][0] * r * gv[u][0]) * (cv[u][0] + 1.0f) + hv[u][0], v1 = (xv[u][1] * r * gv[u][1]) * (cv[u][1] + 1.0f) + hv[u][1];
                const u32x4 hi = {pk2(v0[0], v0[1]), pk2(v0[2], v0[3]), pk2(v1[0], v1[1]), pk2(v1[2], v1[3])};
                *(u32x4*)(hr + 32 * s) = hi;
                float lo[8];
#pragma unroll
                for (int e = 0; e < 4; ++e) { const unsigned wv = hi[e]; float fl, fh; unsigned t = wv << 16; __builtin_memcpy(&fl, &t, 4); t = wv & 0xffff0000u; __builtin_memcpy(&fh, &t, 4);
                    lo[2 * e] = (e < 2 ? v0[2 * e] : v1[2 * e - 4]) - fl; lo[2 * e + 1] = (e < 2 ? v0[2 * e + 1] : v1[2 * e - 3]) - fh; }
                const u32x4 lov = {pk2(lo[0], lo[1]), pk2(lo[2], lo[3]), pk2(lo[4], lo[5]), pk2(lo[6], lo[7])};
                const bf16x8 ahi = __builtin_bit_cast(bf16x8, hi), alo = __builtin_bit_cast(bf16x8, lov);
                acc0 = MFMA16(ahi, bh[u][0], acc0); acc0 = MFMA16(alo, bh[u][0], acc0); acc0 = MFMA16(ahi, bw[u][0], acc0);
                acc1 = MFMA16(ahi, bh[u][1], acc1); acc1 = MFMA16(alo, bh[u][1], acc1); acc1 = MFMA16(ahi, bw[u][1], acc1); }
        }
#pragma unroll
        for (int q = 0; q < 4; ++q) { part[(w * 16 + 4 * g + q) * 32 + rr] = acc0[q]; part[(w * 16 + 4 * g + q) * 32 + 16 + rr] = acc1[q]; }
        LDS_BAR();
        { const int prow = tid >> 5, e = tid & 31; float s = c.in[I_RB][l * NE + e];
#pragma unroll
          for (int ww = 0; ww < 8; ++ww) s += part[(ww * 16 + prow) * 32 + e];
          lgs[prow * 33 + e] = s;
          LDS_BAR();
          int rank = 0;
#pragma unroll
          for (int j = 0; j < NE; ++j) { const float v = lgs[prow * 33 + j]; rank += (v > s || (v == s && j < e)) ? 1 : 0; }
          if (rank < TOPK) { sel_e[prow * TOPK + rank] = e; sel_v[prow * TOPK + rank] = s; } }
        LDS_BAR();
        if (tid < 16 * TOPK) {
            const int prow = tid >> 2, kk = tid & 3;
            const float v0 = sel_v[prow * TOPK];
            float se = 0.f;
#pragma unroll
            for (int k2 = 0; k2 < TOPK; ++k2) se += expf(sel_v[prow * TOPK + k2] - v0);
            const int te = sel_e[tid];
            c.tope()[64 * tile + tid] = te;
            c.topg()[64 * tile + tid] = expf(sel_v[tid] - v0) / se;
            lrec[nit * 64 + tid] = ((unsigned)te << 16) | (unsigned)lds_fetch_inc(lcnt + te);
        }
    }
    LDS_BAR();
    if (tid < 32) { const int n = lcnt[tid]; lbase[tid] = n ? atomicAdd(c.cnt(l) + (dummy ? DEPTH * NE * CNTS : 0) + tid * CNTS, n) : 0; }
    LDS_BAR();
    for (int i = tid; i < nit * 64; i += 512) { const int tile = blk + (i >> 6) * G; const unsigned rec = lrec[i]; c.pos()[64 * tile + (i & 63)] = lbase[rec >> 16] + (int)(rec & 0xffffu); }
}

__device__ __forceinline__ void ph_gin_tail(const Ctx& c, int l, LAS float* part, int blk, int G, int tid) {
    constexpr int SPW = D / 256;
    const int lane = tid & 63, w = RFL(tid >> 6), rr = lane & 15, g = lane >> 4;
    const bf16_t* W = c.win(l) + (size_t)(GIN_CT + rr) * D + 32 * (w * SPW) + 8 * g;
    for (int t0 = blk * 4; t0 < NTOK / 16; t0 += G * 4) {
        const bf16_t* A = c.h() + (size_t)(16 * t0 + rr) * D + 32 * (w * SPW) + 8 * g;
        bf16x8 bv[SPW][4], av[4][SPW];
#pragma unroll
        for (int s = 0; s < SPW; ++s)
#pragma unroll
            for (int cb = 0; cb < 4; ++cb) bv[s][cb] = *(const bf16x8*)(W + (size_t)(16 * cb) * D + 32 * s);
#pragma unroll
        for (int t = 0; t < 4; ++t)
#pragma unroll
            for (int s = 0; s < SPW; ++s) av[t][s] = *(const bf16x8*)(A + (size_t)(16 * t) * D + 32 * s);
#pragma unroll
        for (int t = 0; t < 4; ++t) {
            f32x4 a[4];
#pragma unroll
            for (int cb = 0; cb < 4; ++cb) { a[cb] = f32x4{0.f, 0.f, 0.f, 0.f};
#pragma unroll
                for (int s = 0; s < SPW; ++s) a[cb] = MFMA16(av[t][s], bv[s][cb], a[cb]); }
#pragma unroll
            for (int cb = 0; cb < 4; ++cb)
#pragma unroll
                for (int q = 0; q < 4; ++q) part[((w * 4 + t) * 16 + 4 * g + q) * 64 + 16 * cb + rr] = a[cb][q];
        }
        LDS_BAR();
        { const int o = tid * 8, t = o >> 10, row = (o >> 6) & 15, col = o & 63;
          f32x4 s0 = {0.f, 0.f, 0.f, 0.f}, s1 = {0.f, 0.f, 0.f, 0.f};
#pragma unroll
          for (int ww = 0; ww < 8; ++ww) { const LAS float* pp = part + ((ww * 4 + t) * 16 + row) * 64 + col; s0 += *(const LAS f32x4*)pp; s1 += *(const LAS f32x4*)(pp + 4); }
          u32x4 o4; o4.x = pk2(s0[0], s0[1]); o4.y = pk2(s0[2], s0[3]); o4.z = pk2(s1[0], s1[1]); o4.w = pk2(s1[2], s1[3]);
          *(u32x4*)(c.u() + (size_t)(16 * (t0 + t) + row) * INP + GIN_CT + col) = o4; }
        LDS_BAR();
    }
}

__host__ __device__ __forceinline__ f32x4 silu4(f32x4 x) { return (f32x4){siluf_(x[0]), siluf_(x[1]), siluf_(x[2]), siluf_(x[3])}; }
__host__ __device__ __forceinline__ f32x4 exp4(f32x4 x) { return (f32x4){FEXP(x[0]), FEXP(x[1]), FEXP(x[2]), FEXP(x[3])}; }
__host__ __device__ __forceinline__ f32x4 logsig4(f32x4 x) { return (f32x4){logsigmoidf_(x[0]), logsigmoidf_(x[1]), logsigmoidf_(x[2]), logsigmoidf_(x[3])}; }
__host__ __device__ __forceinline__ f32x4 min4(f32x4 x, float m) { return (f32x4){fminf(x[0], m), fminf(x[1], m), fminf(x[2], m), fminf(x[3], m)}; }
__host__ __device__ __forceinline__ u64_t pk4(f32x4 v) { return (u64_t)pk2(v[0], v[1]) | ((u64_t)pk2(v[2], v[3]) << 32); }
__host__ __device__ __forceinline__ f32x4 tap4_at(const bf16_t* U, const SegC& s, int dir, int q, int ucol, bool colmajor) {
    const bool ok = q >= 0 && q < s.len; const int qc = q < 0 ? 0 : (q >= s.len ? s.len - 1 : q);
    const int r = seg_row(s, dir, qc);
    const f32x4 v = ldb4(U + (size_t)(colmajor ? tokrow_of_srow(r) : r) * INP + ucol);
    return ok ? v : (f32x4){0.f, 0.f, 0.f, 0.f};
}
__host__ __device__ __forceinline__ void store_t8(bf16_t* base, int t0, const f32x4 (&x)[8]) {
#pragma unroll
    for (int cc = 0; cc < 4; ++cc) *(u32x4*)(base + cc * 64 + t0) = (u32x4){pk2(x[0][cc], x[1][cc]), pk2(x[2][cc], x[3][cc]), pk2(x[4][cc], x[5][cc]), pk2(x[6][cc], x[7][cc])};
}
__host__ __device__ __forceinline__ u64_t tapraw4_at(const bf16_t* U, const SegC& s, int dir, int q, int ucol, bool colmajor) {
    const int qc = q < 0 ? 0 : (q >= s.len ? s.len - 1 : q); const int r = seg_row(s, dir, qc);
    return *(const u64_t*)(U + (size_t)(colmajor ? tokrow_of_srow(r) : r) * INP + ucol);
}
__host__ __device__ __forceinline__ bf16_t tapraw1_at(const bf16_t* U, const SegC& s, int dir, int q, int ucol, bool colmajor) {
    const int qc = q < 0 ? 0 : (q >= s.len ? s.len - 1 : q); const int r = seg_row(s, dir, qc);
    return U[(size_t)(colmajor ? tokrow_of_srow(r) : r) * INP + ucol];
}
__host__ __device__ __forceinline__ f32x4 tapcvt4(u64_t raw, const SegC& s, int q) { return (q >= 0 && q < s.len) ? cvtb4(raw) : (f32x4){0.f, 0.f, 0.f, 0.f}; }
__host__ __device__ __forceinline__ void ph_prep4(const Ctx& c, int l, int gt, int gs, int sel = 31) {
    const bf16_t* U = c.u();
    const int rot = (int)CH_G * 16;
    const int gt1 = gt, gt2 = (gt + gs - rot % gs) % gs, gt3 = (gt + gs - (3 * rot) % gs) % gs, gt4 = (gt + gs - (5 * rot) % gs) % gs;
    if (sel & 1) for (int it = gt1; it < (int)CH_G * 16; it += gs) {
        const int k = 4 * (it % 16), hh = (it / 16) % 4, n = (it / 64) % NCH, dir = (it / (64 * NCH)) % 2, b = it / (128 * NCH), cid = (b * 4 + hh) * 2 + dir;
        const SegC sg = seg_of_chunk(b, n);
        const int row0 = seg_row(sg, dir, sg.q0), rs = dir == 0 ? 1 : -1;
        const f32x4 bg = *(const f32x4*)(c.in[I_GBG] + (l * 2 + dir) * 256 + hh * 64 + k);
        const size_t cb = ((size_t)cid * NCH + n);
        bf16_t* QA = c.wsb(WS_GQA) + cb * 4096 + k; bf16_t* KB = c.wsb(WS_GKB) + cb * 4096 + k; bf16_t* KDT = c.wsb(WS_GKDT) + cb * 4096 + k * 64;
        const bf16_t* uq = U + (size_t)row0 * INP + U_GQ + hh * 64 + k; const bf16_t* uk = U + (size_t)row0 * INP + U_GK + hh * 64 + k; const bf16_t* ug = U + (size_t)row0 * INP + U_GGK + dir * 256 + hh * 64 + k;
        f32x4 crun = {0.f, 0.f, 0.f, 0.f};
        u64_t nq[8], nk[8], ng[8];
#pragma unroll
        for (int e = 0; e < 8; ++e) { nq[e] = *(const u64_t*)(uq + (long)rs * e * INP); nk[e] = *(const u64_t*)(uk + (long)rs * e * INP); ng[e] = *(const u64_t*)(ug + (long)rs * e * INP); }
        for (int i0 = 0; i0 < 64; i0 += 8) { const int nb = i0 + 8 < 64 ? i0 + 8 : i0;
            u64_t cq[8], ck[8], cg[8]; f32x4 kd[8];
#pragma unroll
            for (int e = 0; e < 8; ++e) { cq[e] = nq[e]; ck[e] = nk[e]; cg[e] = ng[e]; }
#pragma unroll
            for (int e = 0; e < 8; ++e) { nq[e] = *(const u64_t*)(uq + (long)rs * (nb + e) * INP); nk[e] = *(const u64_t*)(uk + (long)rs * (nb + e) * INP); ng[e] = *(const u64_t*)(ug + (long)rs * (nb + e) * INP); }
            CBAR();
#pragma unroll
            for (int e = 0; e < 8; ++e) { crun = crun + logsig4(cvtb4(cg[e]) + bg) * (1.0f / 16.0f);
                kd[e] = cvtb4(ck[e]) * exp4(min4(-crun, 60.f));
                *(u64_t*)(QA + (i0 + e) * 64) = pk4(cvtb4(cq[e]) * 0.125f * exp4(crun)); *(u64_t*)(KB + (i0 + e) * 64) = pk4(kd[e]); }
        }
        *(f32x4*)(c.wsf(WS_GAL) + cb * 64 + k) = exp4(crun);
    }
    if (sel & 4) for (int it = gt2; it < (int)CH_G * 32; it += gs) {
        const int k = 4 * (it % 16), hh = (it / 16) % 4, which = (it / 64) % 2, n = (it / 128) % NCH, dir = (it / (128 * NCH)) % 2, b = it / (256 * NCH), cid = (b * 4 + hh) * 2 + dir;
        if (which == 0 && dir == 1) continue;
        const SegC sg = seg_of_chunk(b, n);
        const int row0 = seg_row(sg, dir, sg.q0), rs = dir == 0 ? 1 : -1;
        const float bi = c.in[I_MBI][l * 8 + dir * 4 + hh], bf = c.in[I_MBF][l * 8 + dir * 4 + hh];
        const bf16_t* MG = U + (size_t)row0 * INP + U_MG + dir * 4 + hh;
        const size_t cb = ((size_t)cid * NCH + n);
        float rmaxL = 0.f;
        if (which == 1) {
            float F = 0.f, rmax = -1e30f; float* MS = c.wsf(WS_MMS) + cb * 256;
            for (int i0 = 0; i0 < 64; i0 += 16) { float ig[16], lf[16];
#pragma unroll
                for (int e = 0; e < 16; ++e) { ig[e] = bf2f(MG[(long)rs * (i0 + e) * INP]); lf[e] = bf2f(MG[(long)rs * (i0 + e) * INP + 8]); }
#pragma unroll
                for (int e = 0; e < 16; ++e) { F += logsigmoidf_(lf[e] + bf); const float bjv = ig[e] + bi - F; rmax = fmaxf(rmax, bjv); if (k == 0) *(f32x4*)(MS + (i0 + e) * 4) = (f32x4){F, bjv, rmax, 0.f}; } }
            rmaxL = rmax;
        }
        bf16_t* OT = c.wsb(which == 0 ? WS_MQA : WS_MKB) + cb * 4096 + k; bf16_t* KDT = c.wsb(WS_MKDT) + cb * 4096 + k * 64;
        const int cch = which * 256 + hh * 64 + k;
        f32x4 w[7];
#pragma unroll
        for (int j = 0; j < 7; ++j) w[j] = *(const f32x4*)(c.in[I_MCW] + ((size_t)l * 7 + (dir == 0 ? j : 6 - j)) * 512 + cch);
        const f32x4 bc = *(const f32x4*)(c.in[I_MCB] + l * 512 + cch);
        f32x4 win[14];
#pragma unroll
        for (int t = 0; t < 6; ++t) win[t] = tap4_at(U, sg, dir, sg.q0 + t - 3, U_MQK + cch, false);
        float F = 0.f;
        u64_t nt[8]; bf16_t ni[8], nf[8];
#pragma unroll
        for (int e = 0; e < 8; ++e) { nt[e] = tapraw4_at(U, sg, dir, sg.q0 + e + 3, U_MQK + cch, false); ni[e] = MG[(long)rs * e * INP]; nf[e] = MG[(long)rs * e * INP + 8]; }
        for (int i0 = 0; i0 < 64; i0 += 8) { const int nb = i0 + 8 < 64 ? i0 + 8 : i0; f32x4 kd[8]; float ig[8], lf[8];
#pragma unroll
            for (int e = 0; e < 8; ++e) { win[6 + e] = tapcvt4(nt[e], sg, sg.q0 + i0 + e + 3); ig[e] = bf2f(ni[e]); lf[e] = bf2f(nf[e]); }
#pragma unroll
            for (int e = 0; e < 8; ++e) { nt[e] = tapraw4_at(U, sg, dir, sg.q0 + nb + e + 3, U_MQK + cch, false); ni[e] = MG[(long)rs * (nb + e) * INP]; nf[e] = MG[(long)rs * (nb + e) * INP + 8]; }
            CBAR();
#pragma unroll
            for (int e = 0; e < 8; ++e) { f32x4 a = bc;
#pragma unroll
                for (int j = 0; j < 7; ++j) a = a + w[j] * win[e + j];
                f32x4 v = silu4(a); if (which == 1) v = v * 0.125f;
                F += logsigmoidf_(lf[e] + bf);
                if (dir == 0) *(u64_t*)(OT + (i0 + e) * 64) = pk4(v);
                kd[e] = v * FEXP(ig[e] + bi - F - rmaxL); }
            if (which == 1) store_t8(KDT, i0, kd);
#pragma unroll
            for (int t = 0; t < 6; ++t) win[t] = win[t + 8]; }
    }
    if (sel & 8) for (int it = gt3; it < (int)CH_SG * 32; it += gs) {
        const int s = 4 * (it % 32), g = (it / 32) % 2, which = (it / 64) % 2, n = (it / 128) % NCH, dir = 0, b = it / (128 * NCH), gid = (b * 2 + g) * 2 + dir;
        const SegC sg = seg_of_chunk(b, n);
        const size_t cb = ((size_t)gid * NCH + n);
        bf16_t* OT = c.wsb(which == 0 ? WS_SKB : WS_SQA) + cb * 8192 + s; bf16_t* KDT = c.wsb(WS_SKDT) + cb * 8192 + s * 64;
        const int cch = 512 + which * 256 + g * 128 + s;
        f32x4 w[7];
#pragma unroll
        for (int j = 0; j < 7; ++j) w[j] = *(const f32x4*)(c.in[I_2CW] + ((size_t)l * 7 + (dir == 0 ? j : 6 - j)) * 1024 + cch);
        const f32x4 bc = *(const f32x4*)(c.in[I_2CB] + l * 1024 + cch);
        f32x4 win[14];
#pragma unroll
        for (int t = 0; t < 6; ++t) win[t] = tap4_at(U, sg, dir, sg.q0 + t - 3, U_XBC + cch, true);
        u64_t nt[8];
#pragma unroll
        for (int e = 0; e < 8; ++e) nt[e] = tapraw4_at(U, sg, dir, sg.q0 + e + 3, U_XBC + cch, true);
        for (int i0 = 0; i0 < 64; i0 += 8) { const int nb = i0 + 8 < 64 ? i0 + 8 : i0; f32x4 v[8];
#pragma unroll
            for (int e = 0; e < 8; ++e) win[6 + e] = tapcvt4(nt[e], sg, sg.q0 + i0 + e + 3);
#pragma unroll
            for (int e = 0; e < 8; ++e) nt[e] = tapraw4_at(U, sg, dir, sg.q0 + nb + e + 3, U_XBC + cch, true);
            CBAR();
#pragma unroll
            for (int e = 0; e < 8; ++e) { f32x4 a = bc;
#pragma unroll
                for (int j = 0; j < 7; ++j) a = a + w[j] * win[e + j];
                v[e] = silu4(a); *(u64_t*)(OT + (i0 + e) * 128) = pk4(v[e]); }
#pragma unroll
            for (int t = 0; t < 6; ++t) win[t] = win[t + 8]; }
    }
    if (sel & 16) for (int it = gt4; it < (int)CH_S * 16; it += gs) {
        const int p = 4 * (it % 16), hh = (it / 16) % 8, n = (it / 128) % NCH, dir = (it / (128 * NCH)) % 2, b = it / (256 * NCH), cid = (b * 8 + hh) * 2 + dir;
        const SegC sg = seg_of_chunk(b, n);
        const float Ah = -expf(c.in[I_2AL][l * 16 + dir * 8 + hh]), dtb = c.in[I_2DTB][l * 16 + dir * 8 + hh];
        const int cdt = U_DT + dir * 8 + hh;
        float cumL = 0.f;
        for (int i0 = 0; i0 < 64; i0 += 16) { float t[16];
#pragma unroll
            for (int e = 0; e < 16; ++e) t[e] = tap_at(U, sg, dir, sg.q0 + i0 + e, cdt, true);
#pragma unroll
            for (int e = 0; e < 16; ++e) cumL += softplusf_(t[e] + dtb) * Ah; }
        const size_t cb = ((size_t)cid * NCH + n);
        bf16_t* VT = c.wsb(WS_SVT) + cb * 4096 + p * 64; bf16_t* VHT = c.wsb(WS_SVHT) + cb * 4096 + p * 64; float* CS = c.wsf(WS_SCS) + cb * 128;
        const int cx = hh * 64 + p;
        f32x4 wx[7];
#pragma unroll
        for (int j = 0; j < 7; ++j) wx[j] = *(const f32x4*)(c.in[I_2CW] + ((size_t)l * 7 + (dir == 0 ? j : 6 - j)) * 1024 + cx);
        const f32x4 bx = *(const f32x4*)(c.in[I_2CB] + l * 1024 + cx);
        f32x4 win[14];
#pragma unroll
        for (int t = 0; t < 6; ++t) win[t] = tap4_at(U, sg, dir, sg.q0 + t - 3, U_XBC + cx, true);
        float crun = 0.f;
        u64_t nt[8]; bf16_t nd[8];
#pragma unroll
        for (int e = 0; e < 8; ++e) { nt[e] = tapraw4_at(U, sg, dir, sg.q0 + e + 3, U_XBC + cx, true); nd[e] = tapraw1_at(U, sg, dir, sg.q0 + e, cdt, true); }
        for (int i0 = 0; i0 < 64; i0 += 8) { const int nb = i0 + 8 < 64 ? i0 + 8 : i0; float dv[8]; f32x4 a[8], h[8];
#pragma unroll
            for (int e = 0; e < 8; ++e) { win[6 + e] = tapcvt4(nt[e], sg, sg.q0 + i0 + e + 3); dv[e] = bf2f(nd[e]); }
#pragma unroll
            for (int e = 0; e < 8; ++e) { nt[e] = tapraw4_at(U, sg, dir, sg.q0 + nb + e + 3, U_XBC + cx, true); nd[e] = tapraw1_at(U, sg, dir, sg.q0 + nb + e, cdt, true); }
            CBAR();
#pragma unroll
            for (int e = 0; e < 8; ++e) { f32x4 ax = bx;
#pragma unroll
                for (int j = 0; j < 7; ++j) ax = ax + wx[j] * win[e + j];
                const f32x4 xs = silu4(ax); const float dtv = softplusf_(dv[e] + dtb);
                crun += dtv * Ah; a[e] = xs * dtv; h[e] = a[e] * FEXP(cumL - crun);
                if (dir == 0) *(u64_t*)(c.xbc() + (size_t)seg_row(sg, 0, sg.q0 + i0 + e) * 512 + cx) = pk4(xs);
                if (p == 0) { CS[(i0 + e) * 2] = crun; CS[(i0 + e) * 2 + 1] = dtv; } }
            store_t8(VT, i0, a); store_t8(VHT, i0, h);
#pragma unroll
            for (int t = 0; t < 6; ++t) win[t] = win[t + 8]; }
    }
}

constexpr int NPH = 11, NSTEPS = 1 + DEPTH * NPH;
enum { PH_NORM1 = 0, PH_GIN, PH_PREP, PH_SCAN, PH_FIN, PH_GOUT, PH_ROUTE, PH_SCAT, PH_G1, PH_G2, PH_COMB };
constexpr int IT_IN = (D / 64) * (INW / 32), IT_OUT = (MIXW / 64) * (D / 32), IT_GU = (D / 64) * (2 * D / 32), IT_DN = (D / 64) * (D / 32);

#ifndef CPU_TEST
constexpr int LDS_BYTES = 147456, LDS_CTL = 139264;
#define LDS_WAIT() asm volatile("s_waitcnt lgkmcnt(0)" ::: "memory")
typedef __attribute__((address_space(1))) u32x4 g_u32x4;

struct TItem { const float* W; bf16_t* WT; int K, N, mode, item; };
constexpr int IT_DENSE = IT_IN + IT_OUT, IT_MOE = NE * (IT_GU + IT_DN);
__device__ __forceinline__ TItem titem_of(const Ctx& c, int layer, int it) {
    TItem t;
    if (layer < 0) { const int l = it / IT_DENSE; int r = it % IT_DENSE;
        if (r < IT_IN) { t.W = c.in[I_WIN] + (size_t)l * D * INW; t.K = D; t.N = INW; t.WT = c.win(l); t.mode = 0; t.item = r; return t; } r -= IT_IN;
        t.W = c.in[I_WOUT] + (size_t)l * MIXW * D; t.K = MIXW; t.N = D; t.WT = c.wout(l); t.mode = 0; t.item = r; return t; }
    const int l = layer, e = it / (IT_GU + IT_DN); int r = it % (IT_GU + IT_DN);
    if (r < IT_GU) { t.W = c.in[I_WGU] + ((size_t)l * NE + e) * D * 2 * D; t.K = D; t.N = 2 * D; t.WT = c.wgu(l) + (size_t)e * 2 * D * D; t.mode = 1; t.item = r; }
    else { t.W = c.in[I_WDN] + ((size_t)l * NE + e) * D * D; t.K = D; t.N = D; t.WT = c.wdn(l) + (size_t)e * D * D; t.mode = 0; t.item = r - IT_GU; }
    return t;
}
__device__ __forceinline__ void titem_load(const TItem& t, float (&v)[32], int lane) {
    const int nblk = t.N / 32, kb = t.item / nblk, nb = t.item % nblk;
    const float* src = t.W + (size_t)(64 * kb + (lane >> 5)) * t.N + 32 * nb + (lane & 31);
#pragma unroll
    for (int i = 0; i < 32; ++i) v[i] = __builtin_nontemporal_load(src + (size_t)(2 * i) * t.N);
}
__device__ __forceinline__ void titem_store(const TItem& t, const float (&v)[32], LAS float* scr, int lane) {
    const int nblk = t.N / 32, kb = t.item / nblk, nb = t.item % nblk, k0 = 64 * kb, n0 = 32 * nb;
#pragma unroll
    for (int i = 0; i < 32; ++i) scr[(2 * i + (lane >> 5)) * 33 + (lane & 31)] = v[i];
    LDS_WAIT(); asm volatile("" ::: "memory");
    const int c = lane & 7;
    const int r0 = t.mode ? gu_row_of_col(n0) : n0;
#pragma unroll
    for (int j = 0; j < 4; ++j) { const int n = (lane >> 3) + 8 * j; const LAS float* s = scr + (8 * c) * 33 + n;
        u32x4 o; o.x = pk2(s[0 * 33], s[1 * 33]); o.y = pk2(s[2 * 33], s[3 * 33]); o.z = pk2(s[4 * 33], s[5 * 33]); o.w = pk2(s[6 * 33], s[7 * 33]);
        __builtin_nontemporal_store(o, (u32x4*)(t.WT + (size_t)(r0 + n) * t.K + k0 + 8 * c)); }
    LDS_WAIT(); asm volatile("" ::: "memory");
}
__device__ __forceinline__ void ph_transposes(const Ctx& c, LAS unsigned char* lds, int layer, int gw, int ngw, int wave, int lane) {
    LAS float* scr = (LAS float*)(lds + wave * 16384);
    const int nit = layer < 0 ? DEPTH * IT_DENSE : IT_MOE;
    int it = gw;
    if (it >= nit) return;
    TItem cur = titem_of(c, layer, it); float va[32], vb[32];
    titem_load(cur, va, lane);
    for (;;) {
        const int nx = it + ngw; const bool more = nx < nit;
        TItem nxt = cur;
        if (more) { nxt = titem_of(c, layer, nx); titem_load(nxt, vb, lane); }
        titem_store(cur, va, scr, lane);
        if (!more) break;
#pragma unroll
        for (int i = 0; i < 32; ++i) va[i] = vb[i];
        cur = nxt; it = nx;
    }
}

#define FRESH() Ctx c; { const KAS Args* kp_ = (const KAS Args*)__builtin_amdgcn_kernarg_segment_ptr(); asm volatile("" : "+s"(kp_)); c.in = kp_->in; c.out = kp_->out; c.ws = kp_->ws; } \
    int lane; asm volatile("v_mbcnt_lo_u32_b32 %0, -1, 0\n\tv_mbcnt_hi_u32_b32 %0, -1, %0" : "=v"(lane)); const int wave = wave_s, tid = wave * 64 + lane, gt = blk * 512 + tid, gs = G * 512; (void)gt; (void)gs;
__global__ void __launch_bounds__(512, 2) mega_fwd(Args args) {
    extern __shared__ __attribute__((aligned(16))) unsigned char lds_raw[];
    LAS unsigned char* lds = (LAS unsigned char*)lds_raw;
    const int G = gridDim.x, blk = blockIdx.x;
    const int wave_s = __builtin_amdgcn_readfirstlane((int)threadIdx.x >> 6);
    const int lo = args.lo, hi = args.hi;
    for (int u = threadIdx.x; u < (LDS_BYTES - LDS_CTL) / 4; u += 512) ((LAS unsigned*)(lds + LDS_CTL))[u] = 0u;
    __syncthreads();
    volatile LAS unsigned* xbw = (volatile LAS unsigned*)(lds + LDS_CTL + 1024);
    unsigned* barw = (unsigned*)(args.ws + WS_CTL) + CW_BAR + args.li * XCD_BAR_WORDS;
    XcdBarrier bar; bar.bar = barw; bar.x = 0; bar.st = xbw;
    if (hi - lo > 1) bar = xcd_barrier_post(barw, xbw);
    LAS int* tb = (LAS int*)(lds + LDS_CTL + 2048);
    static_assert(2048 + TB_WORDS * 4 <= 4096 && 4096 + NE * 4 <= LDS_BYTES - LDS_CTL, "LDS control region");
#ifndef PHASE_MASK
#define PHASE_MASK 0xFFFFu
#endif
#define EN(p) (((PHASE_MASK) >> (p)) & 1u)
#ifndef DUP_MASK
#define DUP_MASK 0u
#endif
#define DUP(p) (((DUP_MASK) >> (p)) & 1u)
#define IN(s) (lo <= (s) && (s) < hi)
#define SEAM(s) do { if (IN(s) && IN((s) + 1)) xcd_barrier(bar); } while (0)

    if (EN(12) && IN(0)) {
        FRESH();
        const int psel = (hi == 1) ? args.pad : 15;
        if (psel & 1) ph_transposes(c, lds, -1, blk * 8 + wave, G * 8, wave, lane);
        __syncthreads();
        if (psel & 2) ph_mod_w(c, (LAS float*)lds, tid, blk, G);
        if (psel & 8) { ph_foldgate(c, gt, gs); ph_rwsplit(c, gt, gs); }
    }
    SEAM(0);
    for (int l = 0; l < DEPTH; ++l) {
        const int s0 = 1 + l * NPH;
        const bool last = (l == DEPTH - 1);
        const int nrows = last ? NLAT : NTOK;
        if (l == 0) {
            if (EN(PH_NORM1) && IN(s0 + PH_NORM1)) { FRESH(); ph_norm1_w(c, l, blk * 8 + wave, G * 8, lane); }
            SEAM(s0 + PH_NORM1);
        }
        if (EN(PH_GIN) && IN(s0 + PH_GIN)) {
            FRESH();
            { pg8::Gemm g{c.h(), c.win(l), NTOK, GIN_CT, D}; DenseOrder S; S.init(NTOK, GIN_CT, G, blk);
              EpiU E{c.u(), INP};
              pg8::gemm_phase<EpiU, DenseOrder, true, true>(lds, g, S, E, tid); }
            __syncthreads();
            ph_gin_tail(c, l, (LAS float*)lds, blk, G, tid);
        }
        SEAM(s0 + PH_GIN);
        if (EN(PH_PREP) && IN(s0 + PH_PREP)) { FRESH(); ph_prep4(c, l, gt, gs, (args.li > 0 && s0 + PH_PREP == lo) ? args.pad : 31); }
        SEAM(s0 + PH_PREP);
        if (EN(PH_SCAN) && IN(s0 + PH_SCAN)) { FRESH(); ph_chain(c, lds, blk, G, tid, (hi == s0 + PH_SCAN + 1 && args.pad >= 64) ? (args.pad & 15) : 7); }
        SEAM(s0 + PH_SCAN);
        if (EN(PH_FIN) && IN(s0 + PH_FIN)) { FRESH(); ph_finish_w(c, l, nrows, blk * 8 + wave, G * 8, lane); if (DUP(PH_FIN)) ph_finish_w(c, l, nrows, blk * 8 + wave, G * 8, lane); }
        SEAM(s0 + PH_FIN);
        if (EN(PH_GOUT) && IN(s0 + PH_GOUT)) {
            FRESH();
            pg8::Gemm g{c.y(), c.wout(l), nrows, D, MIXW}; DenseOrder S; S.init(nrows, D, G, blk);
            EpiResid E{c.x(), c.mod(l, 0), c.wsf(WS_SSP)};
            pg8::gemm_phase<EpiResid, DenseOrder, true, true>(lds, g, S, E, tid);
        }
        SEAM(s0 + PH_GOUT);
        if (EN(PH_ROUTE) && IN(s0 + PH_ROUTE)) { FRESH(); if (DUP(PH_ROUTE)) { ph_route_b(c, l, nrows, (LAS float*)lds, blk, G, tid, true); __syncthreads(); } ph_route_b(c, l, nrows, (LAS float*)lds, blk, G, tid); }
        SEAM(s0 + PH_ROUTE);
        if (IN(s0 + PH_SCAT) || IN(s0 + PH_G1) || IN(s0 + PH_G2)) {
            FRESH();
            LAS int* ntl = (LAS int*)(lds + LDS_CTL + 4096);
            if (tid < NE) ntl[tid] = (c.cnt(l)[tid * CNTS] + 255) / 256;
            __syncthreads();
            if (tid < NE) { int a = 0; for (int e = 0; e < NE; ++e) a += (e < tid) ? ntl[e] : 0; tb[tid] = a; const int nt = ntl[tid]; for (int t = 0; t < nt; ++t) tb[NE + 1 + a + t] = tid; if (tid == NE - 1) tb[NE] = a + nt; }
            __syncthreads();
        }
        if (EN(PH_SCAT) && IN(s0 + PH_SCAT)) { FRESH(); ph_rowtok_w(c, l, nrows, (const LAS int*)tb, gt, gs); ph_transposes(c, lds, l, blk * 8 + wave, G * 8, wave, lane); }
        SEAM(s0 + PH_SCAT);
        if (EN(PH_G1) && IN(s0 + PH_G1)) {
            FRESH();
            LAS unsigned short* gtab = (LAS unsigned short*)(lds + 131072);
            MoeOrderG<const LAS int*, const LAS unsigned short*> S(tb, 2 * D / 256, G, blk, gtab, c.rtok());
            { pg8::Unit uu; const int* rt_ = c.rtok(); for (int i = 0; i < 16 && S.next(i, uu); ++i) if ((i & 7) == wave) {
                  const int* rp = rt_ + uu.pm * 256 + lane; const int v0 = rp[0], v1 = rp[64], v2 = rp[128], v3 = rp[192];
                  LAS unsigned short* gp = gtab + i * 256 + lane; gp[0] = (unsigned short)v0; gp[64] = (unsigned short)v1; gp[128] = (unsigned short)v2; gp[192] = (unsigned short)v3; } }
            __syncthreads();
            pg8::Gemm g{c.h(), c.wgu(l), NTOK, NE * 2 * D, D};
            EpiSwiglu E{c.act(), c.in[I_BGU] + (size_t)l * NE * 2 * D};
            pg8::gemm_phase<EpiSwiglu, MoeOrderG<const LAS int*, const LAS unsigned short*>, true, true>(lds, g, S, E, tid);
        }
        SEAM(s0 + PH_G1);
        if (EN(PH_G2) && IN(s0 + PH_G2)) {
            FRESH();
            pg8::Gemm g{c.act(), c.wdn(l), MAXROWS, NE * D, D}; MoeOrder<const LAS int*> S{tb, D / 256, G, blk, 8, 0};
            EpiDown E{c.yb(), c.in[I_BDN] + (size_t)l * NE * D};
            pg8::gemm_phase<EpiDown, MoeOrder<const LAS int*>, true, true>(lds, g, S, E, tid);
            if (DUP(PH_G2)) pg8::gemm_phase<EpiDown, MoeOrder<const LAS int*>, true, true>(lds, g, S, E, tid);
        }
        SEAM(s0 + PH_G2);
        if (EN(PH_COMB) && IN(s0 + PH_COMB)) { FRESH(); if (DUP(PH_COMB) && l < DEPTH - 1) ph_combine_w(c, l, nrows, blk * 8 + wave, G * 8, lane, true); ph_combine_w(c, l, nrows, blk * 8 + wave, G * 8, lane); }
        SEAM(s0 + PH_COMB);
    }
#undef IN
#undef SEAM
}

#ifndef MK_MULTI
#define MK_MULTI 0
#endif
extern "C" void kernel_launch(void* const* d_in, const int* in_sizes, int n_in, void* d_out, int out_size, void* d_ws, size_t ws_size, hipStream_t stream) {
    static int grid = 0;
    if (grid == 0) {
        if (n_in != N_IN || out_size != NLAT * D || ws_size < WS_END) { fprintf(stderr, "kernel_launch: unexpected shapes (n_in %d out %d ws %zu need %zu)\n", n_in, out_size, ws_size, (size_t)WS_END); grid = -1; return; }
        int dev = 0, cus = 0;
        if (hipGetDevice(&dev) != hipSuccess || hipDeviceGetAttribute(&cus, hipDeviceAttributeMultiprocessorCount, dev) != hipSuccess) { grid = -1; return; }
        if (hipFuncSetAttribute((const void*)mega_fwd, hipFuncAttributeMaxDynamicSharedMemorySize, LDS_BYTES) != hipSuccess) { fprintf(stderr, "kernel_launch: hipFuncSetAttribute failed\n"); grid = -1; return; }
        int per_cu = 0;
        (void)hipOccupancyMaxActiveBlocksPerMultiprocessor(&per_cu, (const void*)mega_fwd, 512, LDS_BYTES);
        (void)hipGetLastError();
        grid = cus;
        if (grid < NB * 32) { fprintf(stderr, "kernel_launch: needs at least %d CUs (one scan chain per workgroup), device has %d\n", NB * 32, cus); grid = -1; return; }
    }
    if (grid < 0) return;
    (void)hipMemsetAsync((char*)d_ws + WS_CTL, 0, CTL_BYTES, stream);
    Args a{};
    for (int i = 0; i < N_IN; ++i) a.in[i] = (const float*)d_in[i];
    a.out = (float*)d_out; a.ws = (unsigned char*)d_ws;
#if MK_MULTI
    for (int s = 0; s < NSTEPS; ++s) { a.lo = s; a.hi = s + 1; hipLaunchKernelGGL(mega_fwd, dim3(grid), dim3(512), LDS_BYTES, stream, a); }
#elif defined(PROBE_PRO)
    a.lo = 0; a.hi = 1; a.li = 0; a.pad = PROBE_PRO; hipLaunchKernelGGL(mega_fwd, dim3(grid), dim3(512), LDS_BYTES, stream, a);
    a.lo = 0; a.hi = NSTEPS; a.li = 1; a.pad = 0; hipLaunchKernelGGL(mega_fwd, dim3(grid), dim3(512), LDS_BYTES, stream, a);
#elif defined(PROBE_PH)
    { int lo = 0; for (int l = 0; l <= DEPTH; ++l) { const int s = 1 + l * NPH + PROBE_PH; a.lo = lo; a.hi = l < DEPTH ? s + 1 : NSTEPS; a.li = l; a.pad = PROBE_SEL; hipLaunchKernelGGL(mega_fwd, dim3(grid), dim3(512), LDS_BYTES, stream, a); lo = s; } }
#else
    a.lo = 0; a.hi = NSTEPS;
    hipLaunchKernelGGL(mega_fwd, dim3(grid), dim3(512), LDS_BYTES, stream, a);
#endif
}

#else
static void transposes_cpu(const Ctx& c) {
    for (int l = 0; l < DEPTH; ++l) {
        for (int k = 0; k < D; ++k) for (int n = 0; n < INW; ++n) c.win(l)[(size_t)n * D + k] = (bf16_t)f2bf(c.in[I_WIN][((size_t)l * D + k) * INW + n]);
        for (int k = 0; k < MIXW; ++k) for (int n = 0; n < D; ++n) c.wout(l)[(size_t)n * MIXW + k] = (bf16_t)f2bf(c.in[I_WOUT][((size_t)l * MIXW + k) * D + n]);
        for (int e = 0; e < NE; ++e) {
            for (int k = 0; k < D; ++k) for (int n = 0; n < 2 * D; ++n) c.wgu(l)[((size_t)e * 2 * D + gu_row_of_col(n)) * D + k] = (bf16_t)f2bf(c.in[I_WGU][(((size_t)l * NE + e) * D + k) * 2 * D + n]);
            for (int k = 0; k < D; ++k) for (int n = 0; n < D; ++n) c.wdn(l)[((size_t)e * D + n) * D + k] = (bf16_t)f2bf(c.in[I_WDN][(((size_t)l * NE + e) * D + k) * D + n]);
        }
    }
}
template <class Sched> static int gemm_cpu_arow(const Sched& S, const pg8::Unit& u, int r) { if constexpr (Sched::GATHER) return S.rowtok[u.pm * 256 + r]; else return u.pm * 256 + r; }
template <class Epi, class Sched> static void gemm_cpu(const pg8::Gemm& g, Sched S, const Epi& E, int G) {
    static float T[256][256];
    for (int cblk = 0; cblk < G; ++cblk) {
        S.c = cblk;
        for (int i = 0;; ++i) {
            pg8::Unit u; if (!S.next(i, u)) break;
            for (int r = 0; r < 256; ++r) for (int cc = 0; cc < 256; ++cc) {
                const bf16_t* a = g.A + (size_t)gemm_cpu_arow(S, u, r) * g.K; const bf16_t* b = g.Bt + (size_t)(u.pn * 256 + cc) * g.K;
                float s = 0.f; for (int k = 0; k < g.K; ++k) s += bf2f(a[k]) * bf2f(b[k]);
                T[r][cc] = s;
            }
            for (int wid = 0; wid < 8; ++wid) for (int lane = 0; lane < 64; ++lane) {
                const int wr = wid >> 2, wc = wid & 3, fr = lane & 15, fq = lane >> 4;
                accq acc[2][2][4][2];
                for (int ai = 0; ai < 2; ++ai) for (int bj = 0; bj < 2; ++bj) for (int m = 0; m < 4; ++m) for (int n = 0; n < 2; ++n) for (int j = 0; j < 4; ++j) {
                    const int r = 128 * ai + 64 * wr + 16 * m + fr;
                    const int cc = Epi::PERM ? 128 * bj + 32 * wc + 8 * fq + 4 * n + j : 128 * bj + 32 * wc + 16 * n + 4 * fq + j;
                    acc[ai][bj][m][n][j] = T[r][cc];
                }
                E(acc, u, wr, wc, fr, fq);
            }
        }
    }
}
constexpr int LDS_BYTES = 147456;
#define COOP(G_, body_) simt::launch(G_, 512, LDS_BYTES, [&]() { const int tid = threadIdx.x, lane = tid & 63, wave = tid >> 6, blk = blockIdx.x, G = gridDim.x; unsigned char* lds = simt::lds_base; (void)lane; (void)wave; (void)blk; (void)G; (void)lds; body_; })
extern "C" void kernel_launch(void* const* d_in, const int* in_sizes, int n_in, void* d_out, int out_size, void* d_ws, size_t ws_size, hipStream_t stream) {
    Ctx c; c.in = (const float* const*)d_in; c.out = (float*)d_out; c.ws = (unsigned char*)d_ws;
    memset((char*)d_ws + WS_CTL, 0, CTL_BYTES);
    const int G = 256, GC = 8;
    transposes_cpu(c);
    COOP(GC, { ph_mod_w(c, (float*)lds, tid, blk, G); });
    ph_foldgate(c, 0, 1); ph_rwsplit(c, 0, 1);
    for (int l = 0; l < DEPTH; ++l) {
        const bool last = (l == DEPTH - 1); const int nrows = last ? NLAT : NTOK;
        if (l == 0) COOP(GC, ph_norm1_w(c, l, blk * 8 + wave, G * 8, lane));
        { pg8::Gemm g{c.h(), c.win(l), NTOK, GIN_CT, D}; DenseOrder S; S.init(NTOK, GIN_CT, G, 0); EpiU E{c.u(), INP}; gemm_cpu(g, S, E, G); }
        COOP(GC, ph_gin_tail(c, l, (float*)lds, blk, G, tid));
        ph_prep4(c, l, 0, 1);
        COOP(NB * 32, ph_chain(c, lds, blk, G, tid));
        COOP(GC, ph_finish_w(c, l, nrows, blk * 8 + wave, G * 8, lane));
        { pg8::Gemm g{c.y(), c.wout(l), nrows, D, MIXW}; DenseOrder S; S.init(nrows, D, G, 0); EpiResid E{c.x(), c.mod(l, 0), c.wsf(WS_SSP)}; gemm_cpu(g, S, E, G); }
        COOP(GC, ph_route_b(c, l, nrows, (float*)lds, blk, G, tid));
        int tb[TB_WORDS]; expert_tile_base(c.cnt(l), tb);
        COOP(GC, ph_rowtok_w(c, l, nrows, (const int*)tb, blk * 512 + tid, G * 512));
        { pg8::Gemm g{c.h(), c.wgu(l), NTOK, NE * 2 * D, D}; MoeOrderG<const int*, const unsigned short*> S(tb, 2 * D / 256, G, 0, nullptr, c.rtok()); EpiSwiglu E{c.act(), c.in[I_BGU] + (size_t)l * NE * 2 * D}; gemm_cpu(g, S, E, G); }
        { pg8::Gemm g{c.act(), c.wdn(l), MAXROWS, NE * D, D}; MoeOrder<const int*> S{tb, D / 256, G, 0}; EpiDown E{c.yb(), c.in[I_BDN] + (size_t)l * NE * D}; gemm_cpu(g, S, E, G); }
        COOP(GC, ph_combine_w(c, l, nrows, blk * 8 + wave, G * 8, lane));
    }
}
#endif
```

```cpp
#ifndef CPU_TEST
#include <hip/hip_runtime.h>
#else
#include "cpu_shim.h"
#endif
#include <cstdio>
#include <cstdint>
#include <cmath>

#ifndef CFG_D
#define CFG_D 1024
#define CFG_B 8
#define CFG_SEQ 2048
#define CFG_DEPTH 4
#define CFG_CTX 256
#endif
constexpr int D = CFG_D, NB = CFG_B, SEQ = CFG_SEQ, DEPTH = CFG_DEPTH, CTX = CFG_CTX;
constexpr int GRID_W = 64, ROWS = SEQ / GRID_W;
constexpr int NLAT = NB * SEQ, NCTX = NB * CTX, NTOK = NLAT + NCTX;
constexpr int INW = 4672, INWX = 5184, INP = 5376, MIXW = 1536, NE = 32, TOPK = 4;
constexpr int U_GQ = 0, U_GK = 256, U_GV = 512, U_GG = 1024, U_GLR = 1536;
constexpr int U_MQK = 1568, U_MV = 2080, U_MO = 2592, U_MG = 3104;
constexpr int U_Z = 3120, U_XBC = 3632, U_DT = 4656, U_GGK = 4672;
constexpr float EPS = 1e-6f;
constexpr int MAXROWS = NTOK * TOPK + NE * 256;
static_assert(NTOK % 256 == 0 && NLAT % 256 == 0 && D % 128 == 0 && D >= 256, "shape");

constexpr size_t al256(size_t x) { return (x + 255) & ~(size_t)255; }
constexpr size_t WS_CTL = 0, CTL_BYTES = 1u << 20;
constexpr size_t WS_MOD = WS_CTL + CTL_BYTES;
constexpr size_t WS_WIN = al256(WS_MOD + (size_t)DEPTH * (NB + 1) * 6 * D * 4);
constexpr size_t WS_WOUT = al256(WS_WIN + (size_t)DEPTH * INP * D * 2);
constexpr size_t WS_WGU = al256(WS_WOUT + (size_t)DEPTH * D * MIXW * 2);
constexpr size_t WS_WDN = al256(WS_WGU + (size_t)DEPTH * NE * 2 * D * D * 2);
constexpr size_t WS_X = al256(WS_WDN + (size_t)DEPTH * NE * D * D * 2);
constexpr size_t WS_H = al256(WS_X + (size_t)NTOK * D * 4);
constexpr size_t WS_U = al256(WS_H + (size_t)NTOK * D * 2);
constexpr size_t WS_GLA_A = al256(WS_U + (size_t)NTOK * INP * 4);
constexpr size_t WS_ML_QK = al256(WS_GLA_A + (size_t)2 * NTOK * 256 * 4);
constexpr size_t WS_ML_G = al256(WS_ML_QK + (size_t)NTOK * 512 * 4);
constexpr size_t WS_XBC = al256(WS_ML_G + (size_t)NTOK * 16 * 4);
constexpr size_t WS_DT = al256(WS_XBC + (size_t)NTOK * 1024 * 4);
constexpr size_t WS_ODIR = al256(WS_DT + (size_t)NTOK * 16 * 4);
constexpr size_t WS_OD2 = al256(WS_ODIR + (size_t)2 * NTOK * MIXW * 4);
constexpr size_t WS_Y = al256(WS_OD2 + (size_t)2 * NTOK * 512 * 4);
constexpr size_t WS_TOPE = al256(WS_Y + (size_t)NTOK * MIXW * 2);
constexpr size_t WS_TOPG = al256(WS_TOPE + (size_t)NTOK * 4 * 4);
constexpr size_t WS_POS = al256(WS_TOPG + (size_t)NTOK * 4 * 4);
constexpr size_t WS_DEST = al256(WS_POS + (size_t)NTOK * 4 * 4);
constexpr size_t WS_XS = al256(WS_DEST + (size_t)NTOK * 4 * 4);
constexpr size_t WS_ACT = al256(WS_XS + (size_t)MAXROWS * D * 2);
constexpr size_t WS_YB = al256(WS_ACT + (size_t)MAXROWS * D * 2);
constexpr int NCH = (CTX + SEQ) / 64;
static_assert(CTX % 64 == 0 && SEQ % 64 == 0, "chunking");
constexpr size_t CH_G = (size_t)NB * 4 * 2 * NCH, CH_S = (size_t)NB * 8 * 2 * NCH, CH_SG = (size_t)NB * 2 * 2 * NCH;
constexpr size_t WS_GQA = al256(WS_YB + (size_t)MAXROWS * D * 4);
constexpr size_t WS_GKB = al256(WS_GQA + CH_G * 4096 * 2);
constexpr size_t WS_GKDT = al256(WS_GKB + CH_G * 4096 * 2);
constexpr size_t WS_GVT = al256(WS_GKDT + CH_G * 4096 * 2);
constexpr size_t WS_GAL = al256(WS_GVT + CH_G * 8192 * 2);
constexpr size_t WS_MQA = al256(WS_GAL + CH_G * 64 * 4);
constexpr size_t WS_MKB = al256(WS_MQA + CH_G * 4096 * 2);
constexpr size_t WS_MKDT = al256(WS_MKB + CH_G * 4096 * 2);
constexpr size_t WS_MVT = al256(WS_MKDT + CH_G * 4096 * 2);
constexpr size_t WS_MMS = al256(WS_MVT + CH_G * 8192 * 2);
constexpr size_t WS_SQA = al256(WS_MMS + CH_G * 256 * 4);
constexpr size_t WS_SKB = al256(WS_SQA + CH_SG * 8192 * 2);
constexpr size_t WS_SKDT = al256(WS_SKB + CH_SG * 8192 * 2);
constexpr size_t WS_SVT = al256(WS_SKDT + CH_SG * 8192 * 2);
constexpr size_t WS_SVHT = al256(WS_SVT + CH_S * 4096 * 2);
constexpr size_t WS_SCS = al256(WS_SVHT + CH_S * 4096 * 2);
constexpr size_t WS_RWT = al256(WS_SCS + CH_S * 128 * 4);
constexpr size_t WS_SSP = al256(WS_RWT + (size_t)DEPTH * 2 * NE * D * 2);
constexpr size_t WS_RTOK = al256(WS_SSP + (size_t)NTOK * 64 * 4);
constexpr size_t WS_END = al256(WS_RTOK + (size_t)MAXROWS * 4);
static_assert(D == 1024 || D == 256, "ssp slots assume D / 256 <= 4 column tiles");
constexpr int CW_BAR = 4096;
constexpr int CW_CNT = 131072, CNTS = 256;

enum { I_X = 0, I_C, I_CTX, I_CCTX, I_WMOD, I_BMOD, I_N1G, I_WIN, I_GW2, I_GBG, I_GNG, I_MCW, I_MCB, I_MBI, I_MBF, I_MNG,
       I_2CW, I_2CB, I_2DTB, I_2AL, I_2D, I_2NG, I_WOUT, I_N2G, I_RW, I_RB, I_WGU, I_BGU, I_WDN, I_BDN, I_FNG, N_IN };

struct Args { const float* in[N_IN]; float* out; unsigned char* ws; int lo, hi, li, pad; };

#ifndef CPU_TEST
#define KAS __attribute__((address_space(4)))
#else
#define KAS
#endif
typedef unsigned short bf16_t;
typedef float f32x4 __attribute__((ext_vector_type(4)));
typedef unsigned u32x4 __attribute__((ext_vector_type(4)));
typedef short bf16x8 __attribute__((ext_vector_type(8)));

__host__ __device__ __forceinline__ unsigned f2bf(float f) { unsigned u; __builtin_memcpy(&u, &f, 4); return (u + 0x7fffu + ((u >> 16) & 1u)) >> 16; }
#ifndef CPU_TEST
__device__ __forceinline__ unsigned pk2(float lo, float hi) { unsigned r; asm("v_cvt_pk_bf16_f32 %0, %1, %2" : "=v"(r) : "v"(lo), "v"(hi)); return r; }
#else
__host__ __device__ __forceinline__ unsigned pk2(float lo, float hi) { return f2bf(lo) | (f2bf(hi) << 16); }
#endif
__host__ __device__ __forceinline__ float bf2f(bf16_t b) { unsigned u = ((unsigned)b) << 16; float f; __builtin_memcpy(&f, &u, 4); return f; }
#ifndef CPU_TEST
#define FEXP(x) __expf(x)
#define FLOG(x) __logf(x)
#define FRCP(x) __builtin_amdgcn_rcpf(x)
#else
#define FEXP(x) expf(x)
#define FLOG(x) logf(x)
#define FRCP(x) (1.0f / (x))
#endif
__host__ __device__ __forceinline__ float sigmoidf_(float x) { return FRCP(1.0f + FEXP(-x)); }
__host__ __device__ __forceinline__ float siluf_(float x) { return x * sigmoidf_(x); }
__host__ __device__ __forceinline__ float logsigmoidf_(float x) { return fminf(x, 0.f) - FLOG(1.0f + FEXP(-fabsf(x))); }
__host__ __device__ __forceinline__ float softplusf_(float x) { return fmaxf(x, 0.f) + FLOG(1.0f + FEXP(-fabsf(x))); }

__host__ __device__ __forceinline__ f32x4 cvtb4(unsigned long long w) { const unsigned lo = (unsigned)w, hi = (unsigned)(w >> 32); f32x4 r;
    unsigned t; float f; t = lo << 16; __builtin_memcpy(&f, &t, 4); r[0] = f; t = lo & 0xffff0000u; __builtin_memcpy(&f, &t, 4); r[1] = f; t = hi << 16; __builtin_memcpy(&f, &t, 4); r[2] = f; t = hi & 0xffff0000u; __builtin_memcpy(&f, &t, 4); r[3] = f; return r; }
__host__ __device__ __forceinline__ f32x4 ldb4(const bf16_t* p) { const unsigned long long w = *(const unsigned long long*)p; const unsigned lo = (unsigned)w, hi = (unsigned)(w >> 32); f32x4 r;
    unsigned t; float f; t = lo << 16; __builtin_memcpy(&f, &t, 4); r[0] = f; t = lo & 0xffff0000u; __builtin_memcpy(&f, &t, 4); r[1] = f; t = hi << 16; __builtin_memcpy(&f, &t, 4); r[2] = f; t = hi & 0xffff0000u; __builtin_memcpy(&f, &t, 4); r[3] = f; return r; }
struct Ctx {
    const float* const KAS* in; float* out; unsigned char* ws;
    __host__ __device__ float* mod(int l, int r) const { return (float*)(ws + WS_MOD) + ((size_t)l * (NB + 1) + r) * 6 * D; }
    __host__ __device__ bf16_t* win(int l) const { return (bf16_t*)(ws + WS_WIN) + (size_t)l * INP * D; }
    __host__ __device__ bf16_t* wout(int l) const { return (bf16_t*)(ws + WS_WOUT) + (size_t)l * D * MIXW; }
    __host__ __device__ bf16_t* wgu(int l) const { return (bf16_t*)(ws + WS_WGU) + (size_t)l * NE * 2 * D * D; }
    __host__ __device__ bf16_t* wdn(int l) const { return (bf16_t*)(ws + WS_WDN) + (size_t)l * NE * D * D; }
    __host__ __device__ float* x() const { return (float*)(ws + WS_X); }
    __host__ __device__ bf16_t* h() const { return (bf16_t*)(ws + WS_H); }
    __host__ __device__ bf16_t* u() const { return (bf16_t*)(ws + WS_U); }
    __host__ __device__ float* gla_a() const { return (float*)(ws + WS_GLA_A); }
    __host__ __device__ float* ml_qk() const { return (float*)(ws + WS_ML_QK); }
    __host__ __device__ float* ml_g() const { return (float*)(ws + WS_ML_G); }
    __host__ __device__ bf16_t* xbc() const { return (bf16_t*)(ws + WS_XBC); }
    __host__ __device__ float* dt() const { return (float*)(ws + WS_DT); }
    __host__ __device__ bf16_t* odir() const { return (bf16_t*)(ws + WS_ODIR); }
    __host__ __device__ float* od2() const { return (float*)(ws + WS_OD2); }
    __host__ __device__ bf16_t* y() const { return (bf16_t*)(ws + WS_Y); }
    __host__ __device__ int* tope() const { return (int*)(ws + WS_TOPE); }
    __host__ __device__ float* topg() const { return (float*)(ws + WS_TOPG); }
    __host__ __device__ int* pos() const { return (int*)(ws + WS_POS); }
    __host__ __device__ int* dest() const { return (int*)(ws + WS_DEST); }
    __host__ __device__ bf16_t* xs() const { return (bf16_t*)(ws + WS_XS); }
    __host__ __device__ bf16_t* act() const { return (bf16_t*)(ws + WS_ACT); }
    __host__ __device__ bf16_t* yb() const { return (bf16_t*)(ws + WS_YB); }
    __host__ __device__ bf16_t* wsb(size_t off) const { return (bf16_t*)(ws + off); }
    __host__ __device__ float* wsf(size_t off) const { return (float*)(ws + off); }
    __host__ __device__ int* rtok() const { return (int*)(ws + WS_RTOK); }
    __host__ __device__ unsigned* ctl() const { return (unsigned*)(ws + WS_CTL); }
    static_assert((size_t)(CW_CNT + 2 * DEPTH * NE * CNTS) * 4 <= CTL_BYTES, "expert counters fit the zeroed control area");
    __host__ __device__ int* cnt(int l) const { return (int*)(ws + WS_CTL) + CW_CNT + l * NE * CNTS; }
};

constexpr size_t OF_G = 0, OF_M = (size_t)NB * 8 * NCH * 8192, OF_S = 2 * OF_M;
static_assert(OF_S + (size_t)NB * 16 * NCH * 4096 == (size_t)2 * NTOK * MIXW, "fragment layout fills the old [2][NTOK][MIXW] buffer exactly");
__host__ __device__ __forceinline__ int chunk_of(int is_lat, int q) { return (is_lat ? CTX / 64 : 0) + q / 64; }
__host__ __device__ __forceinline__ int mod_row(int row) { return row < NLAT ? row / SEQ : NB; }
__host__ __device__ __forceinline__ void seg_of(int row, int& base, int& pos, int& len) {
    if (row < NLAT) { base = (row / SEQ) * SEQ; pos = row - base; len = SEQ; } else { const int r = row - NLAT; base = NLAT + (r / CTX) * CTX; pos = row - base; len = CTX; }
}
__host__ __device__ __forceinline__ int tok_of_scan(int s) { return (s % ROWS) * GRID_W + s / ROWS; }
__host__ __device__ __forceinline__ int scan_of_tok(int t) { return (t % GRID_W) * ROWS + t / GRID_W; }
__host__ __device__ __forceinline__ int tokrow_of_srow(int srow) { if (srow >= NLAT) return srow; const int b = srow / SEQ; return b * SEQ + tok_of_scan(srow - b * SEQ); }
__host__ __device__ __forceinline__ int srow_of_tokrow(int row) { if (row >= NLAT) return row; const int b = row / SEQ; return b * SEQ + scan_of_tok(row - b * SEQ); }

#ifndef CPU_TEST
#define UNI(x) __builtin_amdgcn_readfirstlane(x)
#define CBAR() __builtin_amdgcn_sched_barrier(0)
#define LAS __attribute__((address_space(3)))
namespace pg8 {
#define PG8_LAS __attribute__((address_space(3)))
typedef unsigned short bf16_t;
typedef short bf16x8 __attribute__((ext_vector_type(8)));
typedef float f32x4 __attribute__((ext_vector_type(4)));
typedef unsigned u32x4 __attribute__((ext_vector_type(4)));
constexpr int BM = 256, BK = 64, HALF = 128, HTB = HALF * BK * 2  , STAGE_BYTES = 8 * HTB, NXCD = 8, WGM = 8;

__host__ __device__ __forceinline__ int lds_byte(int r, int c) { const int st = (r >> 4) * 2 + (c >> 5), rr = r & 15, cc = c & 31, ob = rr * 64 + cc * 2; return st * 1024 + (ob ^ (((ob >> 9) & 1) << 5)); }
__host__ __device__ __forceinline__ void stage_rc(int b, int& R, int& C) { const int st = b / 1024, sb = b % 1024, swz = sb ^ (((sb >> 9) & 1) << 5); R = (st >> 1) * 16 + swz / 64; C = (st & 1) * 32 + (swz % 64) / 2; }
__host__ __device__ __forceinline__ int perm32(int rho) { const int n = rho >> 4, i = rho & 15; return 8 * (i >> 2) + 4 * n + (i & 3); }

struct Unit { int pm, pn; };
struct Gemm { const bf16_t* A; const bf16_t* Bt; int M, N, K; };

struct StaticOrder {
    int nM, nN, nwg, G, c;
    __host__ __device__ void init(int M, int N, int G_, int c_) { nM = M / BM; nN = N / BM; nwg = nM * nN; G = G_; c = c_; }
    __host__ __device__ bool next(int i, Unit& u) const {
        const long L = (long)i * G + c; if (L >= nwg) return false;
        int wgid = (int)L; { const int q = nwg / NXCD, r = nwg % NXCD, xcd = wgid % NXCD, off = wgid / NXCD; wgid = (xcd < r ? xcd * (q + 1) : r * (q + 1) + (xcd - r) * q) + off; }
        const int nig = WGM * nN, gid = wgid / nig, fm = gid * WGM, gsz = (nM - fm) < WGM ? (nM - fm) : WGM;
        u.pm = fm + ((wgid % nig) % gsz); u.pn = (wgid % nig) / gsz; return true;
    }
    __device__ __forceinline__ void a_ready(const Unit&) const {}
    __device__ __forceinline__ void done(const Unit&) const {}
};
__device__ __forceinline__ unsigned cvt_pk_bf16(float lo, float hi) { unsigned r; asm volatile("v_cvt_pk_bf16_f32 %0, %1, %2" : "=v"(r) : "v"(lo), "v"(hi)); return r; }
typedef float f32x2 __attribute__((ext_vector_type(2)));
template <class Epi, class Sched, bool ALIGN_EPI = false, bool SP2 = false>
__device__ __forceinline__ void gemm_phase(PG8_LAS unsigned char* lds, const Gemm g, const Sched& S, const Epi& E, const int tid_in) {
    const int tid = tid_in, wid = __builtin_amdgcn_readfirstlane(tid >> 6), lane = tid & 63, wr = wid >> 2, wc = wid & 3, fr = lane & 15, fq = lane >> 4;
    const int K = g.K, nt = K / BK;
    static_assert(!Sched::GATHER || SP2, "the gathered A operand is wired into the SP2 loop only");
    unsigned voffA[2], voffB[2];
#pragma unroll
    for (int i = 0; i < 2; ++i) { int R, C; stage_rc(tid * 16 + i * 8192, R, C); const int Rb = Epi::PERM ? ((R & ~31) + perm32(R & 31)) : R;
        voffA[i] = (unsigned)(R * K + C) * 2u; voffB[i] = (unsigned)(Rb * K + C) * 2u; }
    unsigned gc00 = 0u, gc01 = 0u, gc10 = 0u, gc11 = 0u, gn00 = 0u, gn01 = 0u, gn10 = 0u, gn11 = 0u;
#define PG8_GOFS(d00, d01, d10, d11, uidx) do { int R0_, C0_, R1_, C1_; stage_rc(tid * 16, R0_, C0_); stage_rc(tid * 16 + 8192, R1_, C1_); \
        d00 = ((unsigned)S.grow((uidx), R0_) * (unsigned)K + (unsigned)C0_) * 2u; d01 = ((unsigned)S.grow((uidx), R1_) * (unsigned)K + (unsigned)C1_) * 2u; \
        d10 = ((unsigned)S.grow((uidx), 128 + R0_) * (unsigned)K + (unsigned)C0_) * 2u; d11 = ((unsigned)S.grow((uidx), 128 + R1_) * (unsigned)K + (unsigned)C1_) * 2u; } while (0)
#define PG8_STAGE2(bufoff, gbase, o0, o1) do { \
        __builtin_amdgcn_global_load_lds((const unsigned*)((const char*)(gbase) + (o0)), (PG8_LAS unsigned*)(lds + (bufoff) + ldsw), 16, 0, 0); \
        __builtin_amdgcn_global_load_lds((const unsigned*)((const char*)(gbase) + (o1)), (PG8_LAS unsigned*)(lds + (bufoff) + ldsw + 8192), 16, 0, 0); } while (0)
#define PG8_STAGE_A(bufoff, base, H, NX) do { if constexpr (Sched::GATHER) { const unsigned o0_ = (NX) ? ((H) ? gn10 : gn00) : ((H) ? gc10 : gc00), o1_ = (NX) ? ((H) ? gn11 : gn01) : ((H) ? gc11 : gc01); PG8_STAGE2(bufoff, base, o0_, o1_); } \
        else { PG8_STAGE(bufoff, (base) + (H) * hstep, voffA); } } while (0)
    const size_t kstep = (size_t)(BK * 2);
    const size_t hstep = (size_t)HALF * K * 2;
    const size_t tstep = 2 * hstep;
    const unsigned ldsw = (unsigned)wid * 1024u;
    const int aoff = lds_byte(wr * 64 + fr, fq * 8), boff = lds_byte(wc * 32 + fr, fq * 8);
#define PG8_SA(b, h) (((b) * 2 + (h)) * HTB)
#define PG8_SB(b, h) ((4 + (b) * 2 + (h)) * HTB)
#define PG8_STAGE(bufoff, gbase, voff) do { _Pragma("unroll") for (int _i = 0; _i < 2; ++_i) \
        __builtin_amdgcn_global_load_lds((const unsigned*)((const char*)(gbase) + (voff)[_i]), (PG8_LAS unsigned*)(lds + (bufoff) + ldsw + _i * 8192), 16, 0, 0); } while (0)
#define PG8_LDA(dst, b, h) do { _Pragma("unroll") for (int m = 0; m < 4; ++m) _Pragma("unroll") for (int k = 0; k < 2; ++k) dst[m][k] = *(const PG8_LAS bf16x8*)(lds + PG8_SA(b, h) + aoff + m * 2048 + k * 1024); } while (0)
#define PG8_LDB(dst, b, h) do { _Pragma("unroll") for (int n = 0; n < 2; ++n) _Pragma("unroll") for (int k = 0; k < 2; ++k) dst[n][k] = *(const PG8_LAS bf16x8*)(lds + PG8_SB(b, h) + boff + n * 2048 + k * 1024); } while (0)
#define PG8_MMA(ai, bj, At, Bt) do { __builtin_amdgcn_s_setprio(1); _Pragma("unroll") for (int m = 0; m < 4; ++m) _Pragma("unroll") for (int n = 0; n < 2; ++n) _Pragma("unroll") for (int k = 0; k < 2; ++k) \
        acc[ai][bj][m][n] = __builtin_amdgcn_mfma_f32_16x16x32_bf16(Bt[n][k], At[m][k], acc[ai][bj][m][n], 0, 0, 0); __builtin_amdgcn_s_setprio(0); } while (0)
#define PG8_WAIT_V(n) asm volatile("s_waitcnt vmcnt(" #n ")" ::: "memory")
#define PG8_WAIT_L(n) asm volatile("s_waitcnt lgkmcnt(" #n ")" ::: "memory")
#define PG8_BAR __builtin_amdgcn_s_barrier()
#define PG8_SCHED __builtin_amdgcn_sched_barrier(0)
    Unit cur, nxt; int ui = 0;
    if (!S.next(0, cur)) return;
    f32x4 acc[2][2][4][2];
#pragma unroll
    for (int a = 0; a < 2; ++a)
#pragma unroll
        for (int b = 0; b < 2; ++b)
#pragma unroll
            for (int m = 0; m < 4; ++m)
#pragma unroll
                for (int n = 0; n < 2; ++n) acc[a][b][m][n] = (f32x4){0.f, 0.f, 0.f, 0.f};
    bf16x8 At[4][2], B0[2][2], B1[2][2];
    const char* cA = (const char*)g.A + (Sched::GATHER ? (size_t)0 : (size_t)cur.pm * tstep); const char* cB = (const char*)g.Bt + (size_t)cur.pn * tstep;
    if constexpr (Sched::GATHER) PG8_GOFS(gc00, gc01, gc10, gc11, 0);
    S.a_ready(cur);
    if constexpr (SP2) {
        PG8_STAGE(PG8_SB(0, 0), cB, voffB); PG8_STAGE(PG8_SB(0, 1), cB + hstep, voffB); PG8_STAGE_A(PG8_SA(0, 0), cA, 0, false); PG8_STAGE_A(PG8_SA(0, 1), cA, 1, false);
        if (wr == 1) PG8_BAR;
        PG8_WAIT_V(2); PG8_BAR;
        PG8_STAGE(PG8_SB(1, 0), cB + kstep, voffB); PG8_STAGE_A(PG8_SA(1, 0), cA + kstep, 0, false); PG8_STAGE(PG8_SB(1, 1), cB + hstep + kstep, voffB);
        PG8_WAIT_V(6); PG8_BAR;
    } else {
        PG8_STAGE(PG8_SB(0, 0), cB, voffB); PG8_STAGE(PG8_SA(0, 0), cA, voffA); PG8_STAGE(PG8_SB(0, 1), cB + hstep, voffB); PG8_STAGE(PG8_SA(0, 1), cA + hstep, voffA);
        if (wr == 1) PG8_BAR;
        PG8_WAIT_V(4); PG8_BAR;
        PG8_STAGE(PG8_SB(1, 0), cB + kstep, voffB); PG8_STAGE(PG8_SA(1, 0), cA + kstep, voffA); PG8_STAGE(PG8_SB(1, 1), cB + hstep + kstep, voffB);
        PG8_WAIT_V(6); PG8_BAR;
    }
    for (;;) {
        const bool has_next = S.next(ui + 1, nxt);
        const char* nA = (has_next && !Sched::GATHER) ? (const char*)g.A + (size_t)nxt.pm * tstep : cA; const char* nB = has_next ? (const char*)g.Bt + (size_t)nxt.pn * tstep : cB;
        if constexpr (Sched::GATHER) { if (has_next) PG8_GOFS(gn00, gn01, gn10, gn11, ui + 1); else { gn00 = gc00; gn01 = gc01; gn10 = gc10; gn11 = gc11; } }
        for (int t = 0; t < nt; t += 2) {
            const bool last = (t == nt - 2);
            const char* a1 = cA + (size_t)(t + 1) * kstep;
            const char* a2 = last ? nA : cA + (size_t)(t + 2) * kstep; const char* b2 = last ? nB : cB + (size_t)(t + 2) * kstep;
            const char* a3 = a2 + kstep; const char* b3 = b2 + kstep;
            if (last && has_next) S.a_ready(nxt);
            if constexpr (SP2) {
            PG8_LDB(B0, 0, 0); PG8_LDB(B1, 0, 1); PG8_SCHED; PG8_LDA(At, 0, 0); PG8_STAGE_A(PG8_SA(1, 1), a1, 1, false);
            PG8_WAIT_V(8); PG8_WAIT_L(0); PG8_BAR; PG8_MMA(0, 0, At, B0); PG8_MMA(0, 1, At, B1); PG8_BAR; PG8_SCHED;
            PG8_LDA(At, 0, 1); PG8_STAGE(PG8_SB(0, 0), b2, voffB); PG8_STAGE(PG8_SB(0, 1), b2 + hstep, voffB); PG8_STAGE_A(PG8_SA(0, 0), a2, 0, last);
            PG8_WAIT_V(8); PG8_WAIT_L(0); PG8_BAR; PG8_MMA(1, 0, At, B0); PG8_MMA(1, 1, At, B1); PG8_BAR; PG8_SCHED;
            PG8_LDB(B0, 1, 0); PG8_LDB(B1, 1, 1); PG8_SCHED; PG8_LDA(At, 1, 0); PG8_STAGE_A(PG8_SA(0, 1), a2, 1, last);
            PG8_WAIT_V(8); PG8_WAIT_L(0); PG8_BAR; PG8_MMA(0, 0, At, B0); PG8_MMA(0, 1, At, B1); PG8_BAR; PG8_SCHED;
            PG8_LDA(At, 1, 1); PG8_STAGE(PG8_SB(1, 0), b3, voffB); PG8_STAGE(PG8_SB(1, 1), b3 + hstep, voffB); PG8_STAGE_A(PG8_SA(1, 0), a3, 0, last);
            PG8_WAIT_V(8); PG8_WAIT_L(0); PG8_BAR; PG8_MMA(1, 0, At, B0); PG8_MMA(1, 1, At, B1); PG8_BAR; PG8_SCHED;
            } else {
            PG8_LDB(B0, 0, 0); PG8_SCHED; PG8_LDA(At, 0, 0); PG8_STAGE(PG8_SA(1, 1), a1 + hstep, voffA);
            PG8_WAIT_L(8); PG8_BAR; PG8_WAIT_L(0); PG8_MMA(0, 0, At, B0); PG8_BAR; PG8_SCHED;
            PG8_LDB(B1, 0, 1); PG8_STAGE(PG8_SB(0, 0), b2, voffB);
            PG8_BAR; PG8_WAIT_L(0); PG8_MMA(0, 1, At, B1); PG8_BAR;
            PG8_LDA(At, 0, 1); PG8_STAGE(PG8_SA(0, 0), a2, voffA);
            PG8_BAR; PG8_WAIT_L(0); PG8_MMA(1, 0, At, B0); PG8_BAR; PG8_SCHED;
            PG8_STAGE(PG8_SB(0, 1), b2 + hstep, voffB);
            PG8_WAIT_V(6); PG8_BAR; PG8_MMA(1, 1, At, B1); PG8_BAR;
            PG8_LDB(B0, 1, 0); PG8_SCHED; PG8_LDA(At, 1, 0); PG8_STAGE(PG8_SA(0, 1), a2 + hstep, voffA);
            PG8_WAIT_L(8); PG8_BAR; PG8_WAIT_L(0); PG8_MMA(0, 0, At, B0); PG8_BAR; PG8_SCHED;
            PG8_LDB(B1, 1, 1); PG8_STAGE(PG8_SB(1, 0), b3, voffB);
            PG8_BAR; PG8_WAIT_L(0); PG8_MMA(0, 1, At, B1); PG8_BAR;
            PG8_LDA(At, 1, 1); PG8_STAGE(PG8_SA(1, 0), a3, voffA);
            PG8_BAR; PG8_WAIT_L(0); PG8_MMA(1, 0, At, B0); PG8_BAR; PG8_SCHED;
            PG8_STAGE(PG8_SB(1, 1), b3 + hstep, voffB);
            PG8_WAIT_V(6); PG8_BAR; PG8_MMA(1, 1, At, B1); PG8_BAR;
            }
        }
        if constexpr (ALIGN_EPI) { if (wr == 0) PG8_BAR; }
        if constexpr (!Epi::AFTER_DRAIN) { E(acc, cur, wr, wc, fr, fq); S.done(cur); }
        if (!has_next) break;
#pragma unroll
        for (int a = 0; a < 2; ++a)
#pragma unroll
            for (int b = 0; b < 2; ++b)
#pragma unroll
                for (int m = 0; m < 4; ++m)
#pragma unroll
                    for (int n = 0; n < 2; ++n) acc[a][b][m][n] = (f32x4){0.f, 0.f, 0.f, 0.f};
        cur = nxt; cA = nA; cB = nB; ++ui;
        if constexpr (Sched::GATHER) { gc00 = gn00; gc01 = gn01; gc10 = gn10; gc11 = gn11; }
        if constexpr (ALIGN_EPI) { if (wr == 1) PG8_BAR; }
    }
    PG8_WAIT_V(0);
    if constexpr (!ALIGN_EPI) { if (wr == 0) PG8_BAR; }
    PG8_BAR;
    if constexpr (Epi::AFTER_DRAIN) { E.fused(acc, cur, wr, wc, fr, fq, lds, wid, lane); S.done(cur); }
#undef PG8_SA
#undef PG8_SB
#undef PG8_STAGE
#undef PG8_LDA
#undef PG8_LDB
#undef PG8_MMA
#undef PG8_WAIT_V
#undef PG8_WAIT_L
#undef PG8_BAR
#undef PG8_SCHED
#undef PG8_GOFS
#undef PG8_STAGE_A
#undef PG8_STAGE2
}
}
#define XB_TMO      128
#define XB_XCNT(j)  (256  + 64 * (j))
#define XB_XSUB(j)  (1280 + 64 * (j))
#define XB_XGEN(j)  (2304 + 64 * (j))
#define XB_TOP      3328
#define XB_TOPGEN   3392
#define XCD_BAR_WORDS 3456
#define XB_SPIN_CAP (1u << 22)

__device__ __forceinline__ unsigned xb_ld(unsigned* p)              { return __hip_atomic_load(p, __ATOMIC_RELAXED, __HIP_MEMORY_SCOPE_AGENT); }
__device__ __forceinline__ unsigned xb_add(unsigned* p, unsigned v) { return __hip_atomic_fetch_add(p, v, __ATOMIC_RELAXED, __HIP_MEMORY_SCOPE_AGENT); }
__device__ __forceinline__ unsigned xb_xcc_id() { return (unsigned)__builtin_amdgcn_s_getreg((3 << 11) | 20) & 0xFu; }
#define XB_SPIN(cond, bar) do { unsigned _sp = 0; while (cond) { __builtin_amdgcn_s_sleep(1); \
    if ((++_sp & 255u) == 0u) { if (xb_ld(&(bar)[XB_TMO])) break; if (_sp > XB_SPIN_CAP) { atomicAdd(&(bar)[XB_TMO], 1u); break; } } } } while (0)

struct XcdBarrier {
    unsigned* bar; unsigned x;
    volatile LAS unsigned* st;
};

__device__ __forceinline__ XcdBarrier xcd_barrier_post(unsigned* bar, volatile LAS unsigned* st) {
    XcdBarrier b; b.bar = bar; b.x = xb_xcc_id(); b.st = st;
    if (threadIdx.x == 0) (void)xb_add(&bar[XB_XCNT(b.x)], 1u);
    return b;
}
__device__ __forceinline__ void xcd_barrier_complete(unsigned* bar, unsigned x, unsigned& nloc, unsigned& nx) {
    const unsigned G = gridDim.x * gridDim.y * gridDim.z;
    unsigned sum, cnt, mine, sp = 0u;
    for (;;) {
        sum = 0u; cnt = 0u; mine = 0u;
#pragma unroll
        for (unsigned j = 0; j < 16; ++j) { const unsigned c = xb_ld(&bar[XB_XCNT(j)]); sum += c; cnt += (c > 0u) ? 1u : 0u; mine = (j == x) ? c : mine; }
        if (sum == G) break;
        __builtin_amdgcn_s_sleep(1);
        if ((++sp & 255u) == 0u) { if (xb_ld(&bar[XB_TMO])) break; if (sp > XB_SPIN_CAP) { atomicAdd(&bar[XB_TMO], 1u); break; } }
    }
    nloc = mine > 0u ? mine : 1u; nx = cnt > 0u ? cnt : 1u;
}

__device__ __forceinline__ void xcd_barrier(const XcdBarrier& b) {
    asm volatile("s_waitcnt vmcnt(0)" ::: "memory");
    __syncthreads();
    if (threadIdx.x == 0) {
        unsigned* bar = b.bar;
        __builtin_amdgcn_s_waitcnt(0);
        unsigned nloc = b.st[0], nx = b.st[1];
        if (nloc == 0u) { xcd_barrier_complete(bar, b.x, nloc, nx); b.st[0] = nloc; b.st[1] = nx; }
        const unsigned old = xb_add(&bar[XB_XSUB(b.x)], 1u);
        const unsigned gen = old / nloc;
        if (old + 1u == (gen + 1u) * nloc) {
            __builtin_amdgcn_fence(__ATOMIC_RELEASE, "agent");
            asm volatile("s_waitcnt vmcnt(0)" ::: "memory");
            const unsigned og = xb_add(&bar[XB_TOP], 1u);
            const unsigned tg = og / nx;
            if (og + 1u == (tg + 1u) * nx) xb_add(&bar[XB_TOPGEN], 1u);
            else XB_SPIN(xb_ld(&bar[XB_TOPGEN]) == tg, bar);
            __builtin_amdgcn_fence(__ATOMIC_ACQUIRE, "agent");
            xb_add(&bar[XB_XGEN(b.x)], 1u);
            asm volatile("s_waitcnt vmcnt(0)" ::: "memory");
        } else {
            XB_SPIN(xb_ld(&bar[XB_XGEN(b.x)]) == gen, bar);
            __builtin_amdgcn_fence(__ATOMIC_ACQUIRE, "agent");
            asm volatile("s_waitcnt vmcnt(0)" ::: "memory");
        }
    }
    __syncthreads();
}
#else
#define UNI(x) (x)
#define CBAR()
namespace pg8 { typedef float f32x4 __attribute__((ext_vector_type(4))); struct Unit { int pm, pn; }; struct Gemm { const unsigned short* A; const unsigned short* Bt; int M, N, K; }; }
#endif

__host__ __device__ __forceinline__ int scan_row(int b, int dir, int st) {
    return st < CTX ? NLAT + b * CTX + (dir == 0 ? st : CTX - 1 - st) : b * SEQ + (dir == 0 ? st - CTX : SEQ - 1 - (st - CTX));
}
__host__ __device__ __forceinline__ void expert_tile_base(const int* cnt, int* tb) { int a = 0; for (int e = 0; e < NE; ++e) { tb[e] = a; const int nt = (cnt[e * CNTS] + 255) / 256; for (int t = 0; t < nt; ++t) tb[NE + 1 + a + t] = e; a += nt; } tb[NE] = a; }
constexpr int TB_WORDS = NE + 1 + MAXROWS / 256;
struct DenseOrder {
    static constexpr bool GATHER = false;
    __device__ __forceinline__ int grow(int, int) const { return 0; }
    int nM, nN, nwg, G, c;
    __host__ __device__ void init(int M, int N, int G_, int c_) { nM = M / 256; nN = N / 256; nwg = nM * nN; G = G_; c = c_; }
    __host__ __device__ __forceinline__ bool next(int i, pg8::Unit& u) const {
        const long L = (long)i * G + c; if (L >= nwg) return false;
        int wgid = (int)L; { const int q = nwg / 8, r = nwg % 8, xcd = wgid % 8, off = wgid / 8; wgid = (xcd < r ? xcd * (q + 1) : r * (q + 1) + (xcd - r) * q) + off; }
        const int nig = 8 * nN, gid = wgid / nig, fm = gid * 8, gsz = (nM - fm) < 8 ? (nM - fm) : 8;
        u.pm = fm + ((wgid % nig) % gsz); u.pn = (wgid % nig) / gsz; return true;
    }
    __device__ __forceinline__ void a_ready(const pg8::Unit&) const {}
    __device__ __forceinline__ void done(const pg8::Unit&) const {}
};
template <class TB> struct MoeOrder {
    static constexpr bool GATHER = false;
    __device__ __forceinline__ int grow(int, int) const { return 0; }
    TB tb; int nN, G, c; int wgm = 8; int rev = 0;
    __host__ __device__ __forceinline__ bool next(int i, pg8::Unit& u) const {
        const int nRT = tb[NE], nwg = nRT * nN;
        const long L = (long)i * G + c; if (L >= nwg) return false;
        int wgid = (int)L; { const int q = nwg / 8, r = nwg % 8, xcd = wgid % 8, off = wgid / 8; wgid = (xcd < r ? xcd * (q + 1) : r * (q + 1) + (xcd - r) * q) + off; }
        if (rev) wgid = nwg - 1 - wgid;
        const int nig = wgm * nN, gid = wgid / nig, fm = gid * wgm, gsz = (nRT - fm) < wgm ? (nRT - fm) : wgm;
        const int rt = fm + ((wgid % nig) % gsz), ln = (wgid % nig) / gsz;
        const int e = tb[NE + 1 + rt];
#ifndef CPU_TEST
        u.pm = __builtin_amdgcn_readfirstlane(rt); u.pn = __builtin_amdgcn_readfirstlane(e * nN + ln);
#else
        u.pm = rt; u.pn = e * nN + ln;
#endif
        return true;
    }
    __device__ __forceinline__ void a_ready(const pg8::Unit&) const {}
    __device__ __forceinline__ void done(const pg8::Unit&) const {}
};
template <class TB, class GT> struct MoeOrderG : MoeOrder<TB> {
    static constexpr bool GATHER = true;
    GT gtab; const int* rowtok;
    __host__ __device__ MoeOrderG(TB tb_, int nN_, int G_, int c_, GT gt_, const int* rt_) { this->tb = tb_; this->nN = nN_; this->G = G_; this->c = c_; this->wgm = 8; gtab = gt_; rowtok = rt_; }
    __device__ __forceinline__ int grow(int ui, int r) const { return (int)gtab[ui * 256 + r]; }
};
#ifdef CPU_TEST
static inline unsigned cvt_pk_bf16(float lo, float hi) { return pk2(lo, hi); }
#else
using pg8::cvt_pk_bf16;
#endif
typedef pg8::f32x4 accq;
struct EpiU {
    static constexpr bool PERM = true, AFTER_DRAIN = false;
    bf16_t* C; int ldc;
    __device__ __forceinline__ void operator()(const accq (&acc)[2][2][4][2], const pg8::Unit& u, int wr, int wc, int fr, int fq) const {
        const int row0 = u.pm * 256 + wr * 64 + fr, col0 = u.pn * 256 + wc * 32 + 8 * fq;
#pragma unroll
        for (int ai = 0; ai < 2; ++ai)
#pragma unroll
            for (int m = 0; m < 4; ++m) { bf16_t* rowp = C + (size_t)(row0 + ai * 128 + m * 16) * ldc + col0;
#pragma unroll
                for (int bj = 0; bj < 2; ++bj) { const accq v0 = acc[ai][bj][m][0], v1 = acc[ai][bj][m][1];
                    u32x4 w; w.x = cvt_pk_bf16(v0[0], v0[1]); w.y = cvt_pk_bf16(v0[2], v0[3]); w.z = cvt_pk_bf16(v1[0], v1[1]); w.w = cvt_pk_bf16(v1[2], v1[3]);
                    *(u32x4*)(rowp + bj * 128) = w; } }
    }
};
struct EpiResid {
    static constexpr bool PERM = false, AFTER_DRAIN = false;
    float* X; const float* modl; float* SSP;
    __device__ __forceinline__ void operator()(const accq (&acc)[2][2][4][2], const pg8::Unit& u, int wr, int wc, int fr, int fq) const {
        const int row0 = u.pm * 256 + wr * 64 + fr, col0 = u.pn * 256 + wc * 32 + 4 * fq;
#pragma unroll
        for (int ai = 0; ai < 2; ++ai)
#pragma unroll
            for (int m = 0; m < 4; ++m) { const int row = row0 + ai * 128 + m * 16; float* rowp = X + (size_t)row * D + col0; const float* gp = modl + (size_t)mod_row(row) * 6 * D + 2 * D + col0;
                float ss = 0.f;
#pragma unroll
                for (int bj = 0; bj < 2; ++bj)
#pragma unroll
                    for (int n = 0; n < 2; ++n) { const accq gv = *(const accq*)(gp + bj * 128 + n * 16); accq xv = *(accq*)(rowp + bj * 128 + n * 16); xv = xv + gv * acc[ai][bj][m][n]; *(accq*)(rowp + bj * 128 + n * 16) = xv;
                        ss += (xv[0] * xv[0] + xv[1] * xv[1]) + (xv[2] * xv[2] + xv[3] * xv[3]); }
                SSP[(size_t)row * 64 + (u.pn * 4 + wc) * 4 + fq] = ss; }
    }
};
struct EpiSwiglu {
    static constexpr bool PERM = true, AFTER_DRAIN = false;
    bf16_t* ACT; const float* bgu;
    __device__ __forceinline__ void operator()(const accq (&acc)[2][2][4][2], const pg8::Unit& u, int wr, int wc, int fr, int fq) const {
        constexpr int nN = 2 * D / 256;
        const int e = u.pn / nN, ln = u.pn % nN;
        const int row0 = u.pm * 256 + wr * 64 + fr, cl = 128 * ln + wc * 32 + 8 * fq;
        const float* bg = bgu + (size_t)e * 2 * D + cl;
        accq bgl[2], bli[2];
#pragma unroll
        for (int n = 0; n < 2; ++n) { bgl[n] = *(const accq*)(bg + 4 * n); bli[n] = *(const accq*)(bg + D + 4 * n); }
#pragma unroll
        for (int ai = 0; ai < 2; ++ai)
#pragma unroll
            for (int m = 0; m < 4; ++m) {
                float a[8];
#pragma unroll
                for (int n = 0; n < 2; ++n)
#pragma unroll
                    for (int j = 0; j < 4; ++j) {
                        float glu = acc[ai][0][m][n][j] + bgl[n][j], lin = acc[ai][1][m][n][j] + bli[n][j];
                        glu = fminf(glu, 7.0f); lin = fminf(fmaxf(lin, -7.0f), 7.0f);
                        a[4 * n + j] = glu * FRCP(1.0f + __expf(-1.702f * glu)) * (lin + 1.0f);
                    }
                u32x4 w; w.x = cvt_pk_bf16(a[0], a[1]); w.y = cvt_pk_bf16(a[2], a[3]); w.z = cvt_pk_bf16(a[4], a[5]); w.w = cvt_pk_bf16(a[6], a[7]);
                *(u32x4*)(ACT + (size_t)(row0 + ai * 128 + m * 16) * D + cl) = w;
            }
    }
};
struct EpiDown {
    static constexpr bool PERM = true, AFTER_DRAIN = false;
    bf16_t* YB; const float* bdn;
    __device__ __forceinline__ void operator()(const accq (&acc)[2][2][4][2], const pg8::Unit& u, int wr, int wc, int fr, int fq) const {
        constexpr int nN = D / 256;
        const int e = u.pn / nN, ln = u.pn % nN;
        const int row0 = u.pm * 256 + wr * 64 + fr, col0 = ln * 256 + wc * 32 + 8 * fq;
        const float* bp = bdn + (size_t)e * D + col0;
        accq bv[2][2];
#pragma unroll
        for (int bj = 0; bj < 2; ++bj)
#pragma unroll
            for (int n = 0; n < 2; ++n) bv[bj][n] = *(const accq*)(bp + bj * 128 + 4 * n);
#pragma unroll
        for (int ai = 0; ai < 2; ++ai)
#pragma unroll
            for (int m = 0; m < 4; ++m) { bf16_t* rowp = YB + (size_t)(row0 + ai * 128 + m * 16) * D + col0;
#pragma unroll
                for (int bj = 0; bj < 2; ++bj) { const accq v0 = acc[ai][bj][m][0] + bv[bj][0], v1 = acc[ai][bj][m][1] + bv[bj][1];
                    u32x4 w; w.x = cvt_pk_bf16(v0[0], v0[1]); w.y = cvt_pk_bf16(v0[2], v0[3]); w.z = cvt_pk_bf16(v1[0], v1[1]); w.w = cvt_pk_bf16(v1[2], v1[3]);
                    *(u32x4*)(rowp + bj * 128) = w; } }
    }
};
__host__ __device__ __forceinline__ int gu_row_of_col(int n) { return n < D ? 256 * (n / 128) + n % 128 : 256 * ((n - D) / 128) + 128 + (n - D) % 128; }

#ifndef CPU_TEST
__device__ __forceinline__ int lane_now() { int l; asm volatile("v_mbcnt_lo_u32_b32 %0, -1, 0\n\tv_mbcnt_hi_u32_b32 %0, -1, %0" : "=v"(l)); return l; }
#define SHFL_XOR_F(v, m) __builtin_bit_cast(float, __builtin_amdgcn_ds_bpermute((lane_now() ^ (m)) << 2, __builtin_bit_cast(int, (float)(v))))
template <int CTRL> __device__ __forceinline__ float dppf(float v) { return __builtin_bit_cast(float, __builtin_amdgcn_update_dpp(0, __builtin_bit_cast(int, v), CTRL, 0xF, 0xF, true)); }
#define RED1(v) dppf<0xB1>(v)
#define RED2(v) dppf<0x4E>(v)
#define RED4(v) dppf<0x141>(v)
#define RED8(v) dppf<0x140>(v)
#define RFL(x) __builtin_amdgcn_readfirstlane(x)
#define WAVE_SYNC() __builtin_amdgcn_wave_barrier()
#else
#define SHFL_XOR_F(v, m) shfl_xor_f((v), (m))
#define RED1(v) shfl_xor_f((v), 1)
#define RED2(v) shfl_xor_f((v), 2)
#define RED4(v) shfl_xor_f((v), 4)
#define RED8(v) shfl_xor_f((v), 8)
#define RFL(x) rfl_i(x)
#define LAS
#define WAVE_SYNC() simt::wave_sync()
#endif
__device__ __forceinline__ float wave_sum(float v) {
    v += RED1(v); v += RED2(v); v += RED4(v); v += RED8(v); v += SHFL_XOR_F(v, 16); v += SHFL_XOR_F(v, 32);
    return v;
}
static_assert(D % 256 == 0, "row layout: lane l holds float4 j at element 4l + 256j");
constexpr int RJ = D / 256;
__device__ __forceinline__ float row_rms(const f32x4 (&v)[RJ]) {
    float s = 0.f;
#pragma unroll
    for (int j = 0; j < RJ; ++j) s += (v[j][0] * v[j][0] + v[j][1] * v[j][1]) + (v[j][2] * v[j][2] + v[j][3] * v[j][3]);
    return 1.0f / sqrtf(wave_sum(s) * (1.0f / D) + EPS);
}
__device__ __forceinline__ void row_modulate_store(f32x4 (&v)[RJ], float r, const float* g, const float* shift, const float* scale, bf16_t* o, int lane) {
#pragma unroll
    for (int j = 0; j < RJ; ++j) {
        const int e0 = 4 * lane + 256 * j;
        const f32x4 gv = *(const f32x4*)(g + e0), sh = *(const f32x4*)(shift + e0), sc = *(const f32x4*)(scale + e0);
        v[j] = (v[j] * r * gv) * (sc + 1.0f) + sh;
        unsigned lo = pk2(v[j][0], v[j][1]), hi = pk2(v[j][2], v[j][3]);
        *(unsigned long long*)(o + e0) = (unsigned long long)lo | ((unsigned long long)hi << 32);
    }
}
__device__ __forceinline__ void ph_xinit_w(const Ctx& c, int gw, int ngw, int lane) {
    for (int row = gw; row < NTOK; row += ngw) {
        const float* src = row < NLAT ? c.in[I_X] + (size_t)row * D : c.in[I_CTX] + (size_t)(row - NLAT) * D;
        float* dst = c.x() + (size_t)row * D;
#pragma unroll
        for (int j = 0; j < RJ; ++j) *(f32x4*)(dst + 4 * lane + 256 * j) = *(const f32x4*)(src + 4 * lane + 256 * j);
    }
}
__device__ __forceinline__ void ph_norm1_w(const Ctx& c, int l, int gw, int ngw, int lane) {
    for (int row = gw; row < NTOK; row += ngw) {
        const float* xr = row < NLAT ? c.in[I_X] + (size_t)row * D : c.in[I_CTX] + (size_t)(row - NLAT) * D;
        float* dst = c.x() + (size_t)row * D;
        f32x4 v[RJ];
#pragma unroll
        for (int j = 0; j < RJ; ++j) { v[j] = *(const f32x4*)(xr + 4 * lane + 256 * j); *(f32x4*)(dst + 4 * lane + 256 * j) = v[j]; }
        const float r = row_rms(v);
        const float* m = c.mod(l, mod_row(row));
        row_modulate_store(v, r, c.in[I_N1G] + l * D, m, m + D, c.h() + (size_t)row * D, lane);
    }
}
__device__ __forceinline__ void ph_finish_w(const Ctx& c, int l, int nrows, int gw, int ngw, int lane) {
    const bf16_t* U = c.u();
    const bf16_t* OD = c.odir();
    for (int grp = gw; grp < nrows / 4; grp += ngw) {
        const int row0 = 4 * grp;
        int base, pos, len; seg_of(row0, base, pos, len);
        const int is_lat = row0 < NLAT ? 1 : 0, b = is_lat ? row0 / SEQ : (row0 - NLAT) / CTX;
        const int unit = lane >> 3, sub = lane & 7, hd = unit & 3, col0 = unit * 128 + sub * 16;
        const int hc = sub * 16;
        unsigned long long graw[4][4];
#pragma unroll
        for (int j = 0; j < 4; ++j) { const bf16_t* ur = U + (size_t)(row0 + j) * INP; const bf16_t* gate = unit < 4 ? ur + U_GG + unit * 128 + hc : ur + U_MO + (unit - 4) * 128 + hc;
#pragma unroll
            for (int q = 0; q < 4; ++q) graw[j][q] = *(const unsigned long long*)(gate + 4 * q); }
        float o[4][16];
#pragma unroll
        for (int d = 0; d < 2; ++d) {
            const int q = d == 0 ? pos : len - 1 - pos, n = chunk_of(is_lat, q), qi = q % 64;
            const bf16_t* fp = OD + (unit < 4 ? OF_G : OF_M) + ((((size_t)((b * 4 + hd) * 2 + d) * NCH + n) * 4 + qi / 16) * 8 + sub) * 256 + ((qi % 16) / 4) * 64;
#pragma unroll
            for (int e = 0; e < 16; ++e) { const f32x4 v = ldb4(fp + e * 4);
#pragma unroll
                for (int j = 0; j < 4; ++j) o[j][e] = d == 0 ? v[j] : o[j][e] + v[3 - j]; }
        }
        const float* gw_ = unit < 4 ? c.in[I_GNG] + l * 128 + hc : c.in[I_MNG] + l * 512 + (unit - 4) * 128 + hc;
        f32x4 gv[4];
#pragma unroll
        for (int q = 0; q < 4; ++q) gv[q] = *(const f32x4*)(gw_ + 4 * q);
#pragma unroll
        for (int j = 0; j < 4; ++j) {
            float ss = 0.f;
#pragma unroll
            for (int e = 0; e < 16; ++e) ss += o[j][e] * o[j][e];
            ss += RED1(ss); ss += RED2(ss); ss += RED4(ss);
            const float r = 1.0f / sqrtf(ss * (1.0f / 128.f) + EPS);
            unsigned w[8];
#pragma unroll
            for (int q = 0; q < 4; ++q) { const f32x4 ga = cvtb4(graw[j][q]); float t[4];
#pragma unroll
                for (int e = 0; e < 4; ++e) t[e] = o[j][4 * q + e] * r * gv[q][e] * (unit < 4 ? siluf_(ga[e]) : sigmoidf_(ga[e]));
                w[2 * q] = pk2(t[0], t[1]); w[2 * q + 1] = pk2(t[2], t[3]); }
            bf16_t* yr = c.y() + (size_t)(row0 + j) * MIXW + col0;
            *(u32x4*)yr = (u32x4){w[0], w[1], w[2], w[3]}; *(u32x4*)(yr + 8) = (u32x4){w[4], w[5], w[6], w[7]};
            CBAR();
        }
    }
    for (int grp = gw; grp < nrows / 4; grp += ngw) {
        const int srow0 = 4 * grp;
        int base, spos, len; seg_of(srow0, base, spos, len);
        const int is_lat = srow0 < NLAT ? 1 : 0, b = is_lat ? srow0 / SEQ : (srow0 - NLAT) / CTX;
        const int ch0 = 8 * lane, hd = ch0 / 64, wc = (ch0 % 64) / 16, cc0 = ch0 % 16;
        const float dsk = c.in[I_2D][l * 8 + hd];
        unsigned long long xraw[4][2], zraw[4][2];
#pragma unroll
        for (int j = 0; j < 4; ++j) { const int srow = srow0 + j, row = tokrow_of_srow(srow); const bf16_t* xr = c.xbc() + (size_t)srow * 512 + ch0; const bf16_t* ur = U + (size_t)row * INP + U_Z + ch0;
#pragma unroll
            for (int q = 0; q < 2; ++q) { xraw[j][q] = *(const unsigned long long*)(xr + 4 * q); zraw[j][q] = *(const unsigned long long*)(ur + 4 * q); } }
        float acc[4][8];
#pragma unroll
        for (int d = 0; d < 2; ++d) {
            const int q = d == 0 ? spos : len - 1 - spos, n = chunk_of(is_lat, q), qi = q % 64;
            const bf16_t* fp = OD + OF_S + ((((size_t)((b * 8 + hd) * 2 + d) * NCH + n) * 4 + qi / 16) * 4 + wc) * 256 + ((qi % 16) / 4) * 64 + cc0 * 4;
#pragma unroll
            for (int e = 0; e < 8; ++e) { const f32x4 v = ldb4(fp + e * 4);
#pragma unroll
                for (int j = 0; j < 4; ++j) acc[j][e] = d == 0 ? v[j] : acc[j][e] + v[3 - j]; }
        }
        const float* ng = c.in[I_2NG] + l * 512 + ch0;
        const f32x4 g0 = *(const f32x4*)ng, g1 = *(const f32x4*)(ng + 4);
#pragma unroll
        for (int j = 0; j < 4; ++j) {
            const int srow = srow0 + j, row = tokrow_of_srow(srow);
            float yv[8]; float ss = 0.f;
#pragma unroll
            for (int q = 0; q < 2; ++q) { const f32x4 xs = cvtb4(xraw[j][q]), z = cvtb4(zraw[j][q]);
#pragma unroll
                for (int e = 0; e < 4; ++e) { const float t = (acc[j][4 * q + e] + dsk * xs[e]) * siluf_(z[e]); yv[4 * q + e] = t; ss += t * t; } }
            ss += RED1(ss); ss += RED2(ss); ss += RED4(ss); ss += RED8(ss); ss += SHFL_XOR_F(ss, 16);
            const float r = 1.0f / sqrtf(ss * (1.0f / 256.f) + EPS);
            *(u32x4*)(c.y() + (size_t)row * MIXW + 1024 + ch0) = (u32x4){pk2(yv[0] * r * g0[0], yv[1] * r * g0[1]), pk2(yv[2] * r * g0[2], yv[3] * r * g0[3]), pk2(yv[4] * r * g1[0], yv[5] * r * g1[1]), pk2(yv[6] * r * g1[2], yv[7] * r * g1[3])};
            CBAR();
        }
    }
}
constexpr int ROUTE_R = 4, ROUTE_LDS = (ROUTE_R * D + ROUTE_R * NE) * 4;
__device__ __forceinline__ void ph_route_w(const Ctx& c, int l, int nrows, LAS float* wlds, int gw, int ngw, int lane, bool dummy = false) {
    LAS float* hv = wlds; LAS float* lgs = wlds + ROUTE_R * D;
    const float* rw = c.in[I_RW] + (size_t)l * D * NE;
    for (int r0 = gw * ROUTE_R; r0 < nrows; r0 += ngw * ROUTE_R) {
#pragma unroll
        for (int q = 0; q < ROUTE_R; ++q) {
            const int row = r0 + q;
            const float* xr = c.x() + (size_t)row * D;
            f32x4 v[RJ];
#pragma unroll
            for (int j = 0; j < RJ; ++j) v[j] = *(const f32x4*)(xr + 4 * lane + 256 * j);
            const float r = row_rms(v);
            const float* m = c.mod(l, mod_row(row));
            row_modulate_store(v, r, c.in[I_N2G] + l * D, m + 3 * D, m + 4 * D, c.h() + (size_t)row * D, lane);
#pragma unroll
            for (int j = 0; j < RJ; ++j) *(LAS f32x4*)(hv + q * D + 4 * lane + 256 * j) = v[j];
        }
        WAVE_SYNC();
        const int e = lane & 31, kh = lane >> 5;
        float acc[ROUTE_R];
#pragma unroll
        for (int q = 0; q < ROUTE_R; ++q) acc[q] = 0.f;
        for (int k = kh * (D / 2); k < (kh + 1) * (D / 2); k += 4) {
            const float w0 = rw[(size_t)(k + 0) * NE + e], w1 = rw[(size_t)(k + 1) * NE + e], w2 = rw[(size_t)(k + 2) * NE + e], w3 = rw[(size_t)(k + 3) * NE + e];
#pragma unroll
            for (int q = 0; q < ROUTE_R; ++q) { const f32x4 hq = *(const LAS f32x4*)(hv + q * D + k); acc[q] += (hq[0] * w0 + hq[1] * w1) + (hq[2] * w2 + hq[3] * w3); }
        }
#pragma unroll
        for (int q = 0; q < ROUTE_R; ++q) { acc[q] += SHFL_XOR_F(acc[q], 32); if (kh == 0) lgs[q * NE + e] = acc[q] + c.in[I_RB][l * NE + e]; }
        WAVE_SYNC();
        if (lane < ROUTE_R) {
            const int row = r0 + lane;
            float lg[NE];
#pragma unroll
            for (int i = 0; i < NE; ++i) lg[i] = lgs[lane * NE + i];
            int te[TOPK]; float tv[TOPK];
#pragma unroll
            for (int kk = 0; kk < TOPK; ++kk) {
                int best = -1; float bv = 0.f;
#pragma unroll
                for (int i = 0; i < NE; ++i) {
                    bool taken = false;
#pragma unroll
                    for (int j = 0; j < kk; ++j) taken = taken || (te[j] == i);
                    if (!taken && (best < 0 || lg[i] > bv)) { best = i; bv = lg[i]; }
                }
                te[kk] = best; tv[kk] = bv;
            }
            float se = 0.f, ex[TOPK];
#pragma unroll
            for (int kk = 0; kk < TOPK; ++kk) { ex[kk] = expf(tv[kk] - tv[0]); se += ex[kk]; }
#pragma unroll
            for (int kk = 0; kk < TOPK; ++kk) {
                c.tope()[row * TOPK + kk] = te[kk];
                c.topg()[row * TOPK + kk] = ex[kk] / se;
                c.pos()[row * TOPK + kk] = atomicAdd(c.cnt(l) + (dummy ? DEPTH * NE * CNTS : 0) + te[kk] * CNTS, 1);
            }
        }
        WAVE_SYNC();
    }
}
template <class TB> __device__ __forceinline__ void ph_rowtok_w(const Ctx& c, int l, int nrows, TB tb, int gt, int gs) {
    for (int it = gt; it < nrows * TOPK; it += gs) {
        const int d = tb[c.tope()[it]] * 256 + c.pos()[it];
        c.dest()[it] = d; c.rtok()[d] = it / TOPK;
    }
    const int* cn = c.cnt(l);
    for (int it = gt; it < NE * 256; it += gs) {
        const int e = it / 256, p = it % 256, n = cn[e * CNTS], nt = (n + 255) / 256;
        if (nt > 0 && (nt - 1) * 256 + p >= n) c.rtok()[tb[e] * 256 + (nt - 1) * 256 + p] = 0;
    }
}
template <int NR> __device__ __forceinline__ void comb_rows(const Ctx& c, int l, const int (&rows)[NR], int lane, bool dummy) {
    typedef int i32x4 __attribute__((ext_vector_type(4)));
    const bool last = (l == DEPTH - 1);
    i32x4 dd[NR]; f32x4 gk[NR];
#pragma unroll
    for (int a = 0; a < NR; ++a) { dd[a] = *(const i32x4*)(c.dest() + rows[a] * TOPK); gk[a] = *(const f32x4*)(c.topg() + rows[a] * TOPK); }
    f32x4 v[NR][RJ];
#pragma unroll
    for (int a = 0; a < NR; ++a) {
        const float* xr = c.x() + (size_t)rows[a] * D;
        const float* m = c.mod(l, mod_row(rows[a])) + 5 * D;
        const bf16_t* y0 = c.yb() + (size_t)dd[a][0] * D; const bf16_t* y1 = c.yb() + (size_t)dd[a][1] * D; const bf16_t* y2 = c.yb() + (size_t)dd[a][2] * D; const bf16_t* y3 = c.yb() + (size_t)dd[a][3] * D;
#pragma unroll
        for (int j = 0; j < RJ; ++j) { const int e0 = 4 * lane + 256 * j;
            const f32x4 s = (ldb4(y0 + e0) * gk[a][0] + ldb4(y1 + e0) * gk[a][1]) + (ldb4(y2 + e0) * gk[a][2] + ldb4(y3 + e0) * gk[a][3]);
            v[a][j] = *(const f32x4*)(xr + e0) + *(const f32x4*)(m + e0) * s; }
    }
#pragma unroll
    for (int a = 0; a < NR; ++a) {
        const int row = rows[a];
        const float r = row_rms(v[a]);
        if (last) {
#pragma unroll
            for (int j = 0; j < RJ; ++j) { const int e0 = 4 * lane + 256 * j; *(f32x4*)(c.out + (size_t)row * D + e0) = v[a][j] * r * *(const f32x4*)(c.in[I_FNG] + e0); }
        } else {
            float* xr = c.x() + (size_t)row * D;
#pragma unroll
            for (int j = 0; j < RJ; ++j) *(f32x4*)((dummy ? c.od2() + (size_t)row * D : xr) + 4 * lane + 256 * j) = v[a][j];
            const float* mn = c.mod(l + 1, mod_row(row));
            row_modulate_store(v[a], r, c.in[I_N1G] + (l + 1) * D, mn, mn + D, c.h() + (size_t)row * D, lane);
        }
    }
}
__device__ __forceinline__ void ph_combine_w(const Ctx& c, int l, int nrows, int gw, int ngw, int lane, bool dummy = false) {
    int row = gw;
    for (; row + 2 * ngw < nrows; row += 3 * ngw) { const int rows[3] = {row, row + ngw, row + 2 * ngw}; comb_rows<3>(c, l, rows, lane, dummy); }
    if (row + ngw < nrows) { const int rows[2] = {row, row + ngw}; comb_rows<2>(c, l, rows, lane, dummy); }
    else if (row < nrows) { const int rows[1] = {row}; comb_rows<1>(c, l, rows, lane, dummy); }
}
__device__ __forceinline__ void ph_mod_w(const Ctx& c, LAS float* tab, int tid, int blk, int G) {
    LAS float* part = tab + (NB + 1) * D;
    for (int i = tid; i < (NB + 1) * D; i += 512) { const int r = i / D, k = i % D; tab[i] = siluf_(r < NB ? c.in[I_C][r * D + k] : c.in[I_CCTX][k]); }
    __syncthreads();
    const int lane = tid & 63, w = tid >> 6;
    for (int cbk = blk; cbk < DEPTH * 6 * D / 64; cbk += G) {
        const int l = cbk / (6 * D / 64), col = (cbk % (6 * D / 64)) * 64 + lane;
        const float* wp = c.in[I_WMOD] + (size_t)l * D * 6 * D + col + (size_t)(w * (D / 8)) * 6 * D;
        float acc[NB + 1];
#pragma unroll
        for (int r = 0; r <= NB; ++r) acc[r] = 0.f;
        for (int k0 = 0; k0 < D / 8; k0 += 16) { float wv[16];
#pragma unroll
            for (int e = 0; e < 16; ++e) wv[e] = wp[(size_t)(k0 + e) * 6 * D];
#pragma unroll
            for (int e = 0; e < 16; ++e)
#pragma unroll
                for (int r = 0; r <= NB; ++r) acc[r] += tab[r * D + w * (D / 8) + k0 + e] * wv[e]; }
#pragma unroll
        for (int r = 0; r <= NB; ++r) part[(w * (NB + 1) + r) * 64 + lane] = acc[r];
        __syncthreads();
        for (int i = tid; i < (NB + 1) * 64; i += 512) { const int r = i / 64, cc = i % 64; float s = 0.f;
#pragma unroll
            for (int ww = 0; ww < 8; ++ww) s += part[(ww * (NB + 1) + r) * 64 + cc];
            const int colo = (cbk % (6 * D / 64)) * 64 + cc;
            c.mod(l, r)[colo] = s + c.in[I_BMOD][l * 6 * D + colo]; }
        __syncthreads();
    }
}
__host__ __device__ __forceinline__ void ph_foldgate(const Ctx& c, int gt, int gs) {
    for (int it = gt; it < DEPTH * (D / 8) * 512; it += gs) {
        const int col = it % 512, k0 = ((it / 512) % (D / 8)) * 8, l = it / (512 * (D / 8)), d = col / 256, cc = col % 256;
        const float* w2 = c.in[I_GW2] + ((size_t)(l * 2 + d) * 16) * 256 + cc;
        float w2r[16];
#pragma unroll
        for (int r = 0; r < 16; ++r) w2r[r] = w2[r * 256];
        float a[8];
#pragma unroll
        for (int e = 0; e < 8; ++e) { const float* wi = c.in[I_WIN] + ((size_t)l * D + k0 + e) * INW + U_GLR + 16 * d; float s = 0.f;
#pragma unroll
            for (int q = 0; q < 4; ++q) { const f32x4 t = *(const f32x4*)(wi + 4 * q); s += t[0] * w2r[4 * q] + t[1] * w2r[4 * q + 1] + t[2] * w2r[4 * q + 2] + t[3] * w2r[4 * q + 3]; }
            a[e] = s; }
        *(u32x4*)(c.win(l) + (size_t)(INW + col) * D + k0) = (u32x4){pk2(a[0], a[1]), pk2(a[2], a[3]), pk2(a[4], a[5]), pk2(a[6], a[7])};
    }
}

__host__ __device__ __forceinline__ void ph_rwsplit(const Ctx& c, int gt, int gs) {
    for (int it = gt; it < DEPTH * NE * D; it += gs) {
        const int e = it % NE, k = (it / NE) % D, l = it / (NE * D);
        const float w = c.in[I_RW][((size_t)l * D + k) * NE + e];
        const unsigned hi = f2bf(w); const float lo = w - bf2f((bf16_t)hi);
        bf16_t* T = c.wsb(WS_RWT) + (size_t)l * 2 * NE * D;
        T[(size_t)e * D + k] = (bf16_t)hi; T[(size_t)(NE + e) * D + k] = (bf16_t)f2bf(lo);
    }
}

__host__ __device__ __forceinline__ u32x4 pack8(const float* v) { return (u32x4){pk2(v[0], v[1]), pk2(v[2], v[3]), pk2(v[4], v[5]), pk2(v[6], v[7])}; }

struct SegC { int base, len, q0; };
__host__ __device__ __forceinline__ SegC seg_of_chunk(int b, int n) { SegC s; if (n < CTX / 64) { s.base = NLAT + b * CTX; s.len = CTX; s.q0 = 64 * n; } else { s.base = b * SEQ; s.len = SEQ; s.q0 = 64 * (n - CTX / 64); } return s; }
__host__ __device__ __forceinline__ int seg_row(const SegC& s, int dir, int q) { return s.base + (dir == 0 ? q : s.len - 1 - q); }
__host__ __device__ __forceinline__ float tap_at(const bf16_t* U, const SegC& s, int dir, int q, int ucol, bool colmajor) {
    const bool ok = q >= 0 && q < s.len; const int qc = q < 0 ? 0 : (q >= s.len ? s.len - 1 : q);
    const int r = seg_row(s, dir, qc);
    const float v = bf2f(U[(size_t)(colmajor ? tokrow_of_srow(r) : r) * INP + ucol]);
    return ok ? v : 0.f;
}

#ifndef CPU_TEST
#define MFMA16(a, b, c) __builtin_amdgcn_mfma_f32_16x16x32_bf16((a), (b), (c), 0, 0, 0)
#else
#define MFMA16(a, b, c) mfma16_emul((a), (b), (c))
#endif
#ifndef CPU_TEST
#define LDS_BAR() do { asm volatile("s_waitcnt lgkmcnt(0)" ::: "memory"); __builtin_amdgcn_s_barrier(); asm volatile("" ::: "memory"); } while (0)
#else
#define LDS_BAR() __syncthreads()
#endif
typedef LAS unsigned char* ldsp_t;
typedef unsigned long long u64_t;
__device__ __forceinline__ bf16x8 lds_rd16(ldsp_t p) { return *(const LAS bf16x8*)p; }
__device__ __forceinline__ bf16x8 lds_rd8x2(ldsp_t p0, ldsp_t p1) { const u64_t a = *(const LAS u64_t*)p0, b = *(const LAS u64_t*)p1; u32x4 v = {(unsigned)a, (unsigned)(a >> 32), (unsigned)b, (unsigned)(b >> 32)}; return __builtin_bit_cast(bf16x8, v); }
template <int KIND> struct ChainCfg {
    static constexpr int DK = KIND == 2 ? 128 : 64, DV = KIND == 2 ? 64 : 128, NCW = DV / 16, KSPLIT = 8 / NCW, KS = DK / 32, KT = DK / 16, KSL = KS / KSPLIT, KTL = KT / KSPLIT, NPC = DK / 64;
    static constexpr int RS_T = DK * 2 + 16, RS_F = 144, OFF_KB = 64 * RS_T, OFF_KDT = 128 * RS_T, OFF_SC = OFF_KDT + DK * RS_F, BUFSZ = OFF_SC + 1024;
    static constexpr int OFF_P = 2 * BUFSZ, OFF_N = OFF_P + 64 * 144, OFF_DEN = OFF_N + 256, OFF_V = OFF_DEN + 1280, RS_V = DV * 2 + 16;
    static constexpr int LDS_NEED = OFF_V + (KIND == 2 ? 4 * 16 * 64 * 4 : 2 * 64 * RS_V);
    static constexpr int SCB = KIND == 0 ? 256 : KIND == 1 ? 1024 : 512;
    static_assert(LDS_NEED <= 139264, "chain LDS");
};
#ifndef CPU_TEST
#define LDS_ADDF(p, v) (void)__hip_atomic_fetch_add((p), (v), __ATOMIC_RELAXED, __HIP_MEMORY_SCOPE_WORKGROUP)
#else
#define LDS_ADDF(p, v) (*(p) += (v))
#endif
template <int KIND> __device__ __forceinline__ void chain_run(const Ctx& c, ldsp_t lds, int cid, int tid, bool noload = false, bool nostore = false) {
    typedef ChainCfg<KIND> CF;
    constexpr int DK = CF::DK, DV = CF::DV, NCW = CF::NCW, KS = CF::KS, KSL = CF::KSL, KTL = CF::KTL, NPC = CF::NPC, RS_T = CF::RS_T, RS_F = CF::RS_F;
    const int lane = tid & 63, w = RFL(tid >> 6), cc = lane & 15, g = lane >> 4;
    const int wc = w % NCW, kh = w / NCW;
    const bool outw = kh == 0;
    const int dir = cid % 2, hh = KIND == 2 ? (cid / 2) % 8 : (cid / 2) % 4, b = KIND == 2 ? cid / 16 : cid / 8;
    constexpr bool SHQ = KIND != 0, SHD = KIND == 2;
    const bool mir = dir == 1;
    const size_t opc = KIND == 2 ? (size_t)((b * 2 + hh / 4) * 2 + (SHQ ? 0 : dir)) * NCH : (size_t)(SHQ ? cid - dir : cid) * NCH;
    const size_t opd = KIND == 2 ? opc : (size_t)cid * NCH;
    const size_t vpc = (size_t)cid * NCH;
    const bf16_t* gQA = c.wsb(KIND == 0 ? WS_GQA : KIND == 1 ? WS_MQA : WS_SQA) + opc * (64 * DK);
    const bf16_t* gKB = c.wsb(KIND == 0 ? WS_GKB : KIND == 1 ? WS_MKB : WS_SKB) + opc * (64 * DK);
    const bf16_t* gKDT = c.wsb(KIND == 0 ? WS_GKDT : KIND == 1 ? WS_MKDT : WS_SKDT) + opd * (64 * DK);
    const bf16_t* gVT = c.wsb(WS_SVT) + vpc * (64 * DV);
    const bf16_t* gU = c.u() + (KIND == 0 ? U_GV : U_MV) + hh * 128;
    const bf16_t* gVHT = c.wsb(WS_SVHT) + vpc * (64 * DV);
    const unsigned char* gSC = (const unsigned char*)(KIND == 0 ? c.wsf(WS_GAL) + vpc * 64 : KIND == 1 ? c.wsf(WS_MMS) + vpc * 256 : c.wsf(WS_SCS) + vpc * 128);
    bf16_t* Og = c.odir() + (KIND == 0 ? OF_G : KIND == 1 ? OF_M : OF_S) + (size_t)cid * NCH * (4 * NCW * 256) + (wc * 64 + lane) * 4;
    LAS float* DEN = (LAS float*)(lds + CF::OFF_DEN);
    LAS float* XR = (LAS float*)(lds + CF::OFF_V);

    f32x4 S[KTL];
#pragma unroll
    for (int kt = 0; kt < KTL; ++kt) S[kt] = (f32x4){0.f, 0.f, 0.f, 0.f};
    float m0 = -1e30f;
    if (KIND == 1 && tid < 64) ((LAS float*)(lds + CF::OFF_N))[tid] = 0.f;

    u32x4 sq[NPC], sk[NPC], sd[NPC], ssc = {0u, 0u, 0u, 0u}, sv[2]; bf16x8 vf[2], vh[2], vfn[2], vhn[2];
#define CHAIN_LOAD(n_) do { const size_t cb_ = (size_t)(n_); const int nm_ = (int)cb_ < CTX / 64 ? CTX / 64 - 1 - (int)cb_ : CTX / 64 + NCH - 1 - (int)cb_; const size_t cq_ = (SHQ && mir) ? (size_t)nm_ : cb_, cd_ = (SHD && mir) ? (size_t)nm_ : cb_; \
        _Pragma("unroll") for (int q = 0; q < NPC; ++q) { const int p = tid + 512 * q; sq[q] = *(const u32x4*)(gQA + cq_ * (64 * DK) + p * 8); sk[q] = *(const u32x4*)(gKB + cq_ * (64 * DK) + p * 8); if (KIND == 1) sd[q] = *(const u32x4*)(gKDT + cd_ * (64 * DK) + p * 8); } \
        if (tid < CF::SCB / 16) ssc = *(const u32x4*)(gSC + cb_ * CF::SCB + tid * 16); \
        if (KIND == 2) { _Pragma("unroll") for (int s = 0; s < 2; ++s) { if (outw) vfn[s] = *(const bf16x8*)(gVT + cb_ * (64 * DV) + (16 * wc + cc) * 64 + 32 * s + 8 * g); vhn[s] = *(const bf16x8*)(gVHT + cb_ * (64 * DV) + (16 * wc + cc) * 64 + 32 * s + 8 * g); } } \
        else { _Pragma("unroll") for (int q = 0; q < 2; ++q) { const int p = tid + 512 * q; sv[q] = *(const u32x4*)(gU + (size_t)scan_row(b, dir, 64 * (int)cb_ + p / 16) * INP + (p % 16) * 8); } } } while (0)
#define CHAIN_STAGE(buf_) do { ldsp_t d_ = lds + (buf_) * CF::BUFSZ; \
        _Pragma("unroll") for (int q = 0; q < NPC; ++q) { const int p = tid + 512 * q; const int rt0 = p / (DK / 8), ct = p % (DK / 8), rt = (SHQ && mir) ? 63 - rt0 : rt0; *(LAS u32x4*)(d_ + rt * RS_T + ct * 16) = sq[q]; *(LAS u32x4*)(d_ + CF::OFF_KB + rt * RS_T + ct * 16) = sk[q]; \
            if (KIND == 1) *(LAS u32x4*)(d_ + CF::OFF_KDT + (p / 8) * RS_F + (p % 8) * 16) = sd[q]; } \
        if (tid < CF::SCB / 16) *(LAS u32x4*)(d_ + CF::OFF_SC + tid * 16) = ssc; \
        if (KIND == 2) { vf[0] = vfn[0]; vf[1] = vfn[1]; vh[0] = vhn[0]; vh[1] = vhn[1]; } \
        else { _Pragma("unroll") for (int q = 0; q < 2; ++q) { const int p = tid + 512 * q; *(LAS u32x4*)(lds + CF::OFF_V + (buf_) * (64 * CF::RS_V) + (p / 16) * CF::RS_V + (p % 16) * 16) = sv[q]; } } } while (0)
    CHAIN_LOAD(0); CHAIN_STAGE(0);
    LDS_BAR();

    for (int n = 0; n < NCH; ++n) {
        ldsp_t cur = lds + (n & 1) * CF::BUFSZ;
        const LAS float* SC = (const LAS float*)(cur + CF::OFF_SC);
        if (n + 1 < NCH && !noload) CHAIN_LOAD(n + 1);
#pragma unroll
        for (int tt = 0; tt < 2; ++tt) {
            const int t = 2 * w + tt, jt = t >> 2, it = t & 3;
            f32x4 acc = {0.f, 0.f, 0.f, 0.f};
#pragma unroll
            for (int s = 0; s < KS; ++s) acc = MFMA16(lds_rd16(cur + CF::OFF_KB + (16 * jt + cc) * RS_T + (32 * s + 8 * g) * 2), lds_rd16(cur + (16 * it + cc) * RS_T + (32 * s + 8 * g) * 2), acc);
            const int i = 16 * it + cc, j0 = 16 * jt + 4 * g;
            float pi = 0.f;
            if (KIND == 1) pi = fmaxf(m0, SC[i * 4 + 2]);
            if (KIND == 2) pi = SC[i * 2];
            float pv[4];
#pragma unroll
            for (int r = 0; r < 4; ++r) { const int j = j0 + r; float d = 1.f;
                if (KIND == 1) d = __expf(SC[j * 4 + 1] - pi);
                if (KIND == 2) d = __expf(pi - SC[j * 2]);
                pv[r] = j <= i ? acc[r] * d : 0.f; }
            const unsigned p01 = pk2(pv[0], pv[1]), p23 = pk2(pv[2], pv[3]);
            *(LAS u64_t*)(lds + CF::OFF_P + i * 144 + j0 * 2) = (u64_t)p01 | ((u64_t)p23 << 32);
            if (KIND == 1) {
                float unp[4]; { unsigned t0 = p01 << 16, t1 = p01 & 0xffff0000u, t2 = p23 << 16, t3 = p23 & 0xffff0000u; __builtin_memcpy(&unp[0], &t0, 4); __builtin_memcpy(&unp[1], &t1, 4); __builtin_memcpy(&unp[2], &t2, 4); __builtin_memcpy(&unp[3], &t3, 4); }
                float rs_ = (unp[0] + unp[1]) + (unp[2] + unp[3]);
                rs_ += SHFL_XOR_F(rs_, 16); rs_ += SHFL_XOR_F(rs_, 32);
                if (g == 0) DEN[jt * 64 + i] = jt <= it ? rs_ : 0.f;
            }
        }
        f32x4 ai[4], ap[4];
        {
            bf16x8 sf[KSL];
#pragma unroll
            for (int s = 0; s < KSL; ++s) { u32x4 v = {pk2(S[2 * s][0], S[2 * s][1]), pk2(S[2 * s][2], S[2 * s][3]), pk2(S[2 * s + 1][0], S[2 * s + 1][1]), pk2(S[2 * s + 1][2], S[2 * s + 1][3])}; sf[s] = __builtin_bit_cast(bf16x8, v); }
#pragma unroll
            for (int it = 0; it < 4; ++it) {
                ai[it] = (f32x4){0.f, 0.f, 0.f, 0.f};
#pragma unroll
                for (int s = 0; s < KSL; ++s) { ldsp_t qa = cur + (16 * it + cc) * RS_T + (32 * (kh * KSL + s) + 4 * g) * 2; ai[it] = MFMA16(lds_rd8x2(qa, qa + 32), sf[s], ai[it]); }
            }
            if (KIND == 2 && !outw) {
#pragma unroll
                for (int it = 0; it < 4; ++it) *(LAS f32x4*)(XR + ((wc * 4 + it) * 64 + lane) * 4) = ai[it];
            }
        }
        if (KIND == 1) {
            const int row = tid >> 3, part = tid & 7;
            const bf16x8 qr = lds_rd16(cur + row * RS_T + part * 16);
            const LAS float* n0 = (const LAS float*)(lds + CF::OFF_N) + part * 8;
            float sqn = 0.f;
#pragma unroll
            for (int e = 0; e < 8; ++e) sqn += bf2f((bf16_t)qr[e]) * n0[e];
            sqn += RED1(sqn); sqn += RED2(sqn); sqn += RED4(sqn);
            if (part == 0) DEN[4 * 64 + row] = __expf(m0 - fmaxf(m0, SC[row * 4 + 2])) * sqn;
        }
        LDS_BAR();
        float c0 = 1.f, c1 = 1.f;
        if (KIND == 1) { const float rL = SC[63 * 4 + 2], ML = fmaxf(m0, rL); c0 = __expf(m0 - ML); c1 = __expf(rL - ML); }
        if (KIND == 2) c0 = __expf(SC[63 * 2]);
        if (KIND == 1) {
            const int krow = tid >> 3, part = tid & 7;
            const bf16x8 kr = lds_rd16(cur + CF::OFF_KDT + krow * RS_F + part * 16);
            float s = 0.f;
#pragma unroll
            for (int e = 0; e < 8; ++e) s += bf2f((bf16_t)kr[e]);
            s += RED1(s); s += RED2(s); s += RED4(s);
            if (part == 0) { LAS float* np = (LAS float*)(lds + CF::OFF_N) + krow; *np = c0 * *np + c1 * s; }
        }
        if (KIND != 2) {
            const LAS bf16_t* vi = (const LAS bf16_t*)(lds + CF::OFF_V + (n & 1) * (64 * CF::RS_V)) + 16 * wc + cc;
#pragma unroll
            for (int s = 0; s < 2; ++s) { unsigned pkd[4];
#pragma unroll
                for (int e = 0; e < 4; ++e) { const unsigned lo_ = vi[(32 * s + 8 * g + 2 * e) * (CF::RS_V / 2)], hi_ = vi[(32 * s + 8 * g + 2 * e + 1) * (CF::RS_V / 2)]; pkd[e] = lo_ | (hi_ << 16); }
                const u32x4 pv_ = {pkd[0], pkd[1], pkd[2], pkd[3]}; vf[s] = __builtin_bit_cast(bf16x8, pv_); }
        }
        if (outw) {
#pragma unroll
            for (int it = 0; it < 4; ++it) {
                if (KIND == 2) ai[it] = ai[it] + *(const LAS f32x4*)(XR + ((wc * 4 + it) * 64 + lane) * 4);
                ap[it] = KIND == 0 ? ai[it] : (f32x4){0.f, 0.f, 0.f, 0.f};
#pragma unroll
                for (int s = 0; s < 2; ++s) ap[it] = MFMA16(lds_rd16(lds + CF::OFF_P + (16 * it + cc) * 144 + (32 * s + 8 * g) * 2), vf[s], ap[it]);
            }
#pragma unroll
            for (int it = 0; it < 4; ++it) {
                f32x4 ov;
                const int i0 = 16 * it + 4 * g;
                if (KIND == 1) {
                    const f32x4 d0 = *(const LAS f32x4*)(DEN + i0), d1 = *(const LAS f32x4*)(DEN + 64 + i0), d2 = *(const LAS f32x4*)(DEN + 128 + i0), d3 = *(const LAS f32x4*)(DEN + 192 + i0), d4 = *(const LAS f32x4*)(DEN + 256 + i0);
                    const f32x4 den4 = ((d0 + d1) + (d2 + d3)) + d4;
#pragma unroll
                    for (int r = 0; r < 4; ++r) { const f32x4 sc = *(const LAS f32x4*)(SC + (i0 + r) * 4);
                        const float Mi = fmaxf(m0, sc[2]);
                        ov[r] = (ap[it][r] + __expf(m0 - Mi) * ai[it][r]) * FRCP(fmaxf(fabsf(den4[r]), __expf(-sc[0] - Mi))); }
                } else {
#pragma unroll
                    for (int r = 0; r < 4; ++r) { float o = ap[it][r]; if (KIND == 2) o = o + __expf(SC[(i0 + r) * 2]) * ai[it][r]; ov[r] = o; }
                }
                if (!nostore) *(u64_t*)(Og + (size_t)((n * 4 + it) * NCW) * 256) = (u64_t)pk2(ov[0], ov[1]) | ((u64_t)pk2(ov[2], ov[3]) << 32);
            }
        }
#pragma unroll
        for (int kt = 0; kt < KTL; ++kt) {
            const int ktg = kh * KTL + kt;
            if (KIND == 2) S[kt] = S[kt] * c0;
            f32x4 T = KIND == 1 ? (f32x4){0.f, 0.f, 0.f, 0.f} : S[kt];
#pragma unroll
            for (int s = 0; s < 2; ++s) {
                bf16x8 ka;
                if (KIND == 1) ka = lds_rd16(cur + CF::OFF_KDT + (16 * ktg + cc) * RS_F + (32 * s + 8 * g) * 2);
                else {
                    const LAS bf16_t* kb = (const LAS bf16_t*)(cur + CF::OFF_KB) + 16 * ktg + cc; unsigned pk_[4];
#pragma unroll
                    for (int e = 0; e < 4; ++e) { const unsigned lo_ = kb[(32 * s + 8 * g + 2 * e) * (RS_T / 2)], hi_ = kb[(32 * s + 8 * g + 2 * e + 1) * (RS_T / 2)]; pk_[e] = lo_ | (hi_ << 16); }
                    const u32x4 kv_ = {pk_[0], pk_[1], pk_[2], pk_[3]}; ka = __builtin_bit_cast(bf16x8, kv_); }
                T = MFMA16(ka, KIND == 2 ? vh[s] : vf[s], T);
            }
            S[kt] = KIND == 1 ? S[kt] * c0 + T * c1 : T;
            if (KIND == 0) { const f32x4 al = *(const LAS f32x4*)(SC + 16 * ktg + 4 * g); S[kt] = S[kt] * al; }
            if (kt & 1) CBAR();
        }
        if (KIND == 1) m0 = SC[63 * 4] + fmaxf(m0, SC[63 * 4 + 2]);
        if (n + 1 < NCH) CHAIN_STAGE((n + 1) & 1);
        LDS_BAR();
    }
#undef CHAIN_LOAD
#undef CHAIN_STAGE
}
__device__ __forceinline__ void ph_chain(const Ctx& c, ldsp_t lds, int blk, int G, int tid, int kmask = 7) {
    const bool noload = false, nostore = (kmask & 8) != 0;
    (void)G;
    const int ch = blk;
    if (ch < NB * 8) { if (kmask & 1) chain_run<0>(c, lds, ch, tid, noload, nostore); }
    else if (ch < NB * 16) { if (kmask & 2) chain_run<1>(c, lds, ch - NB * 8, tid, noload, nostore); }
    else if (ch < NB * 32) { if (kmask & 4) chain_run<2>(c, lds, ch - NB * 16, tid, noload, nostore); }
}

constexpr int ROUTE_M_LDS = 16 * 33 * 4;
__device__ __forceinline__ void ph_route_m(const Ctx& c, int l, int nrows, LAS float* wl, int gw, int ngw, int lane) {
    const int rr = lane & 15, g = lane >> 4;
    const bf16_t* T = c.wsb(WS_RWT) + (size_t)l * 2 * NE * D;
    for (int tile = gw; tile < nrows / 16; tile += ngw) {
        const int row = 16 * tile + rr;
        const float* xr = c.x() + (size_t)row * D + 8 * g;
        const float* m = c.mod(l, mod_row(16 * tile));
        const float* gp = c.in[I_N2G] + l * D + 8 * g; const float* shp = m + 3 * D + 8 * g; const float* scp = m + 4 * D + 8 * g;
        float ss = 0.f;
        { const float* sp = c.wsf(WS_SSP) + (size_t)row * 64 + 16 * g;
#pragma unroll
          for (int q = 0; q < 16; q += 4) { if (16 * g + q < (D / 256) * 16) { const f32x4 t = *(const f32x4*)(sp + q); ss += (t[0] + t[1]) + (t[2] + t[3]); } } }
        ss += SHFL_XOR_F(ss, 16); ss += SHFL_XOR_F(ss, 32);
        const float r = 1.0f / sqrtf(ss * (1.0f / D) + EPS);
        f32x4 acc0 = {0.f, 0.f, 0.f, 0.f}, acc1 = {0.f, 0.f, 0.f, 0.f};
        bf16_t* hr = c.h() + (size_t)row * D + 8 * g;
        for (int s2 = 0; s2 < D / 32; s2 += 2) {
            f32x4 xv[2][2], gv[2][2], hv[2][2], cv[2][2]; bf16x8 bh[2][2], bl[2][2];
#pragma unroll
            for (int u = 0; u < 2; ++u) { const int s = s2 + u;
                xv[u][0] = *(const f32x4*)(xr + 32 * s); xv[u][1] = *(const f32x4*)(xr + 32 * s + 4); gv[u][0] = *(const f32x4*)(gp + 32 * s); gv[u][1] = *(const f32x4*)(gp + 32 * s + 4);
                hv[u][0] = *(const f32x4*)(shp + 32 * s); hv[u][1] = *(const f32x4*)(shp + 32 * s + 4); cv[u][0] = *(const f32x4*)(scp + 32 * s); cv[u][1] = *(const f32x4*)(scp + 32 * s + 4);
                bh[u][0] = *(const bf16x8*)(T + (size_t)rr * D + 32 * s + 8 * g); bh[u][1] = *(const bf16x8*)(T + (size_t)(16 + rr) * D + 32 * s + 8 * g);
                bl[u][0] = *(const bf16x8*)(T + (size_t)(NE + rr) * D + 32 * s + 8 * g); bl[u][1] = *(const bf16x8*)(T + (size_t)(NE + 16 + rr) * D + 32 * s + 8 * g); }
#pragma unroll
            for (int u = 0; u < 2; ++u) { const int s = s2 + u;
                const f32x4 v0 = (xv[u][0] * r * gv[u][0]) * (cv[u][0] + 1.0f) + hv[u][0], v1 = (xv[u][1] * r * gv[u][1]) * (cv[u][1] + 1.0f) + hv[u][1];
                const u32x4 hi = {pk2(v0[0], v0[1]), pk2(v0[2], v0[3]), pk2(v1[0], v1[1]), pk2(v1[2], v1[3])};
                *(u32x4*)(hr + 32 * s) = hi;
                float lo[8];
#pragma unroll
                for (int e = 0; e < 4; ++e) { const unsigned wv = hi[e]; float fl, fh; unsigned t = wv << 16; __builtin_memcpy(&fl, &t, 4); t = wv & 0xffff0000u; __builtin_memcpy(&fh, &t, 4);
                    lo[2 * e] = (e < 2 ? v0[2 * e] : v1[2 * e - 4]) - fl; lo[2 * e + 1] = (e < 2 ? v0[2 * e + 1] : v1[2 * e - 3]) - fh; }
                const u32x4 lov = {pk2(lo[0], lo[1]), pk2(lo[2], lo[3]), pk2(lo[4], lo[5]), pk2(lo[6], lo[7])};
                const bf16x8 ahi = __builtin_bit_cast(bf16x8, hi), alo = __builtin_bit_cast(bf16x8, lov);
                acc0 = MFMA16(ahi, bh[u][0], acc0); acc0 = MFMA16(alo, bh[u][0], acc0); acc0 = MFMA16(ahi, bl[u][0], acc0);
                acc1 = MFMA16(ahi, bh[u][1], acc1); acc1 = MFMA16(alo, bh[u][1], acc1); acc1 = MFMA16(ahi, bl[u][1], acc1); }
            CBAR();
        }
#pragma unroll
        for (int q = 0; q < 4; ++q) { wl[(4 * g + q) * 33 + rr] = acc0[q] + c.in[I_RB][l * NE + rr]; wl[(4 * g + q) * 33 + 16 + rr] = acc1[q] + c.in[I_RB][l * NE + 16 + rr]; }
        WAVE_SYNC();
        if (lane < 16) {
            const int orow = 16 * tile + lane;
            float lg[NE];
#pragma unroll
            for (int i = 0; i < NE; ++i) lg[i] = wl[lane * 33 + i];
            int te[TOPK]; float tv[TOPK];
#pragma unroll
            for (int kk = 0; kk < TOPK; ++kk) {
                int best = -1; float bv = 0.f;
#pragma unroll
                for (int i = 0; i < NE; ++i) {
                    bool taken = false;
#pragma unroll
                    for (int j = 0; j < kk; ++j) taken = taken || (te[j] == i);
                    if (!taken && (best < 0 || lg[i] > bv)) { best = i; bv = lg[i]; }
                }
                te[kk] = best; tv[kk] = bv;
            }
            float se = 0.f, ex[TOPK];
#pragma unroll
            for (int kk = 0; kk < TOPK; ++kk) { ex[kk] = expf(tv[kk] - tv[0]); se += ex[kk]; }
#pragma unroll
            for (int kk = 0; kk < TOPK; ++kk) {
                c.tope()[orow * TOPK + kk] = te[kk];
                c.topg()[orow * TOPK + kk] = ex[kk] / se;
                c.pos()[orow * TOPK + kk] = atomicAdd(c.cnt(l) + te[kk] * CNTS, 1);
            }
        }
        WAVE_SYNC();
    }
}

constexpr int ROUTE_B_LDS = (8 * 16 * 32 + 16 * 33) * 4;
#ifndef CPU_TEST
__device__ __forceinline__ int lds_fetch_inc(LAS int* p) { return __hip_atomic_fetch_add(p, 1, __ATOMIC_RELAXED, __HIP_MEMORY_SCOPE_WORKGROUP); }
#else
static inline int lds_fetch_inc(int* p) { const int o = *p; *p = o + 1; return o; }
#endif
static_assert(TOPK == 4 && 4640 * 4 >= ROUTE_B_LDS, "route LDS map");
__device__ __forceinline__ void ph_route_b(const Ctx& c, int l, int nrows, LAS float* bl, int blk, int G, int tid, bool dummy = false) {
    constexpr int SPW = D / 256, BATCH = SPW >= 2 ? 2 : 1;
    const int lane = tid & 63, w = RFL(tid >> 6), rr = lane & 15, g = lane >> 4;
    const bf16_t* T = c.wsb(WS_RWT) + (size_t)l * 2 * NE * D;
    LAS float* part = bl; LAS float* lgs = bl + 8 * 16 * 32;
    LAS int* lcnt = (LAS int*)(bl + 4640); LAS int* lbase = lcnt + 32; LAS unsigned* lrec = (LAS unsigned*)(lbase + 32);
    if (tid < 32) lcnt[tid] = 0;
    int nit = 0;
    for (int tile = blk; tile < nrows / 16; tile += G, ++nit) {
        const int row = 16 * tile + rr;
        const float* xr = c.x() + (size_t)row * D + 8 * g;
        const float* m = c.mod(l, mod_row(16 * tile));
        const float* gp = c.in[I_N2G] + l * D + 8 * g; const float* shp = m + 3 * D + 8 * g; const float* scp = m + 4 * D + 8 * g;
        float ss = 0.f;
        { const float* sp = c.wsf(WS_SSP) + (size_t)row * 64 + 16 * g;
#pragma unroll
          for (int q = 0; q < 16; q += 4) { if (16 * g + q < (D / 256) * 16) { const f32x4 t = *(const f32x4*)(sp + q); ss += (t[0] + t[1]) + (t[2] + t[3]); } } }
        ss += SHFL_XOR_F(ss, 16); ss += SHFL_XOR_F(ss, 32);
        const float r = 1.0f / sqrtf(ss * (1.0f / D) + EPS);
        f32x4 acc0 = {0.f, 0.f, 0.f, 0.f}, acc1 = {0.f, 0.f, 0.f, 0.f};
        bf16_t* hr = c.h() + (size_t)row * D + 8 * g;
        for (int s2 = w * SPW; s2 < (w + 1) * SPW; s2 += BATCH) {
            f32x4 xv[BATCH][2], gv[BATCH][2], hv[BATCH][2], cv[BATCH][2]; bf16x8 bh[BATCH][2], bw[BATCH][2];
#pragma unroll
            for (int u = 0; u < BATCH; ++u) { const int s = s2 + u;
                xv[u][0] = *(const f32x4*)(xr + 32 * s); xv[u][1] = *(const f32x4*)(xr + 32 * s + 4); gv[u][0] = *(const f32x4*)(gp + 32 * s); gv[u][1] = *(const f32x4*)(gp + 32 * s + 4);
                hv[u][0] = *(const f32x4*)(shp + 32 * s); hv[u][1] = *(const f32x4*)(shp + 32 * s + 4); cv[u][0] = *(const f32x4*)(scp + 32 * s); cv[u][1] = *(const f32x4*)(scp + 32 * s + 4);
                bh[u][0] = *(const bf16x8*)(T + (size_t)rr * D + 32 * s + 8 * g); bh[u][1] = *(const bf16x8*)(T + (size_t)(16 + rr) * D + 32 * s + 8 * g);
                bw[u][0] = *(const bf16x8*)(T + (size_t)(NE + rr) * D + 32 * s + 8 * g); bw[u][1] = *(const bf16x8*)(T + (size_t)(NE + 16 + rr) * D + 32 * s + 8 * g); }
#pragma unroll
            for (int u = 0; u < BATCH; ++u) { const int s = s2 + u;
                const f32x4 v0 = (xv[u][0] * r * gv[u][0]) * (cv[u][0] + 1.0f) + hv[u][0], v1 = (xv[u][1] * r * gv[u][1]) * (cv[u][1] + 1.0f) + hv[u][1];
                const u32x4 hi = {pk2(v0[0], v0[1]), pk2(v0[2], v0[3]), pk2(v1[0], v1[1]), pk2(v1[2], v1[3])};
                *(u32x4*)(hr + 32 * s) = hi;
                float lo[8];
#pragma unroll
                for (int e = 0; e < 4; ++e) { const unsigned wv = hi[e]; float fl, fh; unsigned t = wv << 16; __builtin_memcpy(&fl, &t, 4); t = wv & 0xffff0000u; __builtin_memcpy(&fh, &t, 4);
                    lo[2 * e] = (e < 2 ? v0[2 * e] : v1[2 * e - 4]) - fl; lo[2 * e + 1] = (e < 2 ? v0[2 * e + 1] : v1[2 * e - 3]) - fh; }
                const u32x4 lov = {pk2(lo[0], lo[1]), pk2(lo[2], lo[3]), pk2(lo[4], lo[5]), pk2(lo[6], lo[7])};
                const bf16x8 ahi = __builtin_bit_cast(bf16x8, hi), alo = __builtin_bit_cast(bf16x8, lov);
                acc0 = MFMA16(ahi, bh[u][0], acc0); acc0 = MFMA16(alo, bh[u][0], acc0); acc0 = MFMA16(ahi, bw[u][0], acc0);
                acc1 = MFMA16(ahi, bh[u][1], acc1); acc1 = MFMA16(alo, bh[u][1], acc1); acc1 = MFMA16(ahi, bw[u][1], acc1); }
        }
#pragma unroll
        for (int q = 0; q < 4; ++q) { part[(w * 16 + 4 * g + q) * 32 + rr] = acc0[q]; part[(w * 16 + 4 * g + q) * 32 + 16 + rr] = acc1[q]; }
        LDS_BAR();
        { const int prow = tid >> 5, e = tid & 31; float s = c.in[I_RB][l * NE + e];
#pragma unroll
          for (int ww = 0; ww < 8; ++ww) s += part[(ww * 16 + prow) * 32 + e];
          lgs[prow * 33 + e] = s; }
        LDS_BAR();
        if (tid < 16) {
            const int orow = 16 * tile + tid;
            float lg[NE];
#pragma unroll
            for (int i = 0; i < NE; ++i) lg[i] = lgs[tid * 33 + i];
            int te[TOPK]; float tv[TOPK];
#pragma unroll
            for (int kk = 0; kk < TOPK; ++kk) {
                int best = -1; float bv = 0.f;
#pragma unroll
                for (int i = 0; i < NE; ++i) {
                    bool taken = false;
#pragma unroll
                    for (int j = 0; j < kk; ++j) taken = taken || (te[j] == i);
                    if (!taken && (best < 0 || lg[i] > bv)) { best = i; bv = lg[i]; }
                }
                te[kk] = best; tv[kk] = bv;
            }
            float se = 0.f, ex[TOPK];
#pragma unroll
            for (int kk = 0; kk < TOPK; ++kk) { ex[kk] = expf(tv[kk] - tv[0]); se += ex[kk]; }
#pragma unroll
            for (int kk = 0; kk < TOPK; ++kk) {
                c.tope()[orow * TOPK + kk] = te[kk];
                c.topg()[orow * TOPK + kk] = ex[kk] / se;
                lrec[nit * 64 + tid * TOPK + kk] = ((unsigned)te[kk] << 16) | (unsigned)lds_fetch_inc(lcnt + te[kk]);
            }
        }
    }
    LDS_BAR();
    if (tid < 32) { const int n = lcnt[tid]; lbase[tid] = n ? atomicAdd(c.cnt(l) + (dummy ? DEPTH * NE * CNTS : 0) + tid * CNTS, n) : 0; }
    LDS_BAR();
    for (int i = tid; i < nit * 64; i += 512) { const int tile = blk + (i >> 6) * G; const unsigned rec = lrec[i]; c.pos()[64 * tile + (i & 63)] = lbase[rec >> 16] + (int)(rec & 0xffffu); }
}

__host__ __device__ __forceinline__ f32x4 silu4(f32x4 x) { return (f32x4){siluf_(x[0]), siluf_(x[1]), siluf_(x[2]), siluf_(x[3])}; }
__host__ __device__ __forceinline__ f32x4 exp4(f32x4 x) { return (f32x4){FEXP(x[0]), FEXP(x[1]), FEXP(x[2]), FEXP(x[3])}; }
__host__ __device__ __forceinline__ f32x4 logsig4(f32x4 x) { return (f32x4){logsigmoidf_(x[0]), logsigmoidf_(x[1]), logsigmoidf_(x[2]), logsigmoidf_(x[3])}; }
__host__ __device__ __forceinline__ f32x4 min4(f32x4 x, float m) { return (f32x4){fminf(x[0], m), fminf(x[1], m), fminf(x[2], m), fminf(x[3], m)}; }
__host__ __device__ __forceinline__ u64_t pk4(f32x4 v) { return (u64_t)pk2(v[0], v[1]) | ((u64_t)pk2(v[2], v[3]) << 32); }
__host__ __device__ __forceinline__ f32x4 tap4_at(const bf16_t* U, const SegC& s, int dir, int q, int ucol, bool colmajor) {
    const bool ok = q >= 0 && q < s.len; const int qc = q < 0 ? 0 : (q >= s.len ? s.len - 1 : q);
    const int r = seg_row(s, dir, qc);
    const f32x4 v = ldb4(U + (size_t)(colmajor ? tokrow_of_srow(r) : r) * INP + ucol);
    return ok ? v : (f32x4){0.f, 0.f, 0.f, 0.f};
}
__host__ __device__ __forceinline__ void store_t8(bf16_t* base, int t0, const f32x4 (&x)[8]) {
#pragma unroll
    for (int cc = 0; cc < 4; ++cc) *(u32x4*)(base + cc * 64 + t0) = (u32x4){pk2(x[0][cc], x[1][cc]), pk2(x[2][cc], x[3][cc]), pk2(x[4][cc], x[5][cc]), pk2(x[6][cc], x[7][cc])};
}
__host__ __device__ __forceinline__ u64_t tapraw4_at(const bf16_t* U, const SegC& s, int dir, int q, int ucol, bool colmajor) {
    const int qc = q < 0 ? 0 : (q >= s.len ? s.len - 1 : q); const int r = seg_row(s, dir, qc);
    return *(const u64_t*)(U + (size_t)(colmajor ? tokrow_of_srow(r) : r) * INP + ucol);
}
__host__ __device__ __forceinline__ bf16_t tapraw1_at(const bf16_t* U, const SegC& s, int dir, int q, int ucol, bool colmajor) {
    const int qc = q < 0 ? 0 : (q >= s.len ? s.len - 1 : q); const int r = seg_row(s, dir, qc);
    return U[(size_t)(colmajor ? tokrow_of_srow(r) : r) * INP + ucol];
}
__host__ __device__ __forceinline__ f32x4 tapcvt4(u64_t raw, const SegC& s, int q) { return (q >= 0 && q < s.len) ? cvtb4(raw) : (f32x4){0.f, 0.f, 0.f, 0.f}; }
__host__ __device__ __forceinline__ void ph_prep4(const Ctx& c, int l, int gt, int gs, int sel = 31) {
    const bf16_t* U = c.u();
    const int rot = (int)CH_G * 16;
    const int gt1 = gt, gt2 = (gt + gs - rot % gs) % gs, gt3 = (gt + gs - (3 * rot) % gs) % gs, gt4 = (gt + gs - (5 * rot) % gs) % gs;
    if (sel & 1) for (int it = gt1; it < (int)CH_G * 16; it += gs) {
        const int k = 4 * (it % 16), hh = (it / 16) % 4, n = (it / 64) % NCH, dir = (it / (64 * NCH)) % 2, b = it / (128 * NCH), cid = (b * 4 + hh) * 2 + dir;
        const SegC sg = seg_of_chunk(b, n);
        const int row0 = seg_row(sg, dir, sg.q0), rs = dir == 0 ? 1 : -1;
        const f32x4 bg = *(const f32x4*)(c.in[I_GBG] + (l * 2 + dir) * 256 + hh * 64 + k);
        const size_t cb = ((size_t)cid * NCH + n);
        bf16_t* QA = c.wsb(WS_GQA) + cb * 4096 + k; bf16_t* KB = c.wsb(WS_GKB) + cb * 4096 + k; bf16_t* KDT = c.wsb(WS_GKDT) + cb * 4096 + k * 64;
        const bf16_t* uq = U + (size_t)row0 * INP + U_GQ + hh * 64 + k; const bf16_t* uk = U + (size_t)row0 * INP + U_GK + hh * 64 + k; const bf16_t* ug = U + (size_t)row0 * INP + U_GGK + dir * 256 + hh * 64 + k;
        f32x4 crun = {0.f, 0.f, 0.f, 0.f};
        u64_t nq[8], nk[8], ng[8];
#pragma unroll
        for (int e = 0; e < 8; ++e) { nq[e] = *(const u64_t*)(uq + (long)rs * e * INP); nk[e] = *(const u64_t*)(uk + (long)rs * e * INP); ng[e] = *(const u64_t*)(ug + (long)rs * e * INP); }
        for (int i0 = 0; i0 < 64; i0 += 8) { const int nb = i0 + 8 < 64 ? i0 + 8 : i0;
            u64_t cq[8], ck[8], cg[8]; f32x4 kd[8];
#pragma unroll
            for (int e = 0; e < 8; ++e) { cq[e] = nq[e]; ck[e] = nk[e]; cg[e] = ng[e]; }
#pragma unroll
            for (int e = 0; e < 8; ++e) { nq[e] = *(const u64_t*)(uq + (long)rs * (nb + e) * INP); nk[e] = *(const u64_t*)(uk + (long)rs * (nb + e) * INP); ng[e] = *(const u64_t*)(ug + (long)rs * (nb + e) * INP); }
            CBAR();
#pragma unroll
            for (int e = 0; e < 8; ++e) { crun = crun + logsig4(cvtb4(cg[e]) + bg) * (1.0f / 16.0f);
                kd[e] = cvtb4(ck[e]) * exp4(min4(-crun, 60.f));
                *(u64_t*)(QA + (i0 + e) * 64) = pk4(cvtb4(cq[e]) * 0.125f * exp4(crun)); *(u64_t*)(KB + (i0 + e) * 64) = pk4(kd[e]); }
        }
        *(f32x4*)(c.wsf(WS_GAL) + cb * 64 + k) = exp4(crun);
    }
    if (sel & 4) for (int it = gt2; it < (int)CH_G * 32; it += gs) {
        const int k = 4 * (it % 16), hh = (it / 16) % 4, which = (it / 64) % 2, n = (it / 128) % NCH, dir = (it / (128 * NCH)) % 2, b = it / (256 * NCH), cid = (b * 4 + hh) * 2 + dir;
        if (which == 0 && dir == 1) continue;
        const SegC sg = seg_of_chunk(b, n);
        const int row0 = seg_row(sg, dir, sg.q0), rs = dir == 0 ? 1 : -1;
        const float bi = c.in[I_MBI][l * 8 + dir * 4 + hh], bf = c.in[I_MBF][l * 8 + dir * 4 + hh];
        const bf16_t* MG = U + (size_t)row0 * INP + U_MG + dir * 4 + hh;
        const size_t cb = ((size_t)cid * NCH + n);
        float rmaxL = 0.f;
        if (which == 1) {
            float F = 0.f, rmax = -1e30f; float* MS = c.wsf(WS_MMS) + cb * 256;
            for (int i0 = 0; i0 < 64; i0 += 16) { float ig[16], lf[16];
#pragma unroll
                for (int e = 0; e < 16; ++e) { ig[e] = bf2f(MG[(long)rs * (i0 + e) * INP]); lf[e] = bf2f(MG[(long)rs * (i0 + e) * INP + 8]); }
#pragma unroll
                for (int e = 0; e < 16; ++e) { F += logsigmoidf_(lf[e] + bf); const float bjv = ig[e] + bi - F; rmax = fmaxf(rmax, bjv); if (k == 0) *(f32x4*)(MS + (i0 + e) * 4) = (f32x4){F, bjv, rmax, 0.f}; } }
            rmaxL = rmax;
        }
        bf16_t* OT = c.wsb(which == 0 ? WS_MQA : WS_MKB) + cb * 4096 + k; bf16_t* KDT = c.wsb(WS_MKDT) + cb * 4096 + k * 64;
        const int cch = which * 256 + hh * 64 + k;
        f32x4 w[7];
#pragma unroll
        for (int j = 0; j < 7; ++j) w[j] = *(const f32x4*)(c.in[I_MCW] + ((size_t)l * 7 + (dir == 0 ? j : 6 - j)) * 512 + cch);
        const f32x4 bc = *(const f32x4*)(c.in[I_MCB] + l * 512 + cch);
        f32x4 win[14];
#pragma unroll
        for (int t = 0; t < 6; ++t) win[t] = tap4_at(U, sg, dir, sg.q0 + t - 3, U_MQK + cch, false);
        float F = 0.f;
        u64_t nt[8]; bf16_t ni[8], nf[8];
#pragma unroll
        for (int e = 0; e < 8; ++e) { nt[e] = tapraw4_at(U, sg, dir, sg.q0 + e + 3, U_MQK + cch, false); ni[e] = MG[(long)rs * e * INP]; nf[e] = MG[(long)rs * e * INP + 8]; }
        for (int i0 = 0; i0 < 64; i0 += 8) { const int nb = i0 + 8 < 64 ? i0 + 8 : i0; f32x4 kd[8]; float ig[8], lf[8];
#pragma unroll
            for (int e = 0; e < 8; ++e) { win[6 + e] = tapcvt4(nt[e], sg, sg.q0 + i0 + e + 3); ig[e] = bf2f(ni[e]); lf[e] = bf2f(nf[e]); }
#pragma unroll
            for (int e = 0; e < 8; ++e) { nt[e] = tapraw4_at(U, sg, dir, sg.q0 + nb + e + 3, U_MQK + cch, false); ni[e] = MG[(long)rs * (nb + e) * INP]; nf[e] = MG[(long)rs * (nb + e) * INP + 8]; }
            CBAR();
#pragma unroll
            for (int e = 0; e < 8; ++e) { f32x4 a = bc;
#pragma unroll
                for (int j = 0; j < 7; ++j) a = a + w[j] * win[e + j];
                f32x4 v = silu4(a); if (which == 1) v = v * 0.125f;
                F += logsigmoidf_(lf[e] + bf);
                if (dir == 0) *(u64_t*)(OT + (i0 + e) * 64) = pk4(v);
                kd[e] = v * FEXP(ig[e] + bi - F - rmaxL); }
            if (which == 1) store_t8(KDT, i0, kd);
#pragma unroll
            for (int t = 0; t < 6; ++t) win[t] = win[t + 8]; }
    }
    if (sel & 8) for (int it = gt3; it < (int)CH_SG * 32; it += gs) {
        const int s = 4 * (it % 32), g = (it / 32) % 2, which = (it / 64) % 2, n = (it / 128) % NCH, dir = 0, b = it / (128 * NCH), gid = (b * 2 + g) * 2 + dir;
        const SegC sg = seg_of_chunk(b, n);
        const size_t cb = ((size_t)gid * NCH + n);
        bf16_t* OT = c.wsb(which == 0 ? WS_SKB : WS_SQA) + cb * 8192 + s; bf16_t* KDT = c.wsb(WS_SKDT) + cb * 8192 + s * 64;
        const int cch = 512 + which * 256 + g * 128 + s;
        f32x4 w[7];
#pragma unroll
        for (int j = 0; j < 7; ++j) w[j] = *(const f32x4*)(c.in[I_2CW] + ((size_t)l * 7 + (dir == 0 ? j : 6 - j)) * 1024 + cch);
        const f32x4 bc = *(const f32x4*)(c.in[I_2CB] + l * 1024 + cch);
        f32x4 win[14];
#pragma unroll
        for (int t = 0; t < 6; ++t) win[t] = tap4_at(U, sg, dir, sg.q0 + t - 3, U_XBC + cch, true);
        u64_t nt[8];
#pragma unroll
        for (int e = 0; e < 8; ++e) nt[e] = tapraw4_at(U, sg, dir, sg.q0 + e + 3, U_XBC + cch, true);
        for (int i0 = 0; i0 < 64; i0 += 8) { const int nb = i0 + 8 < 64 ? i0 + 8 : i0; f32x4 v[8];
#pragma unroll
            for (int e = 0; e < 8; ++e) win[6 + e] = tapcvt4(nt[e], sg, sg.q0 + i0 + e + 3);
#pragma unroll
            for (int e = 0; e < 8; ++e) nt[e] = tapraw4_at(U, sg, dir, sg.q0 + nb + e + 3, U_XBC + cch, true);
            CBAR();
#pragma unroll
            for (int e = 0; e < 8; ++e) { f32x4 a = bc;
#pragma unroll
                for (int j = 0; j < 7; ++j) a = a + w[j] * win[e + j];
                v[e] = silu4(a); *(u64_t*)(OT + (i0 + e) * 128) = pk4(v[e]); }
#pragma unroll
            for (int t = 0; t < 6; ++t) win[t] = win[t + 8]; }
    }
    if (sel & 16) for (int it = gt4; it < (int)CH_S * 16; it += gs) {
        const int p = 4 * (it % 16), hh = (it / 16) % 8, n = (it / 128) % NCH, dir = (it / (128 * NCH)) % 2, b = it / (256 * NCH), cid = (b * 8 + hh) * 2 + dir;
        const SegC sg = seg_of_chunk(b, n);
        const float Ah = -expf(c.in[I_2AL][l * 16 + dir * 8 + hh]), dtb = c.in[I_2DTB][l * 16 + dir * 8 + hh];
        const int cdt = U_DT + dir * 8 + hh;
        float cumL = 0.f;
        for (int i0 = 0; i0 < 64; i0 += 16) { float t[16];
#pragma unroll
            for (int e = 0; e < 16; ++e) t[e] = tap_at(U, sg, dir, sg.q0 + i0 + e, cdt, true);
#pragma unroll
            for (int e = 0; e < 16; ++e) cumL += softplusf_(t[e] + dtb) * Ah; }
        const size_t cb = ((size_t)cid * NCH + n);
        bf16_t* VT = c.wsb(WS_SVT) + cb * 4096 + p * 64; bf16_t* VHT = c.wsb(WS_SVHT) + cb * 4096 + p * 64; float* CS = c.wsf(WS_SCS) + cb * 128;
        const int cx = hh * 64 + p;
        f32x4 wx[7];
#pragma unroll
        for (int j = 0; j < 7; ++j) wx[j] = *(const f32x4*)(c.in[I_2CW] + ((size_t)l * 7 + (dir == 0 ? j : 6 - j)) * 1024 + cx);
        const f32x4 bx = *(const f32x4*)(c.in[I_2CB] + l * 1024 + cx);
        f32x4 win[14];
#pragma unroll
        for (int t = 0; t < 6; ++t) win[t] = tap4_at(U, sg, dir, sg.q0 + t - 3, U_XBC + cx, true);
        float crun = 0.f;
        u64_t nt[8]; bf16_t nd[8];
#pragma unroll
        for (int e = 0; e < 8; ++e) { nt[e] = tapraw4_at(U, sg, dir, sg.q0 + e + 3, U_XBC + cx, true); nd[e] = tapraw1_at(U, sg, dir, sg.q0 + e, cdt, true); }
        for (int i0 = 0; i0 < 64; i0 += 8) { const int nb = i0 + 8 < 64 ? i0 + 8 : i0; float dv[8]; f32x4 a[8], h[8];
#pragma unroll
            for (int e = 0; e < 8; ++e) { win[6 + e] = tapcvt4(nt[e], sg, sg.q0 + i0 + e + 3); dv[e] = bf2f(nd[e]); }
#pragma unroll
            for (int e = 0; e < 8; ++e) { nt[e] = tapraw4_at(U, sg, dir, sg.q0 + nb + e + 3, U_XBC + cx, true); nd[e] = tapraw1_at(U, sg, dir, sg.q0 + nb + e, cdt, true); }
            CBAR();
#pragma unroll
            for (int e = 0; e < 8; ++e) { f32x4 ax = bx;
#pragma unroll
                for (int j = 0; j < 7; ++j) ax = ax + wx[j] * win[e + j];
                const f32x4 xs = silu4(ax); const float dtv = softplusf_(dv[e] + dtb);
                crun += dtv * Ah; a[e] = xs * dtv; h[e] = a[e] * FEXP(cumL - crun);
                if (dir == 0) *(u64_t*)(c.xbc() + (size_t)seg_row(sg, 0, sg.q0 + i0 + e) * 512 + cx) = pk4(xs);
                if (p == 0) { CS[(i0 + e) * 2] = crun; CS[(i0 + e) * 2 + 1] = dtv; } }
            store_t8(VT, i0, a); store_t8(VHT, i0, h);
#pragma unroll
            for (int t = 0; t < 6; ++t) win[t] = win[t + 8]; }
    }
}

constexpr int NPH = 11, NSTEPS = 1 + DEPTH * NPH;
enum { PH_NORM1 = 0, PH_GIN, PH_PREP, PH_SCAN, PH_FIN, PH_GOUT, PH_ROUTE, PH_SCAT, PH_G1, PH_G2, PH_COMB };
constexpr int IT_IN = (D / 64) * (INW / 32), IT_OUT = (MIXW / 64) * (D / 32), IT_GU = (D / 64) * (2 * D / 32), IT_DN = (D / 64) * (D / 32);

#ifndef CPU_TEST
constexpr int LDS_BYTES = 147456, LDS_CTL = 139264;
#define LDS_WAIT() asm volatile("s_waitcnt lgkmcnt(0)" ::: "memory")
typedef __attribute__((address_space(1))) u32x4 g_u32x4;

struct TItem { const float* W; bf16_t* WT; int K, N, mode, item; };
constexpr int IT_DENSE = IT_IN + IT_OUT, IT_MOE = NE * (IT_GU + IT_DN);
__device__ __forceinline__ TItem titem_of(const Ctx& c, int layer, int it) {
    TItem t;
    if (layer < 0) { const int l = it / IT_DENSE; int r = it % IT_DENSE;
        if (r < IT_IN) { t.W = c.in[I_WIN] + (size_t)l * D * INW; t.K = D; t.N = INW; t.WT = c.win(l); t.mode = 0; t.item = r; return t; } r -= IT_IN;
        t.W = c.in[I_WOUT] + (size_t)l * MIXW * D; t.K = MIXW; t.N = D; t.WT = c.wout(l); t.mode = 0; t.item = r; return t; }
    const int l = layer, e = it / (IT_GU + IT_DN); int r = it % (IT_GU + IT_DN);
    if (r < IT_GU) { t.W = c.in[I_WGU] + ((size_t)l * NE + e) * D * 2 * D; t.K = D; t.N = 2 * D; t.WT = c.wgu(l) + (size_t)e * 2 * D * D; t.mode = 1; t.item = r; }
    else { t.W = c.in[I_WDN] + ((size_t)l * NE + e) * D * D; t.K = D; t.N = D; t.WT = c.wdn(l) + (size_t)e * D * D; t.mode = 0; t.item = r - IT_GU; }
    return t;
}
__device__ __forceinline__ void titem_load(const TItem& t, float (&v)[32], int lane) {
    const int nblk = t.N / 32, kb = t.item / nblk, nb = t.item % nblk;
    const float* src = t.W + (size_t)(64 * kb + (lane >> 5)) * t.N + 32 * nb + (lane & 31);
#pragma unroll
    for (int i = 0; i < 32; ++i) v[i] = __builtin_nontemporal_load(src + (size_t)(2 * i) * t.N);
}
__device__ __forceinline__ void titem_store(const TItem& t, const float (&v)[32], LAS float* scr, int lane) {
    const int nblk = t.N / 32, kb = t.item / nblk, nb = t.item % nblk, k0 = 64 * kb, n0 = 32 * nb;
#pragma unroll
    for (int i = 0; i < 32; ++i) scr[(2 * i + (lane >> 5)) * 33 + (lane & 31)] = v[i];
    LDS_WAIT(); asm volatile("" ::: "memory");
    const int c = lane & 7;
    const int r0 = t.mode ? gu_row_of_col(n0) : n0;
#pragma unroll
    for (int j = 0; j < 4; ++j) { const int n = (lane >> 3) + 8 * j; const LAS float* s = scr + (8 * c) * 33 + n;
        u32x4 o; o.x = pk2(s[0 * 33], s[1 * 33]); o.y = pk2(s[2 * 33], s[3 * 33]); o.z = pk2(s[4 * 33], s[5 * 33]); o.w = pk2(s[6 * 33], s[7 * 33]);
        __builtin_nontemporal_store(o, (u32x4*)(t.WT + (size_t)(r0 + n) * t.K + k0 + 8 * c)); }
    LDS_WAIT(); asm volatile("" ::: "memory");
}
__device__ __forceinline__ void ph_transposes(const Ctx& c, LAS unsigned char* lds, int layer, int gw, int ngw, int wave, int lane) {
    LAS float* scr = (LAS float*)(lds + wave * 16384);
    const int nit = layer < 0 ? DEPTH * IT_DENSE : IT_MOE;
    int it = gw;
    if (it >= nit) return;
    TItem cur = titem_of(c, layer, it); float va[32], vb[32];
    titem_load(cur, va, lane);
    for (;;) {
        const int nx = it + ngw; const bool more = nx < nit;
        TItem nxt = cur;
        if (more) { nxt = titem_of(c, layer, nx); titem_load(nxt, vb, lane); }
        titem_store(cur, va, scr, lane);
        if (!more) break;
#pragma unroll
        for (int i = 0; i < 32; ++i) va[i] = vb[i];
        cur = nxt; it = nx;
    }
}

#define FRESH() Ctx c; { const KAS Args* kp_ = (const KAS Args*)__builtin_amdgcn_kernarg_segment_ptr(); asm volatile("" : "+s"(kp_)); c.in = kp_->in; c.out = kp_->out; c.ws = kp_->ws; } \
    int lane; asm volatile("v_mbcnt_lo_u32_b32 %0, -1, 0\n\tv_mbcnt_hi_u32_b32 %0, -1, %0" : "=v"(lane)); const int wave = wave_s, tid = wave * 64 + lane, gt = blk * 512 + tid, gs = G * 512; (void)gt; (void)gs;
__global__ void __launch_bounds__(512, 2) mega_fwd(Args args) {
    extern __shared__ __attribute__((aligned(16))) unsigned char lds_raw[];
    LAS unsigned char* lds = (LAS unsigned char*)lds_raw;
    const int G = gridDim.x, blk = blockIdx.x;
    const int wave_s = __builtin_amdgcn_readfirstlane((int)threadIdx.x >> 6);
    const int lo = args.lo, hi = args.hi;
    for (int u = threadIdx.x; u < (LDS_BYTES - LDS_CTL) / 4; u += 512) ((LAS unsigned*)(lds + LDS_CTL))[u] = 0u;
    __syncthreads();
    volatile LAS unsigned* xbw = (volatile LAS unsigned*)(lds + LDS_CTL + 1024);
    unsigned* barw = (unsigned*)(args.ws + WS_CTL) + CW_BAR + args.li * XCD_BAR_WORDS;
    XcdBarrier bar; bar.bar = barw; bar.x = 0; bar.st = xbw;
    if (hi - lo > 1) bar = xcd_barrier_post(barw, xbw);
    LAS int* tb = (LAS int*)(lds + LDS_CTL + 2048);
    static_assert(2048 + TB_WORDS * 4 <= 4096 && 4096 + NE * 4 <= LDS_BYTES - LDS_CTL, "LDS control region");
#ifndef PHASE_MASK
#define PHASE_MASK 0xFFFFu
#endif
#define EN(p) (((PHASE_MASK) >> (p)) & 1u)
#ifndef DUP_MASK
#define DUP_MASK 0u
#endif
#define DUP(p) (((DUP_MASK) >> (p)) & 1u)
#define IN(s) (lo <= (s) && (s) < hi)
#define SEAM(s) do { if (IN(s) && IN((s) + 1)) xcd_barrier(bar); } while (0)

    if (EN(12) && IN(0)) {
        FRESH();
        const int psel = (hi == 1) ? args.pad : 15;
        if (psel & 1) ph_transposes(c, lds, -1, blk * 8 + wave, G * 8, wave, lane);
        __syncthreads();
        if (psel & 2) ph_mod_w(c, (LAS float*)lds, tid, blk, G);
        if (psel & 8) { ph_foldgate(c, gt, gs); ph_rwsplit(c, gt, gs); }
    }
    SEAM(0);
    for (int l = 0; l < DEPTH; ++l) {
        const int s0 = 1 + l * NPH;
        const bool last = (l == DEPTH - 1);
        const int nrows = last ? NLAT : NTOK;
        if (l == 0) {
            if (EN(PH_NORM1) && IN(s0 + PH_NORM1)) { FRESH(); ph_norm1_w(c, l, blk * 8 + wave, G * 8, lane); }
            SEAM(s0 + PH_NORM1);
        }
        if (EN(PH_GIN) && IN(s0 + PH_GIN)) {
            FRESH();
            pg8::Gemm g{c.h(), c.win(l), NTOK, INP, D}; DenseOrder S; S.init(NTOK, INP, G, blk);
            EpiU E{c.u(), INP};
            pg8::gemm_phase<EpiU, DenseOrder, true, true>(lds, g, S, E, tid);
            if (DUP(PH_GIN)) pg8::gemm_phase<EpiU, DenseOrder, true, true>(lds, g, S, E, tid);
        }
        SEAM(s0 + PH_GIN);
        if (EN(PH_PREP) && IN(s0 + PH_PREP)) { FRESH(); ph_prep4(c, l, gt, gs, (args.li > 0 && s0 + PH_PREP == lo) ? args.pad : 31); }
        SEAM(s0 + PH_PREP);
        if (EN(PH_SCAN) && IN(s0 + PH_SCAN)) { FRESH(); ph_chain(c, lds, blk, G, tid, (hi == s0 + PH_SCAN + 1 && args.pad >= 64) ? (args.pad & 15) : 7); }
        SEAM(s0 + PH_SCAN);
        if (EN(PH_FIN) && IN(s0 + PH_FIN)) { FRESH(); ph_finish_w(c, l, nrows, blk * 8 + wave, G * 8, lane); if (DUP(PH_FIN)) ph_finish_w(c, l, nrows, blk * 8 + wave, G * 8, lane); }
        SEAM(s0 + PH_FIN);
        if (EN(PH_GOUT) && IN(s0 + PH_GOUT)) {
            FRESH();
            pg8::Gemm g{c.y(), c.wout(l), nrows, D, MIXW}; DenseOrder S; S.init(nrows, D, G, blk);
            EpiResid E{c.x(), c.mod(l, 0), c.wsf(WS_SSP)};
            pg8::gemm_phase<EpiResid, DenseOrder, true, true>(lds, g, S, E, tid);
        }
        SEAM(s0 + PH_GOUT);
        if (EN(PH_ROUTE) && IN(s0 + PH_ROUTE)) { FRESH(); if (DUP(PH_ROUTE)) { ph_route_b(c, l, nrows, (LAS float*)lds, blk, G, tid, true); __syncthreads(); } ph_route_b(c, l, nrows, (LAS float*)lds, blk, G, tid); }
        SEAM(s0 + PH_ROUTE);
        if (IN(s0 + PH_SCAT) || IN(s0 + PH_G1) || IN(s0 + PH_G2)) {
            FRESH();
            LAS int* ntl = (LAS int*)(lds + LDS_CTL + 4096);
            if (tid < NE) ntl[tid] = (c.cnt(l)[tid * CNTS] + 255) / 256;
            __syncthreads();
            if (tid < NE) { int a = 0; for (int e = 0; e < NE; ++e) a += (e < tid) ? ntl[e] : 0; tb[tid] = a; const int nt = ntl[tid]; for (int t = 0; t < nt; ++t) tb[NE + 1 + a + t] = tid; if (tid == NE - 1) tb[NE] = a + nt; }
            __syncthreads();
        }
        if (EN(PH_SCAT) && IN(s0 + PH_SCAT)) { FRESH(); ph_rowtok_w(c, l, nrows, (const LAS int*)tb, gt, gs); ph_transposes(c, lds, l, blk * 8 + wave, G * 8, wave, lane); }
        SEAM(s0 + PH_SCAT);
        if (EN(PH_G1) && IN(s0 + PH_G1)) {
            FRESH();
            LAS unsigned short* gtab = (LAS unsigned short*)(lds + 131072);
            MoeOrderG<const LAS int*, const LAS unsigned short*> S(tb, 2 * D / 256, G, blk, gtab, c.rtok());
            { pg8::Unit uu; const int* rt_ = c.rtok(); for (int i = 0; i < 16 && S.next(i, uu); ++i) for (int r = tid; r < 256; r += 512) gtab[i * 256 + r] = (unsigned short)rt_[uu.pm * 256 + r]; }
            __syncthreads();
            pg8::Gemm g{c.h(), c.wgu(l), NTOK, NE * 2 * D, D};
            EpiSwiglu E{c.act(), c.in[I_BGU] + (size_t)l * NE * 2 * D};
            pg8::gemm_phase<EpiSwiglu, MoeOrderG<const LAS int*, const LAS unsigned short*>, true, true>(lds, g, S, E, tid);
        }
        SEAM(s0 + PH_G1);
        if (EN(PH_G2) && IN(s0 + PH_G2)) {
            FRESH();
            pg8::Gemm g{c.act(), c.wdn(l), MAXROWS, NE * D, D}; MoeOrder<const LAS int*> S{tb, D / 256, G, blk, 8, 0};
            EpiDown E{c.yb(), c.in[I_BDN] + (size_t)l * NE * D};
            pg8::gemm_phase<EpiDown, MoeOrder<const LAS int*>, true, true>(lds, g, S, E, tid);
            if (DUP(PH_G2)) pg8::gemm_phase<EpiDown, MoeOrder<const LAS int*>, true, true>(lds, g, S, E, tid);
        }
        SEAM(s0 + PH_G2);
        if (EN(PH_COMB) && IN(s0 + PH_COMB)) { FRESH(); if (DUP(PH_COMB) && l < DEPTH - 1) ph_combine_w(c, l, nrows, blk * 8 + wave, G * 8, lane, true); ph_combine_w(c, l, nrows, blk * 8 + wave, G * 8, lane); }
        SEAM(s0 + PH_COMB);
    }
#undef IN
#undef SEAM
}

#ifndef MK_MULTI
#define MK_MULTI 0
#endif
extern "C" void kernel_launch(void* const* d_in, const int* in_sizes, int n_in, void* d_out, int out_size, void* d_ws, size_t ws_size, hipStream_t stream) {
    static int grid = 0;
    if (grid == 0) {
        if (n_in != N_IN || out_size != NLAT * D || ws_size < WS_END) { fprintf(stderr, "kernel_launch: unexpected shapes (n_in %d out %d ws %zu need %zu)\n", n_in, out_size, ws_size, (size_t)WS_END); grid = -1; return; }
        int dev = 0, cus = 0;
        if (hipGetDevice(&dev) != hipSuccess || hipDeviceGetAttribute(&cus, hipDeviceAttributeMultiprocessorCount, dev) != hipSuccess) { grid = -1; return; }
        if (hipFuncSetAttribute((const void*)mega_fwd, hipFuncAttributeMaxDynamicSharedMemorySize, LDS_BYTES) != hipSuccess) { fprintf(stderr, "kernel_launch: hipFuncSetAttribute failed\n"); grid = -1; return; }
        int per_cu = 0;
        (void)hipOccupancyMaxActiveBlocksPerMultiprocessor(&per_cu, (const void*)mega_fwd, 512, LDS_BYTES);
        (void)hipGetLastError();
        grid = cus;
        if (grid < NB * 32) { fprintf(stderr, "kernel_launch: needs at least %d CUs (one scan chain per workgroup), device has %d\n", NB * 32, cus); grid = -1; return; }
    }
    if (grid < 0) return;
    (void)hipMemsetAsync((char*)d_ws + WS_CTL, 0, CTL_BYTES, stream);
    Args a{};
    for (int i = 0; i < N_IN; ++i) a.in[i] = (const float*)d_in[i];
    a.out = (float*)d_out; a.ws = (unsigned char*)d_ws;
#if MK_MULTI
    for (int s = 0; s < NSTEPS; ++s) { a.lo = s; a.hi = s + 1; hipLaunchKernelGGL(mega_fwd, dim3(grid), dim3(512), LDS_BYTES, stream, a); }
#elif defined(PROBE_PRO)
    a.lo = 0; a.hi = 1; a.li = 0; a.pad = PROBE_PRO; hipLaunchKernelGGL(mega_fwd, dim3(grid), dim3(512), LDS_BYTES, stream, a);
    a.lo = 0; a.hi = NSTEPS; a.li = 1; a.pad = 0; hipLaunchKernelGGL(mega_fwd, dim3(grid), dim3(512), LDS_BYTES, stream, a);
#elif defined(PROBE_PH)
    { int lo = 0; for (int l = 0; l <= DEPTH; ++l) { const int s = 1 + l * NPH + PROBE_PH; a.lo = lo; a.hi = l < DEPTH ? s + 1 : NSTEPS; a.li = l; a.pad = PROBE_SEL; hipLaunchKernelGGL(mega_fwd, dim3(grid), dim3(512), LDS_BYTES, stream, a); lo = s; } }
#else
    a.lo = 0; a.hi = NSTEPS;
    hipLaunchKernelGGL(mega_fwd, dim3(grid), dim3(512), LDS_BYTES, stream, a);
#endif
}

#else
static void transposes_cpu(const Ctx& c) {
    for (int l = 0; l < DEPTH; ++l) {
        for (int k = 0; k < D; ++k) for (int n = 0; n < INW; ++n) c.win(l)[(size_t)n * D + k] = (bf16_t)f2bf(c.in[I_WIN][((size_t)l * D + k) * INW + n]);
        for (int k = 0; k < MIXW; ++k) for (int n = 0; n < D; ++n) c.wout(l)[(size_t)n * MIXW + k] = (bf16_t)f2bf(c.in[I_WOUT][((size_t)l * MIXW + k) * D + n]);
        for (int e = 0; e < NE; ++e) {
            for (int k = 0; k < D; ++k) for (int n = 0; n < 2 * D; ++n) c.wgu(l)[((size_t)e * 2 * D + gu_row_of_col(n)) * D + k] = (bf16_t)f2bf(c.in[I_WGU][(((size_t)l * NE + e) * D + k) * 2 * D + n]);
            for (int k = 0; k < D; ++k) for (int n = 0; n < D; ++n) c.wdn(l)[((size_t)e * D + n) * D + k] = (bf16_t)f2bf(c.in[I_WDN][(((size_t)l * NE + e) * D + k) * D + n]);
        }
    }
}
template <class Sched> static int gemm_cpu_arow(const Sched& S, const pg8::Unit& u, int r) { if constexpr (Sched::GATHER) return S.rowtok[u.pm * 256 + r]; else return u.pm * 256 + r; }
template <class Epi, class Sched> static void gemm_cpu(const pg8::Gemm& g, Sched S, const Epi& E, int G) {
    static float T[256][256];
    for (int cblk = 0; cblk < G; ++cblk) {
        S.c = cblk;
        for (int i = 0;; ++i) {
            pg8::Unit u; if (!S.next(i, u)) break;
            for (int r = 0; r < 256; ++r) for (int cc = 0; cc < 256; ++cc) {
                const bf16_t* a = g.A + (size_t)gemm_cpu_arow(S, u, r) * g.K; const bf16_t* b = g.Bt + (size_t)(u.pn * 256 + cc) * g.K;
                float s = 0.f; for (int k = 0; k < g.K; ++k) s += bf2f(a[k]) * bf2f(b[k]);
                T[r][cc] = s;
            }
            for (int wid = 0; wid < 8; ++wid) for (int lane = 0; lane < 64; ++lane) {
                const int wr = wid >> 2, wc = wid & 3, fr = lane & 15, fq = lane >> 4;
                accq acc[2][2][4][2];
                for (int ai = 0; ai < 2; ++ai) for (int bj = 0; bj < 2; ++bj) for (int m = 0; m < 4; ++m) for (int n = 0; n < 2; ++n) for (int j = 0; j < 4; ++j) {
                    const int r = 128 * ai + 64 * wr + 16 * m + fr;
                    const int cc = Epi::PERM ? 128 * bj + 32 * wc + 8 * fq + 4 * n + j : 128 * bj + 32 * wc + 16 * n + 4 * fq + j;
                    acc[ai][bj][m][n][j] = T[r][cc];
                }
                E(acc, u, wr, wc, fr, fq);
            }
        }
    }
}
constexpr int LDS_BYTES = 147456;
#define COOP(G_, body_) simt::launch(G_, 512, LDS_BYTES, [&]() { const int tid = threadIdx.x, lane = tid & 63, wave = tid >> 6, blk = blockIdx.x, G = gridDim.x; unsigned char* lds = simt::lds_base; (void)lane; (void)wave; (void)blk; (void)G; (void)lds; body_; })
extern "C" void kernel_launch(void* const* d_in, const int* in_sizes, int n_in, void* d_out, int out_size, void* d_ws, size_t ws_size, hipStream_t stream) {
    Ctx c; c.in = (const float* const*)d_in; c.out = (float*)d_out; c.ws = (unsigned char*)d_ws;
    memset((char*)d_ws + WS_CTL, 0, CTL_BYTES);
    const int G = 256, GC = 8;
    transposes_cpu(c);
    COOP(GC, { ph_mod_w(c, (float*)lds, tid, blk, G); });
    ph_foldgate(c, 0, 1); ph_rwsplit(c, 0, 1);
    for (int l = 0; l < DEPTH; ++l) {
        const bool last = (l == DEPTH - 1); const int nrows = last ? NLAT : NTOK;
        if (l == 0) COOP(GC, ph_norm1_w(c, l, blk * 8 + wave, G * 8, lane));
        { pg8::Gemm g{c.h(), c.win(l), NTOK, INP, D}; DenseOrder S; S.init(NTOK, INP, G, 0); EpiU E{c.u(), INP}; gemm_cpu(g, S, E, G); }
        ph_prep4(c, l, 0, 1);
        COOP(NB * 32, ph_chain(c, lds, blk, G, tid));
        COOP(GC, ph_finish_w(c, l, nrows, blk * 8 + wave, G * 8, lane));
        { pg8::Gemm g{c.y(), c.wout(l), nrows, D, MIXW}; DenseOrder S; S.init(nrows, D, G, 0); EpiResid E{c.x(), c.mod(l, 0), c.wsf(WS_SSP)}; gemm_cpu(g, S, E, G); }
        COOP(GC, ph_route_b(c, l, nrows, (float*)lds, blk, G, tid));
        int tb[TB_WORDS]; expert_tile_base(c.cnt(l), tb);
        COOP(GC, ph_rowtok_w(c, l, nrows, (const int*)tb, blk * 512 + tid, G * 512));
        { pg8::Gemm g{c.h(), c.wgu(l), NTOK, NE * 2 * D, D}; MoeOrderG<const int*, const unsigned short*> S(tb, 2 * D / 256, G, 0, nullptr, c.rtok()); EpiSwiglu E{c.act(), c.in[I_BGU] + (size_t)l * NE * 2 * D}; gemm_cpu(g, S, E, G); }
        { pg8::Gemm g{c.act(), c.wdn(l), MAXROWS, NE * D, D}; MoeOrder<const int*> S{tb, D / 256, G, 0}; EpiDown E{c.yb(), c.in[I_BDN] + (size_t)l * NE * D}; gemm_cpu(g, S, E, G); }
        COOP(GC, ph_combine_w(c, l, nrows, blk * 8 + wave, G * 8, lane));
    }
}
#endif
```

```cpp
#ifndef CPU_TEST
#include <hip/hip_runtime.h>
#else
#include "cpu_shim.h"
#endif
#include <cstdio>
#include <cstdint>
#include <cmath>

#ifndef CFG_D
#define CFG_D 1024
#define CFG_B 8
#define CFG_SEQ 2048
#define CFG_DEPTH 4
#define CFG_CTX 256
#endif
constexpr int D = CFG_D, NB = CFG_B, SEQ = CFG_SEQ, DEPTH = CFG_DEPTH, CTX = CFG_CTX;
constexpr int GRID_W = 64, ROWS = SEQ / GRID_W;
constexpr int NLAT = NB * SEQ, NCTX = NB * CTX, NTOK = NLAT + NCTX;
constexpr int INW = 4672, INWX = 5184, INP = 5376, MIXW = 1536, NE = 32, TOPK = 4;
constexpr int U_GQ = 0, U_GK = 256, U_GV = 512, U_GG = 1024, U_GLR = 1536;
constexpr int U_MQK = 1568, U_MV = 2080, U_MO = 2592, U_MG = 3104;
constexpr int U_Z = 3120, U_XBC = 3632, U_DT = 4656, U_GGK = 4672;
constexpr float EPS = 1e-6f;
constexpr int MAXROWS = NTOK * TOPK + NE * 256;
static_assert(NTOK % 256 == 0 && NLAT % 256 == 0 && D % 128 == 0 && D >= 256, "shape");

constexpr size_t al256(size_t x) { return (x + 255) & ~(size_t)255; }
constexpr size_t WS_CTL = 0, CTL_BYTES = 1u << 20;
constexpr size_t WS_MOD = WS_CTL + CTL_BYTES;
constexpr size_t WS_WIN = al256(WS_MOD + (size_t)DEPTH * (NB + 1) * 6 * D * 4);
constexpr size_t WS_WOUT = al256(WS_WIN + (size_t)DEPTH * INP * D * 2);
constexpr size_t WS_WGU = al256(WS_WOUT + (size_t)DEPTH * D * MIXW * 2);
constexpr size_t WS_WDN = al256(WS_WGU + (size_t)DEPTH * NE * 2 * D * D * 2);
constexpr size_t WS_X = al256(WS_WDN + (size_t)DEPTH * NE * D * D * 2);
constexpr size_t WS_H = al256(WS_X + (size_t)NTOK * D * 4);
constexpr size_t WS_U = al256(WS_H + (size_t)NTOK * D * 2);
constexpr size_t WS_GLA_A = al256(WS_U + (size_t)NTOK * INP * 4);
constexpr size_t WS_ML_QK = al256(WS_GLA_A + (size_t)2 * NTOK * 256 * 4);
constexpr size_t WS_ML_G = al256(WS_ML_QK + (size_t)NTOK * 512 * 4);
constexpr size_t WS_XBC = al256(WS_ML_G + (size_t)NTOK * 16 * 4);
constexpr size_t WS_DT = al256(WS_XBC + (size_t)NTOK * 1024 * 4);
constexpr size_t WS_ODIR = al256(WS_DT + (size_t)NTOK * 16 * 4);
constexpr size_t WS_OD2 = al256(WS_ODIR + (size_t)2 * NTOK * MIXW * 4);
constexpr size_t WS_Y = al256(WS_OD2 + (size_t)2 * NTOK * 512 * 4);
constexpr size_t WS_TOPE = al256(WS_Y + (size_t)NTOK * MIXW * 2);
constexpr size_t WS_TOPG = al256(WS_TOPE + (size_t)NTOK * 4 * 4);
constexpr size_t WS_POS = al256(WS_TOPG + (size_t)NTOK * 4 * 4);
constexpr size_t WS_DEST = al256(WS_POS + (size_t)NTOK * 4 * 4);
constexpr size_t WS_XS = al256(WS_DEST + (size_t)NTOK * 4 * 4);
constexpr size_t WS_ACT = al256(WS_XS + (size_t)MAXROWS * D * 2);
constexpr size_t WS_YB = al256(WS_ACT + (size_t)MAXROWS * D * 2);
constexpr int NCH = (CTX + SEQ) / 64;
static_assert(CTX % 64 == 0 && SEQ % 64 == 0, "chunking");
constexpr size_t CH_G = (size_t)NB * 4 * 2 * NCH, CH_S = (size_t)NB * 8 * 2 * NCH, CH_SG = (size_t)NB * 2 * 2 * NCH;
constexpr size_t WS_GQA = al256(WS_YB + (size_t)MAXROWS * D * 4);
constexpr size_t WS_GKB = al256(WS_GQA + CH_G * 4096 * 2);
constexpr size_t WS_GKDT = al256(WS_GKB + CH_G * 4096 * 2);
constexpr size_t WS_GVT = al256(WS_GKDT + CH_G * 4096 * 2);
constexpr size_t WS_GAL = al256(WS_GVT + CH_G * 8192 * 2);
constexpr size_t WS_MQA = al256(WS_GAL + CH_G * 64 * 4);
constexpr size_t WS_MKB = al256(WS_MQA + CH_G * 4096 * 2);
constexpr size_t WS_MKDT = al256(WS_MKB + CH_G * 4096 * 2);
constexpr size_t WS_MVT = al256(WS_MKDT + CH_G * 4096 * 2);
constexpr size_t WS_MMS = al256(WS_MVT + CH_G * 8192 * 2);
constexpr size_t WS_SQA = al256(WS_MMS + CH_G * 256 * 4);
constexpr size_t WS_SKB = al256(WS_SQA + CH_SG * 8192 * 2);
constexpr size_t WS_SKDT = al256(WS_SKB + CH_SG * 8192 * 2);
constexpr size_t WS_SVT = al256(WS_SKDT + CH_SG * 8192 * 2);
constexpr size_t WS_SVHT = al256(WS_SVT + CH_S * 4096 * 2);
constexpr size_t WS_SCS = al256(WS_SVHT + CH_S * 4096 * 2);
constexpr size_t WS_RWT = al256(WS_SCS + CH_S * 128 * 4);
constexpr size_t WS_SSP = al256(WS_RWT + (size_t)DEPTH * 2 * NE * D * 2);
constexpr size_t WS_RTOK = al256(WS_SSP + (size_t)NTOK * 64 * 4);
constexpr size_t WS_END = al256(WS_RTOK + (size_t)MAXROWS * 4);
static_assert(D == 1024 || D == 256, "ssp slots assume D / 256 <= 4 column tiles");
constexpr int CW_BAR = 4096;
constexpr int CW_CNT = 131072, CNTS = 256;

enum { I_X = 0, I_C, I_CTX, I_CCTX, I_WMOD, I_BMOD, I_N1G, I_WIN, I_GW2, I_GBG, I_GNG, I_MCW, I_MCB, I_MBI, I_MBF, I_MNG,
       I_2CW, I_2CB, I_2DTB, I_2AL, I_2D, I_2NG, I_WOUT, I_N2G, I_RW, I_RB, I_WGU, I_BGU, I_WDN, I_BDN, I_FNG, N_IN };

struct Args { const float* in[N_IN]; float* out; unsigned char* ws; int lo, hi, li, pad; };

#ifndef CPU_TEST
#define KAS __attribute__((address_space(4)))
#else
#define KAS
#endif
typedef unsigned short bf16_t;
typedef float f32x4 __attribute__((ext_vector_type(4)));
typedef unsigned u32x4 __attribute__((ext_vector_type(4)));
typedef short bf16x8 __attribute__((ext_vector_type(8)));

__host__ __device__ __forceinline__ unsigned f2bf(float f) { unsigned u; __builtin_memcpy(&u, &f, 4); return (u + 0x7fffu + ((u >> 16) & 1u)) >> 16; }
#ifndef CPU_TEST
__device__ __forceinline__ unsigned pk2(float lo, float hi) { unsigned r; asm("v_cvt_pk_bf16_f32 %0, %1, %2" : "=v"(r) : "v"(lo), "v"(hi)); return r; }
#else
__host__ __device__ __forceinline__ unsigned pk2(float lo, float hi) { return f2bf(lo) | (f2bf(hi) << 16); }
#endif
__host__ __device__ __forceinline__ float bf2f(bf16_t b) { unsigned u = ((unsigned)b) << 16; float f; __builtin_memcpy(&f, &u, 4); return f; }
#ifndef CPU_TEST
#define FEXP(x) __expf(x)
#define FLOG(x) __logf(x)
#define FRCP(x) __builtin_amdgcn_rcpf(x)
#else
#define FEXP(x) expf(x)
#define FLOG(x) logf(x)
#define FRCP(x) (1.0f / (x))
#endif
__host__ __device__ __forceinline__ float sigmoidf_(float x) { return FRCP(1.0f + FEXP(-x)); }
__host__ __device__ __forceinline__ float siluf_(float x) { return x * sigmoidf_(x); }
__host__ __device__ __forceinline__ float logsigmoidf_(float x) { return fminf(x, 0.f) - FLOG(1.0f + FEXP(-fabsf(x))); }
__host__ __device__ __forceinline__ float softplusf_(float x) { return fmaxf(x, 0.f) + FLOG(1.0f + FEXP(-fabsf(x))); }

__host__ __device__ __forceinline__ f32x4 cvtb4(unsigned long long w) { const unsigned lo = (unsigned)w, hi = (unsigned)(w >> 32); f32x4 r;
    unsigned t; float f; t = lo << 16; __builtin_memcpy(&f, &t, 4); r[0] = f; t = lo & 0xffff0000u; __builtin_memcpy(&f, &t, 4); r[1] = f; t = hi << 16; __builtin_memcpy(&f, &t, 4); r[2] = f; t = hi & 0xffff0000u; __builtin_memcpy(&f, &t, 4); r[3] = f; return r; }
__host__ __device__ __forceinline__ f32x4 ldb4(const bf16_t* p) { const unsigned long long w = *(const unsigned long long*)p; const unsigned lo = (unsigned)w, hi = (unsigned)(w >> 32); f32x4 r;
    unsigned t; float f; t = lo << 16; __builtin_memcpy(&f, &t, 4); r[0] = f; t = lo & 0xffff0000u; __builtin_memcpy(&f, &t, 4); r[1] = f; t = hi << 16; __builtin_memcpy(&f, &t, 4); r[2] = f; t = hi & 0xffff0000u; __builtin_memcpy(&f, &t, 4); r[3] = f; return r; }
struct Ctx {
    const float* const KAS* in; float* out; unsigned char* ws;
    __host__ __device__ float* mod(int l, int r) const { return (float*)(ws + WS_MOD) + ((size_t)l * (NB + 1) + r) * 6 * D; }
    __host__ __device__ bf16_t* win(int l) const { return (bf16_t*)(ws + WS_WIN) + (size_t)l * INP * D; }
    __host__ __device__ bf16_t* wout(int l) const { return (bf16_t*)(ws + WS_WOUT) + (size_t)l * D * MIXW; }
    __host__ __device__ bf16_t* wgu(int l) const { return (bf16_t*)(ws + WS_WGU) + (size_t)l * NE * 2 * D * D; }
    __host__ __device__ bf16_t* wdn(int l) const { return (bf16_t*)(ws + WS_WDN) + (size_t)l * NE * D * D; }
    __host__ __device__ float* x() const { return (float*)(ws + WS_X); }
    __host__ __device__ bf16_t* h() const { return (bf16_t*)(ws + WS_H); }
    __host__ __device__ bf16_t* u() const { return (bf16_t*)(ws + WS_U); }
    __host__ __device__ float* gla_a() const { return (float*)(ws + WS_GLA_A); }
    __host__ __device__ float* ml_qk() const { return (float*)(ws + WS_ML_QK); }
    __host__ __device__ float* ml_g() const { return (float*)(ws + WS_ML_G); }
    __host__ __device__ bf16_t* xbc() const { return (bf16_t*)(ws + WS_XBC); }
    __host__ __device__ float* dt() const { return (float*)(ws + WS_DT); }
    __host__ __device__ bf16_t* odir() const { return (bf16_t*)(ws + WS_ODIR); }
    __host__ __device__ float* od2() const { return (float*)(ws + WS_OD2); }
    __host__ __device__ bf16_t* y() const { return (bf16_t*)(ws + WS_Y); }
    __host__ __device__ int* tope() const { return (int*)(ws + WS_TOPE); }
    __host__ __device__ float* topg() const { return (float*)(ws + WS_TOPG); }
    __host__ __device__ int* pos() const { return (int*)(ws + WS_POS); }
    __host__ __device__ int* dest() const { return (int*)(ws + WS_DEST); }
    __host__ __device__ bf16_t* xs() const { return (bf16_t*)(ws + WS_XS); }
    __host__ __device__ bf16_t* act() const { return (bf16_t*)(ws + WS_ACT); }
    __host__ __device__ bf16_t* yb() const { return (bf16_t*)(ws + WS_YB); }
    __host__ __device__ bf16_t* wsb(size_t off) const { return (bf16_t*)(ws + off); }
    __host__ __device__ float* wsf(size_t off) const { return (float*)(ws + off); }
    __host__ __device__ int* rtok() const { return (int*)(ws + WS_RTOK); }
    __host__ __device__ unsigned* ctl() const { return (unsigned*)(ws + WS_CTL); }
    static_assert((size_t)(CW_CNT + 2 * DEPTH * NE * CNTS) * 4 <= CTL_BYTES, "expert counters fit the zeroed control area");
    __host__ __device__ int* cnt(int l) const { return (int*)(ws + WS_CTL) + CW_CNT + l * NE * CNTS; }
};

constexpr size_t OF_G = 0, OF_M = (size_t)NB * 8 * NCH * 8192, OF_S = 2 * OF_M;
static_assert(OF_S + (size_t)NB * 16 * NCH * 4096 == (size_t)2 * NTOK * MIXW, "fragment layout fills the old [2][NTOK][MIXW] buffer exactly");
__host__ __device__ __forceinline__ int chunk_of(int is_lat, int q) { return (is_lat ? CTX / 64 : 0) + q / 64; }
__host__ __device__ __forceinline__ int mod_row(int row) { return row < NLAT ? row / SEQ : NB; }
__host__ __device__ __forceinline__ void seg_of(int row, int& base, int& pos, int& len) {
    if (row < NLAT) { base = (row / SEQ) * SEQ; pos = row - base; len = SEQ; } else { const int r = row - NLAT; base = NLAT + (r / CTX) * CTX; pos = row - base; len = CTX; }
}
__host__ __device__ __forceinline__ int tok_of_scan(int s) { return (s % ROWS) * GRID_W + s / ROWS; }
__host__ __device__ __forceinline__ int scan_of_tok(int t) { return (t % GRID_W) * ROWS + t / GRID_W; }
__host__ __device__ __forceinline__ int tokrow_of_srow(int srow) { if (srow >= NLAT) return srow; const int b = srow / SEQ; return b * SEQ + tok_of_scan(srow - b * SEQ); }
__host__ __device__ __forceinline__ int srow_of_tokrow(int row) { if (row >= NLAT) return row; const int b = row / SEQ; return b * SEQ + scan_of_tok(row - b * SEQ); }

#ifndef CPU_TEST
#define UNI(x) __builtin_amdgcn_readfirstlane(x)
#define CBAR() __builtin_amdgcn_sched_barrier(0)
#define LAS __attribute__((address_space(3)))
namespace pg8 {
#define PG8_LAS __attribute__((address_space(3)))
typedef unsigned short bf16_t;
typedef short bf16x8 __attribute__((ext_vector_type(8)));
typedef float f32x4 __attribute__((ext_vector_type(4)));
typedef unsigned u32x4 __attribute__((ext_vector_type(4)));
constexpr int BM = 256, BK = 64, HALF = 128, HTB = HALF * BK * 2  , STAGE_BYTES = 8 * HTB, NXCD = 8, WGM = 8;

__host__ __device__ __forceinline__ int lds_byte(int r, int c) { const int st = (r >> 4) * 2 + (c >> 5), rr = r & 15, cc = c & 31, ob = rr * 64 + cc * 2; return st * 1024 + (ob ^ (((ob >> 9) & 1) << 5)); }
__host__ __device__ __forceinline__ void stage_rc(int b, int& R, int& C) { const int st = b / 1024, sb = b % 1024, swz = sb ^ (((sb >> 9) & 1) << 5); R = (st >> 1) * 16 + swz / 64; C = (st & 1) * 32 + (swz % 64) / 2; }
__host__ __device__ __forceinline__ int perm32(int rho) { const int n = rho >> 4, i = rho & 15; return 8 * (i >> 2) + 4 * n + (i & 3); }

struct Unit { int pm, pn; };
struct Gemm { const bf16_t* A; const bf16_t* Bt; int M, N, K; };

struct StaticOrder {
    int nM, nN, nwg, G, c;
    __host__ __device__ void init(int M, int N, int G_, int c_) { nM = M / BM; nN = N / BM; nwg = nM * nN; G = G_; c = c_; }
    __host__ __device__ bool next(int i, Unit& u) const {
        const long L = (long)i * G + c; if (L >= nwg) return false;
        int wgid = (int)L; { const int q = nwg / NXCD, r = nwg % NXCD, xcd = wgid % NXCD, off = wgid / NXCD; wgid = (xcd < r ? xcd * (q + 1) : r * (q + 1) + (xcd - r) * q) + off; }
        const int nig = WGM * nN, gid = wgid / nig, fm = gid * WGM, gsz = (nM - fm) < WGM ? (nM - fm) : WGM;
        u.pm = fm + ((wgid % nig) % gsz); u.pn = (wgid % nig) / gsz; return true;
    }
    __device__ __forceinline__ void a_ready(const Unit&) const {}
    __device__ __forceinline__ void done(const Unit&) const {}
};
__device__ __forceinline__ unsigned cvt_pk_bf16(float lo, float hi) { unsigned r; asm volatile("v_cvt_pk_bf16_f32 %0, %1, %2" : "=v"(r) : "v"(lo), "v"(hi)); return r; }
typedef float f32x2 __attribute__((ext_vector_type(2)));
template <class Epi, class Sched, bool ALIGN_EPI = false, bool SP2 = false>
__device__ __forceinline__ void gemm_phase(PG8_LAS unsigned char* lds, const Gemm g, const Sched& S, const Epi& E, const int tid_in) {
    const int tid = tid_in, wid = __builtin_amdgcn_readfirstlane(tid >> 6), lane = tid & 63, wr = wid >> 2, wc = wid & 3, fr = lane & 15, fq = lane >> 4;
    const int K = g.K, nt = K / BK;
    static_assert(!Sched::GATHER || SP2, "the gathered A operand is wired into the SP2 loop only");
    unsigned voffA[2], voffB[2];
#pragma unroll
    for (int i = 0; i < 2; ++i) { int R, C; stage_rc(tid * 16 + i * 8192, R, C); const int Rb = Epi::PERM ? ((R & ~31) + perm32(R & 31)) : R;
        voffA[i] = (unsigned)(R * K + C) * 2u; voffB[i] = (unsigned)(Rb * K + C) * 2u; }
    unsigned gc00 = 0u, gc01 = 0u, gc10 = 0u, gc11 = 0u, gn00 = 0u, gn01 = 0u, gn10 = 0u, gn11 = 0u;
#define PG8_GOFS(d00, d01, d10, d11, uidx) do { int R0_, C0_, R1_, C1_; stage_rc(tid * 16, R0_, C0_); stage_rc(tid * 16 + 8192, R1_, C1_); \
        d00 = ((unsigned)S.grow((uidx), R0_) * (unsigned)K + (unsigned)C0_) * 2u; d01 = ((unsigned)S.grow((uidx), R1_) * (unsigned)K + (unsigned)C1_) * 2u; \
        d10 = ((unsigned)S.grow((uidx), 128 + R0_) * (unsigned)K + (unsigned)C0_) * 2u; d11 = ((unsigned)S.grow((uidx), 128 + R1_) * (unsigned)K + (unsigned)C1_) * 2u; } while (0)
#define PG8_STAGE2(bufoff, gbase, o0, o1) do { \
        __builtin_amdgcn_global_load_lds((const unsigned*)((const char*)(gbase) + (o0)), (PG8_LAS unsigned*)(lds + (bufoff) + ldsw), 16, 0, 0); \
        __builtin_amdgcn_global_load_lds((const unsigned*)((const char*)(gbase) + (o1)), (PG8_LAS unsigned*)(lds + (bufoff) + ldsw + 8192), 16, 0, 0); } while (0)
#define PG8_STAGE_A(bufoff, base, H, NX) do { if constexpr (Sched::GATHER) { const unsigned o0_ = (NX) ? ((H) ? gn10 : gn00) : ((H) ? gc10 : gc00), o1_ = (NX) ? ((H) ? gn11 : gn01) : ((H) ? gc11 : gc01); PG8_STAGE2(bufoff, base, o0_, o1_); } \
        else { PG8_STAGE(bufoff, (base) + (H) * hstep, voffA); } } while (0)
    const size_t kstep = (size_t)(BK * 2);
    const size_t hstep = (size_t)HALF * K * 2;
    const size_t tstep = 2 * hstep;
    const unsigned ldsw = (unsigned)wid * 1024u;
    const int aoff = lds_byte(wr * 64 + fr, fq * 8), boff = lds_byte(wc * 32 + fr, fq * 8);
#define PG8_SA(b, h) (((b) * 2 + (h)) * HTB)
#define PG8_SB(b, h) ((4 + (b) * 2 + (h)) * HTB)
#define PG8_STAGE(bufoff, gbase, voff) do { _Pragma("unroll") for (int _i = 0; _i < 2; ++_i) \
        __builtin_amdgcn_global_load_lds((const unsigned*)((const char*)(gbase) + (voff)[_i]), (PG8_LAS unsigned*)(lds + (bufoff) + ldsw + _i * 8192), 16, 0, 0); } while (0)
#define PG8_LDA(dst, b, h) do { _Pragma("unroll") for (int m = 0; m < 4; ++m) _Pragma("unroll") for (int k = 0; k < 2; ++k) dst[m][k] = *(const PG8_LAS bf16x8*)(lds + PG8_SA(b, h) + aoff + m * 2048 + k * 1024); } while (0)
#define PG8_LDB(dst, b, h) do { _Pragma("unroll") for (int n = 0; n < 2; ++n) _Pragma("unroll") for (int k = 0; k < 2; ++k) dst[n][k] = *(const PG8_LAS bf16x8*)(lds + PG8_SB(b, h) + boff + n * 2048 + k * 1024); } while (0)
#define PG8_MMA(ai, bj, At, Bt) do { __builtin_amdgcn_s_setprio(1); _Pragma("unroll") for (int m = 0; m < 4; ++m) _Pragma("unroll") for (int n = 0; n < 2; ++n) _Pragma("unroll") for (int k = 0; k < 2; ++k) \
        acc[ai][bj][m][n] = __builtin_amdgcn_mfma_f32_16x16x32_bf16(Bt[n][k], At[m][k], acc[ai][bj][m][n], 0, 0, 0); __builtin_amdgcn_s_setprio(0); } while (0)
#define PG8_WAIT_V(n) asm volatile("s_waitcnt vmcnt(" #n ")" ::: "memory")
#define PG8_WAIT_L(n) asm volatile("s_waitcnt lgkmcnt(" #n ")" ::: "memory")
#define PG8_BAR __builtin_amdgcn_s_barrier()
#define PG8_SCHED __builtin_amdgcn_sched_barrier(0)
    Unit cur, nxt; int ui = 0;
    if (!S.next(0, cur)) return;
    f32x4 acc[2][2][4][2];
#pragma unroll
    for (int a = 0; a < 2; ++a)
#pragma unroll
        for (int b = 0; b < 2; ++b)
#pragma unroll
            for (int m = 0; m < 4; ++m)
#pragma unroll
                for (int n = 0; n < 2; ++n) acc[a][b][m][n] = (f32x4){0.f, 0.f, 0.f, 0.f};
    bf16x8 At[4][2], B0[2][2], B1[2][2];
    const char* cA = (const char*)g.A + (Sched::GATHER ? (size_t)0 : (size_t)cur.pm * tstep); const char* cB = (const char*)g.Bt + (size_t)cur.pn * tstep;
    if constexpr (Sched::GATHER) PG8_GOFS(gc00, gc01, gc10, gc11, 0);
    S.a_ready(cur);
    if constexpr (SP2) {
        PG8_STAGE(PG8_SB(0, 0), cB, voffB); PG8_STAGE(PG8_SB(0, 1), cB + hstep, voffB); PG8_STAGE_A(PG8_SA(0, 0), cA, 0, false); PG8_STAGE_A(PG8_SA(0, 1), cA, 1, false);
        if (wr == 1) PG8_BAR;
        PG8_WAIT_V(2); PG8_BAR;
        PG8_STAGE(PG8_SB(1, 0), cB + kstep, voffB); PG8_STAGE_A(PG8_SA(1, 0), cA + kstep, 0, false); PG8_STAGE(PG8_SB(1, 1), cB + hstep + kstep, voffB);
        PG8_WAIT_V(6); PG8_BAR;
    } else {
        PG8_STAGE(PG8_SB(0, 0), cB, voffB); PG8_STAGE(PG8_SA(0, 0), cA, voffA); PG8_STAGE(PG8_SB(0, 1), cB + hstep, voffB); PG8_STAGE(PG8_SA(0, 1), cA + hstep, voffA);
        if (wr == 1) PG8_BAR;
        PG8_WAIT_V(4); PG8_BAR;
        PG8_STAGE(PG8_SB(1, 0), cB + kstep, voffB); PG8_STAGE(PG8_SA(1, 0), cA + kstep, voffA); PG8_STAGE(PG8_SB(1, 1), cB + hstep + kstep, voffB);
        PG8_WAIT_V(6); PG8_BAR;
    }
    for (;;) {
        const bool has_next = S.next(ui + 1, nxt);
        const char* nA = (has_next && !Sched::GATHER) ? (const char*)g.A + (size_t)nxt.pm * tstep : cA; const char* nB = has_next ? (const char*)g.Bt + (size_t)nxt.pn * tstep : cB;
        if constexpr (Sched::GATHER) { if (has_next) PG8_GOFS(gn00, gn01, gn10, gn11, ui + 1); else { gn00 = gc00; gn01 = gc01; gn10 = gc10; gn11 = gc11; } }
        for (int t = 0; t < nt; t += 2) {
            const bool last = (t == nt - 2);
            const char* a1 = cA + (size_t)(t + 1) * kstep;
            const char* a2 = last ? nA : cA + (size_t)(t + 2) * kstep; const char* b2 = last ? nB : cB + (size_t)(t + 2) * kstep;
            const char* a3 = a2 + kstep; const char* b3 = b2 + kstep;
            if (last && has_next) S.a_ready(nxt);
            if constexpr (SP2) {
            PG8_LDB(B0, 0, 0); PG8_LDB(B1, 0, 1); PG8_SCHED; PG8_LDA(At, 0, 0); PG8_STAGE_A(PG8_SA(1, 1), a1, 1, false);
            PG8_WAIT_V(8); PG8_WAIT_L(0); PG8_BAR; PG8_MMA(0, 0, At, B0); PG8_MMA(0, 1, At, B1); PG8_BAR; PG8_SCHED;
            PG8_LDA(At, 0, 1); PG8_STAGE(PG8_SB(0, 0), b2, voffB); PG8_STAGE(PG8_SB(0, 1), b2 + hstep, voffB); PG8_STAGE_A(PG8_SA(0, 0), a2, 0, last);
            PG8_WAIT_V(8); PG8_WAIT_L(0); PG8_BAR; PG8_MMA(1, 0, At, B0); PG8_MMA(1, 1, At, B1); PG8_BAR; PG8_SCHED;
            PG8_LDB(B0, 1, 0); PG8_LDB(B1, 1, 1); PG8_SCHED; PG8_LDA(At, 1, 0); PG8_STAGE_A(PG8_SA(0, 1), a2, 1, last);
            PG8_WAIT_V(8); PG8_WAIT_L(0); PG8_BAR; PG8_MMA(0, 0, At, B0); PG8_MMA(0, 1, At, B1); PG8_BAR; PG8_SCHED;
            PG8_LDA(At, 1, 1); PG8_STAGE(PG8_SB(1, 0), b3, voffB); PG8_STAGE(PG8_SB(1, 1), b3 + hstep, voffB); PG8_STAGE_A(PG8_SA(1, 0), a3, 0, last);
            PG8_WAIT_V(8); PG8_WAIT_L(0); PG8_BAR; PG8_MMA(1, 0, At, B0); PG8_MMA(1, 1, At, B1); PG8_BAR; PG8_SCHED;
            } else {
            PG8_LDB(B0, 0, 0); PG8_SCHED; PG8_LDA(At, 0, 0); PG8_STAGE(PG8_SA(1, 1), a1 + hstep, voffA);
            PG8_WAIT_L(8); PG8_BAR; PG8_WAIT_L(0); PG8_MMA(0, 0, At, B0); PG8_BAR; PG8_SCHED;
            PG8_LDB(B1, 0, 1); PG8_STAGE(PG8_SB(0, 0), b2, voffB);
            PG8_BAR; PG8_WAIT_L(0); PG8_MMA(0, 1, At, B1); PG8_BAR;
            PG8_LDA(At, 0, 1); PG8_STAGE(PG8_SA(0, 0), a2, voffA);
            PG8_BAR; PG8_WAIT_L(0); PG8_MMA(1, 0, At, B0); PG8_BAR; PG8_SCHED;
            PG8_STAGE(PG8_SB(0, 1), b2 + hstep, voffB);
            PG8_WAIT_V(6); PG8_BAR; PG8_MMA(1, 1, At, B1); PG8_BAR;
            PG8_LDB(B0, 1, 0); PG8_SCHED; PG8_LDA(At, 1, 0); PG8_STAGE(PG8_SA(0, 1), a2 + hstep, voffA);
            PG8_WAIT_L(8); PG8_BAR; PG8_WAIT_L(0); PG8_MMA(0, 0, At, B0); PG8_BAR; PG8_SCHED;
            PG8_LDB(B1, 1, 1); PG8_STAGE(PG8_SB(1, 0), b3, voffB);
            PG8_BAR; PG8_WAIT_L(0); PG8_MMA(0, 1, At, B1); PG8_BAR;
            PG8_LDA(At, 1, 1); PG8_STAGE(PG8_SA(1, 0), a3, voffA);
            PG8_BAR; PG8_WAIT_L(0); PG8_MMA(1, 0, At, B0); PG8_BAR; PG8_SCHED;
            PG8_STAGE(PG8_SB(1, 1), b3 + hstep, voffB);
            PG8_WAIT_V(6); PG8_BAR; PG8_MMA(1, 1, At, B1); PG8_BAR;
            }
        }
        if constexpr (ALIGN_EPI) { if (wr == 0) PG8_BAR; }
        if constexpr (!Epi::AFTER_DRAIN) { E(acc, cur, wr, wc, fr, fq); S.done(cur); }
        if (!has_next) break;
#pragma unroll
        for (int a = 0; a < 2; ++a)
#pragma unroll
            for (int b = 0; b < 2; ++b)
#pragma unroll
                for (int m = 0; m < 4; ++m)
#pragma unroll
                    for (int n = 0; n < 2; ++n) acc[a][b][m][n] = (f32x4){0.f, 0.f, 0.f, 0.f};
        cur = nxt; cA = nA; cB = nB; ++ui;
        if constexpr (Sched::GATHER) { gc00 = gn00; gc01 = gn01; gc10 = gn10; gc11 = gn11; }
        if constexpr (ALIGN_EPI) { if (wr == 1) PG8_BAR; }
    }
    PG8_WAIT_V(0);
    if constexpr (!ALIGN_EPI) { if (wr == 0) PG8_BAR; }
    PG8_BAR;
    if constexpr (Epi::AFTER_DRAIN) { E.fused(acc, cur, wr, wc, fr, fq, lds, wid, lane); S.done(cur); }
#undef PG8_SA
#undef PG8_SB
#undef PG8_STAGE
#undef PG8_LDA
#undef PG8_LDB
#undef PG8_MMA
#undef PG8_WAIT_V
#undef PG8_WAIT_L
#undef PG8_BAR
#undef PG8_SCHED
#undef PG8_GOFS
#undef PG8_STAGE_A
#undef PG8_STAGE2
}
}
#define XB_TMO      128
#define XB_XCNT(j)  (256  + 64 * (j))
#define XB_XSUB(j)  (1280 + 64 * (j))
#define XB_XGEN(j)  (2304 + 64 * (j))
#define XB_TOP      3328
#define XB_TOPGEN   3392
#define XCD_BAR_WORDS 3456
#define XB_SPIN_CAP (1u << 22)

__device__ __forceinline__ unsigned xb_ld(unsigned* p)              { return __hip_atomic_load(p, __ATOMIC_RELAXED, __HIP_MEMORY_SCOPE_AGENT); }
__device__ __forceinline__ unsigned xb_add(unsigned* p, unsigned v) { return __hip_atomic_fetch_add(p, v, __ATOMIC_RELAXED, __HIP_MEMORY_SCOPE_AGENT); }
__device__ __forceinline__ unsigned xb_xcc_id() { return (unsigned)__builtin_amdgcn_s_getreg((3 << 11) | 20) & 0xFu; }
#define XB_SPIN(cond, bar) do { unsigned _sp = 0; while (cond) { __builtin_amdgcn_s_sleep(1); \
    if ((++_sp & 255u) == 0u) { if (xb_ld(&(bar)[XB_TMO])) break; if (_sp > XB_SPIN_CAP) { atomicAdd(&(bar)[XB_TMO], 1u); break; } } } } while (0)

struct XcdBarrier {
    unsigned* bar; unsigned x;
    volatile LAS unsigned* st;
};

__device__ __forceinline__ XcdBarrier xcd_barrier_post(unsigned* bar, volatile LAS unsigned* st) {
    XcdBarrier b; b.bar = bar; b.x = xb_xcc_id(); b.st = st;
    if (threadIdx.x == 0) (void)xb_add(&bar[XB_XCNT(b.x)], 1u);
    return b;
}
__device__ __forceinline__ void xcd_barrier_complete(unsigned* bar, unsigned x, unsigned& nloc, unsigned& nx) {
    const unsigned G = gridDim.x * gridDim.y * gridDim.z;
    unsigned sum, cnt, mine, sp = 0u;
    for (;;) {
        sum = 0u; cnt = 0u; mine = 0u;
#pragma unroll
        for (unsigned j = 0; j < 16; ++j) { const unsigned c = xb_ld(&bar[XB_XCNT(j)]); sum += c; cnt += (c > 0u) ? 1u : 0u; mine = (j == x) ? c : mine; }
        if (sum == G) break;
        __builtin_amdgcn_s_sleep(1);
        if ((++sp & 255u) == 0u) { if (xb_ld(&bar[XB_TMO])) break; if (sp > XB_SPIN_CAP) { atomicAdd(&bar[XB_TMO], 1u); break; } }
    }
    nloc = mine > 0u ? mine : 1u; nx = cnt > 0u ? cnt : 1u;
}

__device__ __forceinline__ void xcd_barrier(const XcdBarrier& b) {
    asm volatile("s_waitcnt vmcnt(0)" ::: "memory");
    __syncthreads();
    if (threadIdx.x == 0) {
        unsigned* bar = b.bar;
        __builtin_amdgcn_s_waitcnt(0);
        unsigned nloc = b.st[0], nx = b.st[1];
        if (nloc == 0u) { xcd_barrier_complete(bar, b.x, nloc, nx); b.st[0] = nloc; b.st[1] = nx; }
        const unsigned old = xb_add(&bar[XB_XSUB(b.x)], 1u);
        const unsigned gen = old / nloc;
        if (old + 1u == (gen + 1u) * nloc) {
            __builtin_amdgcn_fence(__ATOMIC_RELEASE, "agent");
            asm volatile("s_waitcnt vmcnt(0)" ::: "memory");
            const unsigned og = xb_add(&bar[XB_TOP], 1u);
            const unsigned tg = og / nx;
            if (og + 1u == (tg + 1u) * nx) xb_add(&bar[XB_TOPGEN], 1u);
            else XB_SPIN(xb_ld(&bar[XB_TOPGEN]) == tg, bar);
            __builtin_amdgcn_fence(__ATOMIC_ACQUIRE, "agent");
            xb_add(&bar[XB_XGEN(b.x)], 1u);
            asm volatile("s_waitcnt vmcnt(0)" ::: "memory");
        } else {
            XB_SPIN(xb_ld(&bar[XB_XGEN(b.x)]) == gen, bar);
            __builtin_amdgcn_fence(__ATOMIC_ACQUIRE, "agent");
            asm volatile("s_waitcnt vmcnt(0)" ::: "memory");
        }
    }
    __syncthreads();
}
#else
#define UNI(x) (x)
#define CBAR()
namespace pg8 { typedef float f32x4 __attribute__((ext_vector_type(4))); struct Unit { int pm, pn; }; struct Gemm { const unsigned short* A; const unsigned short* Bt; int M, N, K; }; }
#endif

__host__ __device__ __forceinline__ int scan_row(int b, int dir, int st) {
    return st < CTX ? NLAT + b * CTX + (dir == 0 ? st : CTX - 1 - st) : b * SEQ + (dir == 0 ? st - CTX : SEQ - 1 - (st - CTX));
}
__host__ __device__ __forceinline__ void expert_tile_base(const int* cnt, int* tb) { int a = 0; for (int e = 0; e < NE; ++e) { tb[e] = a; const int nt = (cnt[e * CNTS] + 255) / 256; for (int t = 0; t < nt; ++t) tb[NE + 1 + a + t] = e; a += nt; } tb[NE] = a; }
constexpr int TB_WORDS = NE + 1 + MAXROWS / 256;
struct DenseOrder {
    static constexpr bool GATHER = false;
    __device__ __forceinline__ int grow(int, int) const { return 0; }
    int nM, nN, nwg, G, c;
    __host__ __device__ void init(int M, int N, int G_, int c_) { nM = M / 256; nN = N / 256; nwg = nM * nN; G = G_; c = c_; }
    __host__ __device__ __forceinline__ bool next(int i, pg8::Unit& u) const {
        const long L = (long)i * G + c; if (L >= nwg) return false;
        int wgid = (int)L; { const int q = nwg / 8, r = nwg % 8, xcd = wgid % 8, off = wgid / 8; wgid = (xcd < r ? xcd * (q + 1) : r * (q + 1) + (xcd - r) * q) + off; }
        const int nig = 8 * nN, gid = wgid / nig, fm = gid * 8, gsz = (nM - fm) < 8 ? (nM - fm) : 8;
        u.pm = fm + ((wgid % nig) % gsz); u.pn = (wgid % nig) / gsz; return true;
    }
    __device__ __forceinline__ void a_ready(const pg8::Unit&) const {}
    __device__ __forceinline__ void done(const pg8::Unit&) const {}
};
template <class TB> struct MoeOrder {
    static constexpr bool GATHER = false;
    __device__ __forceinline__ int grow(int, int) const { return 0; }
    TB tb; int nN, G, c; int wgm = 8; int rev = 0;
    __host__ __device__ __forceinline__ bool next(int i, pg8::Unit& u) const {
        const int nRT = tb[NE], nwg = nRT * nN;
        const long L = (long)i * G + c; if (L >= nwg) return false;
        int wgid = (int)L; { const int q = nwg / 8, r = nwg % 8, xcd = wgid % 8, off = wgid / 8; wgid = (xcd < r ? xcd * (q + 1) : r * (q + 1) + (xcd - r) * q) + off; }
        if (rev) wgid = nwg - 1 - wgid;
        const int nig = wgm * nN, gid = wgid / nig, fm = gid * wgm, gsz = (nRT - fm) < wgm ? (nRT - fm) : wgm;
        const int rt = fm + ((wgid % nig) % gsz), ln = (wgid % nig) / gsz;
        const int e = tb[NE + 1 + rt];
#ifndef CPU_TEST
        u.pm = __builtin_amdgcn_readfirstlane(rt); u.pn = __builtin_amdgcn_readfirstlane(e * nN + ln);
#else
        u.pm = rt; u.pn = e * nN + ln;
#endif
        return true;
    }
    __device__ __forceinline__ void a_ready(const pg8::Unit&) const {}
    __device__ __forceinline__ void done(const pg8::Unit&) const {}
};
template <class TB, class GT> struct MoeOrderG : MoeOrder<TB> {
    static constexpr bool GATHER = true;
    GT gtab; const int* rowtok;
    __host__ __device__ MoeOrderG(TB tb_, int nN_, int G_, int c_, GT gt_, const int* rt_) { this->tb = tb_; this->nN = nN_; this->G = G_; this->c = c_; this->wgm = 8; gtab = gt_; rowtok = rt_; }
    __device__ __forceinline__ int grow(int ui, int r) const { return (int)gtab[ui * 256 + r]; }
};
#ifdef CPU_TEST
static inline unsigned cvt_pk_bf16(float lo, float hi) { return pk2(lo, hi); }
#else
using pg8::cvt_pk_bf16;
#endif
typedef pg8::f32x4 accq;
struct EpiU {
    static constexpr bool PERM = true, AFTER_DRAIN = false;
    bf16_t* C; int ldc;
    __device__ __forceinline__ void operator()(const accq (&acc)[2][2][4][2], const pg8::Unit& u, int wr, int wc, int fr, int fq) const {
        const int row0 = u.pm * 256 + wr * 64 + fr, col0 = u.pn * 256 + wc * 32 + 8 * fq;
#pragma unroll
        for (int ai = 0; ai < 2; ++ai)
#pragma unroll
            for (int m = 0; m < 4; ++m) { bf16_t* rowp = C + (size_t)(row0 + ai * 128 + m * 16) * ldc + col0;
#pragma unroll
                for (int bj = 0; bj < 2; ++bj) { const accq v0 = acc[ai][bj][m][0], v1 = acc[ai][bj][m][1];
                    u32x4 w; w.x = cvt_pk_bf16(v0[0], v0[1]); w.y = cvt_pk_bf16(v0[2], v0[3]); w.z = cvt_pk_bf16(v1[0], v1[1]); w.w = cvt_pk_bf16(v1[2], v1[3]);
                    *(u32x4*)(rowp + bj * 128) = w; } }
    }
};
struct EpiResid {
    static constexpr bool PERM = false, AFTER_DRAIN = false;
    float* X; const float* modl; float* SSP;
    __device__ __forceinline__ void operator()(const accq (&acc)[2][2][4][2], const pg8::Unit& u, int wr, int wc, int fr, int fq) const {
        const int row0 = u.pm * 256 + wr * 64 + fr, col0 = u.pn * 256 + wc * 32 + 4 * fq;
#pragma unroll
        for (int ai = 0; ai < 2; ++ai)
#pragma unroll
            for (int m = 0; m < 4; ++m) { const int row = row0 + ai * 128 + m * 16; float* rowp = X + (size_t)row * D + col0; const float* gp = modl + (size_t)mod_row(row) * 6 * D + 2 * D + col0;
                float ss = 0.f;
#pragma unroll
                for (int bj = 0; bj < 2; ++bj)
#pragma unroll
                    for (int n = 0; n < 2; ++n) { const accq gv = *(const accq*)(gp + bj * 128 + n * 16); accq xv = *(accq*)(rowp + bj * 128 + n * 16); xv = xv + gv * acc[ai][bj][m][n]; *(accq*)(rowp + bj * 128 + n * 16) = xv;
                        ss += (xv[0] * xv[0] + xv[1] * xv[1]) + (xv[2] * xv[2] + xv[3] * xv[3]); }
                SSP[(size_t)row * 64 + (u.pn * 4 + wc) * 4 + fq] = ss; }
    }
};
struct EpiSwiglu {
    static constexpr bool PERM = true, AFTER_DRAIN = false;
    bf16_t* ACT; const float* bgu;
    __device__ __forceinline__ void operator()(const accq (&acc)[2][2][4][2], const pg8::Unit& u, int wr, int wc, int fr, int fq) const {
        constexpr int nN = 2 * D / 256;
        const int e = u.pn / nN, ln = u.pn % nN;
        const int row0 = u.pm * 256 + wr * 64 + fr, cl = 128 * ln + wc * 32 + 8 * fq;
        const float* bg = bgu + (size_t)e * 2 * D + cl;
        accq bgl[2], bli[2];
#pragma unroll
        for (int n = 0; n < 2; ++n) { bgl[n] = *(const accq*)(bg + 4 * n); bli[n] = *(const accq*)(bg + D + 4 * n); }
#pragma unroll
        for (int ai = 0; ai < 2; ++ai)
#pragma unroll
            for (int m = 0; m < 4; ++m) {
                float a[8];
#pragma unroll
                for (int n = 0; n < 2; ++n)
#pragma unroll
                    for (int j = 0; j < 4; ++j) {
                        float glu = acc[ai][0][m][n][j] + bgl[n][j], lin = acc[ai][1][m][n][j] + bli[n][j];
                        glu = fminf(glu, 7.0f); lin = fminf(fmaxf(lin, -7.0f), 7.0f);
                        a[4 * n + j] = glu * FRCP(1.0f + __expf(-1.702f * glu)) * (lin + 1.0f);
                    }
                u32x4 w; w.x = cvt_pk_bf16(a[0], a[1]); w.y = cvt_pk_bf16(a[2], a[3]); w.z = cvt_pk_bf16(a[4], a[5]); w.w = cvt_pk_bf16(a[6], a[7]);
                *(u32x4*)(ACT + (size_t)(row0 + ai * 128 + m * 16) * D + cl) = w;
            }
    }
};
struct EpiDown {
    static constexpr bool PERM = true, AFTER_DRAIN = false;
    bf16_t* YB; const float* bdn;
    __device__ __forceinline__ void operator()(const accq (&acc)[2][2][4][2], const pg8::Unit& u, int wr, int wc, int fr, int fq) const {
        constexpr int nN = D / 256;
        const int e = u.pn / nN, ln = u.pn % nN;
        const int row0 = u.pm * 256 + wr * 64 + fr, col0 = ln * 256 + wc * 32 + 8 * fq;
        const float* bp = bdn + (size_t)e * D + col0;
        accq bv[2][2];
#pragma unroll
        for (int bj = 0; bj < 2; ++bj)
#pragma unroll
            for (int n = 0; n < 2; ++n) bv[bj][n] = *(const accq*)(bp + bj * 128 + 4 * n);
#pragma unroll
        for (int ai = 0; ai < 2; ++ai)
#pragma unroll
            for (int m = 0; m < 4; ++m) { bf16_t* rowp = YB + (size_t)(row0 + ai * 128 + m * 16) * D + col0;
#pragma unroll
                for (int bj = 0; bj < 2; ++bj) { const accq v0 = acc[ai][bj][m][0] + bv[bj][0], v1 = acc[ai][bj][m][1] + bv[bj][1];
                    u32x4 w; w.x = cvt_pk_bf16(v0[0], v0[1]); w.y = cvt_pk_bf16(v0[2], v0[3]); w.z = cvt_pk_bf16(v1[0], v1[1]); w.w = cvt_pk_bf16(v1[2], v1[3]);
                    *(u32x4*)(rowp + bj * 128) = w; } }
    }
};
__host__ __device__ __forceinline__ int gu_row_of_col(int n) { return n < D ? 256 * (n / 128) + n % 128 : 256 * ((n - D) / 128) + 128 + (n - D) % 128; }

#ifndef CPU_TEST
__device__ __forceinline__ int lane_now() { int l; asm volatile("v_mbcnt_lo_u32_b32 %0, -1, 0\n\tv_mbcnt_hi_u32_b32 %0, -1, %0" : "=v"(l)); return l; }
#define SHFL_XOR_F(v, m) __builtin_bit_cast(float, __builtin_amdgcn_ds_bpermute((lane_now() ^ (m)) << 2, __builtin_bit_cast(int, (float)(v))))
template <int CTRL> __device__ __forceinline__ float dppf(float v) { return __builtin_bit_cast(float, __builtin_amdgcn_update_dpp(0, __builtin_bit_cast(int, v), CTRL, 0xF, 0xF, true)); }
#define RED1(v) dppf<0xB1>(v)
#define RED2(v) dppf<0x4E>(v)
#define RED4(v) dppf<0x141>(v)
#define RED8(v) dppf<0x140>(v)
#define RFL(x) __builtin_amdgcn_readfirstlane(x)
#define WAVE_SYNC() __builtin_amdgcn_wave_barrier()
#else
#define SHFL_XOR_F(v, m) shfl_xor_f((v), (m))
#define RED1(v) shfl_xor_f((v), 1)
#define RED2(v) shfl_xor_f((v), 2)
#define RED4(v) shfl_xor_f((v), 4)
#define RED8(v) shfl_xor_f((v), 8)
#define RFL(x) rfl_i(x)
#define LAS
#define WAVE_SYNC() simt::wave_sync()
#endif
__device__ __forceinline__ float wave_sum(float v) {
    v += RED1(v); v += RED2(v); v += RED4(v); v += RED8(v); v += SHFL_XOR_F(v, 16); v += SHFL_XOR_F(v, 32);
    return v;
}
static_assert(D % 256 == 0, "row layout: lane l holds float4 j at element 4l + 256j");
constexpr int RJ = D / 256;
__device__ __forceinline__ float row_rms(const f32x4 (&v)[RJ]) {
    float s = 0.f;
#pragma unroll
    for (int j = 0; j < RJ; ++j) s += (v[j][0] * v[j][0] + v[j][1] * v[j][1]) + (v[j][2] * v[j][2] + v[j][3] * v[j][3]);
    return 1.0f / sqrtf(wave_sum(s) * (1.0f / D) + EPS);
}
__device__ __forceinline__ void row_modulate_store(f32x4 (&v)[RJ], float r, const float* g, const float* shift, const float* scale, bf16_t* o, int lane) {
#pragma unroll
    for (int j = 0; j < RJ; ++j) {
        const int e0 = 4 * lane + 256 * j;
        const f32x4 gv = *(const f32x4*)(g + e0), sh = *(const f32x4*)(shift + e0), sc = *(const f32x4*)(scale + e0);
        v[j] = (v[j] * r * gv) * (sc + 1.0f) + sh;
        unsigned lo = pk2(v[j][0], v[j][1]), hi = pk2(v[j][2], v[j][3]);
        *(unsigned long long*)(o + e0) = (unsigned long long)lo | ((unsigned long long)hi << 32);
    }
}
__device__ __forceinline__ void ph_xinit_w(const Ctx& c, int gw, int ngw, int lane) {
    for (int row = gw; row < NTOK; row += ngw) {
        const float* src = row < NLAT ? c.in[I_X] + (size_t)row * D : c.in[I_CTX] + (size_t)(row - NLAT) * D;
        float* dst = c.x() + (size_t)row * D;
#pragma unroll
        for (int j = 0; j < RJ; ++j) *(f32x4*)(dst + 4 * lane + 256 * j) = *(const f32x4*)(src + 4 * lane + 256 * j);
    }
}
__device__ __forceinline__ void ph_norm1_w(const Ctx& c, int l, int gw, int ngw, int lane) {
    for (int row = gw; row < NTOK; row += ngw) {
        const float* xr = row < NLAT ? c.in[I_X] + (size_t)row * D : c.in[I_CTX] + (size_t)(row - NLAT) * D;
        float* dst = c.x() + (size_t)row * D;
        f32x4 v[RJ];
#pragma unroll
        for (int j = 0; j < RJ; ++j) { v[j] = *(const f32x4*)(xr + 4 * lane + 256 * j); *(f32x4*)(dst + 4 * lane + 256 * j) = v[j]; }
        const float r = row_rms(v);
        const float* m = c.mod(l, mod_row(row));
        row_modulate_store(v, r, c.in[I_N1G] + l * D, m, m + D, c.h() + (size_t)row * D, lane);
    }
}
__device__ __forceinline__ void ph_finish_w(const Ctx& c, int l, int nrows, int gw, int ngw, int lane) {
    const bf16_t* U = c.u();
    const bf16_t* OD = c.odir();
    for (int grp = gw; grp < nrows / 4; grp += ngw) {
        const int row0 = 4 * grp;
        int base, pos, len; seg_of(row0, base, pos, len);
        const int is_lat = row0 < NLAT ? 1 : 0, b = is_lat ? row0 / SEQ : (row0 - NLAT) / CTX;
        const int unit = lane >> 3, sub = lane & 7, hd = unit & 3, col0 = unit * 128 + sub * 16;
        const int hc = sub * 16;
        unsigned long long graw[4][4];
#pragma unroll
        for (int j = 0; j < 4; ++j) { const bf16_t* ur = U + (size_t)(row0 + j) * INP; const bf16_t* gate = unit < 4 ? ur + U_GG + unit * 128 + hc : ur + U_MO + (unit - 4) * 128 + hc;
#pragma unroll
            for (int q = 0; q < 4; ++q) graw[j][q] = *(const unsigned long long*)(gate + 4 * q); }
        float o[4][16];
#pragma unroll
        for (int d = 0; d < 2; ++d) {
            const int q = d == 0 ? pos : len - 1 - pos, n = chunk_of(is_lat, q), qi = q % 64;
            const bf16_t* fp = OD + (unit < 4 ? OF_G : OF_M) + ((((size_t)((b * 4 + hd) * 2 + d) * NCH + n) * 4 + qi / 16) * 8 + sub) * 256 + ((qi % 16) / 4) * 64;
#pragma unroll
            for (int e = 0; e < 16; ++e) { const f32x4 v = ldb4(fp + e * 4);
#pragma unroll
                for (int j = 0; j < 4; ++j) o[j][e] = d == 0 ? v[j] : o[j][e] + v[3 - j]; }
        }
        const float* gw_ = unit < 4 ? c.in[I_GNG] + l * 128 + hc : c.in[I_MNG] + l * 512 + (unit - 4) * 128 + hc;
        f32x4 gv[4];
#pragma unroll
        for (int q = 0; q < 4; ++q) gv[q] = *(const f32x4*)(gw_ + 4 * q);
#pragma unroll
        for (int j = 0; j < 4; ++j) {
            float ss = 0.f;
#pragma unroll
            for (int e = 0; e < 16; ++e) ss += o[j][e] * o[j][e];
            ss += RED1(ss); ss += RED2(ss); ss += RED4(ss);
            const float r = 1.0f / sqrtf(ss * (1.0f / 128.f) + EPS);
            unsigned w[8];
#pragma unroll
            for (int q = 0; q < 4; ++q) { const f32x4 ga = cvtb4(graw[j][q]); float t[4];
#pragma unroll
                for (int e = 0; e < 4; ++e) t[e] = o[j][4 * q + e] * r * gv[q][e] * (unit < 4 ? siluf_(ga[e]) : sigmoidf_(ga[e]));
                w[2 * q] = pk2(t[0], t[1]); w[2 * q + 1] = pk2(t[2], t[3]); }
            bf16_t* yr = c.y() + (size_t)(row0 + j) * MIXW + col0;
            *(u32x4*)yr = (u32x4){w[0], w[1], w[2], w[3]}; *(u32x4*)(yr + 8) = (u32x4){w[4], w[5], w[6], w[7]};
            CBAR();
        }
    }
    for (int grp = gw; grp < nrows / 4; grp += ngw) {
        const int srow0 = 4 * grp;
        int base, spos, len; seg_of(srow0, base, spos, len);
        const int is_lat = srow0 < NLAT ? 1 : 0, b = is_lat ? srow0 / SEQ : (srow0 - NLAT) / CTX;
        const int ch0 = 8 * lane, hd = ch0 / 64, wc = (ch0 % 64) / 16, cc0 = ch0 % 16;
        const float dsk = c.in[I_2D][l * 8 + hd];
        unsigned long long xraw[4][2], zraw[4][2];
#pragma unroll
        for (int j = 0; j < 4; ++j) { const int srow = srow0 + j, row = tokrow_of_srow(srow); const bf16_t* xr = c.xbc() + (size_t)srow * 512 + ch0; const bf16_t* ur = U + (size_t)row * INP + U_Z + ch0;
#pragma unroll
            for (int q = 0; q < 2; ++q) { xraw[j][q] = *(const unsigned long long*)(xr + 4 * q); zraw[j][q] = *(const unsigned long long*)(ur + 4 * q); } }
        float acc[4][8];
#pragma unroll
        for (int d = 0; d < 2; ++d) {
            const int q = d == 0 ? spos : len - 1 - spos, n = chunk_of(is_lat, q), qi = q % 64;
            const bf16_t* fp = OD + OF_S + ((((size_t)((b * 8 + hd) * 2 + d) * NCH + n) * 4 + qi / 16) * 4 + wc) * 256 + ((qi % 16) / 4) * 64 + cc0 * 4;
#pragma unroll
            for (int e = 0; e < 8; ++e) { const f32x4 v = ldb4(fp + e * 4);
#pragma unroll
                for (int j = 0; j < 4; ++j) acc[j][e] = d == 0 ? v[j] : acc[j][e] + v[3 - j]; }
        }
        const float* ng = c.in[I_2NG] + l * 512 + ch0;
        const f32x4 g0 = *(const f32x4*)ng, g1 = *(const f32x4*)(ng + 4);
#pragma unroll
        for (int j = 0; j < 4; ++j) {
            const int srow = srow0 + j, row = tokrow_of_srow(srow);
            float yv[8]; float ss = 0.f;
#pragma unroll
            for (int q = 0; q < 2; ++q) { const f32x4 xs = cvtb4(xraw[j][q]), z = cvtb4(zraw[j][q]);
#pragma unroll
                for (int e = 0; e < 4; ++e) { const float t = (acc[j][4 * q + e] + dsk * xs[e]) * siluf_(z[e]); yv[4 * q + e] = t; ss += t * t; } }
            ss += RED1(ss); ss += RED2(ss); ss += RED4(ss); ss += RED8(ss); ss += SHFL_XOR_F(ss, 16);
            const float r = 1.0f / sqrtf(ss * (1.0f / 256.f) + EPS);
            *(u32x4*)(c.y() + (size_t)row * MIXW + 1024 + ch0) = (u32x4){pk2(yv[0] * r * g0[0], yv[1] * r * g0[1]), pk2(yv[2] * r * g0[2], yv[3] * r * g0[3]), pk2(yv[4] * r * g1[0], yv[5] * r * g1[1]), pk2(yv[6] * r * g1[2], yv[7] * r * g1[3])};
            CBAR();
        }
    }
}
constexpr int ROUTE_R = 4, ROUTE_LDS = (ROUTE_R * D + ROUTE_R * NE) * 4;
__device__ __forceinline__ void ph_route_w(const Ctx& c, int l, int nrows, LAS float* wlds, int gw, int ngw, int lane, bool dummy = false) {
    LAS float* hv = wlds; LAS float* lgs = wlds + ROUTE_R * D;
    const float* rw = c.in[I_RW] + (size_t)l * D * NE;
    for (int r0 = gw * ROUTE_R; r0 < nrows; r0 += ngw * ROUTE_R) {
#pragma unroll
        for (int q = 0; q < ROUTE_R; ++q) {
            const int row = r0 + q;
            const float* xr = c.x() + (size_t)row * D;
            f32x4 v[RJ];
#pragma unroll
            for (int j = 0; j < RJ; ++j) v[j] = *(const f32x4*)(xr + 4 * lane + 256 * j);
            const float r = row_rms(v);
            const float* m = c.mod(l, mod_row(row));
            row_modulate_store(v, r, c.in[I_N2G] + l * D, m + 3 * D, m + 4 * D, c.h() + (size_t)row * D, lane);
#pragma unroll
            for (int j = 0; j < RJ; ++j) *(LAS f32x4*)(hv + q * D + 4 * lane + 256 * j) = v[j];
        }
        WAVE_SYNC();
        const int e = lane & 31, kh = lane >> 5;
        float acc[ROUTE_R];
#pragma unroll
        for (int q = 0; q < ROUTE_R; ++q) acc[q] = 0.f;
        for (int k = kh * (D / 2); k < (kh + 1) * (D / 2); k += 4) {
            const float w0 = rw[(size_t)(k + 0) * NE + e], w1 = rw[(size_t)(k + 1) * NE + e], w2 = rw[(size_t)(k + 2) * NE + e], w3 = rw[(size_t)(k + 3) * NE + e];
#pragma unroll
            for (int q = 0; q < ROUTE_R; ++q) { const f32x4 hq = *(const LAS f32x4*)(hv + q * D + k); acc[q] += (hq[0] * w0 + hq[1] * w1) + (hq[2] * w2 + hq[3] * w3); }
        }
#pragma unroll
        for (int q = 0; q < ROUTE_R; ++q) { acc[q] += SHFL_XOR_F(acc[q], 32); if (kh == 0) lgs[q * NE + e] = acc[q] + c.in[I_RB][l * NE + e]; }
        WAVE_SYNC();
        if (lane < ROUTE_R) {
            const int row = r0 + lane;
            float lg[NE];
#pragma unroll
            for (int i = 0; i < NE; ++i) lg[i] = lgs[lane * NE + i];
            int te[TOPK]; float tv[TOPK];
#pragma unroll
            for (int kk = 0; kk < TOPK; ++kk) {
                int best = -1; float bv = 0.f;
#pragma unroll
                for (int i = 0; i < NE; ++i) {
                    bool taken = false;
#pragma unroll
                    for (int j = 0; j < kk; ++j) taken = taken || (te[j] == i);
                    if (!taken && (best < 0 || lg[i] > bv)) { best = i; bv = lg[i]; }
                }
                te[kk] = best; tv[kk] = bv;
            }
            float se = 0.f, ex[TOPK];
#pragma unroll
            for (int kk = 0; kk < TOPK; ++kk) { ex[kk] = expf(tv[kk] - tv[0]); se += ex[kk]; }
#pragma unroll
            for (int kk = 0; kk < TOPK; ++kk) {
                c.tope()[row * TOPK + kk] = te[kk];
                c.topg()[row * TOPK + kk] = ex[kk] / se;
                c.pos()[row * TOPK + kk] = atomicAdd(c.cnt(l) + (dummy ? DEPTH * NE * CNTS : 0) + te[kk] * CNTS, 1);
            }
        }
        WAVE_SYNC();
    }
}
template <class TB> __device__ __forceinline__ void ph_rowtok_w(const Ctx& c, int l, int nrows, TB tb, int gt, int gs) {
    for (int it = gt; it < nrows * TOPK; it += gs) {
        const int d = tb[c.tope()[it]] * 256 + c.pos()[it];
        c.dest()[it] = d; c.rtok()[d] = it / TOPK;
    }
    const int* cn = c.cnt(l);
    for (int it = gt; it < NE * 256; it += gs) {
        const int e = it / 256, p = it % 256, n = cn[e * CNTS], nt = (n + 255) / 256;
        if (nt > 0 && (nt - 1) * 256 + p >= n) c.rtok()[tb[e] * 256 + (nt - 1) * 256 + p] = 0;
    }
}
template <int NR> __device__ __forceinline__ void comb_rows(const Ctx& c, int l, const int (&rows)[NR], int lane, bool dummy) {
    typedef int i32x4 __attribute__((ext_vector_type(4)));
    const bool last = (l == DEPTH - 1);
    i32x4 dd[NR]; f32x4 gk[NR];
#pragma unroll
    for (int a = 0; a < NR; ++a) { dd[a] = *(const i32x4*)(c.dest() + rows[a] * TOPK); gk[a] = *(const f32x4*)(c.topg() + rows[a] * TOPK); }
    f32x4 v[NR][RJ];
#pragma unroll
    for (int a = 0; a < NR; ++a) {
        const float* xr = c.x() + (size_t)rows[a] * D;
        const float* m = c.mod(l, mod_row(rows[a])) + 5 * D;
        const bf16_t* y0 = c.yb() + (size_t)dd[a][0] * D; const bf16_t* y1 = c.yb() + (size_t)dd[a][1] * D; const bf16_t* y2 = c.yb() + (size_t)dd[a][2] * D; const bf16_t* y3 = c.yb() + (size_t)dd[a][3] * D;
#pragma unroll
        for (int j = 0; j < RJ; ++j) { const int e0 = 4 * lane + 256 * j;
            const f32x4 s = (ldb4(y0 + e0) * gk[a][0] + ldb4(y1 + e0) * gk[a][1]) + (ldb4(y2 + e0) * gk[a][2] + ldb4(y3 + e0) * gk[a][3]);
            v[a][j] = *(const f32x4*)(xr + e0) + *(const f32x4*)(m + e0) * s; }
    }
#pragma unroll
    for (int a = 0; a < NR; ++a) {
        const int row = rows[a];
        const float r = row_rms(v[a]);
        if (last) {
#pragma unroll
            for (int j = 0; j < RJ; ++j) { const int e0 = 4 * lane + 256 * j; *(f32x4*)(c.out + (size_t)row * D + e0) = v[a][j] * r * *(const f32x4*)(c.in[I_FNG] + e0); }
        } else {
            float* xr = c.x() + (size_t)row * D;
#pragma unroll
            for (int j = 0; j < RJ; ++j) *(f32x4*)((dummy ? c.od2() + (size_t)row * D : xr) + 4 * lane + 256 * j) = v[a][j];
            const float* mn = c.mod(l + 1, mod_row(row));
            row_modulate_store(v[a], r, c.in[I_N1G] + (l + 1) * D, mn, mn + D, c.h() + (size_t)row * D, lane);
        }
    }
}
__device__ __forceinline__ void ph_combine_w(const Ctx& c, int l, int nrows, int gw, int ngw, int lane, bool dummy = false) {
    int row = gw;
    for (; row + 2 * ngw < nrows; row += 3 * ngw) { const int rows[3] = {row, row + ngw, row + 2 * ngw}; comb_rows<3>(c, l, rows, lane, dummy); }
    if (row + ngw < nrows) { const int rows[2] = {row, row + ngw}; comb_rows<2>(c, l, rows, lane, dummy); }
    else if (row < nrows) { const int rows[1] = {row}; comb_rows<1>(c, l, rows, lane, dummy); }
}
__device__ __forceinline__ void ph_mod_w(const Ctx& c, LAS float* tab, int tid, int blk, int G) {
    LAS float* part = tab + (NB + 1) * D;
    for (int i = tid; i < (NB + 1) * D; i += 512) { const int r = i / D, k = i % D; tab[i] = siluf_(r < NB ? c.in[I_C][r * D + k] : c.in[I_CCTX][k]); }
    __syncthreads();
    const int lane = tid & 63, w = tid >> 6;
    for (int cbk = blk; cbk < DEPTH * 6 * D / 64; cbk += G) {
        const int l = cbk / (6 * D / 64), col = (cbk % (6 * D / 64)) * 64 + lane;
        const float* wp = c.in[I_WMOD] + (size_t)l * D * 6 * D + col + (size_t)(w * (D / 8)) * 6 * D;
        float acc[NB + 1];
#pragma unroll
        for (int r = 0; r <= NB; ++r) acc[r] = 0.f;
        for (int k0 = 0; k0 < D / 8; k0 += 16) { float wv[16];
#pragma unroll
            for (int e = 0; e < 16; ++e) wv[e] = wp[(size_t)(k0 + e) * 6 * D];
#pragma unroll
            for (int e = 0; e < 16; ++e)
#pragma unroll
                for (int r = 0; r <= NB; ++r) acc[r] += tab[r * D + w * (D / 8) + k0 + e] * wv[e]; }
#pragma unroll
        for (int r = 0; r <= NB; ++r) part[(w * (NB + 1) + r) * 64 + lane] = acc[r];
        __syncthreads();
        for (int i = tid; i < (NB + 1) * 64; i += 512) { const int r = i / 64, cc = i % 64; float s = 0.f;
#pragma unroll
            for (int ww = 0; ww < 8; ++ww) s += part[(ww * (NB + 1) + r) * 64 + cc];
            const int colo = (cbk % (6 * D / 64)) * 64 + cc;
            c.mod(l, r)[colo] = s + c.in[I_BMOD][l * 6 * D + colo]; }
        __syncthreads();
    }
}
__host__ __device__ __forceinline__ void ph_foldgate(const Ctx& c, int gt, int gs) {
    for (int it = gt; it < DEPTH * (D / 8) * 512; it += gs) {
        const int col = it % 512, k0 = ((it / 512) % (D / 8)) * 8, l = it / (512 * (D / 8)), d = col / 256, cc = col % 256;
        const float* w2 = c.in[I_GW2] + ((size_t)(l * 2 + d) * 16) * 256 + cc;
        float w2r[16];
#pragma unroll
        for (int r = 0; r < 16; ++r) w2r[r] = w2[r * 256];
        float a[8];
#pragma unroll
        for (int e = 0; e < 8; ++e) { const float* wi = c.in[I_WIN] + ((size_t)l * D + k0 + e) * INW + U_GLR + 16 * d; float s = 0.f;
#pragma unroll
            for (int q = 0; q < 4; ++q) { const f32x4 t = *(const f32x4*)(wi + 4 * q); s += t[0] * w2r[4 * q] + t[1] * w2r[4 * q + 1] + t[2] * w2r[4 * q + 2] + t[3] * w2r[4 * q + 3]; }
            a[e] = s; }
        *(u32x4*)(c.win(l) + (size_t)(INW + col) * D + k0) = (u32x4){pk2(a[0], a[1]), pk2(a[2], a[3]), pk2(a[4], a[5]), pk2(a[6], a[7])};
    }
}

__host__ __device__ __forceinline__ void ph_rwsplit(const Ctx& c, int gt, int gs) {
    for (int it = gt; it < DEPTH * NE * D; it += gs) {
        const int e = it % NE, k = (it / NE) % D, l = it / (NE * D);
        const float w = c.in[I_RW][((size_t)l * D + k) * NE + e];
        const unsigned hi = f2bf(w); const float lo = w - bf2f((bf16_t)hi);
        bf16_t* T = c.wsb(WS_RWT) + (size_t)l * 2 * NE * D;
        T[(size_t)e * D + k] = (bf16_t)hi; T[(size_t)(NE + e) * D + k] = (bf16_t)f2bf(lo);
    }
}

__host__ __device__ __forceinline__ u32x4 pack8(const float* v) { return (u32x4){pk2(v[0], v[1]), pk2(v[2], v[3]), pk2(v[4], v[5]), pk2(v[6], v[7])}; }

struct SegC { int base, len, q0; };
__host__ __device__ __forceinline__ SegC seg_of_chunk(int b, int n) { SegC s; if (n < CTX / 64) { s.base = NLAT + b * CTX; s.len = CTX; s.q0 = 64 * n; } else { s.base = b * SEQ; s.len = SEQ; s.q0 = 64 * (n - CTX / 64); } return s; }
__host__ __device__ __forceinline__ int seg_row(const SegC& s, int dir, int q) { return s.base + (dir == 0 ? q : s.len - 1 - q); }
__host__ __device__ __forceinline__ float tap_at(const bf16_t* U, const SegC& s, int dir, int q, int ucol, bool colmajor) {
    const bool ok = q >= 0 && q < s.len; const int qc = q < 0 ? 0 : (q >= s.len ? s.len - 1 : q);
    const int r = seg_row(s, dir, qc);
    const float v = bf2f(U[(size_t)(colmajor ? tokrow_of_srow(r) : r) * INP + ucol]);
    return ok ? v : 0.f;
}

#ifndef CPU_TEST
#define MFMA16(a, b, c) __builtin_amdgcn_mfma_f32_16x16x32_bf16((a), (b), (c), 0, 0, 0)
#else
#define MFMA16(a, b, c) mfma16_emul((a), (b), (c))
#endif
#ifndef CPU_TEST
#define LDS_BAR() do { asm volatile("s_waitcnt lgkmcnt(0)" ::: "memory"); __builtin_amdgcn_s_barrier(); asm volatile("" ::: "memory"); } while (0)
#else
#define LDS_BAR() __syncthreads()
#endif
typedef LAS unsigned char* ldsp_t;
typedef unsigned long long u64_t;
__device__ __forceinline__ bf16x8 lds_rd16(ldsp_t p) { return *(const LAS bf16x8*)p; }
__device__ __forceinline__ bf16x8 lds_rd8x2(ldsp_t p0, ldsp_t p1) { const u64_t a = *(const LAS u64_t*)p0, b = *(const LAS u64_t*)p1; u32x4 v = {(unsigned)a, (unsigned)(a >> 32), (unsigned)b, (unsigned)(b >> 32)}; return __builtin_bit_cast(bf16x8, v); }
template <int KIND> struct ChainCfg {
    static constexpr int DK = KIND == 2 ? 128 : 64, DV = KIND == 2 ? 64 : 128, NCW = DV / 16, KSPLIT = 8 / NCW, KS = DK / 32, KT = DK / 16, KSL = KS / KSPLIT, KTL = KT / KSPLIT, NPC = DK / 64;
    static constexpr int RS_T = DK * 2 + 16, RS_F = 144, OFF_KB = 64 * RS_T, OFF_KDT = 128 * RS_T, OFF_SC = OFF_KDT + DK * RS_F, BUFSZ = OFF_SC + 1024;
    static constexpr int OFF_P = 2 * BUFSZ, OFF_N = OFF_P + 64 * 144, OFF_DEN = OFF_N + 256, OFF_V = OFF_DEN + 1280, RS_V = DV * 2 + 16;
    static constexpr int LDS_NEED = OFF_V + (KIND == 2 ? 4 * 16 * 64 * 4 : 2 * 64 * RS_V);
    static constexpr int SCB = KIND == 0 ? 256 : KIND == 1 ? 1024 : 512;
    static_assert(LDS_NEED <= 139264, "chain LDS");
};
#ifndef CPU_TEST
#define LDS_ADDF(p, v) (void)__hip_atomic_fetch_add((p), (v), __ATOMIC_RELAXED, __HIP_MEMORY_SCOPE_WORKGROUP)
#else
#define LDS_ADDF(p, v) (*(p) += (v))
#endif
template <int KIND> __device__ __forceinline__ void chain_run(const Ctx& c, ldsp_t lds, int cid, int tid, bool noload = false, bool nostore = false) {
    typedef ChainCfg<KIND> CF;
    constexpr int DK = CF::DK, DV = CF::DV, NCW = CF::NCW, KS = CF::KS, KSL = CF::KSL, KTL = CF::KTL, NPC = CF::NPC, RS_T = CF::RS_T, RS_F = CF::RS_F;
    const int lane = tid & 63, w = RFL(tid >> 6), cc = lane & 15, g = lane >> 4;
    const int wc = w % NCW, kh = w / NCW;
    const bool outw = kh == 0;
    const int dir = cid % 2, hh = KIND == 2 ? (cid / 2) % 8 : (cid / 2) % 4, b = KIND == 2 ? cid / 16 : cid / 8;
    constexpr bool SHQ = KIND != 0, SHD = KIND == 2;
    const bool mir = dir == 1;
    const size_t opc = KIND == 2 ? (size_t)((b * 2 + hh / 4) * 2 + (SHQ ? 0 : dir)) * NCH : (size_t)(SHQ ? cid - dir : cid) * NCH;
    const size_t opd = KIND == 2 ? opc : (size_t)cid * NCH;
    const size_t vpc = (size_t)cid * NCH;
    const bf16_t* gQA = c.wsb(KIND == 0 ? WS_GQA : KIND == 1 ? WS_MQA : WS_SQA) + opc * (64 * DK);
    const bf16_t* gKB = c.wsb(KIND == 0 ? WS_GKB : KIND == 1 ? WS_MKB : WS_SKB) + opc * (64 * DK);
    const bf16_t* gKDT = c.wsb(KIND == 0 ? WS_GKDT : KIND == 1 ? WS_MKDT : WS_SKDT) + opd * (64 * DK);
    const bf16_t* gVT = c.wsb(WS_SVT) + vpc * (64 * DV);
    const bf16_t* gU = c.u() + (KIND == 0 ? U_GV : U_MV) + hh * 128;
    const bf16_t* gVHT = c.wsb(WS_SVHT) + vpc * (64 * DV);
    const unsigned char* gSC = (const unsigned char*)(KIND == 0 ? c.wsf(WS_GAL) + vpc * 64 : KIND == 1 ? c.wsf(WS_MMS) + vpc * 256 : c.wsf(WS_SCS) + vpc * 128);
    bf16_t* Og = c.odir() + (KIND == 0 ? OF_G : KIND == 1 ? OF_M : OF_S) + (size_t)cid * NCH * (4 * NCW * 256) + (wc * 64 + lane) * 4;
    LAS float* DEN = (LAS float*)(lds + CF::OFF_DEN);
    LAS float* XR = (LAS float*)(lds + CF::OFF_V);

    f32x4 S[KTL];
#pragma unroll
    for (int kt = 0; kt < KTL; ++kt) S[kt] = (f32x4){0.f, 0.f, 0.f, 0.f};
    float m0 = -1e30f;
    if (KIND == 1 && tid < 64) ((LAS float*)(lds + CF::OFF_N))[tid] = 0.f;

    u32x4 sq[NPC], sk[NPC], sd[NPC], ssc = {0u, 0u, 0u, 0u}, sv[2]; bf16x8 vf[2], vh[2], vfn[2], vhn[2];
#define CHAIN_LOAD(n_) do { const size_t cb_ = (size_t)(n_); const int nm_ = (int)cb_ < CTX / 64 ? CTX / 64 - 1 - (int)cb_ : CTX / 64 + NCH - 1 - (int)cb_; const size_t cq_ = (SHQ && mir) ? (size_t)nm_ : cb_, cd_ = (SHD && mir) ? (size_t)nm_ : cb_; \
        _Pragma("unroll") for (int q = 0; q < NPC; ++q) { const int p = tid + 512 * q; sq[q] = *(const u32x4*)(gQA + cq_ * (64 * DK) + p * 8); sk[q] = *(const u32x4*)(gKB + cq_ * (64 * DK) + p * 8); if (KIND == 1) sd[q] = *(const u32x4*)(gKDT + cd_ * (64 * DK) + p * 8); } \
        if (tid < CF::SCB / 16) ssc = *(const u32x4*)(gSC + cb_ * CF::SCB + tid * 16); \
        if (KIND == 2) { _Pragma("unroll") for (int s = 0; s < 2; ++s) { if (outw) vfn[s] = *(const bf16x8*)(gVT + cb_ * (64 * DV) + (16 * wc + cc) * 64 + 32 * s + 8 * g); vhn[s] = *(const bf16x8*)(gVHT + cb_ * (64 * DV) + (16 * wc + cc) * 64 + 32 * s + 8 * g); } } \
        else { _Pragma("unroll") for (int q = 0; q < 2; ++q) { const int p = tid + 512 * q; sv[q] = *(const u32x4*)(gU + (size_t)scan_row(b, dir, 64 * (int)cb_ + p / 16) * INP + (p % 16) * 8); } } } while (0)
#define CHAIN_STAGE(buf_) do { ldsp_t d_ = lds + (buf_) * CF::BUFSZ; \
        _Pragma("unroll") for (int q = 0; q < NPC; ++q) { const int p = tid + 512 * q; const int rt0 = p / (DK / 8), ct = p % (DK / 8), rt = (SHQ && mir) ? 63 - rt0 : rt0; *(LAS u32x4*)(d_ + rt * RS_T + ct * 16) = sq[q]; *(LAS u32x4*)(d_ + CF::OFF_KB + rt * RS_T + ct * 16) = sk[q]; \
            if (KIND == 1) *(LAS u32x4*)(d_ + CF::OFF_KDT + (p / 8) * RS_F + (p % 8) * 16) = sd[q]; } \
        if (tid < CF::SCB / 16) *(LAS u32x4*)(d_ + CF::OFF_SC + tid * 16) = ssc; \
        if (KIND == 2) { vf[0] = vfn[0]; vf[1] = vfn[1]; vh[0] = vhn[0]; vh[1] = vhn[1]; } \
        else { _Pragma("unroll") for (int q = 0; q < 2; ++q) { const int p = tid + 512 * q; *(LAS u32x4*)(lds + CF::OFF_V + (buf_) * (64 * CF::RS_V) + (p / 16) * CF::RS_V + (p % 16) * 16) = sv[q]; } } } while (0)
    CHAIN_LOAD(0); CHAIN_STAGE(0);
    LDS_BAR();

    for (int n = 0; n < NCH; ++n) {
        ldsp_t cur = lds + (n & 1) * CF::BUFSZ;
        const LAS float* SC = (const LAS float*)(cur + CF::OFF_SC);
        if (n + 1 < NCH && !noload) CHAIN_LOAD(n + 1);
#pragma unroll
        for (int tt = 0; tt < 2; ++tt) {
            const int t = 2 * w + tt, jt = t >> 2, it = t & 3;
            f32x4 acc = {0.f, 0.f, 0.f, 0.f};
#pragma unroll
            for (int s = 0; s < KS; ++s) acc = MFMA16(lds_rd16(cur + CF::OFF_KB + (16 * jt + cc) * RS_T + (32 * s + 8 * g) * 2), lds_rd16(cur + (16 * it + cc) * RS_T + (32 * s + 8 * g) * 2), acc);
            const int i = 16 * it + cc, j0 = 16 * jt + 4 * g;
            float pi = 0.f;
            if (KIND == 1) pi = fmaxf(m0, SC[i * 4 + 2]);
            if (KIND == 2) pi = SC[i * 2];
            float pv[4];
#pragma unroll
            for (int r = 0; r < 4; ++r) { const int j = j0 + r; float d = 1.f;
                if (KIND == 1) d = __expf(SC[j * 4 + 1] - pi);
                if (KIND == 2) d = __expf(pi - SC[j * 2]);
                pv[r] = j <= i ? acc[r] * d : 0.f; }
            const unsigned p01 = pk2(pv[0], pv[1]), p23 = pk2(pv[2], pv[3]);
            *(LAS u64_t*)(lds + CF::OFF_P + i * 144 + j0 * 2) = (u64_t)p01 | ((u64_t)p23 << 32);
            if (KIND == 1) {
                float unp[4]; { unsigned t0 = p01 << 16, t1 = p01 & 0xffff0000u, t2 = p23 << 16, t3 = p23 & 0xffff0000u; __builtin_memcpy(&unp[0], &t0, 4); __builtin_memcpy(&unp[1], &t1, 4); __builtin_memcpy(&unp[2], &t2, 4); __builtin_memcpy(&unp[3], &t3, 4); }
                float rs_ = (unp[0] + unp[1]) + (unp[2] + unp[3]);
                rs_ += SHFL_XOR_F(rs_, 16); rs_ += SHFL_XOR_F(rs_, 32);
                if (g == 0) DEN[jt * 64 + i] = jt <= it ? rs_ : 0.f;
            }
        }
        f32x4 ai[4], ap[4];
        {
            bf16x8 sf[KSL];
#pragma unroll
            for (int s = 0; s < KSL; ++s) { u32x4 v = {pk2(S[2 * s][0], S[2 * s][1]), pk2(S[2 * s][2], S[2 * s][3]), pk2(S[2 * s + 1][0], S[2 * s + 1][1]), pk2(S[2 * s + 1][2], S[2 * s + 1][3])}; sf[s] = __builtin_bit_cast(bf16x8, v); }
#pragma unroll
            for (int it = 0; it < 4; ++it) {
                ai[it] = (f32x4){0.f, 0.f, 0.f, 0.f};
#pragma unroll
                for (int s = 0; s < KSL; ++s) { ldsp_t qa = cur + (16 * it + cc) * RS_T + (32 * (kh * KSL + s) + 4 * g) * 2; ai[it] = MFMA16(lds_rd8x2(qa, qa + 32), sf[s], ai[it]); }
            }
            if (KIND == 2 && !outw) {
#pragma unroll
                for (int it = 0; it < 4; ++it) *(LAS f32x4*)(XR + ((wc * 4 + it) * 64 + lane) * 4) = ai[it];
            }
        }
        if (KIND == 1) {
            const int row = tid >> 3, part = tid & 7;
            const bf16x8 qr = lds_rd16(cur + row * RS_T + part * 16);
            const LAS float* n0 = (const LAS float*)(lds + CF::OFF_N) + part * 8;
            float sqn = 0.f;
#pragma unroll
            for (int e = 0; e < 8; ++e) sqn += bf2f((bf16_t)qr[e]) * n0[e];
            sqn += RED1(sqn); sqn += RED2(sqn); sqn += RED4(sqn);
            if (part == 0) DEN[4 * 64 + row] = __expf(m0 - fmaxf(m0, SC[row * 4 + 2])) * sqn;
        }
        LDS_BAR();
        float c0 = 1.f, c1 = 1.f;
        if (KIND == 1) { const float rL = SC[63 * 4 + 2], ML = fmaxf(m0, rL); c0 = __expf(m0 - ML); c1 = __expf(rL - ML); }
        if (KIND == 2) c0 = __expf(SC[63 * 2]);
        if (KIND == 1) {
            const int krow = tid >> 3, part = tid & 7;
            const bf16x8 kr = lds_rd16(cur + CF::OFF_KDT + krow * RS_F + part * 16);
            float s = 0.f;
#pragma unroll
            for (int e = 0; e < 8; ++e) s += bf2f((bf16_t)kr[e]);
            s += RED1(s); s += RED2(s); s += RED4(s);
            if (part == 0) { LAS float* np = (LAS float*)(lds + CF::OFF_N) + krow; *np = c0 * *np + c1 * s; }
        }
        if (KIND != 2) {
            const LAS bf16_t* vi = (const LAS bf16_t*)(lds + CF::OFF_V + (n & 1) * (64 * CF::RS_V)) + 16 * wc + cc;
#pragma unroll
            for (int s = 0; s < 2; ++s) { unsigned pkd[4];
#pragma unroll
                for (int e = 0; e < 4; ++e) { const unsigned lo_ = vi[(32 * s + 8 * g + 2 * e) * (CF::RS_V / 2)], hi_ = vi[(32 * s + 8 * g + 2 * e + 1) * (CF::RS_V / 2)]; pkd[e] = lo_ | (hi_ << 16); }
                const u32x4 pv_ = {pkd[0], pkd[1], pkd[2], pkd[3]}; vf[s] = __builtin_bit_cast(bf16x8, pv_); }
        }
        if (outw) {
#pragma unroll
            for (int it = 0; it < 4; ++it) {
                if (KIND == 2) ai[it] = ai[it] + *(const LAS f32x4*)(XR + ((wc * 4 + it) * 64 + lane) * 4);
                ap[it] = KIND == 0 ? ai[it] : (f32x4){0.f, 0.f, 0.f, 0.f};
#pragma unroll
                for (int s = 0; s < 2; ++s) ap[it] = MFMA16(lds_rd16(lds + CF::OFF_P + (16 * it + cc) * 144 + (32 * s + 8 * g) * 2), vf[s], ap[it]);
            }
#pragma unroll
            for (int it = 0; it < 4; ++it) {
                f32x4 ov;
                const int i0 = 16 * it + 4 * g;
                if (KIND == 1) {
                    const f32x4 d0 = *(const LAS f32x4*)(DEN + i0), d1 = *(const LAS f32x4*)(DEN + 64 + i0), d2 = *(const LAS f32x4*)(DEN + 128 + i0), d3 = *(const LAS f32x4*)(DEN + 192 + i0), d4 = *(const LAS f32x4*)(DEN + 256 + i0);
                    const f32x4 den4 = ((d0 + d1) + (d2 + d3)) + d4;
#pragma unroll
                    for (int r = 0; r < 4; ++r) { const f32x4 sc = *(const LAS f32x4*)(SC + (i0 + r) * 4);
                        const float Mi = fmaxf(m0, sc[2]);
                        ov[r] = (ap[it][r] + __expf(m0 - Mi) * ai[it][r]) * FRCP(fmaxf(fabsf(den4[r]), __expf(-sc[0] - Mi))); }
                } else {
#pragma unroll
                    for (int r = 0; r < 4; ++r) { float o = ap[it][r]; if (KIND == 2) o = o + __expf(SC[(i0 + r) * 2]) * ai[it][r]; ov[r] = o; }
                }
                if (!nostore) *(u64_t*)(Og + (size_t)((n * 4 + it) * NCW) * 256) = (u64_t)pk2(ov[0], ov[1]) | ((u64_t)pk2(ov[2], ov[3]) << 32);
            }
        }
#pragma unroll
        for (int kt = 0; kt < KTL; ++kt) {
            const int ktg = kh * KTL + kt;
            if (KIND == 2) S[kt] = S[kt] * c0;
            f32x4 T = KIND == 1 ? (f32x4){0.f, 0.f, 0.f, 0.f} : S[kt];
#pragma unroll
            for (int s = 0; s < 2; ++s) {
                bf16x8 ka;
                if (KIND == 1) ka = lds_rd16(cur + CF::OFF_KDT + (16 * ktg + cc) * RS_F + (32 * s + 8 * g) * 2);
                else {
                    const LAS bf16_t* kb = (const LAS bf16_t*)(cur + CF::OFF_KB) + 16 * ktg + cc; unsigned pk_[4];
#pragma unroll
                    for (int e = 0; e < 4; ++e) { const unsigned lo_ = kb[(32 * s + 8 * g + 2 * e) * (RS_T / 2)], hi_ = kb[(32 * s + 8 * g + 2 * e + 1) * (RS_T / 2)]; pk_[e] = lo_ | (hi_ << 16); }
                    const u32x4 kv_ = {pk_[0], pk_[1], pk_[2], pk_[3]}; ka = __builtin_bit_cast(bf16x8, kv_); }
                T = MFMA16(ka, KIND == 2 ? vh[s] : vf[s], T);
            }
            S[kt] = KIND == 1 ? S[kt] * c0 + T * c1 : T;
            if (KIND == 0) { const f32x4 al = *(const LAS f32x4*)(SC + 16 * ktg + 4 * g); S[kt] = S[kt] * al; }
            if (kt & 1) CBAR();
        }
        if (KIND == 1) m0 = SC[63 * 4] + fmaxf(m0, SC[63 * 4 + 2]);
        if (n + 1 < NCH) CHAIN_STAGE((n + 1) & 1);
        LDS_BAR();
    }
#undef CHAIN_LOAD
#undef CHAIN_STAGE
}
__device__ __forceinline__ void ph_chain(const Ctx& c, ldsp_t lds, int blk, int G, int tid, int kmask = 7) {
    const bool noload = false, nostore = (kmask & 8) != 0;
    (void)G;
    const int ch = blk;
    if (ch < NB * 8) { if (kmask & 1) chain_run<0>(c, lds, ch, tid, noload, nostore); }
    else if (ch < NB * 16) { if (kmask & 2) chain_run<1>(c, lds, ch - NB * 8, tid, noload, nostore); }
    else if (ch < NB * 32) { if (kmask & 4) chain_run<2>(c, lds, ch - NB * 16, tid, noload, nostore); }
}

constexpr int ROUTE_M_LDS = 16 * 33 * 4;
__device__ __forceinline__ void ph_route_m(const Ctx& c, int l, int nrows, LAS float* wl, int gw, int ngw, int lane) {
    const int rr = lane & 15, g = lane >> 4;
    const bf16_t* T = c.wsb(WS_RWT) + (size_t)l * 2 * NE * D;
    for (int tile = gw; tile < nrows / 16; tile += ngw) {
        const int row = 16 * tile + rr;
        const float* xr = c.x() + (size_t)row * D + 8 * g;
        const float* m = c.mod(l, mod_row(16 * tile));
        const float* gp = c.in[I_N2G] + l * D + 8 * g; const float* shp = m + 3 * D + 8 * g; const float* scp = m + 4 * D + 8 * g;
        float ss = 0.f;
        { const float* sp = c.wsf(WS_SSP) + (size_t)row * 64 + 16 * g;
#pragma unroll
          for (int q = 0; q < 16; q += 4) { if (16 * g + q < (D / 256) * 16) { const f32x4 t = *(const f32x4*)(sp + q); ss += (t[0] + t[1]) + (t[2] + t[3]); } } }
        ss += SHFL_XOR_F(ss, 16); ss += SHFL_XOR_F(ss, 32);
        const float r = 1.0f / sqrtf(ss * (1.0f / D) + EPS);
        f32x4 acc0 = {0.f, 0.f, 0.f, 0.f}, acc1 = {0.f, 0.f, 0.f, 0.f};
        bf16_t* hr = c.h() + (size_t)row * D + 8 * g;
        for (int s2 = 0; s2 < D / 32; s2 += 2) {
            f32x4 xv[2][2], gv[2][2], hv[2][2], cv[2][2]; bf16x8 bh[2][2], bl[2][2];
#pragma unroll
            for (int u = 0; u < 2; ++u) { const int s = s2 + u;
                xv[u][0] = *(const f32x4*)(xr + 32 * s); xv[u][1] = *(const f32x4*)(xr + 32 * s + 4); gv[u][0] = *(const f32x4*)(gp + 32 * s); gv[u][1] = *(const f32x4*)(gp + 32 * s + 4);
                hv[u][0] = *(const f32x4*)(shp + 32 * s); hv[u][1] = *(const f32x4*)(shp + 32 * s + 4); cv[u][0] = *(const f32x4*)(scp + 32 * s); cv[u][1] = *(const f32x4*)(scp + 32 * s + 4);
                bh[u][0] = *(const bf16x8*)(T + (size_t)rr * D + 32 * s + 8 * g); bh[u][1] = *(const bf16x8*)(T + (size_t)(16 + rr) * D + 32 * s + 8 * g);
                bl[u][0] = *(const bf16x8*)(T + (size_t)(NE + rr) * D + 32 * s + 8 * g); bl[u][1] = *(const bf16x8*)(T + (size_t)(NE + 16 + rr) * D + 32 * s + 8 * g); }
#pragma unroll
            for (int u = 0; u < 2; ++u) { const int s = s2 + u;
                const f32x4 v0 = (xv[u][0] * r * gv[u][0]) * (cv[u][0] + 1.0f) + hv[u][0], v1 = (xv[u][1] * r * gv[u][1]) * (cv[u][1] + 1.0f) + hv[u][1];
                const u32x4 hi = {pk2(v0[0], v0[1]), pk2(v0[2], v0[3]), pk2(v1[0], v1[1]), pk2(v1[2], v1[3])};
                *(u32x4*)(hr + 32 * s) = hi;
                float lo[8];
#pragma unroll
                for (int e = 0; e < 4; ++e) { const unsigned wv = hi[e]; float fl, fh; unsigned t = wv << 16; __builtin_memcpy(&fl, &t, 4); t = wv & 0xffff0000u; __builtin_memcpy(&fh, &t, 4);
                    lo[2 * e] = (e < 2 ? v0[2 * e] : v1[2 * e - 4]) - fl; lo[2 * e + 1] = (e < 2 ? v0[2 * e + 1] : v1[2 * e - 3]) - fh; }
                const u32x4 lov = {pk2(lo[0], lo[1]), pk2(lo[2], lo[3]), pk2(lo[4], lo[5]), pk2(lo[6], lo[7])};
                const bf16x8 ahi = __builtin_bit_cast(bf16x8, hi), alo = __builtin_bit_cast(bf16x8, lov);
                acc0 = MFMA16(ahi, bh[u][0], acc0); acc0 = MFMA16(alo, bh[u][0], acc0); acc0 = MFMA16(ahi, bl[u][0], acc0);
                acc1 = MFMA16(ahi, bh[u][1], acc1); acc1 = MFMA16(alo, bh[u][1], acc1); acc1 = MFMA16(ahi, bl[u][1], acc1); }
            CBAR();
        }
#pragma unroll
        for (int q = 0; q < 4; ++q) { wl[(4 * g + q) * 33 + rr] = acc0[q] + c.in[I_RB][l * NE + rr]; wl[(4 * g + q) * 33 + 16 + rr] = acc1[q] + c.in[I_RB][l * NE + 16 + rr]; }
        WAVE_SYNC();
        if (lane < 16) {
            const int orow = 16 * tile + lane;
            float lg[NE];
#pragma unroll
            for (int i = 0; i < NE; ++i) lg[i] = wl[lane * 33 + i];
            int te[TOPK]; float tv[TOPK];
#pragma unroll
            for (int kk = 0; kk < TOPK; ++kk) {
                int best = -1; float bv = 0.f;
#pragma unroll
                for (int i = 0; i < NE; ++i) {
                    bool taken = false;
#pragma unroll
                    for (int j = 0; j < kk; ++j) taken = taken || (te[j] == i);
                    if (!taken && (best < 0 || lg[i] > bv)) { best = i; bv = lg[i]; }
                }
                te[kk] = best; tv[kk] = bv;
            }
            float se = 0.f, ex[TOPK];
#pragma unroll
            for (int kk = 0; kk < TOPK; ++kk) { ex[kk] = expf(tv[kk] - tv[0]); se += ex[kk]; }
#pragma unroll
            for (int kk = 0; kk < TOPK; ++kk) {
                c.tope()[orow * TOPK + kk] = te[kk];
                c.topg()[orow * TOPK + kk] = ex[kk] / se;
                c.pos()[orow * TOPK + kk] = atomicAdd(c.cnt(l) + te[kk] * CNTS, 1);
            }
        }
        WAVE_SYNC();
    }
}

constexpr int ROUTE_B_LDS = (8 * 16 * 32 + 16 * 33) * 4;
#ifndef CPU_TEST
__device__ __forceinline__ int lds_fetch_inc(LAS int* p) { return __hip_atomic_fetch_add(p, 1, __ATOMIC_RELAXED, __HIP_MEMORY_SCOPE_WORKGROUP); }
#else
static inline int lds_fetch_inc(int* p) { const int o = *p; *p = o + 1; return o; }
#endif
static_assert(TOPK == 4 && 4640 * 4 >= ROUTE_B_LDS, "route LDS map");
__device__ __forceinline__ void ph_route_b(const Ctx& c, int l, int nrows, LAS float* bl, int blk, int G, int tid, bool dummy = false) {
    constexpr int SPW = D / 256, BATCH = SPW >= 4 ? 4 : (SPW >= 2 ? 2 : 1);
    const int lane = tid & 63, w = RFL(tid >> 6), rr = lane & 15, g = lane >> 4;
    const bf16_t* T = c.wsb(WS_RWT) + (size_t)l * 2 * NE * D;
    LAS float* part = bl; LAS float* lgs = bl + 8 * 16 * 32;
    LAS int* lcnt = (LAS int*)(bl + 4640); LAS int* lbase = lcnt + 32; LAS unsigned* lrec = (LAS unsigned*)(lbase + 32);
    if (tid < 32) lcnt[tid] = 0;
    int nit = 0;
    for (int tile = blk; tile < nrows / 16; tile += G, ++nit) {
        const int row = 16 * tile + rr;
        const float* xr = c.x() + (size_t)row * D + 8 * g;
        const float* m = c.mod(l, mod_row(16 * tile));
        const float* gp = c.in[I_N2G] + l * D + 8 * g; const float* shp = m + 3 * D + 8 * g; const float* scp = m + 4 * D + 8 * g;
        f32x4 sst[4];
        { const float* sp = c.wsf(WS_SSP) + (size_t)row * 64 + 16 * g;
#pragma unroll
          for (int q = 0; q < 4; ++q) { sst[q] = f32x4{0.f, 0.f, 0.f, 0.f}; if (16 * g + 4 * q < (D / 256) * 16) sst[q] = *(const f32x4*)(sp + 4 * q); } }
        float r = 0.f;
        f32x4 acc0 = {0.f, 0.f, 0.f, 0.f}, acc1 = {0.f, 0.f, 0.f, 0.f};
        bf16_t* hr = c.h() + (size_t)row * D + 8 * g;
        for (int s2 = w * SPW; s2 < (w + 1) * SPW; s2 += BATCH) {
            f32x4 xv[BATCH][2], gv[BATCH][2], hv[BATCH][2], cv[BATCH][2]; bf16x8 bh[BATCH][2], bw[BATCH][2];
#pragma unroll
            for (int u = 0; u < BATCH; ++u) { const int s = s2 + u;
                xv[u][0] = *(const f32x4*)(xr + 32 * s); xv[u][1] = *(const f32x4*)(xr + 32 * s + 4); gv[u][0] = *(const f32x4*)(gp + 32 * s); gv[u][1] = *(const f32x4*)(gp + 32 * s + 4);
                hv[u][0] = *(const f32x4*)(shp + 32 * s); hv[u][1] = *(const f32x4*)(shp + 32 * s + 4); cv[u][0] = *(const f32x4*)(scp + 32 * s); cv[u][1] = *(const f32x4*)(scp + 32 * s + 4);
                bh[u][0] = *(const bf16x8*)(T + (size_t)rr * D + 32 * s + 8 * g); bh[u][1] = *(const bf16x8*)(T + (size_t)(16 + rr) * D + 32 * s + 8 * g);
                bw[u][0] = *(const bf16x8*)(T + (size_t)(NE + rr) * D + 32 * s + 8 * g); bw[u][1] = *(const bf16x8*)(T + (size_t)(NE + 16 + rr) * D + 32 * s + 8 * g); }
            if (s2 == w * SPW) {
                float ss = 0.f;
#pragma unroll
                for (int q = 0; q < 4; ++q) { if (16 * g + 4 * q < (D / 256) * 16) ss += (sst[q][0] + sst[q][1]) + (sst[q][2] + sst[q][3]); }
                ss += SHFL_XOR_F(ss, 16); ss += SHFL_XOR_F(ss, 32);
                r = 1.0f / sqrtf(ss * (1.0f / D) + EPS);
            }
#pragma unroll
            for (int u = 0; u < BATCH; ++u) { const int s = s2 + u;
                const f32x4 v0 = (xv[u][0] * r * gv[u][0]) * (cv[u][0] + 1.0f) + hv[u][0], v1 = (xv[u][1] * r * gv[u][1]) * (cv[u][1] + 1.0f) + hv[u][1];
                const u32x4 hi = {pk2(v0[0], v0[1]), pk2(v0[2], v0[3]), pk2(v1[0], v1[1]), pk2(v1[2], v1[3])};
                *(u32x4*)(hr + 32 * s) = hi;
                float lo[8];
#pragma unroll
                for (int e = 0; e < 4; ++e) { const unsigned wv = hi[e]; float fl, fh; unsigned t = wv << 16; __builtin_memcpy(&fl, &t, 4); t = wv & 0xffff0000u; __builtin_memcpy(&fh, &t, 4);
                    lo[2 * e] = (e < 2 ? v0[2 * e] : v1[2 * e - 4]) - fl; lo[2 * e + 1] = (e < 2 ? v0[2 * e + 1] : v1[2 * e - 3]) - fh; }
                const u32x4 lov = {pk2(lo[0], lo[1]), pk2(lo[2], lo[3]), pk2(lo[4], lo[5]), pk2(lo[6], lo[7])};
                const bf16x8 ahi = __builtin_bit_cast(bf16x8, hi), alo = __builtin_bit_cast(bf16x8, lov);
                acc0 = MFMA16(ahi, bh[u][0], acc0); acc0 = MFMA16(alo, bh[u][0], acc0); acc0 = MFMA16(ahi, bw[u][0], acc0);
                acc1 = MFMA16(ahi, bh[u][1], acc1); acc1 = MFMA16(alo, bh[u][1], acc1); acc1 = MFMA16(ahi, bw[u][1], acc1); }
        }
#pragma unroll
        for (int q = 0; q < 4; ++q) { part[(w * 16 + 4 * g + q) * 32 + rr] = acc0[q]; part[(w * 16 + 4 * g + q) * 32 + 16 + rr] = acc1[q]; }
        LDS_BAR();
        { const int prow = tid >> 5, e = tid & 31; float s = c.in[I_RB][l * NE + e];
#pragma unroll
          for (int ww = 0; ww < 8; ++ww) s += part[(ww * 16 + prow) * 32 + e];
          lgs[prow * 33 + e] = s; }
        LDS_BAR();
        if (tid < 16) {
            const int orow = 16 * tile + tid;
            float lg[NE];
#pragma unroll
            for (int i = 0; i < NE; ++i) lg[i] = lgs[tid * 33 + i];
            int te[TOPK]; float tv[TOPK];
#pragma unroll
            for (int kk = 0; kk < TOPK; ++kk) {
                int best = -1; float bv = 0.f;
#pragma unroll
                for (int i = 0; i < NE; ++i) {
                    bool taken = false;
#pragma unroll
                    for (int j = 0; j < kk; ++j) taken = taken || (te[j] == i);
                    if (!taken && (best < 0 || lg[i] > bv)) { best = i; bv = lg[i]; }
                }
                te[kk] = best; tv[kk] = bv;
            }
            float se = 0.f, ex[TOPK];
#pragma unroll
            for (int kk = 0; kk < TOPK; ++kk) { ex[kk] = expf(tv[kk] - tv[0]); se += ex[kk]; }
#pragma unroll
            for (int kk = 0; kk < TOPK; ++kk) {
                c.tope()[orow * TOPK + kk] = te[kk];
                c.topg()[orow * TOPK + kk] = ex[kk] / se;
                lrec[nit * 64 + tid * TOPK + kk] = ((unsigned)te[kk] << 16) | (unsigned)lds_fetch_inc(lcnt + te[kk]);
            }
        }
    }
    LDS_BAR();
    if (tid < 32) { const int n = lcnt[tid]; lbase[tid] = n ? atomicAdd(c.cnt(l) + (dummy ? DEPTH * NE * CNTS : 0) + tid * CNTS, n) : 0; }
    LDS_BAR();
    for (int i = tid; i < nit * 64; i += 512) { const int tile = blk + (i >> 6) * G; const unsigned rec = lrec[i]; c.pos()[64 * tile + (i & 63)] = lbase[rec >> 16] + (int)(rec & 0xffffu); }
}

__host__ __device__ __forceinline__ f32x4 silu4(f32x4 x) { return (f32x4){siluf_(x[0]), siluf_(x[1]), siluf_(x[2]), siluf_(x[3])}; }
__host__ __device__ __forceinline__ f32x4 exp4(f32x4 x) { return (f32x4){FEXP(x[0]), FEXP(x[1]), FEXP(x[2]), FEXP(x[3])}; }
__host__ __device__ __forceinline__ f32x4 logsig4(f32x4 x) { return (f32x4){logsigmoidf_(x[0]), logsigmoidf_(x[1]), logsigmoidf_(x[2]), logsigmoidf_(x[3])}; }
__host__ __device__ __forceinline__ f32x4 min4(f32x4 x, float m) { return (f32x4){fminf(x[0], m), fminf(x[1], m), fminf(x[2], m), fminf(x[3], m)}; }
__host__ __device__ __forceinline__ u64_t pk4(f32x4 v) { return (u64_t)pk2(v[0], v[1]) | ((u64_t)pk2(v[2], v[3]) << 32); }
__host__ __device__ __forceinline__ f32x4 tap4_at(const bf16_t* U, const SegC& s, int dir, int q, int ucol, bool colmajor) {
    const bool ok = q >= 0 && q < s.len; const int qc = q < 0 ? 0 : (q >= s.len ? s.len - 1 : q);
    const int r = seg_row(s, dir, qc);
    const f32x4 v = ldb4(U + (size_t)(colmajor ? tokrow_of_srow(r) : r) * INP + ucol);
    return ok ? v : (f32x4){0.f, 0.f, 0.f, 0.f};
}
__host__ __device__ __forceinline__ void store_t8(bf16_t* base, int t0, const f32x4 (&x)[8]) {
#pragma unroll
    for (int cc = 0; cc < 4; ++cc) *(u32x4*)(base + cc * 64 + t0) = (u32x4){pk2(x[0][cc], x[1][cc]), pk2(x[2][cc], x[3][cc]), pk2(x[4][cc], x[5][cc]), pk2(x[6][cc], x[7][cc])};
}
__host__ __device__ __forceinline__ u64_t tapraw4_at(const bf16_t* U, const SegC& s, int dir, int q, int ucol, bool colmajor) {
    const int qc = q < 0 ? 0 : (q >= s.len ? s.len - 1 : q); const int r = seg_row(s, dir, qc);
    return *(const u64_t*)(U + (size_t)(colmajor ? tokrow_of_srow(r) : r) * INP + ucol);
}
__host__ __device__ __forceinline__ bf16_t tapraw1_at(const bf16_t* U, const SegC& s, int dir, int q, int ucol, bool colmajor) {
    const int qc = q < 0 ? 0 : (q >= s.len ? s.len - 1 : q); const int r = seg_row(s, dir, qc);
    return U[(size_t)(colmajor ? tokrow_of_srow(r) : r) * INP + ucol];
}
__host__ __device__ __forceinline__ f32x4 tapcvt4(u64_t raw, const SegC& s, int q) { return (q >= 0 && q < s.len) ? cvtb4(raw) : (f32x4){0.f, 0.f, 0.f, 0.f}; }
__host__ __device__ __forceinline__ void ph_prep4(const Ctx& c, int l, int gt, int gs, int sel = 31) {
    const bf16_t* U = c.u();
    const int rot = (int)CH_G * 16;
    const int gt1 = gt, gt2 = (gt + gs - rot % gs) % gs, gt3 = (gt + gs - (3 * rot) % gs) % gs, gt4 = (gt + gs - (5 * rot) % gs) % gs;
    if (sel & 1) for (int it = gt1; it < (int)CH_G * 16; it += gs) {
        const int k = 4 * (it % 16), hh = (it / 16) % 4, n = (it / 64) % NCH, dir = (it / (64 * NCH)) % 2, b = it / (128 * NCH), cid = (b * 4 + hh) * 2 + dir;
        const SegC sg = seg_of_chunk(b, n);
        const int row0 = seg_row(sg, dir, sg.q0), rs = dir == 0 ? 1 : -1;
        const f32x4 bg = *(const f32x4*)(c.in[I_GBG] + (l * 2 + dir) * 256 + hh * 64 + k);
        const size_t cb = ((size_t)cid * NCH + n);
        bf16_t* QA = c.wsb(WS_GQA) + cb * 4096 + k; bf16_t* KB = c.wsb(WS_GKB) + cb * 4096 + k; bf16_t* KDT = c.wsb(WS_GKDT) + cb * 4096 + k * 64;
        const bf16_t* uq = U + (size_t)row0 * INP + U_GQ + hh * 64 + k; const bf16_t* uk = U + (size_t)row0 * INP + U_GK + hh * 64 + k; const bf16_t* ug = U + (size_t)row0 * INP + U_GGK + dir * 256 + hh * 64 + k;
        f32x4 crun = {0.f, 0.f, 0.f, 0.f};
        u64_t nq[8], nk[8], ng[8];
#pragma unroll
        for (int e = 0; e < 8; ++e) { nq[e] = *(const u64_t*)(uq + (long)rs * e * INP); nk[e] = *(const u64_t*)(uk + (long)rs * e * INP); ng[e] = *(const u64_t*)(ug + (long)rs * e * INP); }
        for (int i0 = 0; i0 < 64; i0 += 8) { const int nb = i0 + 8 < 64 ? i0 + 8 : i0;
            u64_t cq[8], ck[8], cg[8]; f32x4 kd[8];
#pragma unroll
            for (int e = 0; e < 8; ++e) { cq[e] = nq[e]; ck[e] = nk[e]; cg[e] = ng[e]; }
#pragma unroll
            for (int e = 0; e < 8; ++e) { nq[e] = *(const u64_t*)(uq + (long)rs * (nb + e) * INP); nk[e] = *(const u64_t*)(uk + (long)rs * (nb + e) * INP); ng[e] = *(const u64_t*)(ug + (long)rs * (nb + e) * INP); }
            CBAR();
#pragma unroll
            for (int e = 0; e < 8; ++e) { crun = crun + logsig4(cvtb4(cg[e]) + bg) * (1.0f / 16.0f);
                kd[e] = cvtb4(ck[e]) * exp4(min4(-crun, 60.f));
                *(u64_t*)(QA + (i0 + e) * 64) = pk4(cvtb4(cq[e]) * 0.125f * exp4(crun)); *(u64_t*)(KB + (i0 + e) * 64) = pk4(kd[e]); }
        }
        *(f32x4*)(c.wsf(WS_GAL) + cb * 64 + k) = exp4(crun);
    }
    if (sel & 4) for (int it = gt2; it < (int)CH_G * 32; it += gs) {
        const int k = 4 * (it % 16), hh = (it / 16) % 4, which = (it / 64) % 2, n = (it / 128) % NCH, dir = (it / (128 * NCH)) % 2, b = it / (256 * NCH), cid = (b * 4 + hh) * 2 + dir;
        if (which == 0 && dir == 1) continue;
        const SegC sg = seg_of_chunk(b, n);
        const int row0 = seg_row(sg, dir, sg.q0), rs = dir == 0 ? 1 : -1;
        const float bi = c.in[I_MBI][l * 8 + dir * 4 + hh], bf = c.in[I_MBF][l * 8 + dir * 4 + hh];
        const bf16_t* MG = U + (size_t)row0 * INP + U_MG + dir * 4 + hh;
        const size_t cb = ((size_t)cid * NCH + n);
        float rmaxL = 0.f;
        if (which == 1) {
            float F = 0.f, rmax = -1e30f; float* MS = c.wsf(WS_MMS) + cb * 256;
            for (int i0 = 0; i0 < 64; i0 += 16) { float ig[16], lf[16];
#pragma unroll
                for (int e = 0; e < 16; ++e) { ig[e] = bf2f(MG[(long)rs * (i0 + e) * INP]); lf[e] = bf2f(MG[(long)rs * (i0 + e) * INP + 8]); }
#pragma unroll
                for (int e = 0; e < 16; ++e) { F += logsigmoidf_(lf[e] + bf); const float bjv = ig[e] + bi - F; rmax = fmaxf(rmax, bjv); if (k == 0) *(f32x4*)(MS + (i0 + e) * 4) = (f32x4){F, bjv, rmax, 0.f}; } }
            rmaxL = rmax;
        }
        bf16_t* OT = c.wsb(which == 0 ? WS_MQA : WS_MKB) + cb * 4096 + k; bf16_t* KDT = c.wsb(WS_MKDT) + cb * 4096 + k * 64;
        const int cch = which * 256 + hh * 64 + k;
        f32x4 w[7];
#pragma unroll
        for (int j = 0; j < 7; ++j) w[j] = *(const f32x4*)(c.in[I_MCW] + ((size_t)l * 7 + (dir == 0 ? j : 6 - j)) * 512 + cch);
        const f32x4 bc = *(const f32x4*)(c.in[I_MCB] + l * 512 + cch);
        f32x4 win[14];
#pragma unroll
        for (int t = 0; t < 6; ++t) win[t] = tap4_at(U, sg, dir, sg.q0 + t - 3, U_MQK + cch, false);
        float F = 0.f;
        u64_t nt[8]; bf16_t ni[8], nf[8];
#pragma unroll
        for (int e = 0; e < 8; ++e) { nt[e] = tapraw4_at(U, sg, dir, sg.q0 + e + 3, U_MQK + cch, false); ni[e] = MG[(long)rs * e * INP]; nf[e] = MG[(long)rs * e * INP + 8]; }
        for (int i0 = 0; i0 < 64; i0 += 8) { const int nb = i0 + 8 < 64 ? i0 + 8 : i0; f32x4 kd[8]; float ig[8], lf[8];
#pragma unroll
            for (int e = 0; e < 8; ++e) { win[6 + e] = tapcvt4(nt[e], sg, sg.q0 + i0 + e + 3); ig[e] = bf2f(ni[e]); lf[e] = bf2f(nf[e]); }
#pragma unroll
            for (int e = 0; e < 8; ++e) { nt[e] = tapraw4_at(U, sg, dir, sg.q0 + nb + e + 3, U_MQK + cch, false); ni[e] = MG[(long)rs * (nb + e) * INP]; nf[e] = MG[(long)rs * (nb + e) * INP + 8]; }
            CBAR();
#pragma unroll
            for (int e = 0; e < 8; ++e) { f32x4 a = bc;
#pragma unroll
                for (int j = 0; j < 7; ++j) a = a + w[j] * win[e + j];
                f32x4 v = silu4(a); if (which == 1) v = v * 0.125f;
                F += logsigmoidf_(lf[e] + bf);
                if (dir == 0) *(u64_t*)(OT + (i0 + e) * 64) = pk4(v);
                kd[e] = v * FEXP(ig[e] + bi - F - rmaxL); }
            if (which == 1) store_t8(KDT, i0, kd);
#pragma unroll
            for (int t = 0; t < 6; ++t) win[t] = win[t + 8]; }
    }
    if (sel & 8) for (int it = gt3; it < (int)CH_SG * 32; it += gs) {
        const int s = 4 * (it % 32), g = (it / 32) % 2, which = (it / 64) % 2, n = (it / 128) % NCH, dir = 0, b = it / (128 * NCH), gid = (b * 2 + g) * 2 + dir;
        const SegC sg = seg_of_chunk(b, n);
        const size_t cb = ((size_t)gid * NCH + n);
        bf16_t* OT = c.wsb(which == 0 ? WS_SKB : WS_SQA) + cb * 8192 + s; bf16_t* KDT = c.wsb(WS_SKDT) + cb * 8192 + s * 64;
        const int cch = 512 + which * 256 + g * 128 + s;
        f32x4 w[7];
#pragma unroll
        for (int j = 0; j < 7; ++j) w[j] = *(const f32x4*)(c.in[I_2CW] + ((size_t)l * 7 + (dir == 0 ? j : 6 - j)) * 1024 + cch);
        const f32x4 bc = *(const f32x4*)(c.in[I_2CB] + l * 1024 + cch);
        f32x4 win[14];
#pragma unroll
        for (int t = 0; t < 6; ++t) win[t] = tap4_at(U, sg, dir, sg.q0 + t - 3, U_XBC + cch, true);
        u64_t nt[8];
#pragma unroll
        for (int e = 0; e < 8; ++e) nt[e] = tapraw4_at(U, sg, dir, sg.q0 + e + 3, U_XBC + cch, true);
        for (int i0 = 0; i0 < 64; i0 += 8) { const int nb = i0 + 8 < 64 ? i0 + 8 : i0; f32x4 v[8];
#pragma unroll
            for (int e = 0; e < 8; ++e) win[6 + e] = tapcvt4(nt[e], sg, sg.q0 + i0 + e + 3);
#pragma unroll
            for (int e = 0; e < 8; ++e) nt[e] = tapraw4_at(U, sg, dir, sg.q0 + nb + e + 3, U_XBC + cch, true);
            CBAR();
#pragma unroll
            for (int e = 0; e < 8; ++e) { f32x4 a = bc;
#pragma unroll
                for (int j = 0; j < 7; ++j) a = a + w[j] * win[e + j];
                v[e] = silu4(a); *(u64_t*)(OT + (i0 + e) * 128) = pk4(v[e]); }
#pragma unroll
            for (int t = 0; t < 6; ++t) win[t] = win[t + 8]; }
    }
    if (sel & 16) for (int it = gt4; it < (int)CH_S * 16; it += gs) {
        const int p = 4 * (it % 16), hh = (it / 16) % 8, n = (it / 128) % NCH, dir = (it / (128 * NCH)) % 2, b = it / (256 * NCH), cid = (b * 8 + hh) * 2 + dir;
        const SegC sg = seg_of_chunk(b, n);
        const float Ah = -expf(c.in[I_2AL][l * 16 + dir * 8 + hh]), dtb = c.in[I_2DTB][l * 16 + dir * 8 + hh];
        const int cdt = U_DT + dir * 8 + hh;
        float cumL = 0.f;
        for (int i0 = 0; i0 < 64; i0 += 16) { float t[16];
#pragma unroll
            for (int e = 0; e < 16; ++e) t[e] = tap_at(U, sg, dir, sg.q0 + i0 + e, cdt, true);
#pragma unroll
            for (int e = 0; e < 16; ++e) cumL += softplusf_(t[e] + dtb) * Ah; }
        const size_t cb = ((size_t)cid * NCH + n);
        bf16_t* VT = c.wsb(WS_SVT) + cb * 4096 + p * 64; bf16_t* VHT = c.wsb(WS_SVHT) + cb * 4096 + p * 64; float* CS = c.wsf(WS_SCS) + cb * 128;
        const int cx = hh * 64 + p;
        f32x4 wx[7];
#pragma unroll
        for (int j = 0; j < 7; ++j) wx[j] = *(const f32x4*)(c.in[I_2CW] + ((size_t)l * 7 + (dir == 0 ? j : 6 - j)) * 1024 + cx);
        const f32x4 bx = *(const f32x4*)(c.in[I_2CB] + l * 1024 + cx);
        f32x4 win[14];
#pragma unroll
        for (int t = 0; t < 6; ++t) win[t] = tap4_at(U, sg, dir, sg.q0 + t - 3, U_XBC + cx, true);
        float crun = 0.f;
        u64_t nt[8]; bf16_t nd[8];
#pragma unroll
        for (int e = 0; e < 8; ++e) { nt[e] = tapraw4_at(U, sg, dir, sg.q0 + e + 3, U_XBC + cx, true); nd[e] = tapraw1_at(U, sg, dir, sg.q0 + e, cdt, true); }
        for (int i0 = 0; i0 < 64; i0 += 8) { const int nb = i0 + 8 < 64 ? i0 + 8 : i0; float dv[8]; f32x4 a[8], h[8];
#pragma unroll
            for (int e = 0; e < 8; ++e) { win[6 + e] = tapcvt4(nt[e], sg, sg.q0 + i0 + e + 3); dv[e] = bf2f(nd[e]); }
#pragma unroll
            for (int e = 0; e < 8; ++e) { nt[e] = tapraw4_at(U, sg, dir, sg.q0 + nb + e + 3, U_XBC + cx, true); nd[e] = tapraw1_at(U, sg, dir, sg.q0 + nb + e, cdt, true); }
            CBAR();
#pragma unroll
            for (int e = 0; e < 8; ++e) { f32x4 ax = bx;
#pragma unroll
                for (int j = 0; j < 7; ++j) ax = ax + wx[j] * win[e + j];
                const f32x4 xs = silu4(ax); const float dtv = softplusf_(dv[e] + dtb);
                crun += dtv * Ah; a[e] = xs * dtv; h[e] = a[e] * FEXP(cumL - crun);
                if (dir == 0) *(u64_t*)(c.xbc() + (size_t)seg_row(sg, 0, sg.q0 + i0 + e) * 512 + cx) = pk4(xs);
                if (p == 0) { CS[(i0 + e) * 2] = crun; CS[(i0 + e) * 2 + 1] = dtv; } }
            store_t8(VT, i0, a); store_t8(VHT, i0, h);
#pragma unroll
            for (int t = 0; t < 6; ++t) win[t] = win[t + 8]; }
    }
}

constexpr int NPH = 11, NSTEPS = 1 + DEPTH * NPH;
enum { PH_NORM1 = 0, PH_GIN, PH_PREP, PH_SCAN, PH_FIN, PH_GOUT, PH_ROUTE, PH_SCAT, PH_G1, PH_G2, PH_COMB };
constexpr int IT_IN = (D / 64) * (INW / 32), IT_OUT = (MIXW / 64) * (D / 32), IT_GU = (D / 64) * (2 * D / 32), IT_DN = (D / 64) * (D / 32);

#ifndef CPU_TEST
constexpr int LDS_BYTES = 147456, LDS_CTL = 139264;
#define LDS_WAIT() asm volatile("s_waitcnt lgkmcnt(0)" ::: "memory")
typedef __attribute__((address_space(1))) u32x4 g_u32x4;

struct TItem { const float* W; bf16_t* WT; int K, N, mode, item; };
constexpr int IT_DENSE = IT_IN + IT_OUT, IT_MOE = NE * (IT_GU + IT_DN);
__device__ __forceinline__ TItem titem_of(const Ctx& c, int layer, int it) {
    TItem t;
    if (layer < 0) { const int l = it / IT_DENSE; int r = it % IT_DENSE;
        if (r < IT_IN) { t.W = c.in[I_WIN] + (size_t)l * D * INW; t.K = D; t.N = INW; t.WT = c.win(l); t.mode = 0; t.item = r; return t; } r -= IT_IN;
        t.W = c.in[I_WOUT] + (size_t)l * MIXW * D; t.K = MIXW; t.N = D; t.WT = c.wout(l); t.mode = 0; t.item = r; return t; }
    const int l = layer, e = it / (IT_GU + IT_DN); int r = it % (IT_GU + IT_DN);
    if (r < IT_GU) { t.W = c.in[I_WGU] + ((size_t)l * NE + e) * D * 2 * D; t.K = D; t.N = 2 * D; t.WT = c.wgu(l) + (size_t)e * 2 * D * D; t.mode = 1; t.item = r; }
    else { t.W = c.in[I_WDN] + ((size_t)l * NE + e) * D * D; t.K = D; t.N = D; t.WT = c.wdn(l) + (size_t)e * D * D; t.mode = 0; t.item = r - IT_GU; }
    return t;
}
__device__ __forceinline__ void titem_load(const TItem& t, float (&v)[32], int lane) {
    const int nblk = t.N / 32, kb = t.item / nblk, nb = t.item % nblk;
    const float* src = t.W + (size_t)(64 * kb + (lane >> 5)) * t.N + 32 * nb + (lane & 31);
#pragma unroll
    for (int i = 0; i < 32; ++i) v[i] = __builtin_nontemporal_load(src + (size_t)(2 * i) * t.N);
}
__device__ __forceinline__ void titem_store(const TItem& t, const float (&v)[32], LAS float* scr, int lane) {
    const int nblk = t.N / 32, kb = t.item / nblk, nb = t.item % nblk, k0 = 64 * kb, n0 = 32 * nb;
#pragma unroll
    for (int i = 0; i < 32; ++i) scr[(2 * i + (lane >> 5)) * 33 + (lane & 31)] = v[i];
    LDS_WAIT(); asm volatile("" ::: "memory");
    const int c = lane & 7;
    const int r0 = t.mode ? gu_row_of_col(n0) : n0;
#pragma unroll
    for (int j = 0; j < 4; ++j) { const int n = (lane >> 3) + 8 * j; const LAS float* s = scr + (8 * c) * 33 + n;
        u32x4 o; o.x = pk2(s[0 * 33], s[1 * 33]); o.y = pk2(s[2 * 33], s[3 * 33]); o.z = pk2(s[4 * 33], s[5 * 33]); o.w = pk2(s[6 * 33], s[7 * 33]);
        __builtin_nontemporal_store(o, (u32x4*)(t.WT + (size_t)(r0 + n) * t.K + k0 + 8 * c)); }
    LDS_WAIT(); asm volatile("" ::: "memory");
}
__device__ __forceinline__ void ph_transposes(const Ctx& c, LAS unsigned char* lds, int layer, int gw, int ngw, int wave, int lane) {
    LAS float* scr = (LAS float*)(lds + wave * 16384);
    const int nit = layer < 0 ? DEPTH * IT_DENSE : IT_MOE;
    int it = gw;
    if (it >= nit) return;
    TItem cur = titem_of(c, layer, it); float va[32], vb[32];
    titem_load(cur, va, lane);
    for (;;) {
        const int nx = it + ngw; const bool more = nx < nit;
        TItem nxt = cur;
        if (more) { nxt = titem_of(c, layer, nx); titem_load(nxt, vb, lane); }
        titem_store(cur, va, scr, lane);
        if (!more) break;
#pragma unroll
        for (int i = 0; i < 32; ++i) va[i] = vb[i];
        cur = nxt; it = nx;
    }
}

#define FRESH() Ctx c; { const KAS Args* kp_ = (const KAS Args*)__builtin_amdgcn_kernarg_segment_ptr(); asm volatile("" : "+s"(kp_)); c.in = kp_->in; c.out = kp_->out; c.ws = kp_->ws; } \
    int lane; asm volatile("v_mbcnt_lo_u32_b32 %0, -1, 0\n\tv_mbcnt_hi_u32_b32 %0, -1, %0" : "=v"(lane)); const int wave = wave_s, tid = wave * 64 + lane, gt = blk * 512 + tid, gs = G * 512; (void)gt; (void)gs;
__global__ void __launch_bounds__(512, 2) mega_fwd(Args args) {
    extern __shared__ __attribute__((aligned(16))) unsigned char lds_raw[];
    LAS unsigned char* lds = (LAS unsigned char*)lds_raw;
    const int G = gridDim.x, blk = blockIdx.x;
    const int wave_s = __builtin_amdgcn_readfirstlane((int)threadIdx.x >> 6);
    const int lo = args.lo, hi = args.hi;
    for (int u = threadIdx.x; u < (LDS_BYTES - LDS_CTL) / 4; u += 512) ((LAS unsigned*)(lds + LDS_CTL))[u] = 0u;
    __syncthreads();
    volatile LAS unsigned* xbw = (volatile LAS unsigned*)(lds + LDS_CTL + 1024);
    unsigned* barw = (unsigned*)(args.ws + WS_CTL) + CW_BAR + args.li * XCD_BAR_WORDS;
    XcdBarrier bar; bar.bar = barw; bar.x = 0; bar.st = xbw;
    if (hi - lo > 1) bar = xcd_barrier_post(barw, xbw);
    LAS int* tb = (LAS int*)(lds + LDS_CTL + 2048);
    static_assert(2048 + TB_WORDS * 4 <= 4096 && 4096 + NE * 4 <= LDS_BYTES - LDS_CTL, "LDS control region");
#ifndef PHASE_MASK
#define PHASE_MASK 0xFFFFu
#endif
#define EN(p) (((PHASE_MASK) >> (p)) & 1u)
#ifndef DUP_MASK
#define DUP_MASK 0u
#endif
#define DUP(p) (((DUP_MASK) >> (p)) & 1u)
#define IN(s) (lo <= (s) && (s) < hi)
#define SEAM(s) do { if (IN(s) && IN((s) + 1)) xcd_barrier(bar); } while (0)

    if (EN(12) && IN(0)) {
        FRESH();
        const int psel = (hi == 1) ? args.pad : 15;
        if (psel & 1) ph_transposes(c, lds, -1, blk * 8 + wave, G * 8, wave, lane);
        __syncthreads();
        if (psel & 2) ph_mod_w(c, (LAS float*)lds, tid, blk, G);
        if (psel & 8) { ph_foldgate(c, gt, gs); ph_rwsplit(c, gt, gs); }
    }
    SEAM(0);
    for (int l = 0; l < DEPTH; ++l) {
        const int s0 = 1 + l * NPH;
        const bool last = (l == DEPTH - 1);
        const int nrows = last ? NLAT : NTOK;
        if (l == 0) {
            if (EN(PH_NORM1) && IN(s0 + PH_NORM1)) { FRESH(); ph_norm1_w(c, l, blk * 8 + wave, G * 8, lane); }
            SEAM(s0 + PH_NORM1);
        }
        if (EN(PH_GIN) && IN(s0 + PH_GIN)) {
            FRESH();
            pg8::Gemm g{c.h(), c.win(l), NTOK, INP, D}; DenseOrder S; S.init(NTOK, INP, G, blk);
            EpiU E{c.u(), INP};
            pg8::gemm_phase<EpiU, DenseOrder, true, true>(lds, g, S, E, tid);
            if (DUP(PH_GIN)) pg8::gemm_phase<EpiU, DenseOrder, true, true>(lds, g, S, E, tid);
        }
        SEAM(s0 + PH_GIN);
        if (EN(PH_PREP) && IN(s0 + PH_PREP)) { FRESH(); ph_prep4(c, l, gt, gs, (args.li > 0 && s0 + PH_PREP == lo) ? args.pad : 31); }
        SEAM(s0 + PH_PREP);
        if (EN(PH_SCAN) && IN(s0 + PH_SCAN)) { FRESH(); ph_chain(c, lds, blk, G, tid, (hi == s0 + PH_SCAN + 1 && args.pad >= 64) ? (args.pad & 15) : 7); }
        SEAM(s0 + PH_SCAN);
        if (EN(PH_FIN) && IN(s0 + PH_FIN)) { FRESH(); ph_finish_w(c, l, nrows, blk * 8 + wave, G * 8, lane); if (DUP(PH_FIN)) ph_finish_w(c, l, nrows, blk * 8 + wave, G * 8, lane); }
        SEAM(s0 + PH_FIN);
        if (EN(PH_GOUT) && IN(s0 + PH_GOUT)) {
            FRESH();
            pg8::Gemm g{c.y(), c.wout(l), nrows, D, MIXW}; DenseOrder S; S.init(nrows, D, G, blk);
            EpiResid E{c.x(), c.mod(l, 0), c.wsf(WS_SSP)};
            pg8::gemm_phase<EpiResid, DenseOrder, true, true>(lds, g, S, E, tid);
        }
        SEAM(s0 + PH_GOUT);
        if (EN(PH_ROUTE) && IN(s0 + PH_ROUTE)) { FRESH(); if (DUP(PH_ROUTE)) { ph_route_b(c, l, nrows, (LAS float*)lds, blk, G, tid, true); __syncthreads(); } ph_route_b(c, l, nrows, (LAS float*)lds, blk, G, tid); }
        SEAM(s0 + PH_ROUTE);
        if (IN(s0 + PH_SCAT) || IN(s0 + PH_G1) || IN(s0 + PH_G2)) {
            FRESH();
            LAS int* ntl = (LAS int*)(lds + LDS_CTL + 4096);
            if (tid < NE) ntl[tid] = (c.cnt(l)[tid * CNTS] + 255) / 256;
            __syncthreads();
            if (tid < NE) { int a = 0; for (int e = 0; e < NE; ++e) a += (e < tid) ? ntl[e] : 0; tb[tid] = a; const int nt = ntl[tid]; for (int t = 0; t < nt; ++t) tb[NE + 1 + a + t] = tid; if (tid == NE - 1) tb[NE] = a + nt; }
            __syncthreads();
        }
        if (EN(PH_SCAT) && IN(s0 + PH_SCAT)) { FRESH(); ph_rowtok_w(c, l, nrows, (const LAS int*)tb, gt, gs); ph_transposes(c, lds, l, blk * 8 + wave, G * 8, wave, lane); }
        SEAM(s0 + PH_SCAT);
        if (EN(PH_G1) && IN(s0 + PH_G1)) {
            FRESH();
            LAS unsigned short* gtab = (LAS unsigned short*)(lds + 131072);
            MoeOrderG<const LAS int*, const LAS unsigned short*> S(tb, 2 * D / 256, G, blk, gtab, c.rtok());
            { pg8::Unit uu; const int* rt_ = c.rtok(); for (int i = 0; i < 16 && S.next(i, uu); ++i) for (int r = tid; r < 256; r += 512) gtab[i * 256 + r] = (unsigned short)rt_[uu.pm * 256 + r]; }
            __syncthreads();
            pg8::Gemm g{c.h(), c.wgu(l), NTOK, NE * 2 * D, D};
            EpiSwiglu E{c.act(), c.in[I_BGU] + (size_t)l * NE * 2 * D};
            pg8::gemm_phase<EpiSwiglu, MoeOrderG<const LAS int*, const LAS unsigned short*>, true, true>(lds, g, S, E, tid);
        }
        SEAM(s0 + PH_G1);
        if (EN(PH_G2) && IN(s0 + PH_G2)) {
            FRESH();
            pg8::Gemm g{c.act(), c.wdn(l), MAXROWS, NE * D, D}; MoeOrder<const LAS int*> S{tb, D / 256, G, blk, 8, 0};
            EpiDown E{c.yb(), c.in[I_BDN] + (size_t)l * NE * D};
            pg8::gemm_phase<EpiDown, MoeOrder<const LAS int*>, true, true>(lds, g, S, E, tid);
            if (DUP(PH_G2)) pg8::gemm_phase<EpiDown, MoeOrder<const LAS int*>, true, true>(lds, g, S, E, tid);
        }
        SEAM(s0 + PH_G2);
        if (EN(PH_COMB) && IN(s0 + PH_COMB)) { FRESH(); if (DUP(PH_COMB) && l < DEPTH - 1) ph_combine_w(c, l, nrows, blk * 8 + wave, G * 8, lane, true); ph_combine_w(c, l, nrows, blk * 8 + wave, G * 8, lane); }
        SEAM(s0 + PH_COMB);
    }
#undef IN
#undef SEAM
}

#ifndef MK_MULTI
#define MK_MULTI 0
#endif
extern "C" void kernel_launch(void* const* d_in, const int* in_sizes, int n_in, void* d_out, int out_size, void* d_ws, size_t ws_size, hipStream_t stream) {
    static int grid = 0;
    if (grid == 0) {
        if (n_in != N_IN || out_size != NLAT * D || ws_size < WS_END) { fprintf(stderr, "kernel_launch: unexpected shapes (n_in %d out %d ws %zu need %zu)\n", n_in, out_size, ws_size, (size_t)WS_END); grid = -1; return; }
        int dev = 0, cus = 0;
        if (hipGetDevice(&dev) != hipSuccess || hipDeviceGetAttribute(&cus, hipDeviceAttributeMultiprocessorCount, dev) != hipSuccess) { grid = -1; return; }
        if (hipFuncSetAttribute((const void*)mega_fwd, hipFuncAttributeMaxDynamicSharedMemorySize, LDS_BYTES) != hipSuccess) { fprintf(stderr, "kernel_launch: hipFuncSetAttribute failed\n"); grid = -1; return; }
        int per_cu = 0;
        (void)hipOccupancyMaxActiveBlocksPerMultiprocessor(&per_cu, (const void*)mega_fwd, 512, LDS_BYTES);
        (void)hipGetLastError();
        grid = cus;
        if (grid < NB * 32) { fprintf(stderr, "kernel_launch: needs at least %d CUs (one scan chain per workgroup), device has %d\n", NB * 32, cus); grid = -1; return; }
    }
    if (grid < 0) return;
    (void)hipMemsetAsync((char*)d_ws + WS_CTL, 0, CTL_BYTES, stream);
    Args a{};
    for (int i = 0; i < N_IN; ++i) a.in[i] = (const float*)d_in[i];
    a.out = (float*)d_out; a.ws = (unsigned char*)d_ws;
#if MK_MULTI
    for (int s = 0; s < NSTEPS; ++s) { a.lo = s; a.hi = s + 1; hipLaunchKernelGGL(mega_fwd, dim3(grid), dim3(512), LDS_BYTES, stream, a); }
#elif defined(PROBE_PRO)
    a.lo = 0; a.hi = 1; a.li = 0; a.pad = PROBE_PRO; hipLaunchKernelGGL(mega_fwd, dim3(grid), dim3(512), LDS_BYTES, stream, a);
    a.lo = 0; a.hi = NSTEPS; a.li = 1; a.pad = 0; hipLaunchKernelGGL(mega_fwd, dim3(grid), dim3(512), LDS_BYTES, stream, a);
#elif defined(PROBE_PH)
    { int lo = 0; for (int l = 0; l <= DEPTH; ++l) { const int s = 1 + l * NPH + PROBE_PH; a.lo = lo; a.hi = l < DEPTH ? s + 1 : NSTEPS; a.li = l; a.pad = PROBE_SEL; hipLaunchKernelGGL(mega_fwd, dim3(grid), dim3(512), LDS_BYTES, stream, a); lo = s; } }
#else
    a.lo = 0; a.hi = NSTEPS;
    hipLaunchKernelGGL(mega_fwd, dim3(grid), dim3(512), LDS_BYTES, stream, a);
#endif
}

#else
static void transposes_cpu(const Ctx& c) {
    for (int l = 0; l < DEPTH; ++l) {
        for (int k = 0; k < D; ++k) for (int n = 0; n < INW; ++n) c.win(l)[(size_t)n * D + k] = (bf16_t)f2bf(c.in[I_WIN][((size_t)l * D + k) * INW + n]);
        for (int k = 0; k < MIXW; ++k) for (int n = 0; n < D; ++n) c.wout(l)[(size_t)n * MIXW + k] = (bf16_t)f2bf(c.in[I_WOUT][((size_t)l * MIXW + k) * D + n]);
        for (int e = 0; e < NE; ++e) {
            for (int k = 0; k < D; ++k) for (int n = 0; n < 2 * D; ++n) c.wgu(l)[((size_t)e * 2 * D + gu_row_of_col(n)) * D + k] = (bf16_t)f2bf(c.in[I_WGU][(((size_t)l * NE + e) * D + k) * 2 * D + n]);
            for (int k = 0; k < D; ++k) for (int n = 0; n < D; ++n) c.wdn(l)[((size_t)e * D + n) * D + k] = (bf16_t)f2bf(c.in[I_WDN][(((size_t)l * NE + e) * D + k) * D + n]);
        }
    }
}
template <class Sched> static int gemm_cpu_arow(const Sched& S, const pg8::Unit& u, int r) { if constexpr (Sched::GATHER) return S.rowtok[u.pm * 256 + r]; else return u.pm * 256 + r; }
template <class Epi, class Sched> static void gemm_cpu(const pg8::Gemm& g, Sched S, const Epi& E, int G) {
    static float T[256][256];
    for (int cblk = 0; cblk < G; ++cblk) {
        S.c = cblk;
        for (int i = 0;; ++i) {
            pg8::Unit u; if (!S.next(i, u)) break;
            for (int r = 0; r < 256; ++r) for (int cc = 0; cc < 256; ++cc) {
                const bf16_t* a = g.A + (size_t)gemm_cpu_arow(S, u, r) * g.K; const bf16_t* b = g.Bt + (size_t)(u.pn * 256 + cc) * g.K;
                float s = 0.f; for (int k = 0; k < g.K; ++k) s += bf2f(a[k]) * bf2f(b[k]);
                T[r][cc] = s;
            }
            for (int wid = 0; wid < 8; ++wid) for (int lane = 0; lane < 64; ++lane) {
                const int wr = wid >> 2, wc = wid & 3, fr = lane & 15, fq = lane >> 4;
                accq acc[2][2][4][2];
                for (int ai = 0; ai < 2; ++ai) for (int bj = 0; bj < 2; ++bj) for (int m = 0; m < 4; ++m) for (int n = 0; n < 2; ++n) for (int j = 0; j < 4; ++j) {
                    const int r = 128 * ai + 64 * wr + 16 * m + fr;
                    const int cc = Epi::PERM ? 128 * bj + 32 * wc + 8 * fq + 4 * n + j : 128 * bj + 32 * wc + 16 * n + 4 * fq + j;
                    acc[ai][bj][m][n][j] = T[r][cc];
                }
                E(acc, u, wr, wc, fr, fq);
            }
        }
    }
}
constexpr int LDS_BYTES = 147456;
#define COOP(G_, body_) simt::launch(G_, 512, LDS_BYTES, [&]() { const int tid = threadIdx.x, lane = tid & 63, wave = tid >> 6, blk = blockIdx.x, G = gridDim.x; unsigned char* lds = simt::lds_base; (void)lane; (void)wave; (void)blk; (void)G; (void)lds; body_; })
extern "C" void kernel_launch(void* const* d_in, const int* in_sizes, int n_in, void* d_out, int out_size, void* d_ws, size_t ws_size, hipStream_t stream) {
    Ctx c; c.in = (const float* const*)d_in; c.out = (float*)d_out; c.ws = (unsigned char*)d_ws;
    memset((char*)d_ws + WS_CTL, 0, CTL_BYTES);
    const int G = 256, GC = 8;
    transposes_cpu(c);
    COOP(GC, { ph_mod_w(c, (float*)lds, tid, blk, G); });
    ph_foldgate(c, 0, 1); ph_rwsplit(c, 0, 1);
    for (int l = 0; l < DEPTH; ++l) {
        const bool last = (l == DEPTH - 1); const int nrows = last ? NLAT : NTOK;
        if (l == 0) COOP(GC, ph_norm1_w(c, l, blk * 8 + wave, G * 8, lane));
        { pg8::Gemm g{c.h(), c.win(l), NTOK, INP, D}; DenseOrder S; S.init(NTOK, INP, G, 0); EpiU E{c.u(), INP}; gemm_cpu(g, S, E, G); }
        ph_prep4(c, l, 0, 1);
        COOP(NB * 32, ph_chain(c, lds, blk, G, tid));
        COOP(GC, ph_finish_w(c, l, nrows, blk * 8 + wave, G * 8, lane));
        { pg8::Gemm g{c.y(), c.wout(l), nrows, D, MIXW}; DenseOrder S; S.init(nrows, D, G, 0); EpiResid E{c.x(), c.mod(l, 0), c.wsf(WS_SSP)}; gemm_cpu(g, S, E, G); }
        COOP(GC, ph_route_b(c, l, nrows, (float*)lds, blk, G, tid));
        int tb[TB_WORDS]; expert_tile_base(c.cnt(l), tb);
        COOP(GC, ph_rowtok_w(c, l, nrows, (const int*)tb, blk * 512 + tid, G * 512));
        { pg8::Gemm g{c.h(), c.wgu(l), NTOK, NE * 2 * D, D}; MoeOrderG<const int*, const unsigned short*> S(tb, 2 * D / 256, G, 0, nullptr, c.rtok()); EpiSwiglu E{c.act(), c.in[I_BGU] + (size_t)l * NE * 2 * D}; gemm_cpu(g, S, E, G); }
        { pg8::Gemm g{c.act(), c.wdn(l), MAXROWS, NE * D, D}; MoeOrder<const int*> S{tb, D / 256, G, 0}; EpiDown E{c.yb(), c.in[I_BDN] + (size_t)l * NE * D}; gemm_cpu(g, S, E, G); }
        COOP(GC, ph_combine_w(c, l, nrows, blk * 8 + wave, G * 8, lane));
    }
}
#endif
```

```cpp
#ifndef CPU_TEST
#include <hip/hip_runtime.h>
#else
#include "cpu_shim.h"
#endif
#include <cstdio>
#include <cstdint>
#include <cmath>

#ifndef CFG_D
#define CFG_D 1024
#define CFG_B 8
#define CFG_SEQ 2048
#define CFG_DEPTH 4
#define CFG_CTX 256
#endif
constexpr int D = CFG_D, NB = CFG_B, SEQ = CFG_SEQ, DEPTH = CFG_DEPTH, CTX = CFG_CTX;
constexpr int GRID_W = 64, ROWS = SEQ / GRID_W;
constexpr int NLAT = NB * SEQ, NCTX = NB * CTX, NTOK = NLAT + NCTX;
constexpr int INW = 4672, INWX = 5184, INP = 5376, MIXW = 1536, NE = 32, TOPK = 4;
constexpr int U_GQ = 0, U_GK = 256, U_GV = 512, U_GG = 1024, U_GLR = 1536;
constexpr int U_MQK = 1568, U_MV = 2080, U_MO = 2592, U_MG = 3104;
constexpr int U_Z = 3120, U_XBC = 3632, U_DT = 4656, U_GGK = 4672;
constexpr float EPS = 1e-6f;
constexpr int MAXROWS = NTOK * TOPK + NE * 256;
static_assert(NTOK % 256 == 0 && NLAT % 256 == 0 && D % 128 == 0 && D >= 256, "shape");

constexpr size_t al256(size_t x) { return (x + 255) & ~(size_t)255; }
constexpr size_t WS_CTL = 0, CTL_BYTES = 1u << 20;
constexpr size_t WS_MOD = WS_CTL + CTL_BYTES;
constexpr size_t WS_WIN = al256(WS_MOD + (size_t)DEPTH * (NB + 1) * 6 * D * 4);
constexpr size_t WS_WOUT = al256(WS_WIN + (size_t)DEPTH * INP * D * 2);
constexpr size_t WS_WGU = al256(WS_WOUT + (size_t)DEPTH * D * MIXW * 2);
constexpr size_t WS_WDN = al256(WS_WGU + (size_t)DEPTH * NE * 2 * D * D * 2);
constexpr size_t WS_X = al256(WS_WDN + (size_t)DEPTH * NE * D * D * 2);
constexpr size_t WS_H = al256(WS_X + (size_t)NTOK * D * 4);
constexpr size_t WS_U = al256(WS_H + (size_t)NTOK * D * 2);
constexpr size_t WS_GLA_A = al256(WS_U + (size_t)NTOK * INP * 4);
constexpr size_t WS_ML_QK = al256(WS_GLA_A + (size_t)2 * NTOK * 256 * 4);
constexpr size_t WS_ML_G = al256(WS_ML_QK + (size_t)NTOK * 512 * 4);
constexpr size_t WS_XBC = al256(WS_ML_G + (size_t)NTOK * 16 * 4);
constexpr size_t WS_DT = al256(WS_XBC + (size_t)NTOK * 1024 * 4);
constexpr size_t WS_ODIR = al256(WS_DT + (size_t)NTOK * 16 * 4);
constexpr size_t WS_OD2 = al256(WS_ODIR + (size_t)2 * NTOK * MIXW * 4);
constexpr size_t WS_Y = al256(WS_OD2 + (size_t)2 * NTOK * 512 * 4);
constexpr size_t WS_TOPE = al256(WS_Y + (size_t)NTOK * MIXW * 2);
constexpr size_t WS_TOPG = al256(WS_TOPE + (size_t)NTOK * 4 * 4);
constexpr size_t WS_POS = al256(WS_TOPG + (size_t)NTOK * 4 * 4);
constexpr size_t WS_DEST = al256(WS_POS + (size_t)NTOK * 4 * 4);
constexpr size_t WS_XS = al256(WS_DEST + (size_t)NTOK * 4 * 4);
constexpr size_t WS_ACT = al256(WS_XS + (size_t)MAXROWS * D * 2);
constexpr size_t WS_YB = al256(WS_ACT + (size_t)MAXROWS * D * 2);
constexpr int NCH = (CTX + SEQ) / 64;
static_assert(CTX % 64 == 0 && SEQ % 64 == 0, "chunking");
constexpr size_t CH_G = (size_t)NB * 4 * 2 * NCH, CH_S = (size_t)NB * 8 * 2 * NCH, CH_SG = (size_t)NB * 2 * 2 * NCH;
constexpr size_t WS_GQA = al256(WS_YB + (size_t)MAXROWS * D * 4);
constexpr size_t WS_GKB = al256(WS_GQA + CH_G * 4096 * 2);
constexpr size_t WS_GKDT = al256(WS_GKB + CH_G * 4096 * 2);
constexpr size_t WS_GVT = al256(WS_GKDT + CH_G * 4096 * 2);
constexpr size_t WS_GAL = al256(WS_GVT + CH_G * 8192 * 2);
constexpr size_t WS_MQA = al256(WS_GAL + CH_G * 64 * 4);
constexpr size_t WS_MKB = al256(WS_MQA + CH_G * 4096 * 2);
constexpr size_t WS_MKDT = al256(WS_MKB + CH_G * 4096 * 2);
constexpr size_t WS_MVT = al256(WS_MKDT + CH_G * 4096 * 2);
constexpr size_t WS_MMS = al256(WS_MVT + CH_G * 8192 * 2);
constexpr size_t WS_SQA = al256(WS_MMS + CH_G * 256 * 4);
constexpr size_t WS_SKB = al256(WS_SQA + CH_SG * 8192 * 2);
constexpr size_t WS_SKDT = al256(WS_SKB + CH_SG * 8192 * 2);
constexpr size_t WS_SVT = al256(WS_SKDT + CH_SG * 8192 * 2);
constexpr size_t WS_SVHT = al256(WS_SVT + CH_S * 4096 * 2);
constexpr size_t WS_SCS = al256(WS_SVHT + CH_S * 4096 * 2);
constexpr size_t WS_RWT = al256(WS_SCS + CH_S * 128 * 4);
constexpr size_t WS_SSP = al256(WS_RWT + (size_t)DEPTH * 2 * NE * D * 2);
constexpr size_t WS_RTOK = al256(WS_SSP + (size_t)NTOK * 64 * 4);
constexpr size_t WS_END = al256(WS_RTOK + (size_t)MAXROWS * 4);
static_assert(D == 1024 || D == 256, "ssp slots assume D / 256 <= 4 column tiles");
constexpr int CW_BAR = 4096;
constexpr int CW_CNT = 131072, CNTS = 256;

enum { I_X = 0, I_C, I_CTX, I_CCTX, I_WMOD, I_BMOD, I_N1G, I_WIN, I_GW2, I_GBG, I_GNG, I_MCW, I_MCB, I_MBI, I_MBF, I_MNG,
       I_2CW, I_2CB, I_2DTB, I_2AL, I_2D, I_2NG, I_WOUT, I_N2G, I_RW, I_RB, I_WGU, I_BGU, I_WDN, I_BDN, I_FNG, N_IN };

struct Args { const float* in[N_IN]; float* out; unsigned char* ws; int lo, hi, li, pad; };

#ifndef CPU_TEST
#define KAS __attribute__((address_space(4)))
#else
#define KAS
#endif
typedef unsigned short bf16_t;
typedef float f32x4 __attribute__((ext_vector_type(4)));
typedef unsigned u32x4 __attribute__((ext_vector_type(4)));
typedef short bf16x8 __attribute__((ext_vector_type(8)));

__host__ __device__ __forceinline__ unsigned f2bf(float f) { unsigned u; __builtin_memcpy(&u, &f, 4); return (u + 0x7fffu + ((u >> 16) & 1u)) >> 16; }
#ifndef CPU_TEST
__device__ __forceinline__ unsigned pk2(float lo, float hi) { unsigned r; asm("v_cvt_pk_bf16_f32 %0, %1, %2" : "=v"(r) : "v"(lo), "v"(hi)); return r; }
#else
__host__ __device__ __forceinline__ unsigned pk2(float lo, float hi) { return f2bf(lo) | (f2bf(hi) << 16); }
#endif
__host__ __device__ __forceinline__ float bf2f(bf16_t b) { unsigned u = ((unsigned)b) << 16; float f; __builtin_memcpy(&f, &u, 4); return f; }
#ifndef CPU_TEST
#define FEXP(x) __expf(x)
#define FLOG(x) __logf(x)
#define FRCP(x) __builtin_amdgcn_rcpf(x)
#else
#define FEXP(x) expf(x)
#define FLOG(x) logf(x)
#define FRCP(x) (1.0f / (x))
#endif
__host__ __device__ __forceinline__ float sigmoidf_(float x) { return FRCP(1.0f + FEXP(-x)); }
__host__ __device__ __forceinline__ float siluf_(float x) { return x * sigmoidf_(x); }
__host__ __device__ __forceinline__ float logsigmoidf_(float x) { return fminf(x, 0.f) - FLOG(1.0f + FEXP(-fabsf(x))); }
__host__ __device__ __forceinline__ float softplusf_(float x) { return fmaxf(x, 0.f) + FLOG(1.0f + FEXP(-fabsf(x))); }

__host__ __device__ __forceinline__ f32x4 cvtb4(unsigned long long w) { const unsigned lo = (unsigned)w, hi = (unsigned)(w >> 32); f32x4 r;
    unsigned t; float f; t = lo << 16; __builtin_memcpy(&f, &t, 4); r[0] = f; t = lo & 0xffff0000u; __builtin_memcpy(&f, &t, 4); r[1] = f; t = hi << 16; __builtin_memcpy(&f, &t, 4); r[2] = f; t = hi & 0xffff0000u; __builtin_memcpy(&f, &t, 4); r[3] = f; return r; }
__host__ __device__ __forceinline__ f32x4 ldb4(const bf16_t* p) { const unsigned long long w = *(const unsigned long long*)p; const unsigned lo = (unsigned)w, hi = (unsigned)(w >> 32); f32x4 r;
    unsigned t; float f; t = lo << 16; __builtin_memcpy(&f, &t, 4); r[0] = f; t = lo & 0xffff0000u; __builtin_memcpy(&f, &t, 4); r[1] = f; t = hi << 16; __builtin_memcpy(&f, &t, 4); r[2] = f; t = hi & 0xffff0000u; __builtin_memcpy(&f, &t, 4); r[3] = f; return r; }
struct Ctx {
    const float* const KAS* in; float* out; unsigned char* ws;
    __host__ __device__ float* mod(int l, int r) const { return (float*)(ws + WS_MOD) + ((size_t)l * (NB + 1) + r) * 6 * D; }
    __host__ __device__ bf16_t* win(int l) const { return (bf16_t*)(ws + WS_WIN) + (size_t)l * INP * D; }
    __host__ __device__ bf16_t* wout(int l) const { return (bf16_t*)(ws + WS_WOUT) + (size_t)l * D * MIXW; }
    __host__ __device__ bf16_t* wgu(int l) const { return (bf16_t*)(ws + WS_WGU) + (size_t)l * NE * 2 * D * D; }
    __host__ __device__ bf16_t* wdn(int l) const { return (bf16_t*)(ws + WS_WDN) + (size_t)l * NE * D * D; }
    __host__ __device__ float* x() const { return (float*)(ws + WS_X); }
    __host__ __device__ bf16_t* h() const { return (bf16_t*)(ws + WS_H); }
    __host__ __device__ bf16_t* u() const { return (bf16_t*)(ws + WS_U); }
    __host__ __device__ float* gla_a() const { return (float*)(ws + WS_GLA_A); }
    __host__ __device__ float* ml_qk() const { return (float*)(ws + WS_ML_QK); }
    __host__ __device__ float* ml_g() const { return (float*)(ws + WS_ML_G); }
    __host__ __device__ bf16_t* xbc() const { return (bf16_t*)(ws + WS_XBC); }
    __host__ __device__ float* dt() const { return (float*)(ws + WS_DT); }
    __host__ __device__ bf16_t* odir() const { return (bf16_t*)(ws + WS_ODIR); }
    __host__ __device__ float* od2() const { return (float*)(ws + WS_OD2); }
    __host__ __device__ bf16_t* y() const { return (bf16_t*)(ws + WS_Y); }
    __host__ __device__ int* tope() const { return (int*)(ws + WS_TOPE); }
    __host__ __device__ float* topg() const { return (float*)(ws + WS_TOPG); }
    __host__ __device__ int* pos() const { return (int*)(ws + WS_POS); }
    __host__ __device__ int* dest() const { return (int*)(ws + WS_DEST); }
    __host__ __device__ bf16_t* xs() const { return (bf16_t*)(ws + WS_XS); }
    __host__ __device__ bf16_t* act() const { return (bf16_t*)(ws + WS_ACT); }
    __host__ __device__ bf16_t* yb() const { return (bf16_t*)(ws + WS_YB); }
    __host__ __device__ bf16_t* wsb(size_t off) const { return (bf16_t*)(ws + off); }
    __host__ __device__ float* wsf(size_t off) const { return (float*)(ws + off); }
    __host__ __device__ int* rtok() const { return (int*)(ws + WS_RTOK); }
    __host__ __device__ unsigned* ctl() const { return (unsigned*)(ws + WS_CTL); }
    static_assert((size_t)(CW_CNT + 2 * DEPTH * NE * CNTS) * 4 <= CTL_BYTES, "expert counters fit the zeroed control area");
    __host__ __device__ int* cnt(int l) const { return (int*)(ws + WS_CTL) + CW_CNT + l * NE * CNTS; }
};

constexpr size_t OF_G = 0, OF_M = (size_t)NB * 8 * NCH * 8192, OF_S = 2 * OF_M;
static_assert(OF_S + (size_t)NB * 16 * NCH * 4096 == (size_t)2 * NTOK * MIXW, "fragment layout fills the old [2][NTOK][MIXW] buffer exactly");
__host__ __device__ __forceinline__ int chunk_of(int is_lat, int q) { return (is_lat ? CTX / 64 : 0) + q / 64; }
__host__ __device__ __forceinline__ int mod_row(int row) { return row < NLAT ? row / SEQ : NB; }
__host__ __device__ __forceinline__ void seg_of(int row, int& base, int& pos, int& len) {
    if (row < NLAT) { base = (row / SEQ) * SEQ; pos = row - base; len = SEQ; } else { const int r = row - NLAT; base = NLAT + (r / CTX) * CTX; pos = row - base; len = CTX; }
}
__host__ __device__ __forceinline__ int tok_of_scan(int s) { return (s % ROWS) * GRID_W + s / ROWS; }
__host__ __device__ __forceinline__ int scan_of_tok(int t) { return (t % GRID_W) * ROWS + t / GRID_W; }
__host__ __device__ __forceinline__ int tokrow_of_srow(int srow) { if (srow >= NLAT) return srow; const int b = srow / SEQ; return b * SEQ + tok_of_scan(srow - b * SEQ); }
__host__ __device__ __forceinline__ int srow_of_tokrow(int row) { if (row >= NLAT) return row; const int b = row / SEQ; return b * SEQ + scan_of_tok(row - b * SEQ); }

#ifndef CPU_TEST
#define UNI(x) __builtin_amdgcn_readfirstlane(x)
#define CBAR() __builtin_amdgcn_sched_barrier(0)
#define LAS __attribute__((address_space(3)))
namespace pg8 {
#define PG8_LAS __attribute__((address_space(3)))
typedef unsigned short bf16_t;
typedef short bf16x8 __attribute__((ext_vector_type(8)));
typedef float f32x4 __attribute__((ext_vector_type(4)));
typedef unsigned u32x4 __attribute__((ext_vector_type(4)));
constexpr int BM = 256, BK = 64, HALF = 128, HTB = HALF * BK * 2  , STAGE_BYTES = 8 * HTB, NXCD = 8, WGM = 8;

__host__ __device__ __forceinline__ int lds_byte(int r, int c) { const int st = (r >> 4) * 2 + (c >> 5), rr = r & 15, cc = c & 31, ob = rr * 64 + cc * 2; return st * 1024 + (ob ^ (((ob >> 9) & 1) << 5)); }
__host__ __device__ __forceinline__ void stage_rc(int b, int& R, int& C) { const int st = b / 1024, sb = b % 1024, swz = sb ^ (((sb >> 9) & 1) << 5); R = (st >> 1) * 16 + swz / 64; C = (st & 1) * 32 + (swz % 64) / 2; }
__host__ __device__ __forceinline__ int perm32(int rho) { const int n = rho >> 4, i = rho & 15; return 8 * (i >> 2) + 4 * n + (i & 3); }

struct Unit { int pm, pn; };
struct Gemm { const bf16_t* A; const bf16_t* Bt; int M, N, K; };

struct StaticOrder {
    int nM, nN, nwg, G, c;
    __host__ __device__ void init(int M, int N, int G_, int c_) { nM = M / BM; nN = N / BM; nwg = nM * nN; G = G_; c = c_; }
    __host__ __device__ bool next(int i, Unit& u) const {
        const long L = (long)i * G + c; if (L >= nwg) return false;
        int wgid = (int)L; { const int q = nwg / NXCD, r = nwg % NXCD, xcd = wgid % NXCD, off = wgid / NXCD; wgid = (xcd < r ? xcd * (q + 1) : r * (q + 1) + (xcd - r) * q) + off; }
        const int nig = WGM * nN, gid = wgid / nig, fm = gid * WGM, gsz = (nM - fm) < WGM ? (nM - fm) : WGM;
        u.pm = fm + ((wgid % nig) % gsz); u.pn = (wgid % nig) / gsz; return true;
    }
    __device__ __forceinline__ void a_ready(const Unit&) const {}
    __device__ __forceinline__ void done(const Unit&) const {}
};
__device__ __forceinline__ unsigned cvt_pk_bf16(float lo, float hi) { unsigned r; asm volatile("v_cvt_pk_bf16_f32 %0, %1, %2" : "=v"(r) : "v"(lo), "v"(hi)); return r; }
typedef float f32x2 __attribute__((ext_vector_type(2)));
template <class Epi, class Sched, bool ALIGN_EPI = false, bool SP2 = false>
__device__ __forceinline__ void gemm_phase(PG8_LAS unsigned char* lds, const Gemm g, const Sched& S, const Epi& E, const int tid_in) {
    const int tid = tid_in, wid = __builtin_amdgcn_readfirstlane(tid >> 6), lane = tid & 63, wr = wid >> 2, wc = wid & 3, fr = lane & 15, fq = lane >> 4;
    const int K = g.K, nt = K / BK;
    static_assert(!Sched::GATHER || SP2, "the gathered A operand is wired into the SP2 loop only");
    unsigned voffA[2], voffB[2];
#pragma unroll
    for (int i = 0; i < 2; ++i) { int R, C; stage_rc(tid * 16 + i * 8192, R, C); const int Rb = Epi::PERM ? ((R & ~31) + perm32(R & 31)) : R;
        voffA[i] = (unsigned)(R * K + C) * 2u; voffB[i] = (unsigned)(Rb * K + C) * 2u; }
    unsigned gc00 = 0u, gc01 = 0u, gc10 = 0u, gc11 = 0u, gn00 = 0u, gn01 = 0u, gn10 = 0u, gn11 = 0u;
#define PG8_GOFS(d00, d01, d10, d11, uidx) do { int R0_, C0_, R1_, C1_; stage_rc(tid * 16, R0_, C0_); stage_rc(tid * 16 + 8192, R1_, C1_); \
        d00 = ((unsigned)S.grow((uidx), R0_) * (unsigned)K + (unsigned)C0_) * 2u; d01 = ((unsigned)S.grow((uidx), R1_) * (unsigned)K + (unsigned)C1_) * 2u; \
        d10 = ((unsigned)S.grow((uidx), 128 + R0_) * (unsigned)K + (unsigned)C0_) * 2u; d11 = ((unsigned)S.grow((uidx), 128 + R1_) * (unsigned)K + (unsigned)C1_) * 2u; } while (0)
#define PG8_STAGE2(bufoff, gbase, o0, o1) do { \
        __builtin_amdgcn_global_load_lds((const unsigned*)((const char*)(gbase) + (o0)), (PG8_LAS unsigned*)(lds + (bufoff) + ldsw), 16, 0, 0); \
        __builtin_amdgcn_global_load_lds((const unsigned*)((const char*)(gbase) + (o1)), (PG8_LAS unsigned*)(lds + (bufoff) + ldsw + 8192), 16, 0, 0); } while (0)
#define PG8_STAGE_A(bufoff, base, H, NX) do { if constexpr (Sched::GATHER) { const unsigned o0_ = (NX) ? ((H) ? gn10 : gn00) : ((H) ? gc10 : gc00), o1_ = (NX) ? ((H) ? gn11 : gn01) : ((H) ? gc11 : gc01); PG8_STAGE2(bufoff, base, o0_, o1_); } \
        else { PG8_STAGE(bufoff, (base) + (H) * hstep, voffA); } } while (0)
    const size_t kstep = (size_t)(BK * 2);
    const size_t hstep = (size_t)HALF * K * 2;
    const size_t tstep = 2 * hstep;
    const unsigned ldsw = (unsigned)wid * 1024u;
    const int aoff = lds_byte(wr * 64 + fr, fq * 8), boff = lds_byte(wc * 32 + fr, fq * 8);
#define PG8_SA(b, h) (((b) * 2 + (h)) * HTB)
#define PG8_SB(b, h) ((4 + (b) * 2 + (h)) * HTB)
#define PG8_STAGE(bufoff, gbase, voff) do { _Pragma("unroll") for (int _i = 0; _i < 2; ++_i) \
        __builtin_amdgcn_global_load_lds((const unsigned*)((const char*)(gbase) + (voff)[_i]), (PG8_LAS unsigned*)(lds + (bufoff) + ldsw + _i * 8192), 16, 0, 0); } while (0)
#define PG8_LDA(dst, b, h) do { _Pragma("unroll") for (int m = 0; m < 4; ++m) _Pragma("unroll") for (int k = 0; k < 2; ++k) dst[m][k] = *(const PG8_LAS bf16x8*)(lds + PG8_SA(b, h) + aoff + m * 2048 + k * 1024); } while (0)
#define PG8_LDB(dst, b, h) do { _Pragma("unroll") for (int n = 0; n < 2; ++n) _Pragma("unroll") for (int k = 0; k < 2; ++k) dst[n][k] = *(const PG8_LAS bf16x8*)(lds + PG8_SB(b, h) + boff + n * 2048 + k * 1024); } while (0)
#define PG8_MMA(ai, bj, At, Bt) do { __builtin_amdgcn_s_setprio(1); _Pragma("unroll") for (int m = 0; m < 4; ++m) _Pragma("unroll") for (int n = 0; n < 2; ++n) _Pragma("unroll") for (int k = 0; k < 2; ++k) \
        acc[ai][bj][m][n] = __builtin_amdgcn_mfma_f32_16x16x32_bf16(Bt[n][k], At[m][k], acc[ai][bj][m][n], 0, 0, 0); __builtin_amdgcn_s_setprio(0); } while (0)
#define PG8_WAIT_V(n) asm volatile("s_waitcnt vmcnt(" #n ")" ::: "memory")
#define PG8_WAIT_L(n) asm volatile("s_waitcnt lgkmcnt(" #n ")" ::: "memory")
#define PG8_BAR __builtin_amdgcn_s_barrier()
#define PG8_SCHED __builtin_amdgcn_sched_barrier(0)
    Unit cur, nxt; int ui = 0;
    if (!S.next(0, cur)) return;
    f32x4 acc[2][2][4][2];
#pragma unroll
    for (int a = 0; a < 2; ++a)
#pragma unroll
        for (int b = 0; b < 2; ++b)
#pragma unroll
            for (int m = 0; m < 4; ++m)
#pragma unroll
                for (int n = 0; n < 2; ++n) acc[a][b][m][n] = (f32x4){0.f, 0.f, 0.f, 0.f};
    bf16x8 At[4][2], B0[2][2], B1[2][2];
    const char* cA = (const char*)g.A + (Sched::GATHER ? (size_t)0 : (size_t)cur.pm * tstep); const char* cB = (const char*)g.Bt + (size_t)cur.pn * tstep;
    if constexpr (Sched::GATHER) PG8_GOFS(gc00, gc01, gc10, gc11, 0);
    S.a_ready(cur);
    if constexpr (SP2) {
        PG8_STAGE(PG8_SB(0, 0), cB, voffB); PG8_STAGE(PG8_SB(0, 1), cB + hstep, voffB); PG8_STAGE_A(PG8_SA(0, 0), cA, 0, false); PG8_STAGE_A(PG8_SA(0, 1), cA, 1, false);
        if (wr == 1) PG8_BAR;
        PG8_WAIT_V(2); PG8_BAR;
        PG8_STAGE(PG8_SB(1, 0), cB + kstep, voffB); PG8_STAGE_A(PG8_SA(1, 0), cA + kstep, 0, false); PG8_STAGE(PG8_SB(1, 1), cB + hstep + kstep, voffB);
        PG8_WAIT_V(6); PG8_BAR;
    } else {
        PG8_STAGE(PG8_SB(0, 0), cB, voffB); PG8_STAGE(PG8_SA(0, 0), cA, voffA); PG8_STAGE(PG8_SB(0, 1), cB + hstep, voffB); PG8_STAGE(PG8_SA(0, 1), cA + hstep, voffA);
        if (wr == 1) PG8_BAR;
        PG8_WAIT_V(4); PG8_BAR;
        PG8_STAGE(PG8_SB(1, 0), cB + kstep, voffB); PG8_STAGE(PG8_SA(1, 0), cA + kstep, voffA); PG8_STAGE(PG8_SB(1, 1), cB + hstep + kstep, voffB);
        PG8_WAIT_V(6); PG8_BAR;
    }
    for (;;) {
        const bool has_next = S.next(ui + 1, nxt);
        const char* nA = (has_next && !Sched::GATHER) ? (const char*)g.A + (size_t)nxt.pm * tstep : cA; const char* nB = has_next ? (const char*)g.Bt + (size_t)nxt.pn * tstep : cB;
        if constexpr (Sched::GATHER) { if (has_next) PG8_GOFS(gn00, gn01, gn10, gn11, ui + 1); else { gn00 = gc00; gn01 = gc01; gn10 = gc10; gn11 = gc11; } }
        for (int t = 0; t < nt; t += 2) {
            const bool last = (t == nt - 2);
            const char* a1 = cA + (size_t)(t + 1) * kstep;
            const char* a2 = last ? nA : cA + (size_t)(t + 2) * kstep; const char* b2 = last ? nB : cB + (size_t)(t + 2) * kstep;
            const char* a3 = a2 + kstep; const char* b3 = b2 + kstep;
            if (last && has_next) S.a_ready(nxt);
            if constexpr (SP2) {
            PG8_LDB(B0, 0, 0); PG8_LDB(B1, 0, 1); PG8_SCHED; PG8_LDA(At, 0, 0); PG8_STAGE_A(PG8_SA(1, 1), a1, 1, false);
            PG8_WAIT_V(8); PG8_WAIT_L(0); PG8_BAR; PG8_MMA(0, 0, At, B0); PG8_MMA(0, 1, At, B1); PG8_BAR; PG8_SCHED;
            PG8_LDA(At, 0, 1); PG8_STAGE(PG8_SB(0, 0), b2, voffB); PG8_STAGE(PG8_SB(0, 1), b2 + hstep, voffB); PG8_STAGE_A(PG8_SA(0, 0), a2, 0, last);
            PG8_WAIT_V(8); PG8_WAIT_L(0); PG8_BAR; PG8_MMA(1, 0, At, B0); PG8_MMA(1, 1, At, B1); PG8_BAR; PG8_SCHED;
            PG8_LDB(B0, 1, 0); PG8_LDB(B1, 1, 1); PG8_SCHED; PG8_LDA(At, 1, 0); PG8_STAGE_A(PG8_SA(0, 1), a2, 1, last);
            PG8_WAIT_V(8); PG8_WAIT_L(0); PG8_BAR; PG8_MMA(0, 0, At, B0); PG8_MMA(0, 1, At, B1); PG8_BAR; PG8_SCHED;
            PG8_LDA(At, 1, 1); PG8_STAGE(PG8_SB(1, 0), b3, voffB); PG8_STAGE(PG8_SB(1, 1), b3 + hstep, voffB); PG8_STAGE_A(PG8_SA(1, 0), a3, 0, last);
            PG8_WAIT_V(8); PG8_WAIT_L(0); PG8_BAR; PG8_MMA(1, 0, At, B0); PG8_MMA(1, 1, At, B1); PG8_BAR; PG8_SCHED;
            } else {
            PG8_LDB(B0, 0, 0); PG8_SCHED; PG8_LDA(At, 0, 0); PG8_STAGE(PG8_SA(1, 1), a1 + hstep, voffA);
            PG8_WAIT_L(8); PG8_BAR; PG8_WAIT_L(0); PG8_MMA(0, 0, At, B0); PG8_BAR; PG8_SCHED;
            PG8_LDB(B1, 0, 1); PG8_STAGE(PG8_SB(0, 0), b2, voffB);
            PG8_BAR; PG8_WAIT_L(0); PG8_MMA(0, 1, At, B1); PG8_BAR;
            PG8_LDA(At, 0, 1); PG8_STAGE(PG8_SA(0, 0), a2, voffA);
            PG8_BAR; PG8_WAIT_L(0); PG8_MMA(1, 0, At, B0); PG8_BAR; PG8_SCHED;
            PG8_STAGE(PG8_SB(0, 1), b2 + hstep, voffB);
            PG8_WAIT_V(6); PG8_BAR; PG8_MMA(1, 1, At, B1); PG8_BAR;
            PG8_LDB(B0, 1, 0); PG8_SCHED; PG8_LDA(At, 1, 0); PG8_STAGE(PG8_SA(0, 1), a2 + hstep, voffA);
            PG8_WAIT_L(8); PG8_BAR; PG8_WAIT_L(0); PG8_MMA(0, 0, At, B0); PG8_BAR; PG8_SCHED;
            PG8_LDB(B1, 1, 1); PG8_STAGE(PG8_SB(1, 0), b3, voffB);
            PG8_BAR; PG8_WAIT_L(0); PG8_MMA(0, 1, At, B1); PG8_BAR;
            PG8_LDA(At, 1, 1); PG8_STAGE(PG8_SA(1, 0), a3, voffA);
            PG8_BAR; PG8_WAIT_L(0); PG8_MMA(1, 0, At, B0); PG8_BAR; PG8_SCHED;
            PG8_STAGE(PG8_SB(1, 1), b3 + hstep, voffB);
            PG8_WAIT_V(6); PG8_BAR; PG8_MMA(1, 1, At, B1); PG8_BAR;
            }
        }
        if constexpr (ALIGN_EPI) { if (wr == 0) PG8_BAR; }
        if constexpr (!Epi::AFTER_DRAIN) { E(acc, cur, wr, wc, fr, fq); S.done(cur); }
        if (!has_next) break;
#pragma unroll
        for (int a = 0; a < 2; ++a)
#pragma unroll
            for (int b = 0; b < 2; ++b)
#pragma unroll
                for (int m = 0; m < 4; ++m)
#pragma unroll
                    for (int n = 0; n < 2; ++n) acc[a][b][m][n] = (f32x4){0.f, 0.f, 0.f, 0.f};
        cur = nxt; cA = nA; cB = nB; ++ui;
        if constexpr (Sched::GATHER) { gc00 = gn00; gc01 = gn01; gc10 = gn10; gc11 = gn11; }
        if constexpr (ALIGN_EPI) { if (wr == 1) PG8_BAR; }
    }
    PG8_WAIT_V(0);
    if constexpr (!ALIGN_EPI) { if (wr == 0) PG8_BAR; }
    PG8_BAR;
    if constexpr (Epi::AFTER_DRAIN) { E.fused(acc, cur, wr, wc, fr, fq, lds, wid, lane); S.done(cur); }
#undef PG8_SA
#undef PG8_SB
#undef PG8_STAGE
#undef PG8_LDA
#undef PG8_LDB
#undef PG8_MMA
#undef PG8_WAIT_V
#undef PG8_WAIT_L
#undef PG8_BAR
#undef PG8_SCHED
#undef PG8_GOFS
#undef PG8_STAGE_A
#undef PG8_STAGE2
}
}
#define XB_TMO      128
#define XB_XCNT(j)  (256  + 64 * (j))
#define XB_XSUB(j)  (1280 + 64 * (j))
#define XB_XGEN(j)  (2304 + 64 * (j))
#define XB_TOP      3328
#define XB_TOPGEN   3392
#define XCD_BAR_WORDS 3456
#define XB_SPIN_CAP (1u << 22)

__device__ __forceinline__ unsigned xb_ld(unsigned* p)              { return __hip_atomic_load(p, __ATOMIC_RELAXED, __HIP_MEMORY_SCOPE_AGENT); }
__device__ __forceinline__ unsigned xb_add(unsigned* p, unsigned v) { return __hip_atomic_fetch_add(p, v, __ATOMIC_RELAXED, __HIP_MEMORY_SCOPE_AGENT); }
__device__ __forceinline__ unsigned xb_xcc_id() { return (unsigned)__builtin_amdgcn_s_getreg((3 << 11) | 20) & 0xFu; }
#define XB_SPIN(cond, bar) do { unsigned _sp = 0; while (cond) { __builtin_amdgcn_s_sleep(1); \
    if ((++_sp & 255u) == 0u) { if (xb_ld(&(bar)[XB_TMO])) break; if (_sp > XB_SPIN_CAP) { atomicAdd(&(bar)[XB_TMO], 1u); break; } } } } while (0)

struct XcdBarrier {
    unsigned* bar; unsigned x;
    volatile LAS unsigned* st;
};

__device__ __forceinline__ XcdBarrier xcd_barrier_post(unsigned* bar, volatile LAS unsigned* st) {
    XcdBarrier b; b.bar = bar; b.x = xb_xcc_id(); b.st = st;
    if (threadIdx.x == 0) (void)xb_add(&bar[XB_XCNT(b.x)], 1u);
    return b;
}
__device__ __forceinline__ void xcd_barrier_complete(unsigned* bar, unsigned x, unsigned& nloc, unsigned& nx) {
    const unsigned G = gridDim.x * gridDim.y * gridDim.z;
    unsigned sum, cnt, mine, sp = 0u;
    for (;;) {
        sum = 0u; cnt = 0u; mine = 0u;
#pragma unroll
        for (unsigned j = 0; j < 16; ++j) { const unsigned c = xb_ld(&bar[XB_XCNT(j)]); sum += c; cnt += (c > 0u) ? 1u : 0u; mine = (j == x) ? c : mine; }
        if (sum == G) break;
        __builtin_amdgcn_s_sleep(1);
        if ((++sp & 255u) == 0u) { if (xb_ld(&bar[XB_TMO])) break; if (sp > XB_SPIN_CAP) { atomicAdd(&bar[XB_TMO], 1u); break; } }
    }
    nloc = mine > 0u ? mine : 1u; nx = cnt > 0u ? cnt : 1u;
}

__device__ __forceinline__ void xcd_barrier(const XcdBarrier& b) {
    asm volatile("s_waitcnt vmcnt(0)" ::: "memory");
    __syncthreads();
    if (threadIdx.x == 0) {
        unsigned* bar = b.bar;
        __builtin_amdgcn_s_waitcnt(0);
        unsigned nloc = b.st[0], nx = b.st[1];
        if (nloc == 0u) { xcd_barrier_complete(bar, b.x, nloc, nx); b.st[0] = nloc; b.st[1] = nx; }
        const unsigned old = xb_add(&bar[XB_XSUB(b.x)], 1u);
        const unsigned gen = old / nloc;
        if (old + 1u == (gen + 1u) * nloc) {
            __builtin_amdgcn_fence(__ATOMIC_RELEASE, "agent");
            asm volatile("s_waitcnt vmcnt(0)" ::: "memory");
            const unsigned og = xb_add(&bar[XB_TOP], 1u);
            const unsigned tg = og / nx;
            if (og + 1u == (tg + 1u) * nx) xb_add(&bar[XB_TOPGEN], 1u);
            else XB_SPIN(xb_ld(&bar[XB_TOPGEN]) == tg, bar);
            __builtin_amdgcn_fence(__ATOMIC_ACQUIRE, "agent");
            xb_add(&bar[XB_XGEN(b.x)], 1u);
            asm volatile("s_waitcnt vmcnt(0)" ::: "memory");
        } else {
            XB_SPIN(xb_ld(&bar[XB_XGEN(b.x)]) == gen, bar);
            __builtin_amdgcn_fence(__ATOMIC_ACQUIRE, "agent");
            asm volatile("s_waitcnt vmcnt(0)" ::: "memory");
        }
    }
    __syncthreads();
}
#else
#define UNI(x) (x)
#define CBAR()
namespace pg8 { typedef float f32x4 __attribute__((ext_vector_type(4))); struct Unit { int pm, pn; }; struct Gemm { const unsigned short* A; const unsigned short* Bt; int M, N, K; }; }
#endif

__host__ __device__ __forceinline__ int scan_row(int b, int dir, int st) {
    return st < CTX ? NLAT + b * CTX + (dir == 0 ? st : CTX - 1 - st) : b * SEQ + (dir == 0 ? st - CTX : SEQ - 1 - (st - CTX));
}
__host__ __device__ __forceinline__ void expert_tile_base(const int* cnt, int* tb) { int a = 0; for (int e = 0; e < NE; ++e) { tb[e] = a; const int nt = (cnt[e * CNTS] + 255) / 256; for (int t = 0; t < nt; ++t) tb[NE + 1 + a + t] = e; a += nt; } tb[NE] = a; }
constexpr int TB_WORDS = NE + 1 + MAXROWS / 256;
struct DenseOrder {
    static constexpr bool GATHER = false;
    __device__ __forceinline__ int grow(int, int) const { return 0; }
    int nM, nN, nwg, G, c;
    __host__ __device__ void init(int M, int N, int G_, int c_) { nM = M / 256; nN = N / 256; nwg = nM * nN; G = G_; c = c_; }
    __host__ __device__ __forceinline__ bool next(int i, pg8::Unit& u) const {
        const long L = (long)i * G + c; if (L >= nwg) return false;
        int wgid = (int)L; { const int q = nwg / 8, r = nwg % 8, xcd = wgid % 8, off = wgid / 8; wgid = (xcd < r ? xcd * (q + 1) : r * (q + 1) + (xcd - r) * q) + off; }
        const int nig = 8 * nN, gid = wgid / nig, fm = gid * 8, gsz = (nM - fm) < 8 ? (nM - fm) : 8;
        u.pm = fm + ((wgid % nig) % gsz); u.pn = (wgid % nig) / gsz; return true;
    }
    __device__ __forceinline__ void a_ready(const pg8::Unit&) const {}
    __device__ __forceinline__ void done(const pg8::Unit&) const {}
};
template <class TB> struct MoeOrder {
    static constexpr bool GATHER = false;
    __device__ __forceinline__ int grow(int, int) const { return 0; }
    TB tb; int nN, G, c; int wgm = 8; int rev = 0;
    __host__ __device__ __forceinline__ bool next(int i, pg8::Unit& u) const {
        const int nRT = tb[NE], nwg = nRT * nN;
        const long L = (long)i * G + c; if (L >= nwg) return false;
        int wgid = (int)L; { const int q = nwg / 8, r = nwg % 8, xcd = wgid % 8, off = wgid / 8; wgid = (xcd < r ? xcd * (q + 1) : r * (q + 1) + (xcd - r) * q) + off; }
        if (rev) wgid = nwg - 1 - wgid;
        const int nig = wgm * nN, gid = wgid / nig, fm = gid * wgm, gsz = (nRT - fm) < wgm ? (nRT - fm) : wgm;
        const int rt = fm + ((wgid % nig) % gsz), ln = (wgid % nig) / gsz;
        const int e = tb[NE + 1 + rt];
#ifndef CPU_TEST
        u.pm = __builtin_amdgcn_readfirstlane(rt); u.pn = __builtin_amdgcn_readfirstlane(e * nN + ln);
#else
        u.pm = rt; u.pn = e * nN + ln;
#endif
        return true;
    }
    __device__ __forceinline__ void a_ready(const pg8::Unit&) const {}
    __device__ __forceinline__ void done(const pg8::Unit&) const {}
};
template <class TB, class GT> struct MoeOrderG : MoeOrder<TB> {
    static constexpr bool GATHER = true;
    GT gtab; const int* rowtok;
    __host__ __device__ MoeOrderG(TB tb_, int nN_, int G_, int c_, GT gt_, const int* rt_) { this->tb = tb_; this->nN = nN_; this->G = G_; this->c = c_; this->wgm = 8; gtab = gt_; rowtok = rt_; }
    __device__ __forceinline__ int grow(int ui, int r) const { return (int)gtab[ui * 256 + r]; }
};
#ifdef CPU_TEST
static inline unsigned cvt_pk_bf16(float lo, float hi) { return pk2(lo, hi); }
#else
using pg8::cvt_pk_bf16;
#endif
typedef pg8::f32x4 accq;
struct EpiU {
    static constexpr bool PERM = true, AFTER_DRAIN = false;
    bf16_t* C; int ldc;
    __device__ __forceinline__ void operator()(const accq (&acc)[2][2][4][2], const pg8::Unit& u, int wr, int wc, int fr, int fq) const {
        const int row0 = u.pm * 256 + wr * 64 + fr, col0 = u.pn * 256 + wc * 32 + 8 * fq;
#pragma unroll
        for (int ai = 0; ai < 2; ++ai)
#pragma unroll
            for (int m = 0; m < 4; ++m) { bf16_t* rowp = C + (size_t)(row0 + ai * 128 + m * 16) * ldc + col0;
#pragma unroll
                for (int bj = 0; bj < 2; ++bj) { const accq v0 = acc[ai][bj][m][0], v1 = acc[ai][bj][m][1];
                    u32x4 w; w.x = cvt_pk_bf16(v0[0], v0[1]); w.y = cvt_pk_bf16(v0[2], v0[3]); w.z = cvt_pk_bf16(v1[0], v1[1]); w.w = cvt_pk_bf16(v1[2], v1[3]);
                    *(u32x4*)(rowp + bj * 128) = w; } }
    }
};
struct EpiResid {
    static constexpr bool PERM = false, AFTER_DRAIN = false;
    float* X; const float* modl; float* SSP;
    __device__ __forceinline__ void operator()(const accq (&acc)[2][2][4][2], const pg8::Unit& u, int wr, int wc, int fr, int fq) const {
        const int row0 = u.pm * 256 + wr * 64 + fr, col0 = u.pn * 256 + wc * 32 + 4 * fq;
#pragma unroll
        for (int ai = 0; ai < 2; ++ai)
#pragma unroll
            for (int m = 0; m < 4; ++m) { const int row = row0 + ai * 128 + m * 16; float* rowp = X + (size_t)row * D + col0; const float* gp = modl + (size_t)mod_row(row) * 6 * D + 2 * D + col0;
                float ss = 0.f;
#pragma unroll
                for (int bj = 0; bj < 2; ++bj)
#pragma unroll
                    for (int n = 0; n < 2; ++n) { const accq gv = *(const accq*)(gp + bj * 128 + n * 16); accq xv = *(accq*)(rowp + bj * 128 + n * 16); xv = xv + gv * acc[ai][bj][m][n]; *(accq*)(rowp + bj * 128 + n * 16) = xv;
                        ss += (xv[0] * xv[0] + xv[1] * xv[1]) + (xv[2] * xv[2] + xv[3] * xv[3]); }
                SSP[(size_t)row * 64 + (u.pn * 4 + wc) * 4 + fq] = ss; }
    }
};
struct EpiSwiglu {
    static constexpr bool PERM = true, AFTER_DRAIN = false;
    bf16_t* ACT; const float* bgu;
    __device__ __forceinline__ void operator()(const accq (&acc)[2][2][4][2], const pg8::Unit& u, int wr, int wc, int fr, int fq) const {
        constexpr int nN = 2 * D / 256;
        const int e = u.pn / nN, ln = u.pn % nN;
        const int row0 = u.pm * 256 + wr * 64 + fr, cl = 128 * ln + wc * 32 + 8 * fq;
        const float* bg = bgu + (size_t)e * 2 * D + cl;
        accq bgl[2], bli[2];
#pragma unroll
        for (int n = 0; n < 2; ++n) { bgl[n] = *(const accq*)(bg + 4 * n); bli[n] = *(const accq*)(bg + D + 4 * n); }
#pragma unroll
        for (int ai = 0; ai < 2; ++ai)
#pragma unroll
            for (int m = 0; m < 4; ++m) {
                float a[8];
#pragma unroll
                for (int n = 0; n < 2; ++n)
#pragma unroll
                    for (int j = 0; j < 4; ++j) {
                        float glu = acc[ai][0][m][n][j] + bgl[n][j], lin = acc[ai][1][m][n][j] + bli[n][j];
                        glu = fminf(glu, 7.0f); lin = fminf(fmaxf(lin, -7.0f), 7.0f);
                        a[4 * n + j] = glu * FRCP(1.0f + __expf(-1.702f * glu)) * (lin + 1.0f);
                    }
                u32x4 w; w.x = cvt_pk_bf16(a[0], a[1]); w.y = cvt_pk_bf16(a[2], a[3]); w.z = cvt_pk_bf16(a[4], a[5]); w.w = cvt_pk_bf16(a[6], a[7]);
                *(u32x4*)(ACT + (size_t)(row0 + ai * 128 + m * 16) * D + cl) = w;
            }
    }
};
struct EpiDown {
    static constexpr bool PERM = true, AFTER_DRAIN = false;
    bf16_t* YB; const float* bdn;
    __device__ __forceinline__ void operator()(const accq (&acc)[2][2][4][2], const pg8::Unit& u, int wr, int wc, int fr, int fq) const {
        constexpr int nN = D / 256;
        const int e = u.pn / nN, ln = u.pn % nN;
        const int row0 = u.pm * 256 + wr * 64 + fr, col0 = ln * 256 + wc * 32 + 8 * fq;
        const float* bp = bdn + (size_t)e * D + col0;
        accq bv[2][2];
#pragma unroll
        for (int bj = 0; bj < 2; ++bj)
#pragma unroll
            for (int n = 0; n < 2; ++n) bv[bj][n] = *(const accq*)(bp + bj * 128 + 4 * n);
#pragma unroll
        for (int ai = 0; ai < 2; ++ai)
#pragma unroll
            for (int m = 0; m < 4; ++m) { bf16_t* rowp = YB + (size_t)(row0 + ai * 128 + m * 16) * D + col0;
#pragma unroll
                for (int bj = 0; bj < 2; ++bj) { const accq v0 = acc[ai][bj][m][0] + bv[bj][0], v1 = acc[ai][bj][m][1] + bv[bj][1];
                    u32x4 w; w.x = cvt_pk_bf16(v0[0], v0[1]); w.y = cvt_pk_bf16(v0[2], v0[3]); w.z = cvt_pk_bf16(v1[0], v1[1]); w.w = cvt_pk_bf16(v1[2], v1[3]);
                    *(u32x4*)(rowp + bj * 128) = w; } }
    }
};
__host__ __device__ __forceinline__ int gu_row_of_col(int n) { return n < D ? 256 * (n / 128) + n % 128 : 256 * ((n - D) / 128) + 128 + (n - D) % 128; }

#ifndef CPU_TEST
__device__ __forceinline__ int lane_now() { int l; asm volatile("v_mbcnt_lo_u32_b32 %0, -1, 0\n\tv_mbcnt_hi_u32_b32 %0, -1, %0" : "=v"(l)); return l; }
#define SHFL_XOR_F(v, m) __builtin_bit_cast(float, __builtin_amdgcn_ds_bpermute((lane_now() ^ (m)) << 2, __builtin_bit_cast(int, (float)(v))))
template <int CTRL> __device__ __forceinline__ float dppf(float v) { return __builtin_bit_cast(float, __builtin_amdgcn_update_dpp(0, __builtin_bit_cast(int, v), CTRL, 0xF, 0xF, true)); }
#define RED1(v) dppf<0xB1>(v)
#define RED2(v) dppf<0x4E>(v)
#define RED4(v) dppf<0x141>(v)
#define RED8(v) dppf<0x140>(v)
#define RFL(x) __builtin_amdgcn_readfirstlane(x)
#define WAVE_SYNC() __builtin_amdgcn_wave_barrier()
#else
#define SHFL_XOR_F(v, m) shfl_xor_f((v), (m))
#define RED1(v) shfl_xor_f((v), 1)
#define RED2(v) shfl_xor_f((v), 2)
#define RED4(v) shfl_xor_f((v), 4)
#define RED8(v) shfl_xor_f((v), 8)
#define RFL(x) rfl_i(x)
#define LAS
#define WAVE_SYNC() simt::wave_sync()
#endif
__device__ __forceinline__ float wave_sum(float v) {
    v += RED1(v); v += RED2(v); v += RED4(v); v += RED8(v); v += SHFL_XOR_F(v, 16); v += SHFL_XOR_F(v, 32);
    return v;
}
static_assert(D % 256 == 0, "row layout: lane l holds float4 j at element 4l + 256j");
constexpr int RJ = D / 256;
__device__ __forceinline__ float row_rms(const f32x4 (&v)[RJ]) {
    float s = 0.f;
#pragma unroll
    for (int j = 0; j < RJ; ++j) s += (v[j][0] * v[j][0] + v[j][1] * v[j][1]) + (v[j][2] * v[j][2] + v[j][3] * v[j][3]);
    return 1.0f / sqrtf(wave_sum(s) * (1.0f / D) + EPS);
}
__device__ __forceinline__ void row_modulate_store(f32x4 (&v)[RJ], float r, const float* g, const float* shift, const float* scale, bf16_t* o, int lane) {
#pragma unroll
    for (int j = 0; j < RJ; ++j) {
        const int e0 = 4 * lane + 256 * j;
        const f32x4 gv = *(const f32x4*)(g + e0), sh = *(const f32x4*)(shift + e0), sc = *(const f32x4*)(scale + e0);
        v[j] = (v[j] * r * gv) * (sc + 1.0f) + sh;
        unsigned lo = pk2(v[j][0], v[j][1]), hi = pk2(v[j][2], v[j][3]);
        *(unsigned long long*)(o + e0) = (unsigned long long)lo | ((unsigned long long)hi << 32);
    }
}
__device__ __forceinline__ void ph_xinit_w(const Ctx& c, int gw, int ngw, int lane) {
    for (int row = gw; row < NTOK; row += ngw) {
        const float* src = row < NLAT ? c.in[I_X] + (size_t)row * D : c.in[I_CTX] + (size_t)(row - NLAT) * D;
        float* dst = c.x() + (size_t)row * D;
#pragma unroll
        for (int j = 0; j < RJ; ++j) *(f32x4*)(dst + 4 * lane + 256 * j) = *(const f32x4*)(src + 4 * lane + 256 * j);
    }
}
__device__ __forceinline__ void ph_norm1_w(const Ctx& c, int l, int gw, int ngw, int lane) {
    for (int row = gw; row < NTOK; row += ngw) {
        const float* xr = row < NLAT ? c.in[I_X] + (size_t)row * D : c.in[I_CTX] + (size_t)(row - NLAT) * D;
        float* dst = c.x() + (size_t)row * D;
        f32x4 v[RJ];
#pragma unroll
        for (int j = 0; j < RJ; ++j) { v[j] = *(const f32x4*)(xr + 4 * lane + 256 * j); *(f32x4*)(dst + 4 * lane + 256 * j) = v[j]; }
        const float r = row_rms(v);
        const float* m = c.mod(l, mod_row(row));
        row_modulate_store(v, r, c.in[I_N1G] + l * D, m, m + D, c.h() + (size_t)row * D, lane);
    }
}
__device__ __forceinline__ void ph_finish_w(const Ctx& c, int l, int nrows, int gw, int ngw, int lane) {
    const bf16_t* U = c.u();
    const bf16_t* OD = c.odir();
    for (int grp = gw; grp < nrows / 4; grp += ngw) {
        const int row0 = 4 * grp;
        int base, pos, len; seg_of(row0, base, pos, len);
        const int is_lat = row0 < NLAT ? 1 : 0, b = is_lat ? row0 / SEQ : (row0 - NLAT) / CTX;
        const int unit = lane >> 3, sub = lane & 7, hd = unit & 3, col0 = unit * 128 + sub * 16;
        const int hc = sub * 16;
        unsigned long long graw[4][4];
#pragma unroll
        for (int j = 0; j < 4; ++j) { const bf16_t* ur = U + (size_t)(row0 + j) * INP; const bf16_t* gate = unit < 4 ? ur + U_GG + unit * 128 + hc : ur + U_MO + (unit - 4) * 128 + hc;
#pragma unroll
            for (int q = 0; q < 4; ++q) graw[j][q] = *(const unsigned long long*)(gate + 4 * q); }
        float o[4][16];
#pragma unroll
        for (int d = 0; d < 2; ++d) {
            const int q = d == 0 ? pos : len - 1 - pos, n = chunk_of(is_lat, q), qi = q % 64;
            const bf16_t* fp = OD + (unit < 4 ? OF_G : OF_M) + ((((size_t)((b * 4 + hd) * 2 + d) * NCH + n) * 4 + qi / 16) * 8 + sub) * 256 + ((qi % 16) / 4) * 64;
#pragma unroll
            for (int e = 0; e < 16; ++e) { const f32x4 v = ldb4(fp + e * 4);
#pragma unroll
                for (int j = 0; j < 4; ++j) o[j][e] = d == 0 ? v[j] : o[j][e] + v[3 - j]; }
        }
        const float* gw_ = unit < 4 ? c.in[I_GNG] + l * 128 + hc : c.in[I_MNG] + l * 512 + (unit - 4) * 128 + hc;
        f32x4 gv[4];
#pragma unroll
        for (int q = 0; q < 4; ++q) gv[q] = *(const f32x4*)(gw_ + 4 * q);
#pragma unroll
        for (int j = 0; j < 4; ++j) {
            float ss = 0.f;
#pragma unroll
            for (int e = 0; e < 16; ++e) ss += o[j][e] * o[j][e];
            ss += RED1(ss); ss += RED2(ss); ss += RED4(ss);
            const float r = 1.0f / sqrtf(ss * (1.0f / 128.f) + EPS);
            unsigned w[8];
#pragma unroll
            for (int q = 0; q < 4; ++q) { const f32x4 ga = cvtb4(graw[j][q]); float t[4];
#pragma unroll
                for (int e = 0; e < 4; ++e) t[e] = o[j][4 * q + e] * r * gv[q][e] * (unit < 4 ? siluf_(ga[e]) : sigmoidf_(ga[e]));
                w[2 * q] = pk2(t[0], t[1]); w[2 * q + 1] = pk2(t[2], t[3]); }
            bf16_t* yr = c.y() + (size_t)(row0 + j) * MIXW + col0;
            *(u32x4*)yr = (u32x4){w[0], w[1], w[2], w[3]}; *(u32x4*)(yr + 8) = (u32x4){w[4], w[5], w[6], w[7]};
            CBAR();
        }
    }
    for (int grp = gw; grp < nrows / 4; grp += ngw) {
        const int srow0 = 4 * grp;
        int base, spos, len; seg_of(srow0, base, spos, len);
        const int is_lat = srow0 < NLAT ? 1 : 0, b = is_lat ? srow0 / SEQ : (srow0 - NLAT) / CTX;
        const int ch0 = 8 * lane, hd = ch0 / 64, wc = (ch0 % 64) / 16, cc0 = ch0 % 16;
        const float dsk = c.in[I_2D][l * 8 + hd];
        unsigned long long xraw[4][2], zraw[4][2];
#pragma unroll
        for (int j = 0; j < 4; ++j) { const int srow = srow0 + j, row = tokrow_of_srow(srow); const bf16_t* xr = c.xbc() + (size_t)srow * 512 + ch0; const bf16_t* ur = U + (size_t)row * INP + U_Z + ch0;
#pragma unroll
            for (int q = 0; q < 2; ++q) { xraw[j][q] = *(const unsigned long long*)(xr + 4 * q); zraw[j][q] = *(const unsigned long long*)(ur + 4 * q); } }
        float acc[4][8];
#pragma unroll
        for (int d = 0; d < 2; ++d) {
            const int q = d == 0 ? spos : len - 1 - spos, n = chunk_of(is_lat, q), qi = q % 64;
            const bf16_t* fp = OD + OF_S + ((((size_t)((b * 8 + hd) * 2 + d) * NCH + n) * 4 + qi / 16) * 4 + wc) * 256 + ((qi % 16) / 4) * 64 + cc0 * 4;
#pragma unroll
            for (int e = 0; e < 8; ++e) { const f32x4 v = ldb4(fp + e * 4);
#pragma unroll
                for (int j = 0; j < 4; ++j) acc[j][e] = d == 0 ? v[j] : acc[j][e] + v[3 - j]; }
        }
        const float* ng = c.in[I_2NG] + l * 512 + ch0;
        const f32x4 g0 = *(const f32x4*)ng, g1 = *(const f32x4*)(ng + 4);
#pragma unroll
        for (int j = 0; j < 4; ++j) {
            const int srow = srow0 + j, row = tokrow_of_srow(srow);
            float yv[8]; float ss = 0.f;
#pragma unroll
            for (int q = 0; q < 2; ++q) { const f32x4 xs = cvtb4(xraw[j][q]), z = cvtb4(zraw[j][q]);
#pragma unroll
                for (int e = 0; e < 4; ++e) { const float t = (acc[j][4 * q + e] + dsk * xs[e]) * siluf_(z[e]); yv[4 * q + e] = t; ss += t * t; } }
            ss += RED1(ss); ss += RED2(ss); ss += RED4(ss); ss += RED8(ss); ss += SHFL_XOR_F(ss, 16);
            const float r = 1.0f / sqrtf(ss * (1.0f / 256.f) + EPS);
            *(u32x4*)(c.y() + (size_t)row * MIXW + 1024 + ch0) = (u32x4){pk2(yv[0] * r * g0[0], yv[1] * r * g0[1]), pk2(yv[2] * r * g0[2], yv[3] * r * g0[3]), pk2(yv[4] * r * g1[0], yv[5] * r * g1[1]), pk2(yv[6] * r * g1[2], yv[7] * r * g1[3])};
            CBAR();
        }
    }
}
constexpr int ROUTE_R = 4, ROUTE_LDS = (ROUTE_R * D + ROUTE_R * NE) * 4;
__device__ __forceinline__ void ph_route_w(const Ctx& c, int l, int nrows, LAS float* wlds, int gw, int ngw, int lane, bool dummy = false) {
    LAS float* hv = wlds; LAS float* lgs = wlds + ROUTE_R * D;
    const float* rw = c.in[I_RW] + (size_t)l * D * NE;
    for (int r0 = gw * ROUTE_R; r0 < nrows; r0 += ngw * ROUTE_R) {
#pragma unroll
        for (int q = 0; q < ROUTE_R; ++q) {
            const int row = r0 + q;
            const float* xr = c.x() + (size_t)row * D;
            f32x4 v[RJ];
#pragma unroll
            for (int j = 0; j < RJ; ++j) v[j] = *(const f32x4*)(xr + 4 * lane + 256 * j);
            const float r = row_rms(v);
            const float* m = c.mod(l, mod_row(row));
            row_modulate_store(v, r, c.in[I_N2G] + l * D, m + 3 * D, m + 4 * D, c.h() + (size_t)row * D, lane);
#pragma unroll
            for (int j = 0; j < RJ; ++j) *(LAS f32x4*)(hv + q * D + 4 * lane + 256 * j) = v[j];
        }
        WAVE_SYNC();
        const int e = lane & 31, kh = lane >> 5;
        float acc[ROUTE_R];
#pragma unroll
        for (int q = 0; q < ROUTE_R; ++q) acc[q] = 0.f;
        for (int k = kh * (D / 2); k < (kh + 1) * (D / 2); k += 4) {
            const float w0 = rw[(size_t)(k + 0) * NE + e], w1 = rw[(size_t)(k + 1) * NE + e], w2 = rw[(size_t)(k + 2) * NE + e], w3 = rw[(size_t)(k + 3) * NE + e];
#pragma unroll
            for (int q = 0; q < ROUTE_R; ++q) { const f32x4 hq = *(const LAS f32x4*)(hv + q * D + k); acc[q] += (hq[0] * w0 + hq[1] * w1) + (hq[2] * w2 + hq[3] * w3); }
        }
#pragma unroll
        for (int q = 0; q < ROUTE_R; ++q) { acc[q] += SHFL_XOR_F(acc[q], 32); if (kh == 0) lgs[q * NE + e] = acc[q] + c.in[I_RB][l * NE + e]; }
        WAVE_SYNC();
        if (lane < ROUTE_R) {
            const int row = r0 + lane;
            float lg[NE];
#pragma unroll
            for (int i = 0; i < NE; ++i) lg[i] = lgs[lane * NE + i];
            int te[TOPK]; float tv[TOPK];
#pragma unroll
            for (int kk = 0; kk < TOPK; ++kk) {
                int best = -1; float bv = 0.f;
#pragma unroll
                for (int i = 0; i < NE; ++i) {
                    bool taken = false;
#pragma unroll
                    for (int j = 0; j < kk; ++j) taken = taken || (te[j] == i);
                    if (!taken && (best < 0 || lg[i] > bv)) { best = i; bv = lg[i]; }
                }
                te[kk] = best; tv[kk] = bv;
            }
            float se = 0.f, ex[TOPK];
#pragma unroll
            for (int kk = 0; kk < TOPK; ++kk) { ex[kk] = expf(tv[kk] - tv[0]); se += ex[kk]; }
#pragma unroll
            for (int kk = 0; kk < TOPK; ++kk) {
                c.tope()[row * TOPK + kk] = te[kk];
                c.topg()[row * TOPK + kk] = ex[kk] / se;
                c.pos()[row * TOPK + kk] = atomicAdd(c.cnt(l) + (dummy ? DEPTH * NE * CNTS : 0) + te[kk] * CNTS, 1);
            }
        }
        WAVE_SYNC();
    }
}
template <class TB> __device__ __forceinline__ void ph_rowtok_w(const Ctx& c, int l, int nrows, TB tb, int gt, int gs) {
    for (int it = gt; it < nrows * TOPK; it += gs) {
        const int d = tb[c.tope()[it]] * 256 + c.pos()[it];
        c.dest()[it] = d; c.rtok()[d] = it / TOPK;
    }
    const int* cn = c.cnt(l);
    for (int it = gt; it < NE * 256; it += gs) {
        const int e = it / 256, p = it % 256, n = cn[e * CNTS], nt = (n + 255) / 256;
        if (nt > 0 && (nt - 1) * 256 + p >= n) c.rtok()[tb[e] * 256 + (nt - 1) * 256 + p] = 0;
    }
}
template <int NR> __device__ __forceinline__ void comb_rows(const Ctx& c, int l, const int (&rows)[NR], int lane, bool dummy) {
    typedef int i32x4 __attribute__((ext_vector_type(4)));
    const bool last = (l == DEPTH - 1);
    i32x4 dd[NR]; f32x4 gk[NR];
#pragma unroll
    for (int a = 0; a < NR; ++a) { dd[a] = *(const i32x4*)(c.dest() + rows[a] * TOPK); gk[a] = *(const f32x4*)(c.topg() + rows[a] * TOPK); }
    f32x4 v[NR][RJ];
#pragma unroll
    for (int a = 0; a < NR; ++a) {
        const float* xr = c.x() + (size_t)rows[a] * D;
        const float* m = c.mod(l, mod_row(rows[a])) + 5 * D;
        const bf16_t* y0 = c.yb() + (size_t)dd[a][0] * D; const bf16_t* y1 = c.yb() + (size_t)dd[a][1] * D; const bf16_t* y2 = c.yb() + (size_t)dd[a][2] * D; const bf16_t* y3 = c.yb() + (size_t)dd[a][3] * D;
#pragma unroll
        for (int j = 0; j < RJ; ++j) { const int e0 = 4 * lane + 256 * j;
            const f32x4 s = (ldb4(y0 + e0) * gk[a][0] + ldb4(y1 + e0) * gk[a][1]) + (ldb4(y2 + e0) * gk[a][2] + ldb4(y3 + e0) * gk[a][3]);
            v[a][j] = *(const f32x4*)(xr + e0) + *(const f32x4*)(m + e0) * s; }
    }
    f32x4 ng[RJ];
    { const float* gp = last ? c.in[I_FNG] : c.in[I_N1G] + (l + 1) * D;
#pragma unroll
      for (int j = 0; j < RJ; ++j) ng[j] = *(const f32x4*)(gp + 4 * lane + 256 * j); }
#pragma unroll
    for (int a = 0; a < NR; ++a) {
        const int row = rows[a];
        f32x4 nsh[RJ], nsc[RJ];
        { const float* mn = c.mod(last ? l : l + 1, mod_row(row));
#pragma unroll
          for (int j = 0; j < RJ; ++j) { nsh[j] = *(const f32x4*)(mn + 4 * lane + 256 * j); nsc[j] = *(const f32x4*)(mn + D + 4 * lane + 256 * j); } }
        const float r = row_rms(v[a]);
        if (last) {
#pragma unroll
            for (int j = 0; j < RJ; ++j) { const int e0 = 4 * lane + 256 * j; *(f32x4*)(c.out + (size_t)row * D + e0) = v[a][j] * r * ng[j]; }
        } else {
            float* xr = c.x() + (size_t)row * D;
#pragma unroll
            for (int j = 0; j < RJ; ++j) *(f32x4*)((dummy ? c.od2() + (size_t)row * D : xr) + 4 * lane + 256 * j) = v[a][j];
            bf16_t* ho = c.h() + (size_t)row * D;
#pragma unroll
            for (int j = 0; j < RJ; ++j) { const f32x4 t = (v[a][j] * r * ng[j]) * (nsc[j] + 1.0f) + nsh[j];
                const unsigned lo = pk2(t[0], t[1]), hi = pk2(t[2], t[3]);
                *(unsigned long long*)(ho + 4 * lane + 256 * j) = (unsigned long long)lo | ((unsigned long long)hi << 32); }
        }
    }
}
__device__ __forceinline__ void ph_combine_w(const Ctx& c, int l, int nrows, int gw, int ngw, int lane, bool dummy = false) {
    int row = gw;
    for (; row + 2 * ngw < nrows; row += 3 * ngw) { const int rows[3] = {row, row + ngw, row + 2 * ngw}; comb_rows<3>(c, l, rows, lane, dummy); }
    if (row + ngw < nrows) { const int rows[2] = {row, row + ngw}; comb_rows<2>(c, l, rows, lane, dummy); }
    else if (row < nrows) { const int rows[1] = {row}; comb_rows<1>(c, l, rows, lane, dummy); }
}
__device__ __forceinline__ void ph_mod_w(const Ctx& c, LAS float* tab, int tid, int blk, int G) {
    LAS float* part = tab + (NB + 1) * D;
    for (int i = tid; i < (NB + 1) * D; i += 512) { const int r = i / D, k = i % D; tab[i] = siluf_(r < NB ? c.in[I_C][r * D + k] : c.in[I_CCTX][k]); }
    __syncthreads();
    const int lane = tid & 63, w = tid >> 6;
    for (int cbk = blk; cbk < DEPTH * 6 * D / 64; cbk += G) {
        const int l = cbk / (6 * D / 64), col = (cbk % (6 * D / 64)) * 64 + lane;
        const float* wp = c.in[I_WMOD] + (size_t)l * D * 6 * D + col + (size_t)(w * (D / 8)) * 6 * D;
        float acc[NB + 1];
#pragma unroll
        for (int r = 0; r <= NB; ++r) acc[r] = 0.f;
        for (int k0 = 0; k0 < D / 8; k0 += 16) { float wv[16];
#pragma unroll
            for (int e = 0; e < 16; ++e) wv[e] = wp[(size_t)(k0 + e) * 6 * D];
#pragma unroll
            for (int e = 0; e < 16; ++e)
#pragma unroll
                for (int r = 0; r <= NB; ++r) acc[r] += tab[r * D + w * (D / 8) + k0 + e] * wv[e]; }
#pragma unroll
        for (int r = 0; r <= NB; ++r) part[(w * (NB + 1) + r) * 64 + lane] = acc[r];
        __syncthreads();
        for (int i = tid; i < (NB + 1) * 64; i += 512) { const int r = i / 64, cc = i % 64; float s = 0.f;
#pragma unroll
            for (int ww = 0; ww < 8; ++ww) s += part[(ww * (NB + 1) + r) * 64 + cc];
            const int colo = (cbk % (6 * D / 64)) * 64 + cc;
            c.mod(l, r)[colo] = s + c.in[I_BMOD][l * 6 * D + colo]; }
        __syncthreads();
    }
}
__host__ __device__ __forceinline__ void ph_foldgate(const Ctx& c, int gt, int gs) {
    for (int it = gt; it < DEPTH * (D / 8) * 512; it += gs) {
        const int col = it % 512, k0 = ((it / 512) % (D / 8)) * 8, l = it / (512 * (D / 8)), d = col / 256, cc = col % 256;
        const float* w2 = c.in[I_GW2] + ((size_t)(l * 2 + d) * 16) * 256 + cc;
        float w2r[16];
#pragma unroll
        for (int r = 0; r < 16; ++r) w2r[r] = w2[r * 256];
        float a[8];
#pragma unroll
        for (int e = 0; e < 8; ++e) { const float* wi = c.in[I_WIN] + ((size_t)l * D + k0 + e) * INW + U_GLR + 16 * d; float s = 0.f;
#pragma unroll
            for (int q = 0; q < 4; ++q) { const f32x4 t = *(const f32x4*)(wi + 4 * q); s += t[0] * w2r[4 * q] + t[1] * w2r[4 * q + 1] + t[2] * w2r[4 * q + 2] + t[3] * w2r[4 * q + 3]; }
            a[e] = s; }
        *(u32x4*)(c.win(l) + (size_t)(INW + col) * D + k0) = (u32x4){pk2(a[0], a[1]), pk2(a[2], a[3]), pk2(a[4], a[5]), pk2(a[6], a[7])};
    }
}

__host__ __device__ __forceinline__ void ph_rwsplit(const Ctx& c, int gt, int gs) {
    for (int it = gt; it < DEPTH * NE * D; it += gs) {
        const int e = it % NE, k = (it / NE) % D, l = it / (NE * D);
        const float w = c.in[I_RW][((size_t)l * D + k) * NE + e];
        const unsigned hi = f2bf(w); const float lo = w - bf2f((bf16_t)hi);
        bf16_t* T = c.wsb(WS_RWT) + (size_t)l * 2 * NE * D;
        T[(size_t)e * D + k] = (bf16_t)hi; T[(size_t)(NE + e) * D + k] = (bf16_t)f2bf(lo);
    }
}

__host__ __device__ __forceinline__ u32x4 pack8(const float* v) { return (u32x4){pk2(v[0], v[1]), pk2(v[2], v[3]), pk2(v[4], v[5]), pk2(v[6], v[7])}; }

struct SegC { int base, len, q0; };
__host__ __device__ __forceinline__ SegC seg_of_chunk(int b, int n) { SegC s; if (n < CTX / 64) { s.base = NLAT + b * CTX; s.len = CTX; s.q0 = 64 * n; } else { s.base = b * SEQ; s.len = SEQ; s.q0 = 64 * (n - CTX / 64); } return s; }
__host__ __device__ __forceinline__ int seg_row(const SegC& s, int dir, int q) { return s.base + (dir == 0 ? q : s.len - 1 - q); }
__host__ __device__ __forceinline__ float tap_at(const bf16_t* U, const SegC& s, int dir, int q, int ucol, bool colmajor) {
    const bool ok = q >= 0 && q < s.len; const int qc = q < 0 ? 0 : (q >= s.len ? s.len - 1 : q);
    const int r = seg_row(s, dir, qc);
    const float v = bf2f(U[(size_t)(colmajor ? tokrow_of_srow(r) : r) * INP + ucol]);
    return ok ? v : 0.f;
}

#ifndef CPU_TEST
#define MFMA16(a, b, c) __builtin_amdgcn_mfma_f32_16x16x32_bf16((a), (b), (c), 0, 0, 0)
#else
#define MFMA16(a, b, c) mfma16_emul((a), (b), (c))
#endif
#ifndef CPU_TEST
#define LDS_BAR() do { asm volatile("s_waitcnt lgkmcnt(0)" ::: "memory"); __builtin_amdgcn_s_barrier(); asm volatile("" ::: "memory"); } while (0)
#else
#define LDS_BAR() __syncthreads()
#endif
typedef LAS unsigned char* ldsp_t;
typedef unsigned long long u64_t;
__device__ __forceinline__ bf16x8 lds_rd16(ldsp_t p) { return *(const LAS bf16x8*)p; }
__device__ __forceinline__ bf16x8 lds_rd8x2(ldsp_t p0, ldsp_t p1) { const u64_t a = *(const LAS u64_t*)p0, b = *(const LAS u64_t*)p1; u32x4 v = {(unsigned)a, (unsigned)(a >> 32), (unsigned)b, (unsigned)(b >> 32)}; return __builtin_bit_cast(bf16x8, v); }
template <int KIND> struct ChainCfg {
    static constexpr int DK = KIND == 2 ? 128 : 64, DV = KIND == 2 ? 64 : 128, NCW = DV / 16, KSPLIT = 8 / NCW, KS = DK / 32, KT = DK / 16, KSL = KS / KSPLIT, KTL = KT / KSPLIT, NPC = DK / 64;
    static constexpr int RS_T = DK * 2 + 16, RS_F = 144, OFF_KB = 64 * RS_T, OFF_KDT = 128 * RS_T, OFF_SC = OFF_KDT + DK * RS_F, BUFSZ = OFF_SC + 1024;
    static constexpr int OFF_P = 2 * BUFSZ, OFF_N = OFF_P + 64 * 144, OFF_DEN = OFF_N + 256, OFF_V = OFF_DEN + 1280, RS_V = DV * 2 + 16;
    static constexpr int LDS_NEED = OFF_V + (KIND == 2 ? 4 * 16 * 64 * 4 : 2 * 64 * RS_V);
    static constexpr int SCB = KIND == 0 ? 256 : KIND == 1 ? 1024 : 512;
    static_assert(LDS_NEED <= 139264, "chain LDS");
};
#ifndef CPU_TEST
#define LDS_ADDF(p, v) (void)__hip_atomic_fetch_add((p), (v), __ATOMIC_RELAXED, __HIP_MEMORY_SCOPE_WORKGROUP)
#else
#define LDS_ADDF(p, v) (*(p) += (v))
#endif
template <int KIND> __device__ __forceinline__ void chain_run(const Ctx& c, ldsp_t lds, int cid, int tid, bool noload = false, bool nostore = false) {
    typedef ChainCfg<KIND> CF;
    constexpr int DK = CF::DK, DV = CF::DV, NCW = CF::NCW, KS = CF::KS, KSL = CF::KSL, KTL = CF::KTL, NPC = CF::NPC, RS_T = CF::RS_T, RS_F = CF::RS_F;
    const int lane = tid & 63, w = RFL(tid >> 6), cc = lane & 15, g = lane >> 4;
    const int wc = w % NCW, kh = w / NCW;
    const bool outw = kh == 0;
    const int dir = cid % 2, hh = KIND == 2 ? (cid / 2) % 8 : (cid / 2) % 4, b = KIND == 2 ? cid / 16 : cid / 8;
    constexpr bool SHQ = KIND != 0, SHD = KIND == 2;
    const bool mir = dir == 1;
    const size_t opc = KIND == 2 ? (size_t)((b * 2 + hh / 4) * 2 + (SHQ ? 0 : dir)) * NCH : (size_t)(SHQ ? cid - dir : cid) * NCH;
    const size_t opd = KIND == 2 ? opc : (size_t)cid * NCH;
    const size_t vpc = (size_t)cid * NCH;
    const bf16_t* gQA = c.wsb(KIND == 0 ? WS_GQA : KIND == 1 ? WS_MQA : WS_SQA) + opc * (64 * DK);
    const bf16_t* gKB = c.wsb(KIND == 0 ? WS_GKB : KIND == 1 ? WS_MKB : WS_SKB) + opc * (64 * DK);
    const bf16_t* gKDT = c.wsb(KIND == 0 ? WS_GKDT : KIND == 1 ? WS_MKDT : WS_SKDT) + opd * (64 * DK);
    const bf16_t* gVT = c.wsb(WS_SVT) + vpc * (64 * DV);
    const bf16_t* gU = c.u() + (KIND == 0 ? U_GV : U_MV) + hh * 128;
    const bf16_t* gVHT = c.wsb(WS_SVHT) + vpc * (64 * DV);
    const unsigned char* gSC = (const unsigned char*)(KIND == 0 ? c.wsf(WS_GAL) + vpc * 64 : KIND == 1 ? c.wsf(WS_MMS) + vpc * 256 : c.wsf(WS_SCS) + vpc * 128);
    bf16_t* Og = c.odir() + (KIND == 0 ? OF_G : KIND == 1 ? OF_M : OF_S) + (size_t)cid * NCH * (4 * NCW * 256) + (wc * 64 + lane) * 4;
    LAS float* DEN = (LAS float*)(lds + CF::OFF_DEN);
    LAS float* XR = (LAS float*)(lds + CF::OFF_V);

    f32x4 S[KTL];
#pragma unroll
    for (int kt = 0; kt < KTL; ++kt) S[kt] = (f32x4){0.f, 0.f, 0.f, 0.f};
    float m0 = -1e30f;
    if (KIND == 1 && tid < 64) ((LAS float*)(lds + CF::OFF_N))[tid] = 0.f;

    u32x4 sq[NPC], sk[NPC], sd[NPC], ssc = {0u, 0u, 0u, 0u}, sv[2]; bf16x8 vf[2], vh[2], vfn[2], vhn[2];
#define CHAIN_LOAD(n_) do { const size_t cb_ = (size_t)(n_); const int nm_ = (int)cb_ < CTX / 64 ? CTX / 64 - 1 - (int)cb_ : CTX / 64 + NCH - 1 - (int)cb_; const size_t cq_ = (SHQ && mir) ? (size_t)nm_ : cb_, cd_ = (SHD && mir) ? (size_t)nm_ : cb_; \
        _Pragma("unroll") for (int q = 0; q < NPC; ++q) { const int p = tid + 512 * q; sq[q] = *(const u32x4*)(gQA + cq_ * (64 * DK) + p * 8); sk[q] = *(const u32x4*)(gKB + cq_ * (64 * DK) + p * 8); if (KIND == 1) sd[q] = *(const u32x4*)(gKDT + cd_ * (64 * DK) + p * 8); } \
        if (tid < CF::SCB / 16) ssc = *(const u32x4*)(gSC + cb_ * CF::SCB + tid * 16); \
        if (KIND == 2) { _Pragma("unroll") for (int s = 0; s < 2; ++s) { if (outw) vfn[s] = *(const bf16x8*)(gVT + cb_ * (64 * DV) + (16 * wc + cc) * 64 + 32 * s + 8 * g); vhn[s] = *(const bf16x8*)(gVHT + cb_ * (64 * DV) + (16 * wc + cc) * 64 + 32 * s + 8 * g); } } \
        else { _Pragma("unroll") for (int q = 0; q < 2; ++q) { const int p = tid + 512 * q; sv[q] = *(const u32x4*)(gU + (size_t)scan_row(b, dir, 64 * (int)cb_ + p / 16) * INP + (p % 16) * 8); } } } while (0)
#define CHAIN_STAGE(buf_) do { ldsp_t d_ = lds + (buf_) * CF::BUFSZ; \
        _Pragma("unroll") for (int q = 0; q < NPC; ++q) { const int p = tid + 512 * q; const int rt0 = p / (DK / 8), ct = p % (DK / 8), rt = (SHQ && mir) ? 63 - rt0 : rt0; *(LAS u32x4*)(d_ + rt * RS_T + ct * 16) = sq[q]; *(LAS u32x4*)(d_ + CF::OFF_KB + rt * RS_T + ct * 16) = sk[q]; \
            if (KIND == 1) *(LAS u32x4*)(d_ + CF::OFF_KDT + (p / 8) * RS_F + (p % 8) * 16) = sd[q]; } \
        if (tid < CF::SCB / 16) *(LAS u32x4*)(d_ + CF::OFF_SC + tid * 16) = ssc; \
        if (KIND == 2) { vf[0] = vfn[0]; vf[1] = vfn[1]; vh[0] = vhn[0]; vh[1] = vhn[1]; } \
        else { _Pragma("unroll") for (int q = 0; q < 2; ++q) { const int p = tid + 512 * q; *(LAS u32x4*)(lds + CF::OFF_V + (buf_) * (64 * CF::RS_V) + (p / 16) * CF::RS_V + (p % 16) * 16) = sv[q]; } } } while (0)
    CHAIN_LOAD(0); CHAIN_STAGE(0);
    LDS_BAR();

    for (int n = 0; n < NCH; ++n) {
        ldsp_t cur = lds + (n & 1) * CF::BUFSZ;
        const LAS float* SC = (const LAS float*)(cur + CF::OFF_SC);
        if (n + 1 < NCH && !noload) CHAIN_LOAD(n + 1);
#pragma unroll
        for (int tt = 0; tt < 2; ++tt) {
            const int t = 2 * w + tt, jt = t >> 2, it = t & 3;
            f32x4 acc = {0.f, 0.f, 0.f, 0.f};
#pragma unroll
            for (int s = 0; s < KS; ++s) acc = MFMA16(lds_rd16(cur + CF::OFF_KB + (16 * jt + cc) * RS_T + (32 * s + 8 * g) * 2), lds_rd16(cur + (16 * it + cc) * RS_T + (32 * s + 8 * g) * 2), acc);
            const int i = 16 * it + cc, j0 = 16 * jt + 4 * g;
            float pi = 0.f;
            if (KIND == 1) pi = fmaxf(m0, SC[i * 4 + 2]);
            if (KIND == 2) pi = SC[i * 2];
            float pv[4];
#pragma unroll
            for (int r = 0; r < 4; ++r) { const int j = j0 + r; float d = 1.f;
                if (KIND == 1) d = __expf(SC[j * 4 + 1] - pi);
                if (KIND == 2) d = __expf(pi - SC[j * 2]);
                pv[r] = j <= i ? acc[r] * d : 0.f; }
            const unsigned p01 = pk2(pv[0], pv[1]), p23 = pk2(pv[2], pv[3]);
            *(LAS u64_t*)(lds + CF::OFF_P + i * 144 + j0 * 2) = (u64_t)p01 | ((u64_t)p23 << 32);
            if (KIND == 1) {
                float unp[4]; { unsigned t0 = p01 << 16, t1 = p01 & 0xffff0000u, t2 = p23 << 16, t3 = p23 & 0xffff0000u; __builtin_memcpy(&unp[0], &t0, 4); __builtin_memcpy(&unp[1], &t1, 4); __builtin_memcpy(&unp[2], &t2, 4); __builtin_memcpy(&unp[3], &t3, 4); }
                float rs_ = (unp[0] + unp[1]) + (unp[2] + unp[3]);
                rs_ += SHFL_XOR_F(rs_, 16); rs_ += SHFL_XOR_F(rs_, 32);
                if (g == 0) DEN[jt * 64 + i] = jt <= it ? rs_ : 0.f;
            }
        }
        f32x4 ai[4], ap[4];
        {
            bf16x8 sf[KSL];
#pragma unroll
            for (int s = 0; s < KSL; ++s) { u32x4 v = {pk2(S[2 * s][0], S[2 * s][1]), pk2(S[2 * s][2], S[2 * s][3]), pk2(S[2 * s + 1][0], S[2 * s + 1][1]), pk2(S[2 * s + 1][2], S[2 * s + 1][3])}; sf[s] = __builtin_bit_cast(bf16x8, v); }
#pragma unroll
            for (int it = 0; it < 4; ++it) {
                ai[it] = (f32x4){0.f, 0.f, 0.f, 0.f};
#pragma unroll
                for (int s = 0; s < KSL; ++s) { ldsp_t qa = cur + (16 * it + cc) * RS_T + (32 * (kh * KSL + s) + 4 * g) * 2; ai[it] = MFMA16(lds_rd8x2(qa, qa + 32), sf[s], ai[it]); }
            }
            if (KIND == 2 && !outw) {
#pragma unroll
                for (int it = 0; it < 4; ++it) *(LAS f32x4*)(XR + ((wc * 4 + it) * 64 + lane) * 4) = ai[it];
            }
        }
        if (KIND == 1) {
            const int row = tid >> 3, part = tid & 7;
            const bf16x8 qr = lds_rd16(cur + row * RS_T + part * 16);
            const LAS float* n0 = (const LAS float*)(lds + CF::OFF_N) + part * 8;
            float sqn = 0.f;
#pragma unroll
            for (int e = 0; e < 8; ++e) sqn += bf2f((bf16_t)qr[e]) * n0[e];
            sqn += RED1(sqn); sqn += RED2(sqn); sqn += RED4(sqn);
            if (part == 0) DEN[4 * 64 + row] = __expf(m0 - fmaxf(m0, SC[row * 4 + 2])) * sqn;
        }
        LDS_BAR();
        float c0 = 1.f, c1 = 1.f;
        if (KIND == 1) { const float rL = SC[63 * 4 + 2], ML = fmaxf(m0, rL); c0 = __expf(m0 - ML); c1 = __expf(rL - ML); }
        if (KIND == 2) c0 = __expf(SC[63 * 2]);
        if (KIND == 1) {
            const int krow = tid >> 3, part = tid & 7;
            const bf16x8 kr = lds_rd16(cur + CF::OFF_KDT + krow * RS_F + part * 16);
            float s = 0.f;
#pragma unroll
            for (int e = 0; e < 8; ++e) s += bf2f((bf16_t)kr[e]);
            s += RED1(s); s += RED2(s); s += RED4(s);
            if (part == 0) { LAS float* np = (LAS float*)(lds + CF::OFF_N) + krow; *np = c0 * *np + c1 * s; }
        }
        if (KIND != 2) {
            const LAS bf16_t* vi = (const LAS bf16_t*)(lds + CF::OFF_V + (n & 1) * (64 * CF::RS_V)) + 16 * wc + cc;
#pragma unroll
            for (int s = 0; s < 2; ++s) { unsigned pkd[4];
#pragma unroll
                for (int e = 0; e < 4; ++e) { const unsigned lo_ = vi[(32 * s + 8 * g + 2 * e) * (CF::RS_V / 2)], hi_ = vi[(32 * s + 8 * g + 2 * e + 1) * (CF::RS_V / 2)]; pkd[e] = lo_ | (hi_ << 16); }
                const u32x4 pv_ = {pkd[0], pkd[1], pkd[2], pkd[3]}; vf[s] = __builtin_bit_cast(bf16x8, pv_); }
        }
        if (outw) {
#pragma unroll
            for (int it = 0; it < 4; ++it) {
                if (KIND == 2) ai[it] = ai[it] + *(const LAS f32x4*)(XR + ((wc * 4 + it) * 64 + lane) * 4);
                ap[it] = KIND == 0 ? ai[it] : (f32x4){0.f, 0.f, 0.f, 0.f};
#pragma unroll
                for (int s = 0; s < 2; ++s) ap[it] = MFMA16(lds_rd16(lds + CF::OFF_P + (16 * it + cc) * 144 + (32 * s + 8 * g) * 2), vf[s], ap[it]);
            }
#pragma unroll
            for (int it = 0; it < 4; ++it) {
                f32x4 ov;
                const int i0 = 16 * it + 4 * g;
                if (KIND == 1) {
                    const f32x4 d0 = *(const LAS f32x4*)(DEN + i0), d1 = *(const LAS f32x4*)(DEN + 64 + i0), d2 = *(const LAS f32x4*)(DEN + 128 + i0), d3 = *(const LAS f32x4*)(DEN + 192 + i0), d4 = *(const LAS f32x4*)(DEN + 256 + i0);
                    const f32x4 den4 = ((d0 + d1) + (d2 + d3)) + d4;
#pragma unroll
                    for (int r = 0; r < 4; ++r) { const f32x4 sc = *(const LAS f32x4*)(SC + (i0 + r) * 4);
                        const float Mi = fmaxf(m0, sc[2]);
                        ov[r] = (ap[it][r] + __expf(m0 - Mi) * ai[it][r]) * FRCP(fmaxf(fabsf(den4[r]), __expf(-sc[0] - Mi))); }
                } else {
#pragma unroll
                    for (int r = 0; r < 4; ++r) { float o = ap[it][r]; if (KIND == 2) o = o + __expf(SC[(i0 + r) * 2]) * ai[it][r]; ov[r] = o; }
                }
                if (!nostore) *(u64_t*)(Og + (size_t)((n * 4 + it) * NCW) * 256) = (u64_t)pk2(ov[0], ov[1]) | ((u64_t)pk2(ov[2], ov[3]) << 32);
            }
        }
#pragma unroll
        for (int kt = 0; kt < KTL; ++kt) {
            const int ktg = kh * KTL + kt;
            if (KIND == 2) S[kt] = S[kt] * c0;
            f32x4 T = KIND == 1 ? (f32x4){0.f, 0.f, 0.f, 0.f} : S[kt];
#pragma unroll
            for (int s = 0; s < 2; ++s) {
                bf16x8 ka;
                if (KIND == 1) ka = lds_rd16(cur + CF::OFF_KDT + (16 * ktg + cc) * RS_F + (32 * s + 8 * g) * 2);
                else {
                    const LAS bf16_t* kb = (const LAS bf16_t*)(cur + CF::OFF_KB) + 16 * ktg + cc; unsigned pk_[4];
#pragma unroll
                    for (int e = 0; e < 4; ++e) { const unsigned lo_ = kb[(32 * s + 8 * g + 2 * e) * (RS_T / 2)], hi_ = kb[(32 * s + 8 * g + 2 * e + 1) * (RS_T / 2)]; pk_[e] = lo_ | (hi_ << 16); }
                    const u32x4 kv_ = {pk_[0], pk_[1], pk_[2], pk_[3]}; ka = __builtin_bit_cast(bf16x8, kv_); }
                T = MFMA16(ka, KIND == 2 ? vh[s] : vf[s], T);
            }
            S[kt] = KIND == 1 ? S[kt] * c0 + T * c1 : T;
            if (KIND == 0) { const f32x4 al = *(const LAS f32x4*)(SC + 16 * ktg + 4 * g); S[kt] = S[kt] * al; }
            if (kt & 1) CBAR();
        }
        if (KIND == 1) m0 = SC[63 * 4] + fmaxf(m0, SC[63 * 4 + 2]);
        if (n + 1 < NCH) CHAIN_STAGE((n + 1) & 1);
        LDS_BAR();
    }
#undef CHAIN_LOAD
#undef CHAIN_STAGE
}
__device__ __forceinline__ void ph_chain(const Ctx& c, ldsp_t lds, int blk, int G, int tid, int kmask = 7) {
    const bool noload = false, nostore = (kmask & 8) != 0;
    (void)G;
    const int ch = blk;
    if (ch < NB * 8) { if (kmask & 1) chain_run<0>(c, lds, ch, tid, noload, nostore); }
    else if (ch < NB * 16) { if (kmask & 2) chain_run<1>(c, lds, ch - NB * 8, tid, noload, nostore); }
    else if (ch < NB * 32) { if (kmask & 4) chain_run<2>(c, lds, ch - NB * 16, tid, noload, nostore); }
}

constexpr int ROUTE_M_LDS = 16 * 33 * 4;
__device__ __forceinline__ void ph_route_m(const Ctx& c, int l, int nrows, LAS float* wl, int gw, int ngw, int lane) {
    const int rr = lane & 15, g = lane >> 4;
    const bf16_t* T = c.wsb(WS_RWT) + (size_t)l * 2 * NE * D;
    for (int tile = gw; tile < nrows / 16; tile += ngw) {
        const int row = 16 * tile + rr;
        const float* xr = c.x() + (size_t)row * D + 8 * g;
        const float* m = c.mod(l, mod_row(16 * tile));
        const float* gp = c.in[I_N2G] + l * D + 8 * g; const float* shp = m + 3 * D + 8 * g; const float* scp = m + 4 * D + 8 * g;
        float ss = 0.f;
        { const float* sp = c.wsf(WS_SSP) + (size_t)row * 64 + 16 * g;
#pragma unroll
          for (int q = 0; q < 16; q += 4) { if (16 * g + q < (D / 256) * 16) { const f32x4 t = *(const f32x4*)(sp + q); ss += (t[0] + t[1]) + (t[2] + t[3]); } } }
        ss += SHFL_XOR_F(ss, 16); ss += SHFL_XOR_F(ss, 32);
        const float r = 1.0f / sqrtf(ss * (1.0f / D) + EPS);
        f32x4 acc0 = {0.f, 0.f, 0.f, 0.f}, acc1 = {0.f, 0.f, 0.f, 0.f};
        bf16_t* hr = c.h() + (size_t)row * D + 8 * g;
        for (int s2 = 0; s2 < D / 32; s2 += 2) {
            f32x4 xv[2][2], gv[2][2], hv[2][2], cv[2][2]; bf16x8 bh[2][2], bl[2][2];
#pragma unroll
            for (int u = 0; u < 2; ++u) { const int s = s2 + u;
                xv[u][0] = *(const f32x4*)(xr + 32 * s); xv[u][1] = *(const f32x4*)(xr + 32 * s + 4); gv[u][0] = *(const f32x4*)(gp + 32 * s); gv[u][1] = *(const f32x4*)(gp + 32 * s + 4);
                hv[u][0] = *(const f32x4*)(shp + 32 * s); hv[u][1] = *(const f32x4*)(shp + 32 * s + 4); cv[u][0] = *(const f32x4*)(scp + 32 * s); cv[u][1] = *(const f32x4*)(scp + 32 * s + 4);
                bh[u][0] = *(const bf16x8*)(T + (size_t)rr * D + 32 * s + 8 * g); bh[u][1] = *(const bf16x8*)(T + (size_t)(16 + rr) * D + 32 * s + 8 * g);
                bl[u][0] = *(const bf16x8*)(T + (size_t)(NE + rr) * D + 32 * s + 8 * g); bl[u][1] = *(const bf16x8*)(T + (size_t)(NE + 16 + rr) * D + 32 * s + 8 * g); }
#pragma unroll
            for (int u = 0; u < 2; ++u) { const int s = s2 + u;
                const f32x4 v0 = (xv[u][0] * r * gv[u][0]) * (cv[u][0] + 1.0f) + hv[u][0], v1 = (xv[u][1] * r * gv[u][1]) * (cv[u][1] + 1.0f) + hv[u][1];
                const u32x4 hi = {pk2(v0[0], v0[1]), pk2(v0[2], v0[3]), pk2(v1[0], v1[1]), pk2(v1[2], v1[3])};
                *(u32x4*)(hr + 32 * s) = hi;
                float lo[8];
#pragma unroll
                for (int e = 0; e < 4; ++e) { const unsigned wv = hi[e]; float fl, fh; unsigned t = wv << 16; __builtin_memcpy(&fl, &t, 4); t = wv & 0xffff0000u; __builtin_memcpy(&fh, &t, 4);
                    lo[2 * e] = (e < 2 ? v0[2 * e] : v1[2 * e - 4]) - fl; lo[2 * e + 1] = (e < 2 ? v0[2 * e + 1] : v1[2 * e - 3]) - fh; }
                const u32x4 lov = {pk2(lo[0], lo[1]), pk2(lo[2], lo[3]), pk2(lo[4], lo[5]), pk2(lo[6], lo[7])};
                const bf16x8 ahi = __builtin_bit_cast(bf16x8, hi), alo = __builtin_bit_cast(bf16x8, lov);
                acc0 = MFMA16(ahi, bh[u][0], acc0); acc0 = MFMA16(alo, bh[u][0], acc0); acc0 = MFMA16(ahi, bl[u][0], acc0);
                acc1 = MFMA16(ahi, bh[u][1], acc1); acc1 = MFMA16(alo, bh[u][1], acc1); acc1 = MFMA16(ahi, bl[u][1], acc1); }
            CBAR();
        }
#pragma unroll
        for (int q = 0; q < 4; ++q) { wl[(4 * g + q) * 33 + rr] = acc0[q] + c.in[I_RB][l * NE + rr]; wl[(4 * g + q) * 33 + 16 + rr] = acc1[q] + c.in[I_RB][l * NE + 16 + rr]; }
        WAVE_SYNC();
        if (lane < 16) {
            const int orow = 16 * tile + lane;
            float lg[NE];
#pragma unroll
            for (int i = 0; i < NE; ++i) lg[i] = wl[lane * 33 + i];
            int te[TOPK]; float tv[TOPK];
#pragma unroll
            for (int kk = 0; kk < TOPK; ++kk) {
                int best = -1; float bv = 0.f;
#pragma unroll
                for (int i = 0; i < NE; ++i) {
                    bool taken = false;
#pragma unroll
                    for (int j = 0; j < kk; ++j) taken = taken || (te[j] == i);
                    if (!taken && (best < 0 || lg[i] > bv)) { best = i; bv = lg[i]; }
                }
                te[kk] = best; tv[kk] = bv;
            }
            float se = 0.f, ex[TOPK];
#pragma unroll
            for (int kk = 0; kk < TOPK; ++kk) { ex[kk] = expf(tv[kk] - tv[0]); se += ex[kk]; }
#pragma unroll
            for (int kk = 0; kk < TOPK; ++kk) {
                c.tope()[orow * TOPK + kk] = te[kk];
                c.topg()[orow * TOPK + kk] = ex[kk] / se;
                c.pos()[orow * TOPK + kk] = atomicAdd(c.cnt(l) + te[kk] * CNTS, 1);
            }
        }
        WAVE_SYNC();
    }
}

constexpr int ROUTE_B_LDS = (8 * 16 * 32 + 16 * 33) * 4;
#ifndef CPU_TEST
__device__ __forceinline__ int lds_fetch_inc(LAS int* p) { return __hip_atomic_fetch_add(p, 1, __ATOMIC_RELAXED, __HIP_MEMORY_SCOPE_WORKGROUP); }
#else
static inline int lds_fetch_inc(int* p) { const int o = *p; *p = o + 1; return o; }
#endif
static_assert(TOPK == 4 && 4640 * 4 >= ROUTE_B_LDS, "route LDS map");
__device__ __forceinline__ void ph_route_b(const Ctx& c, int l, int nrows, LAS float* bl, int blk, int G, int tid, bool dummy = false) {
    constexpr int SPW = D / 256, BATCH = SPW >= 4 ? 4 : (SPW >= 2 ? 2 : 1);
    const int lane = tid & 63, w = RFL(tid >> 6), rr = lane & 15, g = lane >> 4;
    const bf16_t* T = c.wsb(WS_RWT) + (size_t)l * 2 * NE * D;
    LAS float* part = bl; LAS float* lgs = bl + 8 * 16 * 32;
    LAS int* lcnt = (LAS int*)(bl + 4640); LAS int* lbase = lcnt + 32; LAS unsigned* lrec = (LAS unsigned*)(lbase + 32);
    if (tid < 32) lcnt[tid] = 0;
    int nit = 0;
    for (int tile = blk; tile < nrows / 16; tile += G, ++nit) {
        const int row = 16 * tile + rr;
        const float* xr = c.x() + (size_t)row * D + 8 * g;
        const float* m = c.mod(l, mod_row(16 * tile));
        const float* gp = c.in[I_N2G] + l * D + 8 * g; const float* shp = m + 3 * D + 8 * g; const float* scp = m + 4 * D + 8 * g;
        f32x4 sst[4];
        { const float* sp = c.wsf(WS_SSP) + (size_t)row * 64 + 16 * g;
#pragma unroll
          for (int q = 0; q < 4; ++q) { sst[q] = f32x4{0.f, 0.f, 0.f, 0.f}; if (16 * g + 4 * q < (D / 256) * 16) sst[q] = *(const f32x4*)(sp + 4 * q); } }
        float r = 0.f;
        f32x4 acc0 = {0.f, 0.f, 0.f, 0.f}, acc1 = {0.f, 0.f, 0.f, 0.f};
        bf16_t* hr = c.h() + (size_t)row * D + 8 * g;
        for (int s2 = w * SPW; s2 < (w + 1) * SPW; s2 += BATCH) {
            f32x4 xv[BATCH][2], gv[BATCH][2], hv[BATCH][2], cv[BATCH][2]; bf16x8 bh[BATCH][2], bw[BATCH][2];
#pragma unroll
            for (int u = 0; u < BATCH; ++u) { const int s = s2 + u;
                xv[u][0] = *(const f32x4*)(xr + 32 * s); xv[u][1] = *(const f32x4*)(xr + 32 * s + 4); gv[u][0] = *(const f32x4*)(gp + 32 * s); gv[u][1] = *(const f32x4*)(gp + 32 * s + 4);
                hv[u][0] = *(const f32x4*)(shp + 32 * s); hv[u][1] = *(const f32x4*)(shp + 32 * s + 4); cv[u][0] = *(const f32x4*)(scp + 32 * s); cv[u][1] = *(const f32x4*)(scp + 32 * s + 4);
                bh[u][0] = *(const bf16x8*)(T + (size_t)rr * D + 32 * s + 8 * g); bh[u][1] = *(const bf16x8*)(T + (size_t)(16 + rr) * D + 32 * s + 8 * g);
                bw[u][0] = *(const bf16x8*)(T + (size_t)(NE + rr) * D + 32 * s + 8 * g); bw[u][1] = *(const bf16x8*)(T + (size_t)(NE + 16 + rr) * D + 32 * s + 8 * g); }
            if (s2 == w * SPW) {
                float ss = 0.f;
#pragma unroll
                for (int q = 0; q < 4; ++q) { if (16 * g + 4 * q < (D / 256) * 16) ss += (sst[q][0] + sst[q][1]) + (sst[q][2] + sst[q][3]); }
                ss += SHFL_XOR_F(ss, 16); ss += SHFL_XOR_F(ss, 32);
                r = 1.0f / sqrtf(ss * (1.0f / D) + EPS);
            }
#pragma unroll
            for (int u = 0; u < BATCH; ++u) { const int s = s2 + u;
                const f32x4 v0 = (xv[u][0] * r * gv[u][0]) * (cv[u][0] + 1.0f) + hv[u][0], v1 = (xv[u][1] * r * gv[u][1]) * (cv[u][1] + 1.0f) + hv[u][1];
                const u32x4 hi = {pk2(v0[0], v0[1]), pk2(v0[2], v0[3]), pk2(v1[0], v1[1]), pk2(v1[2], v1[3])};
                *(u32x4*)(hr + 32 * s) = hi;
                float lo[8];
#pragma unroll
                for (int e = 0; e < 4; ++e) { const unsigned wv = hi[e]; float fl, fh; unsigned t = wv << 16; __builtin_memcpy(&fl, &t, 4); t = wv & 0xffff0000u; __builtin_memcpy(&fh, &t, 4);
                    lo[2 * e] = (e < 2 ? v0[2 * e] : v1[2 * e - 4]) - fl; lo[2 * e + 1] = (e < 2 ? v0[2 * e + 1] : v1[2 * e - 3]) - fh; }
                const u32x4 lov = {pk2(lo[0], lo[1]), pk2(lo[2], lo[3]), pk2(lo[4], lo[5]), pk2(lo[6], lo[7])};
                const bf16x8 ahi = __builtin_bit_cast(bf16x8, hi), alo = __builtin_bit_cast(bf16x8, lov);
                acc0 = MFMA16(ahi, bh[u][0], acc0); acc0 = MFMA16(alo, bh[u][0], acc0); acc0 = MFMA16(ahi, bw[u][0], acc0);
                acc1 = MFMA16(ahi, bh[u][1], acc1); acc1 = MFMA16(alo, bh[u][1], acc1); acc1 = MFMA16(ahi, bw[u][1], acc1); }
        }
#pragma unroll
        for (int q = 0; q < 4; ++q) { part[(w * 16 + 4 * g + q) * 32 + rr] = acc0[q]; part[(w * 16 + 4 * g + q) * 32 + 16 + rr] = acc1[q]; }
        LDS_BAR();
        { const int prow = tid >> 5, e = tid & 31; float s = c.in[I_RB][l * NE + e];
#pragma unroll
          for (int ww = 0; ww < 8; ++ww) s += part[(ww * 16 + prow) * 32 + e];
          lgs[prow * 33 + e] = s; }
        LDS_BAR();
        if (tid < 16) {
            const int orow = 16 * tile + tid;
            float lg[NE];
#pragma unroll
            for (int i = 0; i < NE; ++i) lg[i] = lgs[tid * 33 + i];
            int te[TOPK]; float tv[TOPK];
#pragma unroll
            for (int kk = 0; kk < TOPK; ++kk) {
                int best = -1; float bv = 0.f;
#pragma unroll
                for (int i = 0; i < NE; ++i) {
                    bool taken = false;
#pragma unroll
                    for (int j = 0; j < kk; ++j) taken = taken || (te[j] == i);
                    if (!taken && (best < 0 || lg[i] > bv)) { best = i; bv = lg[i]; }
                }
                te[kk] = best; tv[kk] = bv;
            }
            float se = 0.f, ex[TOPK];
#pragma unroll
            for (int kk = 0; kk < TOPK; ++kk) { ex[kk] = expf(tv[kk] - tv[0]); se += ex[kk]; }
#pragma unroll
            for (int kk = 0; kk < TOPK; ++kk) {
                c.tope()[orow * TOPK + kk] = te[kk];
                c.topg()[orow * TOPK + kk] = ex[kk] / se;
                lrec[nit * 64 + tid * TOPK + kk] = ((unsigned)te[kk] << 16) | (unsigned)lds_fetch_inc(lcnt + te[kk]);
            }
        }
    }
    LDS_BAR();
    if (tid < 32) { const int n = lcnt[tid]; lbase[tid] = n ? atomicAdd(c.cnt(l) + (dummy ? DEPTH * NE * CNTS : 0) + tid * CNTS, n) : 0; }
    LDS_BAR();
    for (int i = tid; i < nit * 64; i += 512) { const int tile = blk + (i >> 6) * G; const unsigned rec = lrec[i]; c.pos()[64 * tile + (i & 63)] = lbase[rec >> 16] + (int)(rec & 0xffffu); }
}

__host__ __device__ __forceinline__ f32x4 silu4(f32x4 x) { return (f32x4){siluf_(x[0]), siluf_(x[1]), siluf_(x[2]), siluf_(x[3])}; }
__host__ __device__ __forceinline__ f32x4 exp4(f32x4 x) { return (f32x4){FEXP(x[0]), FEXP(x[1]), FEXP(x[2]), FEXP(x[3])}; }
__host__ __device__ __forceinline__ f32x4 logsig4(f32x4 x) { return (f32x4){logsigmoidf_(x[0]), logsigmoidf_(x[1]), logsigmoidf_(x[2]), logsigmoidf_(x[3])}; }
__host__ __device__ __forceinline__ f32x4 min4(f32x4 x, float m) { return (f32x4){fminf(x[0], m), fminf(x[1], m), fminf(x[2], m), fminf(x[3], m)}; }
__host__ __device__ __forceinline__ u64_t pk4(f32x4 v) { return (u64_t)pk2(v[0], v[1]) | ((u64_t)pk2(v[2], v[3]) << 32); }
__host__ __device__ __forceinline__ f32x4 tap4_at(const bf16_t* U, const SegC& s, int dir, int q, int ucol, bool colmajor) {
    const bool ok = q >= 0 && q < s.len; const int qc = q < 0 ? 0 : (q >= s.len ? s.len - 1 : q);
    const int r = seg_row(s, dir, qc);
    const f32x4 v = ldb4(U + (size_t)(colmajor ? tokrow_of_srow(r) : r) * INP + ucol);
    return ok ? v : (f32x4){0.f, 0.f, 0.f, 0.f};
}
__host__ __device__ __forceinline__ void store_t8(bf16_t* base, int t0, const f32x4 (&x)[8]) {
#pragma unroll
    for (int cc = 0; cc < 4; ++cc) *(u32x4*)(base + cc * 64 + t0) = (u32x4){pk2(x[0][cc], x[1][cc]), pk2(x[2][cc], x[3][cc]), pk2(x[4][cc], x[5][cc]), pk2(x[6][cc], x[7][cc])};
}
__host__ __device__ __forceinline__ u64_t tapraw4_at(const bf16_t* U, const SegC& s, int dir, int q, int ucol, bool colmajor) {
    const int qc = q < 0 ? 0 : (q >= s.len ? s.len - 1 : q); const int r = seg_row(s, dir, qc);
    return *(const u64_t*)(U + (size_t)(colmajor ? tokrow_of_srow(r) : r) * INP + ucol);
}
__host__ __device__ __forceinline__ bf16_t tapraw1_at(const bf16_t* U, const SegC& s, int dir, int q, int ucol, bool colmajor) {
    const int qc = q < 0 ? 0 : (q >= s.len ? s.len - 1 : q); const int r = seg_row(s, dir, qc);
    return U[(size_t)(colmajor ? tokrow_of_srow(r) : r) * INP + ucol];
}
__host__ __device__ __forceinline__ f32x4 tapcvt4(u64_t raw, const SegC& s, int q) { return (q >= 0 && q < s.len) ? cvtb4(raw) : (f32x4){0.f, 0.f, 0.f, 0.f}; }
__host__ __device__ __forceinline__ void ph_prep4(const Ctx& c, int l, int gt, int gs, int sel = 31) {
    const bf16_t* U = c.u();
    const int rot = (int)CH_G * 16;
    const int gt1 = gt, gt2 = (gt + gs - rot % gs) % gs, gt3 = (gt + gs - (3 * rot) % gs) % gs, gt4 = (gt + gs - (5 * rot) % gs) % gs;
    if (sel & 1) for (int it = gt1; it < (int)CH_G * 16; it += gs) {
        const int k = 4 * (it % 16), hh = (it / 16) % 4, n = (it / 64) % NCH, dir = (it / (64 * NCH)) % 2, b = it / (128 * NCH), cid = (b * 4 + hh) * 2 + dir;
        const SegC sg = seg_of_chunk(b, n);
        const int row0 = seg_row(sg, dir, sg.q0), rs = dir == 0 ? 1 : -1;
        const f32x4 bg = *(const f32x4*)(c.in[I_GBG] + (l * 2 + dir) * 256 + hh * 64 + k);
        const size_t cb = ((size_t)cid * NCH + n);
        bf16_t* QA = c.wsb(WS_GQA) + cb * 4096 + k; bf16_t* KB = c.wsb(WS_GKB) + cb * 4096 + k; bf16_t* KDT = c.wsb(WS_GKDT) + cb * 4096 + k * 64;
        const bf16_t* uq = U + (size_t)row0 * INP + U_GQ + hh * 64 + k; const bf16_t* uk = U + (size_t)row0 * INP + U_GK + hh * 64 + k; const bf16_t* ug = U + (size_t)row0 * INP + U_GGK + dir * 256 + hh * 64 + k;
        f32x4 crun = {0.f, 0.f, 0.f, 0.f};
        u64_t nq[8], nk[8], ng[8];
#pragma unroll
        for (int e = 0; e < 8; ++e) { nq[e] = *(const u64_t*)(uq + (long)rs * e * INP); nk[e] = *(const u64_t*)(uk + (long)rs * e * INP); ng[e] = *(const u64_t*)(ug + (long)rs * e * INP); }
        for (int i0 = 0; i0 < 64; i0 += 8) { const int nb = i0 + 8 < 64 ? i0 + 8 : i0;
            u64_t cq[8], ck[8], cg[8]; f32x4 kd[8];
#pragma unroll
            for (int e = 0; e < 8; ++e) { cq[e] = nq[e]; ck[e] = nk[e]; cg[e] = ng[e]; }
#pragma unroll
            for (int e = 0; e < 8; ++e) { nq[e] = *(const u64_t*)(uq + (long)rs * (nb + e) * INP); nk[e] = *(const u64_t*)(uk + (long)rs * (nb + e) * INP); ng[e] = *(const u64_t*)(ug + (long)rs * (nb + e) * INP); }
            CBAR();
#pragma unroll
            for (int e = 0; e < 8; ++e) { crun = crun + logsig4(cvtb4(cg[e]) + bg) * (1.0f / 16.0f);
                kd[e] = cvtb4(ck[e]) * exp4(min4(-crun, 60.f));
                *(u64_t*)(QA + (i0 + e) * 64) = pk4(cvtb4(cq[e]) * 0.125f * exp4(crun)); *(u64_t*)(KB + (i0 + e) * 64) = pk4(kd[e]); }
        }
        *(f32x4*)(c.wsf(WS_GAL) + cb * 64 + k) = exp4(crun);
    }
    if (sel & 4) for (int it = gt2; it < (int)CH_G * 32; it += gs) {
        const int k = 4 * (it % 16), hh = (it / 16) % 4, which = (it / 64) % 2, n = (it / 128) % NCH, dir = (it / (128 * NCH)) % 2, b = it / (256 * NCH), cid = (b * 4 + hh) * 2 + dir;
        if (which == 0 && dir == 1) continue;
        const SegC sg = seg_of_chunk(b, n);
        const int row0 = seg_row(sg, dir, sg.q0), rs = dir == 0 ? 1 : -1;
        const float bi = c.in[I_MBI][l * 8 + dir * 4 + hh], bf = c.in[I_MBF][l * 8 + dir * 4 + hh];
        const bf16_t* MG = U + (size_t)row0 * INP + U_MG + dir * 4 + hh;
        const size_t cb = ((size_t)cid * NCH + n);
        float rmaxL = 0.f;
        if (which == 1) {
            float F = 0.f, rmax = -1e30f; float* MS = c.wsf(WS_MMS) + cb * 256;
            for (int i0 = 0; i0 < 64; i0 += 16) { float ig[16], lf[16];
#pragma unroll
                for (int e = 0; e < 16; ++e) { ig[e] = bf2f(MG[(long)rs * (i0 + e) * INP]); lf[e] = bf2f(MG[(long)rs * (i0 + e) * INP + 8]); }
#pragma unroll
                for (int e = 0; e < 16; ++e) { F += logsigmoidf_(lf[e] + bf); const float bjv = ig[e] + bi - F; rmax = fmaxf(rmax, bjv); if (k == 0) *(f32x4*)(MS + (i0 + e) * 4) = (f32x4){F, bjv, rmax, 0.f}; } }
            rmaxL = rmax;
        }
        bf16_t* OT = c.wsb(which == 0 ? WS_MQA : WS_MKB) + cb * 4096 + k; bf16_t* KDT = c.wsb(WS_MKDT) + cb * 4096 + k * 64;
        const int cch = which * 256 + hh * 64 + k;
        f32x4 w[7];
#pragma unroll
        for (int j = 0; j < 7; ++j) w[j] = *(const f32x4*)(c.in[I_MCW] + ((size_t)l * 7 + (dir == 0 ? j : 6 - j)) * 512 + cch);
        const f32x4 bc = *(const f32x4*)(c.in[I_MCB] + l * 512 + cch);
        f32x4 win[14];
#pragma unroll
        for (int t = 0; t < 6; ++t) win[t] = tap4_at(U, sg, dir, sg.q0 + t - 3, U_MQK + cch, false);
        float F = 0.f;
        u64_t nt[8]; bf16_t ni[8], nf[8];
#pragma unroll
        for (int e = 0; e < 8; ++e) { nt[e] = tapraw4_at(U, sg, dir, sg.q0 + e + 3, U_MQK + cch, false); ni[e] = MG[(long)rs * e * INP]; nf[e] = MG[(long)rs * e * INP + 8]; }
        for (int i0 = 0; i0 < 64; i0 += 8) { const int nb = i0 + 8 < 64 ? i0 + 8 : i0; f32x4 kd[8]; float ig[8], lf[8];
#pragma unroll
            for (int e = 0; e < 8; ++e) { win[6 + e] = tapcvt4(nt[e], sg, sg.q0 + i0 + e + 3); ig[e] = bf2f(ni[e]); lf[e] = bf2f(nf[e]); }
#pragma unroll
            for (int e = 0; e < 8; ++e) { nt[e] = tapraw4_at(U, sg, dir, sg.q0 + nb + e + 3, U_MQK + cch, false); ni[e] = MG[(long)rs * (nb + e) * INP]; nf[e] = MG[(long)rs * (nb + e) * INP + 8]; }
            CBAR();
#pragma unroll
            for (int e = 0; e < 8; ++e) { f32x4 a = bc;
#pragma unroll
                for (int j = 0; j < 7; ++j) a = a + w[j] * win[e + j];
                f32x4 v = silu4(a); if (which == 1) v = v * 0.125f;
                F += logsigmoidf_(lf[e] + bf);
                if (dir == 0) *(u64_t*)(OT + (i0 + e) * 64) = pk4(v);
                kd[e] = v * FEXP(ig[e] + bi - F - rmaxL); }
            if (which == 1) store_t8(KDT, i0, kd);
#pragma unroll
            for (int t = 0; t < 6; ++t) win[t] = win[t + 8]; }
    }
    if (sel & 8) for (int it = gt3; it < (int)CH_SG * 32; it += gs) {
        const int s = 4 * (it % 32), g = (it / 32) % 2, which = (it / 64) % 2, n = (it / 128) % NCH, dir = 0, b = it / (128 * NCH), gid = (b * 2 + g) * 2 + dir;
        const SegC sg = seg_of_chunk(b, n);
        const size_t cb = ((size_t)gid * NCH + n);
        bf16_t* OT = c.wsb(which == 0 ? WS_SKB : WS_SQA) + cb * 8192 + s; bf16_t* KDT = c.wsb(WS_SKDT) + cb * 8192 + s * 64;
        const int cch = 512 + which * 256 + g * 128 + s;
        f32x4 w[7];
#pragma unroll
        for (int j = 0; j < 7; ++j) w[j] = *(const f32x4*)(c.in[I_2CW] + ((size_t)l * 7 + (dir == 0 ? j : 6 - j)) * 1024 + cch);
        const f32x4 bc = *(const f32x4*)(c.in[I_2CB] + l * 1024 + cch);
        f32x4 win[14];
#pragma unroll
        for (int t = 0; t < 6; ++t) win[t] = tap4_at(U, sg, dir, sg.q0 + t - 3, U_XBC + cch, true);
        u64_t nt[8];
#pragma unroll
        for (int e = 0; e < 8; ++e) nt[e] = tapraw4_at(U, sg, dir, sg.q0 + e + 3, U_XBC + cch, true);
        for (int i0 = 0; i0 < 64; i0 += 8) { const int nb = i0 + 8 < 64 ? i0 + 8 : i0; f32x4 v[8];
#pragma unroll
            for (int e = 0; e < 8; ++e) win[6 + e] = tapcvt4(nt[e], sg, sg.q0 + i0 + e + 3);
#pragma unroll
            for (int e = 0; e < 8; ++e) nt[e] = tapraw4_at(U, sg, dir, sg.q0 + nb + e + 3, U_XBC + cch, true);
            CBAR();
#pragma unroll
            for (int e = 0; e < 8; ++e) { f32x4 a = bc;
#pragma unroll
                for (int j = 0; j < 7; ++j) a = a + w[j] * win[e + j];
                v[e] = silu4(a); *(u64_t*)(OT + (i0 + e) * 128) = pk4(v[e]); }
#pragma unroll
            for (int t = 0; t < 6; ++t) win[t] = win[t + 8]; }
    }
    if (sel & 16) for (int it = gt4; it < (int)CH_S * 16; it += gs) {
        const int p = 4 * (it % 16), hh = (it / 16) % 8, n = (it / 128) % NCH, dir = (it / (128 * NCH)) % 2, b = it / (256 * NCH), cid = (b * 8 + hh) * 2 + dir;
        const SegC sg = seg_of_chunk(b, n);
        const float Ah = -expf(c.in[I_2AL][l * 16 + dir * 8 + hh]), dtb = c.in[I_2DTB][l * 16 + dir * 8 + hh];
        const int cdt = U_DT + dir * 8 + hh;
        float cumL = 0.f;
        for (int i0 = 0; i0 < 64; i0 += 16) { float t[16];
#pragma unroll
            for (int e = 0; e < 16; ++e) t[e] = tap_at(U, sg, dir, sg.q0 + i0 + e, cdt, true);
#pragma unroll
            for (int e = 0; e < 16; ++e) cumL += softplusf_(t[e] + dtb) * Ah; }
        const size_t cb = ((size_t)cid * NCH + n);
        bf16_t* VT = c.wsb(WS_SVT) + cb * 4096 + p * 64; bf16_t* VHT = c.wsb(WS_SVHT) + cb * 4096 + p * 64; float* CS = c.wsf(WS_SCS) + cb * 128;
        const int cx = hh * 64 + p;
        f32x4 wx[7];
#pragma unroll
        for (int j = 0; j < 7; ++j) wx[j] = *(const f32x4*)(c.in[I_2CW] + ((size_t)l * 7 + (dir == 0 ? j : 6 - j)) * 1024 + cx);
        const f32x4 bx = *(const f32x4*)(c.in[I_2CB] + l * 1024 + cx);
        f32x4 win[14];
#pragma unroll
        for (int t = 0; t < 6; ++t) win[t] = tap4_at(U, sg, dir, sg.q0 + t - 3, U_XBC + cx, true);
        float crun = 0.f;
        u64_t nt[8]; bf16_t nd[8];
#pragma unroll
        for (int e = 0; e < 8; ++e) { nt[e] = tapraw4_at(U, sg, dir, sg.q0 + e + 3, U_XBC + cx, true); nd[e] = tapraw1_at(U, sg, dir, sg.q0 + e, cdt, true); }
        for (int i0 = 0; i0 < 64; i0 += 8) { const int nb = i0 + 8 < 64 ? i0 + 8 : i0; float dv[8]; f32x4 a[8], h[8];
#pragma unroll
            for (int e = 0; e < 8; ++e) { win[6 + e] = tapcvt4(nt[e], sg, sg.q0 + i0 + e + 3); dv[e] = bf2f(nd[e]); }
#pragma unroll
            for (int e = 0; e < 8; ++e) { nt[e] = tapraw4_at(U, sg, dir, sg.q0 + nb + e + 3, U_XBC + cx, true); nd[e] = tapraw1_at(U, sg, dir, sg.q0 + nb + e, cdt, true); }
            CBAR();
#pragma unroll
            for (int e = 0; e < 8; ++e) { f32x4 ax = bx;
#pragma unroll
                for (int j = 0; j < 7; ++j) ax = ax + wx[j] * win[e + j];
                const f32x4 xs = silu4(ax); const float dtv = softplusf_(dv[e] + dtb);
                crun += dtv * Ah; a[e] = xs * dtv; h[e] = a[e] * FEXP(cumL - crun);
                if (dir == 0) *(u64_t*)(c.xbc() + (size_t)seg_row(sg, 0, sg.q0 + i0 + e) * 512 + cx) = pk4(xs);
                if (p == 0) { CS[(i0 + e) * 2] = crun; CS[(i0 + e) * 2 + 1] = dtv; } }
            store_t8(VT, i0, a); store_t8(VHT, i0, h);
#pragma unroll
            for (int t = 0; t < 6; ++t) win[t] = win[t + 8]; }
    }
}

constexpr int NPH = 11, NSTEPS = 1 + DEPTH * NPH;
enum { PH_NORM1 = 0, PH_GIN, PH_PREP, PH_SCAN, PH_FIN, PH_GOUT, PH_ROUTE, PH_SCAT, PH_G1, PH_G2, PH_COMB };
constexpr int IT_IN = (D / 64) * (INW / 32), IT_OUT = (MIXW / 64) * (D / 32), IT_GU = (D / 64) * (2 * D / 32), IT_DN = (D / 64) * (D / 32);

#ifndef CPU_TEST
constexpr int LDS_BYTES = 147456, LDS_CTL = 139264;
#define LDS_WAIT() asm volatile("s_waitcnt lgkmcnt(0)" ::: "memory")
typedef __attribute__((address_space(1))) u32x4 g_u32x4;

struct TItem { const float* W; bf16_t* WT; int K, N, mode, item; };
constexpr int IT_DENSE = IT_IN + IT_OUT, IT_MOE = NE * (IT_GU + IT_DN);
__device__ __forceinline__ TItem titem_of(const Ctx& c, int layer, int it) {
    TItem t;
    if (layer < 0) { const int l = it / IT_DENSE; int r = it % IT_DENSE;
        if (r < IT_IN) { t.W = c.in[I_WIN] + (size_t)l * D * INW; t.K = D; t.N = INW; t.WT = c.win(l); t.mode = 0; t.item = r; return t; } r -= IT_IN;
        t.W = c.in[I_WOUT] + (size_t)l * MIXW * D; t.K = MIXW; t.N = D; t.WT = c.wout(l); t.mode = 0; t.item = r; return t; }
    const int l = layer, e = it / (IT_GU + IT_DN); int r = it % (IT_GU + IT_DN);
    if (r < IT_GU) { t.W = c.in[I_WGU] + ((size_t)l * NE + e) * D * 2 * D; t.K = D; t.N = 2 * D; t.WT = c.wgu(l) + (size_t)e * 2 * D * D; t.mode = 1; t.item = r; }
    else { t.W = c.in[I_WDN] + ((size_t)l * NE + e) * D * D; t.K = D; t.N = D; t.WT = c.wdn(l) + (size_t)e * D * D; t.mode = 0; t.item = r - IT_GU; }
    return t;
}
__device__ __forceinline__ void titem_load(const TItem& t, float (&v)[32], int lane) {
    const int nblk = t.N / 32, kb = t.item / nblk, nb = t.item % nblk;
    const float* src = t.W + (size_t)(64 * kb + (lane >> 5)) * t.N + 32 * nb + (lane & 31);
#pragma unroll
    for (int i = 0; i < 32; ++i) v[i] = __builtin_nontemporal_load(src + (size_t)(2 * i) * t.N);
}
__device__ __forceinline__ void titem_store(const TItem& t, const float (&v)[32], LAS float* scr, int lane) {
    const int nblk = t.N / 32, kb = t.item / nblk, nb = t.item % nblk, k0 = 64 * kb, n0 = 32 * nb;
#pragma unroll
    for (int i = 0; i < 32; ++i) scr[(2 * i + (lane >> 5)) * 33 + (lane & 31)] = v[i];
    LDS_WAIT(); asm volatile("" ::: "memory");
    const int c = lane & 7;
    const int r0 = t.mode ? gu_row_of_col(n0) : n0;
#pragma unroll
    for (int j = 0; j < 4; ++j) { const int n = (lane >> 3) + 8 * j; const LAS float* s = scr + (8 * c) * 33 + n;
        u32x4 o; o.x = pk2(s[0 * 33], s[1 * 33]); o.y = pk2(s[2 * 33], s[3 * 33]); o.z = pk2(s[4 * 33], s[5 * 33]); o.w = pk2(s[6 * 33], s[7 * 33]);
        __builtin_nontemporal_store(o, (u32x4*)(t.WT + (size_t)(r0 + n) * t.K + k0 + 8 * c)); }
    LDS_WAIT(); asm volatile("" ::: "memory");
}
__device__ __forceinline__ void ph_transposes(const Ctx& c, LAS unsigned char* lds, int layer, int gw, int ngw, int wave, int lane) {
    LAS float* scr = (LAS float*)(lds + wave * 16384);
    const int nit = layer < 0 ? DEPTH * IT_DENSE : IT_MOE;
    int it = gw;
    if (it >= nit) return;
    TItem cur = titem_of(c, layer, it); float va[32], vb[32];
    titem_load(cur, va, lane);
    for (;;) {
        const int nx = it + ngw; const bool more = nx < nit;
        TItem nxt = cur;
        if (more) { nxt = titem_of(c, layer, nx); titem_load(nxt, vb, lane); }
        titem_store(cur, va, scr, lane);
        if (!more) break;
#pragma unroll
        for (int i = 0; i < 32; ++i) va[i] = vb[i];
        cur = nxt; it = nx;
    }
}

#define FRESH() Ctx c; { const KAS Args* kp_ = (const KAS Args*)__builtin_amdgcn_kernarg_segment_ptr(); asm volatile("" : "+s"(kp_)); c.in = kp_->in; c.out = kp_->out; c.ws = kp_->ws; } \
    int lane; asm volatile("v_mbcnt_lo_u32_b32 %0, -1, 0\n\tv_mbcnt_hi_u32_b32 %0, -1, %0" : "=v"(lane)); const int wave = wave_s, tid = wave * 64 + lane, gt = blk * 512 + tid, gs = G * 512; (void)gt; (void)gs;
__global__ void __launch_bounds__(512, 2) mega_fwd(Args args) {
    extern __shared__ __attribute__((aligned(16))) unsigned char lds_raw[];
    LAS unsigned char* lds = (LAS unsigned char*)lds_raw;
    const int G = gridDim.x, blk = blockIdx.x;
    const int wave_s = __builtin_amdgcn_readfirstlane((int)threadIdx.x >> 6);
    const int lo = args.lo, hi = args.hi;
    for (int u = threadIdx.x; u < (LDS_BYTES - LDS_CTL) / 4; u += 512) ((LAS unsigned*)(lds + LDS_CTL))[u] = 0u;
    __syncthreads();
    volatile LAS unsigned* xbw = (volatile LAS unsigned*)(lds + LDS_CTL + 1024);
    unsigned* barw = (unsigned*)(args.ws + WS_CTL) + CW_BAR + args.li * XCD_BAR_WORDS;
    XcdBarrier bar; bar.bar = barw; bar.x = 0; bar.st = xbw;
    if (hi - lo > 1) bar = xcd_barrier_post(barw, xbw);
    LAS int* tb = (LAS int*)(lds + LDS_CTL + 2048);
    static_assert(2048 + TB_WORDS * 4 <= 4096 && 4096 + NE * 4 <= LDS_BYTES - LDS_CTL, "LDS control region");
#ifndef PHASE_MASK
#define PHASE_MASK 0xFFFFu
#endif
#define EN(p) (((PHASE_MASK) >> (p)) & 1u)
#ifndef DUP_MASK
#define DUP_MASK 0u
#endif
#define DUP(p) (((DUP_MASK) >> (p)) & 1u)
#define IN(s) (lo <= (s) && (s) < hi)
#define SEAM(s) do { if (IN(s) && IN((s) + 1)) xcd_barrier(bar); } while (0)

    if (EN(12) && IN(0)) {
        FRESH();
        const int psel = (hi == 1) ? args.pad : 15;
        if (psel & 1) ph_transposes(c, lds, -1, blk * 8 + wave, G * 8, wave, lane);
        __syncthreads();
        if (psel & 2) ph_mod_w(c, (LAS float*)lds, tid, blk, G);
        if (psel & 8) { ph_foldgate(c, gt, gs); ph_rwsplit(c, gt, gs); }
    }
    SEAM(0);
    for (int l = 0; l < DEPTH; ++l) {
        const int s0 = 1 + l * NPH;
        const bool last = (l == DEPTH - 1);
        const int nrows = last ? NLAT : NTOK;
        if (l == 0) {
            if (EN(PH_NORM1) && IN(s0 + PH_NORM1)) { FRESH(); ph_norm1_w(c, l, blk * 8 + wave, G * 8, lane); }
            SEAM(s0 + PH_NORM1);
        }
        if (EN(PH_GIN) && IN(s0 + PH_GIN)) {
            FRESH();
            pg8::Gemm g{c.h(), c.win(l), NTOK, INP, D}; DenseOrder S; S.init(NTOK, INP, G, blk);
            EpiU E{c.u(), INP};
            pg8::gemm_phase<EpiU, DenseOrder, true, true>(lds, g, S, E, tid);
            if (DUP(PH_GIN)) pg8::gemm_phase<EpiU, DenseOrder, true, true>(lds, g, S, E, tid);
        }
        SEAM(s0 + PH_GIN);
        if (EN(PH_PREP) && IN(s0 + PH_PREP)) { FRESH(); ph_prep4(c, l, gt, gs, (args.li > 0 && s0 + PH_PREP == lo) ? args.pad : 31); }
        SEAM(s0 + PH_PREP);
        if (EN(PH_SCAN) && IN(s0 + PH_SCAN)) { FRESH(); ph_chain(c, lds, blk, G, tid, (hi == s0 + PH_SCAN + 1 && args.pad >= 64) ? (args.pad & 15) : 7); }
        SEAM(s0 + PH_SCAN);
        if (EN(PH_FIN) && IN(s0 + PH_FIN)) { FRESH(); ph_finish_w(c, l, nrows, blk * 8 + wave, G * 8, lane); if (DUP(PH_FIN)) ph_finish_w(c, l, nrows, blk * 8 + wave, G * 8, lane); }
        SEAM(s0 + PH_FIN);
        if (EN(PH_GOUT) && IN(s0 + PH_GOUT)) {
            FRESH();
            pg8::Gemm g{c.y(), c.wout(l), nrows, D, MIXW}; DenseOrder S; S.init(nrows, D, G, blk);
            EpiResid E{c.x(), c.mod(l, 0), c.wsf(WS_SSP)};
            pg8::gemm_phase<EpiResid, DenseOrder, true, true>(lds, g, S, E, tid);
        }
        SEAM(s0 + PH_GOUT);
        if (EN(PH_ROUTE) && IN(s0 + PH_ROUTE)) { FRESH(); if (DUP(PH_ROUTE)) { ph_route_b(c, l, nrows, (LAS float*)lds, blk, G, tid, true); __syncthreads(); } ph_route_b(c, l, nrows, (LAS float*)lds, blk, G, tid); }
        SEAM(s0 + PH_ROUTE);
        if (IN(s0 + PH_SCAT) || IN(s0 + PH_G1) || IN(s0 + PH_G2)) {
            FRESH();
            LAS int* ntl = (LAS int*)(lds + LDS_CTL + 4096);
            if (tid < NE) ntl[tid] = (c.cnt(l)[tid * CNTS] + 255) / 256;
            __syncthreads();
            if (tid < NE) { int a = 0; for (int e = 0; e < NE; ++e) a += (e < tid) ? ntl[e] : 0; tb[tid] = a; const int nt = ntl[tid]; for (int t = 0; t < nt; ++t) tb[NE + 1 + a + t] = tid; if (tid == NE - 1) tb[NE] = a + nt; }
            __syncthreads();
        }
        if (EN(PH_SCAT) && IN(s0 + PH_SCAT)) { FRESH(); ph_rowtok_w(c, l, nrows, (const LAS int*)tb, gt, gs); ph_transposes(c, lds, l, blk * 8 + wave, G * 8, wave, lane); }
        SEAM(s0 + PH_SCAT);
        if (EN(PH_G1) && IN(s0 + PH_G1)) {
            FRESH();
            LAS unsigned short* gtab = (LAS unsigned short*)(lds + 131072);
            MoeOrderG<const LAS int*, const LAS unsigned short*> S(tb, 2 * D / 256, G, blk, gtab, c.rtok());
            { pg8::Unit uu; const int* rt_ = c.rtok(); for (int i = 0; i < 16 && S.next(i, uu); ++i) for (int r = tid; r < 256; r += 512) gtab[i * 256 + r] = (unsigned short)rt_[uu.pm * 256 + r]; }
            __syncthreads();
            pg8::Gemm g{c.h(), c.wgu(l), NTOK, NE * 2 * D, D};
            EpiSwiglu E{c.act(), c.in[I_BGU] + (size_t)l * NE * 2 * D};
            pg8::gemm_phase<EpiSwiglu, MoeOrderG<const LAS int*, const LAS unsigned short*>, true, true>(lds, g, S, E, tid);
        }
        SEAM(s0 + PH_G1);
        if (EN(PH_G2) && IN(s0 + PH_G2)) {
            FRESH();
            pg8::Gemm g{c.act(), c.wdn(l), MAXROWS, NE * D, D}; MoeOrder<const LAS int*> S{tb, D / 256, G, blk, 8, 0};
            EpiDown E{c.yb(), c.in[I_BDN] + (size_t)l * NE * D};
            pg8::gemm_phase<EpiDown, MoeOrder<const LAS int*>, true, true>(lds, g, S, E, tid);
            if (DUP(PH_G2)) pg8::gemm_phase<EpiDown, MoeOrder<const LAS int*>, true, true>(lds, g, S, E, tid);
        }
        SEAM(s0 + PH_G2);
        if (EN(PH_COMB) && IN(s0 + PH_COMB)) { FRESH(); if (DUP(PH_COMB) && l < DEPTH - 1) ph_combine_w(c, l, nrows, blk * 8 + wave, G * 8, lane, true); ph_combine_w(c, l, nrows, blk * 8 + wave, G * 8, lane); }
        SEAM(s0 + PH_COMB);
    }
#undef IN
#undef SEAM
}

#ifndef MK_MULTI
#define MK_MULTI 0
#endif
extern "C" void kernel_launch(void* const* d_in, const int* in_sizes, int n_in, void* d_out, int out_size, void* d_ws, size_t ws_size, hipStream_t stream) {
    static int grid = 0;
    if (grid == 0) {
        if (n_in != N_IN || out_size != NLAT * D || ws_size < WS_END) { fprintf(stderr, "kernel_launch: unexpected shapes (n_in %d out %d ws %zu need %zu)\n", n_in, out_size, ws_size, (size_t)WS_END); grid = -1; return; }
        int dev = 0, cus = 0;
        if (hipGetDevice(&dev) != hipSuccess || hipDeviceGetAttribute(&cus, hipDeviceAttributeMultiprocessorCount, dev) != hipSuccess) { grid = -1; return; }
        if (hipFuncSetAttribute((const void*)mega_fwd, hipFuncAttributeMaxDynamicSharedMemorySize, LDS_BYTES) != hipSuccess) { fprintf(stderr, "kernel_launch: hipFuncSetAttribute failed\n"); grid = -1; return; }
        int per_cu = 0;
        (void)hipOccupancyMaxActiveBlocksPerMultiprocessor(&per_cu, (const void*)mega_fwd, 512, LDS_BYTES);
        (void)hipGetLastError();
        grid = cus;
        if (grid < NB * 32) { fprintf(stderr, "kernel_launch: needs at least %d CUs (one scan chain per workgroup), device has %d\n", NB * 32, cus); grid = -1; return; }
    }
    if (grid < 0) return;
    (void)hipMemsetAsync((char*)d_ws + WS_CTL, 0, CTL_BYTES, stream);
    Args a{};
    for (int i = 0; i < N_IN; ++i) a.in[i] = (const float*)d_in[i];
    a.out = (float*)d_out; a.ws = (unsigned char*)d_ws;
#if MK_MULTI
    for (int s = 0; s < NSTEPS; ++s) { a.lo = s; a.hi = s + 1; hipLaunchKernelGGL(mega_fwd, dim3(grid), dim3(512), LDS_BYTES, stream, a); }
#elif defined(PROBE_PRO)
    a.lo = 0; a.hi = 1; a.li = 0; a.pad = PROBE_PRO; hipLaunchKernelGGL(mega_fwd, dim3(grid), dim3(512), LDS_BYTES, stream, a);
    a.lo = 0; a.hi = NSTEPS; a.li = 1; a.pad = 0; hipLaunchKernelGGL(mega_fwd, dim3(grid), dim3(512), LDS_BYTES, stream, a);
#elif defined(PROBE_PH)
    { int lo = 0; for (int l = 0; l <= DEPTH; ++l) { const int s = 1 + l * NPH + PROBE_PH; a.lo = lo; a.hi = l < DEPTH ? s + 1 : NSTEPS; a.li = l; a.pad = PROBE_SEL; hipLaunchKernelGGL(mega_fwd, dim3(grid), dim3(512), LDS_BYTES, stream, a); lo = s; } }
#else
    a.lo = 0; a.hi = NSTEPS;
    hipLaunchKernelGGL(mega_fwd, dim3(grid), dim3(512), LDS_BYTES, stream, a);
#endif
}

#else
static void transposes_cpu(const Ctx& c) {
    for (int l = 0; l < DEPTH; ++l) {
        for (int k = 0; k < D; ++k) for (int n = 0; n < INW; ++n) c.win(l)[(size_t)n * D + k] = (bf16_t)f2bf(c.in[I_WIN][((size_t)l * D + k) * INW + n]);
        for (int k = 0; k < MIXW; ++k) for (int n = 0; n < D; ++n) c.wout(l)[(size_t)n * MIXW + k] = (bf16_t)f2bf(c.in[I_WOUT][((size_t)l * MIXW + k) * D + n]);
        for (int e = 0; e < NE; ++e) {
            for (int k = 0; k < D; ++k) for (int n = 0; n < 2 * D; ++n) c.wgu(l)[((size_t)e * 2 * D + gu_row_of_col(n)) * D + k] = (bf16_t)f2bf(c.in[I_WGU][(((size_t)l * NE + e) * D + k) * 2 * D + n]);
            for (int k = 0; k < D; ++k) for (int n = 0; n < D; ++n) c.wdn(l)[((size_t)e * D + n) * D + k] = (bf16_t)f2bf(c.in[I_WDN][(((size_t)l * NE + e) * D + k) * D + n]);
        }
    }
}
template <class Sched> static int gemm_cpu_arow(const Sched& S, const pg8::Unit& u, int r) { if constexpr (Sched::GATHER) return S.rowtok[u.pm * 256 + r]; else return u.pm * 256 + r; }
template <class Epi, class Sched> static void gemm_cpu(const pg8::Gemm& g, Sched S, const Epi& E, int G) {
    static float T[256][256];
    for (int cblk = 0; cblk < G; ++cblk) {
        S.c = cblk;
        for (int i = 0;; ++i) {
            pg8::Unit u; if (!S.next(i, u)) break;
            for (int r = 0; r < 256; ++r) for (int cc = 0; cc < 256; ++cc) {
                const bf16_t* a = g.A + (size_t)gemm_cpu_arow(S, u, r) * g.K; const bf16_t* b = g.Bt + (size_t)(u.pn * 256 + cc) * g.K;
                float s = 0.f; for (int k = 0; k < g.K; ++k) s += bf2f(a[k]) * bf2f(b[k]);
                T[r][cc] = s;
            }
            for (int wid = 0; wid < 8; ++wid) for (int lane = 0; lane < 64; ++lane) {
                const int wr = wid >> 2, wc = wid & 3, fr = lane & 15, fq = lane >> 4;
                accq acc[2][2][4][2];
                for (int ai = 0; ai < 2; ++ai) for (int bj = 0; bj < 2; ++bj) for (int m = 0; m < 4; ++m) for (int n = 0; n < 2; ++n) for (int j = 0; j < 4; ++j) {
                    const int r = 128 * ai + 64 * wr + 16 * m + fr;
                    const int cc = Epi::PERM ? 128 * bj + 32 * wc + 8 * fq + 4 * n + j : 128 * bj + 32 * wc + 16 * n + 4 * fq + j;
                    acc[ai][bj][m][n][j] = T[r][cc];
                }
                E(acc, u, wr, wc, fr, fq);
            }
        }
    }
}
constexpr int LDS_BYTES = 147456;
#define COOP(G_, body_) simt::launch(G_, 512, LDS_BYTES, [&]() { const int tid = threadIdx.x, lane = tid & 63, wave = tid >> 6, blk = blockIdx.x, G = gridDim.x; unsigned char* lds = simt::lds_base; (void)lane; (void)wave; (void)blk; (void)G; (void)lds; body_; })
extern "C" void kernel_launch(void* const* d_in, const int* in_sizes, int n_in, void* d_out, int out_size, void* d_ws, size_t ws_size, hipStream_t stream) {
    Ctx c; c.in = (const float* const*)d_in; c.out = (float*)d_out; c.ws = (unsigned char*)d_ws;
    memset((char*)d_ws + WS_CTL, 0, CTL_BYTES);
    const int G = 256, GC = 8;
    transposes_cpu(c);
    COOP(GC, { ph_mod_w(c, (float*)lds, tid, blk, G); });
    ph_foldgate(c, 0, 1); ph_rwsplit(c, 0, 1);
    for (int l = 0; l < DEPTH; ++l) {
        const bool last = (l == DEPTH - 1); const int nrows = last ? NLAT : NTOK;
        if (l == 0) COOP(GC, ph_norm1_w(c, l, blk * 8 + wave, G * 8, lane));
        { pg8::Gemm g{c.h(), c.win(l), NTOK, INP, D}; DenseOrder S; S.init(NTOK, INP, G, 0); EpiU E{c.u(), INP}; gemm_cpu(g, S, E, G); }
        ph_prep4(c, l, 0, 1);
        COOP(NB * 32, ph_chain(c, lds, blk, G, tid));
        COOP(GC, ph_finish_w(c, l, nrows, blk * 8 + wave, G * 8, lane));
        { pg8::Gemm g{c.y(), c.wout(l), nrows, D, MIXW}; DenseOrder S; S.init(nrows, D, G, 0); EpiResid E{c.x(), c.mod(l, 0), c.wsf(WS_SSP)}; gemm_cpu(g, S, E, G); }
        COOP(GC, ph_route_b(c, l, nrows, (float*)lds, blk, G, tid));
        int tb[TB_WORDS]; expert_tile_base(c.cnt(l), tb);
        COOP(GC, ph_rowtok_w(c, l, nrows, (const int*)tb, blk * 512 + tid, G * 512));
        { pg8::Gemm g{c.h(), c.wgu(l), NTOK, NE * 2 * D, D}; MoeOrderG<const int*, const unsigned short*> S(tb, 2 * D / 256, G, 0, nullptr, c.rtok()); EpiSwiglu E{c.act(), c.in[I_BGU] + (size_t)l * NE * 2 * D}; gemm_cpu(g, S, E, G); }
        { pg8::Gemm g{c.act(), c.wdn(l), MAXROWS, NE * D, D}; MoeOrder<const int*> S{tb, D / 256, G, 0}; EpiDown E{c.yb(), c.in[I_BDN] + (size_t)l * NE * D}; gemm_cpu(g, S, E, G); }
        COOP(GC, ph_combine_w(c, l, nrows, blk * 8 + wave, G * 8, lane));
    }
}
#endif
```

```cpp
#ifndef CPU_TEST
#include <hip/hip_runtime.h>
#else
#include "cpu_shim.h"
#endif
#include <cstdio>
#include <cstdint>
#include <cmath>

#ifndef CFG_D
#define CFG_D 1024
#define CFG_B 8
#define CFG_SEQ 2048
#define CFG_DEPTH 4
#define CFG_CTX 256
#endif
constexpr int D = CFG_D, NB = CFG_B, SEQ = CFG_SEQ, DEPTH = CFG_DEPTH, CTX = CFG_CTX;
constexpr int GRID_W = 64, ROWS = SEQ / GRID_W;
constexpr int NLAT = NB * SEQ, NCTX = NB * CTX, NTOK = NLAT + NCTX;
constexpr int INW = 4672, INWX = 5184, INP = 5376, MIXW = 1536, NE = 32, TOPK = 4;
constexpr int U_GQ = 0, U_GK = 256, U_GV = 512, U_GG = 1024, U_GLR = 1536;
constexpr int U_MQK = 1568, U_MV = 2080, U_MO = 2592, U_MG = 3104;
constexpr int U_Z = 3120, U_XBC = 3632, U_DT = 4656, U_GGK = 4672;
constexpr float EPS = 1e-6f;
constexpr int MAXROWS = NTOK * TOPK + NE * 256;
static_assert(NTOK % 256 == 0 && NLAT % 256 == 0 && D % 128 == 0 && D >= 256, "shape");

constexpr size_t al256(size_t x) { return (x + 255) & ~(size_t)255; }
constexpr size_t WS_CTL = 0, CTL_BYTES = 1u << 20;
constexpr size_t WS_MOD = WS_CTL + CTL_BYTES;
constexpr size_t WS_WIN = al256(WS_MOD + (size_t)DEPTH * (NB + 1) * 6 * D * 4);
constexpr size_t WS_WOUT = al256(WS_WIN + (size_t)DEPTH * INP * D * 2);
constexpr size_t WS_WGU = al256(WS_WOUT + (size_t)DEPTH * D * MIXW * 2);
constexpr size_t WS_WDN = al256(WS_WGU + (size_t)DEPTH * NE * 2 * D * D * 2);
constexpr size_t WS_X = al256(WS_WDN + (size_t)DEPTH * NE * D * D * 2);
constexpr size_t WS_H = al256(WS_X + (size_t)NTOK * D * 4);
constexpr size_t WS_U = al256(WS_H + (size_t)NTOK * D * 2);
constexpr size_t WS_GLA_A = al256(WS_U + (size_t)NTOK * INP * 4);
constexpr size_t WS_ML_QK = al256(WS_GLA_A + (size_t)2 * NTOK * 256 * 4);
constexpr size_t WS_ML_G = al256(WS_ML_QK + (size_t)NTOK * 512 * 4);
constexpr size_t WS_XBC = al256(WS_ML_G + (size_t)NTOK * 16 * 4);
constexpr size_t WS_DT = al256(WS_XBC + (size_t)NTOK * 1024 * 4);
constexpr size_t WS_ODIR = al256(WS_DT + (size_t)NTOK * 16 * 4);
constexpr size_t WS_OD2 = al256(WS_ODIR + (size_t)2 * NTOK * MIXW * 4);
constexpr size_t WS_Y = al256(WS_OD2 + (size_t)2 * NTOK * 512 * 4);
constexpr size_t WS_TOPE = al256(WS_Y + (size_t)NTOK * MIXW * 2);
constexpr size_t WS_TOPG = al256(WS_TOPE + (size_t)NTOK * 4 * 4);
constexpr size_t WS_POS = al256(WS_TOPG + (size_t)NTOK * 4 * 4);
constexpr size_t WS_DEST = al256(WS_POS + (size_t)NTOK * 4 * 4);
constexpr size_t WS_XS = al256(WS_DEST + (size_t)NTOK * 4 * 4);
constexpr size_t WS_ACT = al256(WS_XS + (size_t)MAXROWS * D * 2);
constexpr size_t WS_YB = al256(WS_ACT + (size_t)MAXROWS * D * 2);
constexpr int NCH = (CTX + SEQ) / 64;
static_assert(CTX % 64 == 0 && SEQ % 64 == 0, "chunking");
constexpr size_t CH_G = (size_t)NB * 4 * 2 * NCH, CH_S = (size_t)NB * 8 * 2 * NCH, CH_SG = (size_t)NB * 2 * 2 * NCH;
constexpr size_t WS_GQA = al256(WS_YB + (size_t)MAXROWS * D * 4);
constexpr size_t WS_GKB = al256(WS_GQA + CH_G * 4096 * 2);
constexpr size_t WS_GKDT = al256(WS_GKB + CH_G * 4096 * 2);
constexpr size_t WS_GVT = al256(WS_GKDT + CH_G * 4096 * 2);
constexpr size_t WS_GAL = al256(WS_GVT + CH_G * 8192 * 2);
constexpr size_t WS_MQA = al256(WS_GAL + CH_G * 64 * 4);
constexpr size_t WS_MKB = al256(WS_MQA + CH_G * 4096 * 2);
constexpr size_t WS_MKDT = al256(WS_MKB + CH_G * 4096 * 2);
constexpr size_t WS_MVT = al256(WS_MKDT + CH_G * 4096 * 2);
constexpr size_t WS_MMS = al256(WS_MVT + CH_G * 8192 * 2);
constexpr size_t WS_SQA = al256(WS_MMS + CH_G * 256 * 4);
constexpr size_t WS_SKB = al256(WS_SQA + CH_SG * 8192 * 2);
constexpr size_t WS_SKDT = al256(WS_SKB + CH_SG * 8192 * 2);
constexpr size_t WS_SVT = al256(WS_SKDT + CH_SG * 8192 * 2);
constexpr size_t WS_SVHT = al256(WS_SVT + CH_S * 4096 * 2);
constexpr size_t WS_SCS = al256(WS_SVHT + CH_S * 4096 * 2);
constexpr size_t WS_RWT = al256(WS_SCS + CH_S * 128 * 4);
constexpr size_t WS_SSP = al256(WS_RWT + (size_t)DEPTH * 2 * NE * D * 2);
constexpr size_t WS_RTOK = al256(WS_SSP + (size_t)NTOK * 64 * 4);
constexpr size_t WS_END = al256(WS_RTOK + (size_t)MAXROWS * 4);
static_assert(D == 1024 || D == 256, "ssp slots assume D / 256 <= 4 column tiles");
constexpr int CW_BAR = 4096;
constexpr int CW_CNT = 131072, CNTS = 256;

enum { I_X = 0, I_C, I_CTX, I_CCTX, I_WMOD, I_BMOD, I_N1G, I_WIN, I_GW2, I_GBG, I_GNG, I_MCW, I_MCB, I_MBI, I_MBF, I_MNG,
       I_2CW, I_2CB, I_2DTB, I_2AL, I_2D, I_2NG, I_WOUT, I_N2G, I_RW, I_RB, I_WGU, I_BGU, I_WDN, I_BDN, I_FNG, N_IN };

struct Args { const float* in[N_IN]; float* out; unsigned char* ws; int lo, hi, li, pad; };

#ifndef CPU_TEST
#define KAS __attribute__((address_space(4)))
#else
#define KAS
#endif
typedef unsigned short bf16_t;
typedef float f32x4 __attribute__((ext_vector_type(4)));
typedef unsigned u32x4 __attribute__((ext_vector_type(4)));
typedef short bf16x8 __attribute__((ext_vector_type(8)));

__host__ __device__ __forceinline__ unsigned f2bf(float f) { unsigned u; __builtin_memcpy(&u, &f, 4); return (u + 0x7fffu + ((u >> 16) & 1u)) >> 16; }
#ifndef CPU_TEST
__device__ __forceinline__ unsigned pk2(float lo, float hi) { unsigned r; asm("v_cvt_pk_bf16_f32 %0, %1, %2" : "=v"(r) : "v"(lo), "v"(hi)); return r; }
#else
__host__ __device__ __forceinline__ unsigned pk2(float lo, float hi) { return f2bf(lo) | (f2bf(hi) << 16); }
#endif
__host__ __device__ __forceinline__ float bf2f(bf16_t b) { unsigned u = ((unsigned)b) << 16; float f; __builtin_memcpy(&f, &u, 4); return f; }
#ifndef CPU_TEST
#define FEXP(x) __expf(x)
#define FLOG(x) __logf(x)
#define FRCP(x) __builtin_amdgcn_rcpf(x)
#else
#define FEXP(x) expf(x)
#define FLOG(x) logf(x)
#define FRCP(x) (1.0f / (x))
#endif
__host__ __device__ __forceinline__ float sigmoidf_(float x) { return FRCP(1.0f + FEXP(-x)); }
__host__ __device__ __forceinline__ float siluf_(float x) { return x * sigmoidf_(x); }
__host__ __device__ __forceinline__ float logsigmoidf_(float x) { return fminf(x, 0.f) - FLOG(1.0f + FEXP(-fabsf(x))); }
__host__ __device__ __forceinline__ float softplusf_(float x) { return fmaxf(x, 0.f) + FLOG(1.0f + FEXP(-fabsf(x))); }

__host__ __device__ __forceinline__ f32x4 cvtb4(unsigned long long w) { const unsigned lo = (unsigned)w, hi = (unsigned)(w >> 32); f32x4 r;
    unsigned t; float f; t = lo << 16; __builtin_memcpy(&f, &t, 4); r[0] = f; t = lo & 0xffff0000u; __builtin_memcpy(&f, &t, 4); r[1] = f; t = hi << 16; __builtin_memcpy(&f, &t, 4); r[2] = f; t = hi & 0xffff0000u; __builtin_memcpy(&f, &t, 4); r[3] = f; return r; }
__host__ __device__ __forceinline__ f32x4 ldb4(const bf16_t* p) { const unsigned long long w = *(const unsigned long long*)p; const unsigned lo = (unsigned)w, hi = (unsigned)(w >> 32); f32x4 r;
    unsigned t; float f; t = lo << 16; __builtin_memcpy(&f, &t, 4); r[0] = f; t = lo & 0xffff0000u; __builtin_memcpy(&f, &t, 4); r[1] = f; t = hi << 16; __builtin_memcpy(&f, &t, 4); r[2] = f; t = hi & 0xffff0000u; __builtin_memcpy(&f, &t, 4); r[3] = f; return r; }
struct Ctx {
    const float* const KAS* in; float* out; unsigned char* ws;
    __host__ __device__ float* mod(int l, int r) const { return (float*)(ws + WS_MOD) + ((size_t)l * (NB + 1) + r) * 6 * D; }
    __host__ __device__ bf16_t* win(int l) const { return (bf16_t*)(ws + WS_WIN) + (size_t)l * INP * D; }
    __host__ __device__ bf16_t* wout(int l) const { return (bf16_t*)(ws + WS_WOUT) + (size_t)l * D * MIXW; }
    __host__ __device__ bf16_t* wgu(int l) const { return (bf16_t*)(ws + WS_WGU) + (size_t)l * NE * 2 * D * D; }
    __host__ __device__ bf16_t* wdn(int l) const { return (bf16_t*)(ws + WS_WDN) + (size_t)l * NE * D * D; }
    __host__ __device__ float* x() const { return (float*)(ws + WS_X); }
    __host__ __device__ bf16_t* h() const { return (bf16_t*)(ws + WS_H); }
    __host__ __device__ bf16_t* u() const { return (bf16_t*)(ws + WS_U); }
    __host__ __device__ float* gla_a() const { return (float*)(ws + WS_GLA_A); }
    __host__ __device__ float* ml_qk() const { return (float*)(ws + WS_ML_QK); }
    __host__ __device__ float* ml_g() const { return (float*)(ws + WS_ML_G); }
    __host__ __device__ bf16_t* xbc() const { return (bf16_t*)(ws + WS_XBC); }
    __host__ __device__ float* dt() const { return (float*)(ws + WS_DT); }
    __host__ __device__ bf16_t* odir() const { return (bf16_t*)(ws + WS_ODIR); }
    __host__ __device__ float* od2() const { return (float*)(ws + WS_OD2); }
    __host__ __device__ bf16_t* y() const { return (bf16_t*)(ws + WS_Y); }
    __host__ __device__ int* tope() const { return (int*)(ws + WS_TOPE); }
    __host__ __device__ float* topg() const { return (float*)(ws + WS_TOPG); }
    __host__ __device__ int* pos() const { return (int*)(ws + WS_POS); }
    __host__ __device__ int* dest() const { return (int*)(ws + WS_DEST); }
    __host__ __device__ bf16_t* xs() const { return (bf16_t*)(ws + WS_XS); }
    __host__ __device__ bf16_t* act() const { return (bf16_t*)(ws + WS_ACT); }
    __host__ __device__ bf16_t* yb() const { return (bf16_t*)(ws + WS_YB); }
    __host__ __device__ bf16_t* wsb(size_t off) const { return (bf16_t*)(ws + off); }
    __host__ __device__ float* wsf(size_t off) const { return (float*)(ws + off); }
    __host__ __device__ int* rtok() const { return (int*)(ws + WS_RTOK); }
    __host__ __device__ unsigned* ctl() const { return (unsigned*)(ws + WS_CTL); }
    static_assert((size_t)(CW_CNT + 2 * DEPTH * NE * CNTS) * 4 <= CTL_BYTES, "expert counters fit the zeroed control area");
    __host__ __device__ int* cnt(int l) const { return (int*)(ws + WS_CTL) + CW_CNT + l * NE * CNTS; }
};

constexpr size_t OF_G = 0, OF_M = (size_t)NB * 8 * NCH * 8192, OF_S = 2 * OF_M;
static_assert(OF_S + (size_t)NB * 16 * NCH * 4096 == (size_t)2 * NTOK * MIXW, "fragment layout fills the old [2][NTOK][MIXW] buffer exactly");
__host__ __device__ __forceinline__ int chunk_of(int is_lat, int q) { return (is_lat ? CTX / 64 : 0) + q / 64; }
__host__ __device__ __forceinline__ int mod_row(int row) { return row < NLAT ? row / SEQ : NB; }
__host__ __device__ __forceinline__ void seg_of(int row, int& base, int& pos, int& len) {
    if (row < NLAT) { base = (row / SEQ) * SEQ; pos = row - base; len = SEQ; } else { const int r = row - NLAT; base = NLAT + (r / CTX) * CTX; pos = row - base; len = CTX; }
}
__host__ __device__ __forceinline__ int tok_of_scan(int s) { return (s % ROWS) * GRID_W + s / ROWS; }
__host__ __device__ __forceinline__ int scan_of_tok(int t) { return (t % GRID_W) * ROWS + t / GRID_W; }
__host__ __device__ __forceinline__ int tokrow_of_srow(int srow) { if (srow >= NLAT) return srow; const int b = srow / SEQ; return b * SEQ + tok_of_scan(srow - b * SEQ); }
__host__ __device__ __forceinline__ int srow_of_tokrow(int row) { if (row >= NLAT) return row; const int b = row / SEQ; return b * SEQ + scan_of_tok(row - b * SEQ); }

#ifndef CPU_TEST
#define UNI(x) __builtin_amdgcn_readfirstlane(x)
#define CBAR() __builtin_amdgcn_sched_barrier(0)
#define LAS __attribute__((address_space(3)))
namespace pg8 {
#define PG8_LAS __attribute__((address_space(3)))
typedef unsigned short bf16_t;
typedef short bf16x8 __attribute__((ext_vector_type(8)));
typedef float f32x4 __attribute__((ext_vector_type(4)));
typedef unsigned u32x4 __attribute__((ext_vector_type(4)));
constexpr int BM = 256, BK = 64, HALF = 128, HTB = HALF * BK * 2  , STAGE_BYTES = 8 * HTB, NXCD = 8, WGM = 8;

__host__ __device__ __forceinline__ int lds_byte(int r, int c) { const int st = (r >> 4) * 2 + (c >> 5), rr = r & 15, cc = c & 31, ob = rr * 64 + cc * 2; return st * 1024 + (ob ^ (((ob >> 9) & 1) << 5)); }
__host__ __device__ __forceinline__ void stage_rc(int b, int& R, int& C) { const int st = b / 1024, sb = b % 1024, swz = sb ^ (((sb >> 9) & 1) << 5); R = (st >> 1) * 16 + swz / 64; C = (st & 1) * 32 + (swz % 64) / 2; }
__host__ __device__ __forceinline__ int perm32(int rho) { const int n = rho >> 4, i = rho & 15; return 8 * (i >> 2) + 4 * n + (i & 3); }

struct Unit { int pm, pn; };
struct Gemm { const bf16_t* A; const bf16_t* Bt; int M, N, K; };

struct StaticOrder {
    int nM, nN, nwg, G, c;
    __host__ __device__ void init(int M, int N, int G_, int c_) { nM = M / BM; nN = N / BM; nwg = nM * nN; G = G_; c = c_; }
    __host__ __device__ bool next(int i, Unit& u) const {
        const long L = (long)i * G + c; if (L >= nwg) return false;
        int wgid = (int)L; { const int q = nwg / NXCD, r = nwg % NXCD, xcd = wgid % NXCD, off = wgid / NXCD; wgid = (xcd < r ? xcd * (q + 1) : r * (q + 1) + (xcd - r) * q) + off; }
        const int nig = WGM * nN, gid = wgid / nig, fm = gid * WGM, gsz = (nM - fm) < WGM ? (nM - fm) : WGM;
        u.pm = fm + ((wgid % nig) % gsz); u.pn = (wgid % nig) / gsz; return true;
    }
    __device__ __forceinline__ void a_ready(const Unit&) const {}
    __device__ __forceinline__ void done(const Unit&) const {}
};
__device__ __forceinline__ unsigned cvt_pk_bf16(float lo, float hi) { unsigned r; asm volatile("v_cvt_pk_bf16_f32 %0, %1, %2" : "=v"(r) : "v"(lo), "v"(hi)); return r; }
typedef float f32x2 __attribute__((ext_vector_type(2)));
template <class Epi, class Sched, bool ALIGN_EPI = false, bool SP2 = false>
__device__ __forceinline__ void gemm_phase(PG8_LAS unsigned char* lds, const Gemm g, const Sched& S, const Epi& E, const int tid_in) {
    const int tid = tid_in, wid = __builtin_amdgcn_readfirstlane(tid >> 6), lane = tid & 63, wr = wid >> 2, wc = wid & 3, fr = lane & 15, fq = lane >> 4;
    const int K = g.K, nt = K / BK;
    static_assert(!Sched::GATHER || SP2, "the gathered A operand is wired into the SP2 loop only");
    unsigned voffA[2], voffB[2];
#pragma unroll
    for (int i = 0; i < 2; ++i) { int R, C; stage_rc(tid * 16 + i * 8192, R, C); const int Rb = Epi::PERM ? ((R & ~31) + perm32(R & 31)) : R;
        voffA[i] = (unsigned)(R * K + C) * 2u; voffB[i] = (unsigned)(Rb * K + C) * 2u; }
    unsigned gc00 = 0u, gc01 = 0u, gc10 = 0u, gc11 = 0u, gn00 = 0u, gn01 = 0u, gn10 = 0u, gn11 = 0u;
#define PG8_GOFS(d00, d01, d10, d11, uidx) do { int R0_, C0_, R1_, C1_; stage_rc(tid * 16, R0_, C0_); stage_rc(tid * 16 + 8192, R1_, C1_); \
        d00 = ((unsigned)S.grow((uidx), R0_) * (unsigned)K + (unsigned)C0_) * 2u; d01 = ((unsigned)S.grow((uidx), R1_) * (unsigned)K + (unsigned)C1_) * 2u; \
        d10 = ((unsigned)S.grow((uidx), 128 + R0_) * (unsigned)K + (unsigned)C0_) * 2u; d11 = ((unsigned)S.grow((uidx), 128 + R1_) * (unsigned)K + (unsigned)C1_) * 2u; } while (0)
#define PG8_STAGE2(bufoff, gbase, o0, o1) do { \
        __builtin_amdgcn_global_load_lds((const unsigned*)((const char*)(gbase) + (o0)), (PG8_LAS unsigned*)(lds + (bufoff) + ldsw), 16, 0, 0); \
        __builtin_amdgcn_global_load_lds((const unsigned*)((const char*)(gbase) + (o1)), (PG8_LAS unsigned*)(lds + (bufoff) + ldsw + 8192), 16, 0, 0); } while (0)
#define PG8_STAGE_A(bufoff, base, H, NX) do { if constexpr (Sched::GATHER) { const unsigned o0_ = (NX) ? ((H) ? gn10 : gn00) : ((H) ? gc10 : gc00), o1_ = (NX) ? ((H) ? gn11 : gn01) : ((H) ? gc11 : gc01); PG8_STAGE2(bufoff, base, o0_, o1_); } \
        else { PG8_STAGE(bufoff, (base) + (H) * hstep, voffA); } } while (0)
    const size_t kstep = (size_t)(BK * 2);
    const size_t hstep = (size_t)HALF * K * 2;
    const size_t tstep = 2 * hstep;
    const unsigned ldsw = (unsigned)wid * 1024u;
    const int aoff = lds_byte(wr * 64 + fr, fq * 8), boff = lds_byte(wc * 32 + fr, fq * 8);
#define PG8_SA(b, h) (((b) * 2 + (h)) * HTB)
#define PG8_SB(b, h) ((4 + (b) * 2 + (h)) * HTB)
#define PG8_STAGE(bufoff, gbase, voff) do { _Pragma("unroll") for (int _i = 0; _i < 2; ++_i) \
        __builtin_amdgcn_global_load_lds((const unsigned*)((const char*)(gbase) + (voff)[_i]), (PG8_LAS unsigned*)(lds + (bufoff) + ldsw + _i * 8192), 16, 0, 0); } while (0)
#define PG8_LDA(dst, b, h) do { _Pragma("unroll") for (int m = 0; m < 4; ++m) _Pragma("unroll") for (int k = 0; k < 2; ++k) dst[m][k] = *(const PG8_LAS bf16x8*)(lds + PG8_SA(b, h) + aoff + m * 2048 + k * 1024); } while (0)
#define PG8_LDB(dst, b, h) do { _Pragma("unroll") for (int n = 0; n < 2; ++n) _Pragma("unroll") for (int k = 0; k < 2; ++k) dst[n][k] = *(const PG8_LAS bf16x8*)(lds + PG8_SB(b, h) + boff + n * 2048 + k * 1024); } while (0)
#define PG8_MMA(ai, bj, At, Bt) do { __builtin_amdgcn_s_setprio(1); _Pragma("unroll") for (int m = 0; m < 4; ++m) _Pragma("unroll") for (int n = 0; n < 2; ++n) _Pragma("unroll") for (int k = 0; k < 2; ++k) \
        acc[ai][bj][m][n] = __builtin_amdgcn_mfma_f32_16x16x32_bf16(Bt[n][k], At[m][k], acc[ai][bj][m][n], 0, 0, 0); __builtin_amdgcn_s_setprio(0); } while (0)
#define PG8_WAIT_V(n) asm volatile("s_waitcnt vmcnt(" #n ")" ::: "memory")
#define PG8_WAIT_L(n) asm volatile("s_waitcnt lgkmcnt(" #n ")" ::: "memory")
#define PG8_BAR __builtin_amdgcn_s_barrier()
#define PG8_SCHED __builtin_amdgcn_sched_barrier(0)
    Unit cur, nxt; int ui = 0;
    if (!S.next(0, cur)) return;
    f32x4 acc[2][2][4][2];
#pragma unroll
    for (int a = 0; a < 2; ++a)
#pragma unroll
        for (int b = 0; b < 2; ++b)
#pragma unroll
            for (int m = 0; m < 4; ++m)
#pragma unroll
                for (int n = 0; n < 2; ++n) acc[a][b][m][n] = (f32x4){0.f, 0.f, 0.f, 0.f};
    bf16x8 At[4][2], B0[2][2], B1[2][2];
    const char* cA = (const char*)g.A + (Sched::GATHER ? (size_t)0 : (size_t)cur.pm * tstep); const char* cB = (const char*)g.Bt + (size_t)cur.pn * tstep;
    if constexpr (Sched::GATHER) PG8_GOFS(gc00, gc01, gc10, gc11, 0);
    S.a_ready(cur);
    if constexpr (SP2) {
        PG8_STAGE(PG8_SB(0, 0), cB, voffB); PG8_STAGE(PG8_SB(0, 1), cB + hstep, voffB); PG8_STAGE_A(PG8_SA(0, 0), cA, 0, false); PG8_STAGE_A(PG8_SA(0, 1), cA, 1, false);
        if (wr == 1) PG8_BAR;
        PG8_WAIT_V(2); PG8_BAR;
        PG8_STAGE(PG8_SB(1, 0), cB + kstep, voffB); PG8_STAGE_A(PG8_SA(1, 0), cA + kstep, 0, false); PG8_STAGE(PG8_SB(1, 1), cB + hstep + kstep, voffB);
        PG8_WAIT_V(6); PG8_BAR;
    } else {
        PG8_STAGE(PG8_SB(0, 0), cB, voffB); PG8_STAGE(PG8_SA(0, 0), cA, voffA); PG8_STAGE(PG8_SB(0, 1), cB + hstep, voffB); PG8_STAGE(PG8_SA(0, 1), cA + hstep, voffA);
        if (wr == 1) PG8_BAR;
        PG8_WAIT_V(4); PG8_BAR;
        PG8_STAGE(PG8_SB(1, 0), cB + kstep, voffB); PG8_STAGE(PG8_SA(1, 0), cA + kstep, voffA); PG8_STAGE(PG8_SB(1, 1), cB + hstep + kstep, voffB);
        PG8_WAIT_V(6); PG8_BAR;
    }
    for (;;) {
        const bool has_next = S.next(ui + 1, nxt);
        const char* nA = (has_next && !Sched::GATHER) ? (const char*)g.A + (size_t)nxt.pm * tstep : cA; const char* nB = has_next ? (const char*)g.Bt + (size_t)nxt.pn * tstep : cB;
        if constexpr (Sched::GATHER) { if (has_next) PG8_GOFS(gn00, gn01, gn10, gn11, ui + 1); else { gn00 = gc00; gn01 = gc01; gn10 = gc10; gn11 = gc11; } }
        for (int t = 0; t < nt; t += 2) {
            const bool last = (t == nt - 2);
            const char* a1 = cA + (size_t)(t + 1) * kstep;
            const char* a2 = last ? nA : cA + (size_t)(t + 2) * kstep; const char* b2 = last ? nB : cB + (size_t)(t + 2) * kstep;
            const char* a3 = a2 + kstep; const char* b3 = b2 + kstep;
            if (last && has_next) S.a_ready(nxt);
            if constexpr (SP2) {
            PG8_LDB(B0, 0, 0); PG8_LDB(B1, 0, 1); PG8_SCHED; PG8_LDA(At, 0, 0); PG8_STAGE_A(PG8_SA(1, 1), a1, 1, false);
            PG8_WAIT_V(8); PG8_WAIT_L(0); PG8_BAR; PG8_MMA(0, 0, At, B0); PG8_MMA(0, 1, At, B1); PG8_BAR; PG8_SCHED;
            PG8_LDA(At, 0, 1); PG8_STAGE(PG8_SB(0, 0), b2, voffB); PG8_STAGE(PG8_SB(0, 1), b2 + hstep, voffB); PG8_STAGE_A(PG8_SA(0, 0), a2, 0, last);
            PG8_WAIT_V(8); PG8_WAIT_L(0); PG8_BAR; PG8_MMA(1, 0, At, B0); PG8_MMA(1, 1, At, B1); PG8_BAR; PG8_SCHED;
            PG8_LDB(B0, 1, 0); PG8_LDB(B1, 1, 1); PG8_SCHED; PG8_LDA(At, 1, 0); PG8_STAGE_A(PG8_SA(0, 1), a2, 1, last);
            PG8_WAIT_V(8); PG8_WAIT_L(0); PG8_BAR; PG8_MMA(0, 0, At, B0); PG8_MMA(0, 1, At, B1); PG8_BAR; PG8_SCHED;
            PG8_LDA(At, 1, 1); PG8_STAGE(PG8_SB(1, 0), b3, voffB); PG8_STAGE(PG8_SB(1, 1), b3 + hstep, voffB); PG8_STAGE_A(PG8_SA(1, 0), a3, 0, last);
            PG8_WAIT_V(8); PG8_WAIT_L(0); PG8_BAR; PG8_MMA(1, 0, At, B0); PG8_MMA(1, 1, At, B1); PG8_BAR; PG8_SCHED;
            } else {
            PG8_LDB(B0, 0, 0); PG8_SCHED; PG8_LDA(At, 0, 0); PG8_STAGE(PG8_SA(1, 1), a1 + hstep, voffA);
            PG8_WAIT_L(8); PG8_BAR; PG8_WAIT_L(0); PG8_MMA(0, 0, At, B0); PG8_BAR; PG8_SCHED;
            PG8_LDB(B1, 0, 1); PG8_STAGE(PG8_SB(0, 0), b2, voffB);
            PG8_BAR; PG8_WAIT_L(0); PG8_MMA(0, 1, At, B1); PG8_BAR;
            PG8_LDA(At, 0, 1); PG8_STAGE(PG8_SA(0, 0), a2, voffA);
            PG8_BAR; PG8_WAIT_L(0); PG8_MMA(1, 0, At, B0); PG8_BAR; PG8_SCHED;
            PG8_STAGE(PG8_SB(0, 1), b2 + hstep, voffB);
            PG8_WAIT_V(6); PG8_BAR; PG8_MMA(1, 1, At, B1); PG8_BAR;
            PG8_LDB(B0, 1, 0); PG8_SCHED; PG8_LDA(At, 1, 0); PG8_STAGE(PG8_SA(0, 1), a2 + hstep, voffA);
            PG8_WAIT_L(8); PG8_BAR; PG8_WAIT_L(0); PG8_MMA(0, 0, At, B0); PG8_BAR; PG8_SCHED;
            PG8_LDB(B1, 1, 1); PG8_STAGE(PG8_SB(1, 0), b3, voffB);
            PG8_BAR; PG8_WAIT_L(0); PG8_MMA(0, 1, At, B1); PG8_BAR;
            PG8_LDA(At, 1, 1); PG8_STAGE(PG8_SA(1, 0), a3, voffA);
            PG8_BAR; PG8_WAIT_L(0); PG8_MMA(1, 0, At, B0); PG8_BAR; PG8_SCHED;
            PG8_STAGE(PG8_SB(1, 1), b3 + hstep, voffB);
            PG8_WAIT_V(6); PG8_BAR; PG8_MMA(1, 1, At, B1); PG8_BAR;
            }
        }
        if constexpr (ALIGN_EPI) { if (wr == 0) PG8_BAR; }
        if constexpr (!Epi::AFTER_DRAIN) { E(acc, cur, wr, wc, fr, fq); S.done(cur); }
        if (!has_next) break;
#pragma unroll
        for (int a = 0; a < 2; ++a)
#pragma unroll
            for (int b = 0; b < 2; ++b)
#pragma unroll
                for (int m = 0; m < 4; ++m)
#pragma unroll
                    for (int n = 0; n < 2; ++n) acc[a][b][m][n] = (f32x4){0.f, 0.f, 0.f, 0.f};
        cur = nxt; cA = nA; cB = nB; ++ui;
        if constexpr (Sched::GATHER) { gc00 = gn00; gc01 = gn01; gc10 = gn10; gc11 = gn11; }
        if constexpr (ALIGN_EPI) { if (wr == 1) PG8_BAR; }
    }
    PG8_WAIT_V(0);
    if constexpr (!ALIGN_EPI) { if (wr == 0) PG8_BAR; }
    PG8_BAR;
    if constexpr (Epi::AFTER_DRAIN) { E.fused(acc, cur, wr, wc, fr, fq, lds, wid, lane); S.done(cur); }
#undef PG8_SA
#undef PG8_SB
#undef PG8_STAGE
#undef PG8_LDA
#undef PG8_LDB
#undef PG8_MMA
#undef PG8_WAIT_V
#undef PG8_WAIT_L
#undef PG8_BAR
#undef PG8_SCHED
#undef PG8_GOFS
#undef PG8_STAGE_A
#undef PG8_STAGE2
}
}
#define XB_TMO      128
#define XB_XCNT(j)  (256  + 64 * (j))
#define XB_XSUB(j)  (1280 + 64 * (j))
#define XB_XGEN(j)  (2304 + 64 * (j))
#define XB_TOP      3328
#define XB_TOPGEN   3392
#define XCD_BAR_WORDS 3456
#define XB_SPIN_CAP (1u << 22)

__device__ __forceinline__ unsigned xb_ld(unsigned* p)              { return __hip_atomic_load(p, __ATOMIC_RELAXED, __HIP_MEMORY_SCOPE_AGENT); }
__device__ __forceinline__ unsigned xb_add(unsigned* p, unsigned v) { return __hip_atomic_fetch_add(p, v, __ATOMIC_RELAXED, __HIP_MEMORY_SCOPE_AGENT); }
__device__ __forceinline__ unsigned xb_xcc_id() { return (unsigned)__builtin_amdgcn_s_getreg((3 << 11) | 20) & 0xFu; }
#define XB_SPIN(cond, bar) do { unsigned _sp = 0; while (cond) { __builtin_amdgcn_s_sleep(1); \
    if ((++_sp & 255u) == 0u) { if (xb_ld(&(bar)[XB_TMO])) break; if (_sp > XB_SPIN_CAP) { atomicAdd(&(bar)[XB_TMO], 1u); break; } } } } while (0)

struct XcdBarrier {
    unsigned* bar; unsigned x;
    volatile LAS unsigned* st;
};

__device__ __forceinline__ XcdBarrier xcd_barrier_post(unsigned* bar, volatile LAS unsigned* st) {
    XcdBarrier b; b.bar = bar; b.x = xb_xcc_id(); b.st = st;
    if (threadIdx.x == 0) (void)xb_add(&bar[XB_XCNT(b.x)], 1u);
    return b;
}
__device__ __forceinline__ void xcd_barrier_complete(unsigned* bar, unsigned x, unsigned& nloc, unsigned& nx) {
    const unsigned G = gridDim.x * gridDim.y * gridDim.z;
    unsigned sum, cnt, mine, sp = 0u;
    for (;;) {
        sum = 0u; cnt = 0u; mine = 0u;
#pragma unroll
        for (unsigned j = 0; j < 16; ++j) { const unsigned c = xb_ld(&bar[XB_XCNT(j)]); sum += c; cnt += (c > 0u) ? 1u : 0u; mine = (j == x) ? c : mine; }
        if (sum == G) break;
        __builtin_amdgcn_s_sleep(1);
        if ((++sp & 255u) == 0u) { if (xb_ld(&bar[XB_TMO])) break; if (sp > XB_SPIN_CAP) { atomicAdd(&bar[XB_TMO], 1u); break; } }
    }
    nloc = mine > 0u ? mine : 1u; nx = cnt > 0u ? cnt : 1u;
}

__device__ __forceinline__ void xcd_barrier(const XcdBarrier& b) {
    asm volatile("s_waitcnt vmcnt(0)" ::: "memory");
    __syncthreads();
    if (threadIdx.x == 0) {
        unsigned* bar = b.bar;
        __builtin_amdgcn_s_waitcnt(0);
        unsigned nloc = b.st[0], nx = b.st[1];
        if (nloc == 0u) { xcd_barrier_complete(bar, b.x, nloc, nx); b.st[0] = nloc; b.st[1] = nx; }
        const unsigned old = xb_add(&bar[XB_XSUB(b.x)], 1u);
        const unsigned gen = old / nloc;
        if (old + 1u == (gen + 1u) * nloc) {
            __builtin_amdgcn_fence(__ATOMIC_RELEASE, "agent");
            asm volatile("s_waitcnt vmcnt(0)" ::: "memory");
            const unsigned og = xb_add(&bar[XB_TOP], 1u);
            const unsigned tg = og / nx;
            if (og + 1u == (tg + 1u) * nx) xb_add(&bar[XB_TOPGEN], 1u);
            else XB_SPIN(xb_ld(&bar[XB_TOPGEN]) == tg, bar);
            __builtin_amdgcn_fence(__ATOMIC_ACQUIRE, "agent");
            xb_add(&bar[XB_XGEN(b.x)], 1u);
            asm volatile("s_waitcnt vmcnt(0)" ::: "memory");
        } else {
            XB_SPIN(xb_ld(&bar[XB_XGEN(b.x)]) == gen, bar);
            __builtin_amdgcn_fence(__ATOMIC_ACQUIRE, "agent");
            asm volatile("s_waitcnt vmcnt(0)" ::: "memory");
        }
    }
    __syncthreads();
}
#else
#define UNI(x) (x)
#define CBAR()
namespace pg8 { typedef float f32x4 __attribute__((ext_vector_type(4))); struct Unit { int pm, pn; }; struct Gemm { const unsigned short* A; const unsigned short* Bt; int M, N, K; }; }
#endif

__host__ __device__ __forceinline__ int scan_row(int b, int dir, int st) {
    return st < CTX ? NLAT + b * CTX + (dir == 0 ? st : CTX - 1 - st) : b * SEQ + (dir == 0 ? st - CTX : SEQ - 1 - (st - CTX));
}
__host__ __device__ __forceinline__ void expert_tile_base(const int* cnt, int* tb) { int a = 0; for (int e = 0; e < NE; ++e) { tb[e] = a; const int nt = (cnt[e * CNTS] + 255) / 256; for (int t = 0; t < nt; ++t) tb[NE + 1 + a + t] = e; a += nt; } tb[NE] = a; }
constexpr int TB_WORDS = NE + 1 + MAXROWS / 256;
struct DenseOrder {
    static constexpr bool GATHER = false;
    __device__ __forceinline__ int grow(int, int) const { return 0; }
    int nM, nN, nwg, G, c;
    __host__ __device__ void init(int M, int N, int G_, int c_) { nM = M / 256; nN = N / 256; nwg = nM * nN; G = G_; c = c_; }
    __host__ __device__ __forceinline__ bool next(int i, pg8::Unit& u) const {
        const long L = (long)i * G + c; if (L >= nwg) return false;
        int wgid = (int)L; { const int q = nwg / 8, r = nwg % 8, xcd = wgid % 8, off = wgid / 8; wgid = (xcd < r ? xcd * (q + 1) : r * (q + 1) + (xcd - r) * q) + off; }
        const int nig = 8 * nN, gid = wgid / nig, fm = gid * 8, gsz = (nM - fm) < 8 ? (nM - fm) : 8;
        u.pm = fm + ((wgid % nig) % gsz); u.pn = (wgid % nig) / gsz; return true;
    }
    __device__ __forceinline__ void a_ready(const pg8::Unit&) const {}
    __device__ __forceinline__ void done(const pg8::Unit&) const {}
};
template <class TB> struct MoeOrder {
    static constexpr bool GATHER = false;
    __device__ __forceinline__ int grow(int, int) const { return 0; }
    TB tb; int nN, G, c; int wgm = 8; int rev = 0;
    __host__ __device__ __forceinline__ bool next(int i, pg8::Unit& u) const {
        const int nRT = tb[NE], nwg = nRT * nN;
        const long L = (long)i * G + c; if (L >= nwg) return false;
        int wgid = (int)L; { const int q = nwg / 8, r = nwg % 8, xcd = wgid % 8, off = wgid / 8; wgid = (xcd < r ? xcd * (q + 1) : r * (q + 1) + (xcd - r) * q) + off; }
        if (rev) wgid = nwg - 1 - wgid;
        const int nig = wgm * nN, gid = wgid / nig, fm = gid * wgm, gsz = (nRT - fm) < wgm ? (nRT - fm) : wgm;
        const int rt = fm + ((wgid % nig) % gsz), ln = (wgid % nig) / gsz;
        const int e = tb[NE + 1 + rt];
#ifndef CPU_TEST
        u.pm = __builtin_amdgcn_readfirstlane(rt); u.pn = __builtin_amdgcn_readfirstlane(e * nN + ln);
#else
        u.pm = rt; u.pn = e * nN + ln;
#endif
        return true;
    }
    __device__ __forceinline__ void a_ready(const pg8::Unit&) const {}
    __device__ __forceinline__ void done(const pg8::Unit&) const {}
};
template <class TB, class GT> struct MoeOrderG : MoeOrder<TB> {
    static constexpr bool GATHER = true;
    GT gtab; const int* rowtok;
    __host__ __device__ MoeOrderG(TB tb_, int nN_, int G_, int c_, GT gt_, const int* rt_) { this->tb = tb_; this->nN = nN_; this->G = G_; this->c = c_; this->wgm = 8; gtab = gt_; rowtok = rt_; }
    __device__ __forceinline__ int grow(int ui, int r) const { return (int)gtab[ui * 256 + r]; }
};
#ifdef CPU_TEST
static inline unsigned cvt_pk_bf16(float lo, float hi) { return pk2(lo, hi); }
#else
using pg8::cvt_pk_bf16;
#endif
typedef pg8::f32x4 accq;
struct EpiU {
    static constexpr bool PERM = true, AFTER_DRAIN = false;
    bf16_t* C; int ldc;
    __device__ __forceinline__ void operator()(const accq (&acc)[2][2][4][2], const pg8::Unit& u, int wr, int wc, int fr, int fq) const {
        const int row0 = u.pm * 256 + wr * 64 + fr, col0 = u.pn * 256 + wc * 32 + 8 * fq;
#pragma unroll
        for (int ai = 0; ai < 2; ++ai)
#pragma unroll
            for (int m = 0; m < 4; ++m) { bf16_t* rowp = C + (size_t)(row0 + ai * 128 + m * 16) * ldc + col0;
#pragma unroll
                for (int bj = 0; bj < 2; ++bj) { const accq v0 = acc[ai][bj][m][0], v1 = acc[ai][bj][m][1];
                    u32x4 w; w.x = cvt_pk_bf16(v0[0], v0[1]); w.y = cvt_pk_bf16(v0[2], v0[3]); w.z = cvt_pk_bf16(v1[0], v1[1]); w.w = cvt_pk_bf16(v1[2], v1[3]);
                    *(u32x4*)(rowp + bj * 128) = w; } }
    }
};
struct EpiResid {
    static constexpr bool PERM = false, AFTER_DRAIN = false;
    float* X; const float* modl; float* SSP;
    __device__ __forceinline__ void operator()(const accq (&acc)[2][2][4][2], const pg8::Unit& u, int wr, int wc, int fr, int fq) const {
        const int row0 = u.pm * 256 + wr * 64 + fr, col0 = u.pn * 256 + wc * 32 + 4 * fq;
#pragma unroll
        for (int ai = 0; ai < 2; ++ai)
#pragma unroll
            for (int m2 = 0; m2 < 4; m2 += 2) {
                accq gv[2][4], xv[2][4];
#pragma unroll
                for (int mm = 0; mm < 2; ++mm) { const int row = row0 + ai * 128 + (m2 + mm) * 16; const float* rowp = X + (size_t)row * D + col0; const float* gp = modl + (size_t)mod_row(row) * 6 * D + 2 * D + col0;
#pragma unroll
                    for (int bj = 0; bj < 2; ++bj)
#pragma unroll
                        for (int n = 0; n < 2; ++n) { gv[mm][bj * 2 + n] = *(const accq*)(gp + bj * 128 + n * 16); xv[mm][bj * 2 + n] = *(const accq*)(rowp + bj * 128 + n * 16); } }
#pragma unroll
                for (int mm = 0; mm < 2; ++mm) { const int m = m2 + mm, row = row0 + ai * 128 + m * 16; float* rowp = X + (size_t)row * D + col0;
                    float ss = 0.f;
#pragma unroll
                    for (int bj = 0; bj < 2; ++bj)
#pragma unroll
                        for (int n = 0; n < 2; ++n) { const accq x2 = xv[mm][bj * 2 + n] + gv[mm][bj * 2 + n] * acc[ai][bj][m][n]; *(accq*)(rowp + bj * 128 + n * 16) = x2;
                            ss += (x2[0] * x2[0] + x2[1] * x2[1]) + (x2[2] * x2[2] + x2[3] * x2[3]); }
                    SSP[(size_t)row * 64 + (u.pn * 4 + wc) * 4 + fq] = ss; }
            }
    }
};
struct EpiSwiglu {
    static constexpr bool PERM = true, AFTER_DRAIN = false;
    bf16_t* ACT; const float* bgu;
    __device__ __forceinline__ void operator()(const accq (&acc)[2][2][4][2], const pg8::Unit& u, int wr, int wc, int fr, int fq) const {
        constexpr int nN = 2 * D / 256;
        const int e = u.pn / nN, ln = u.pn % nN;
        const int row0 = u.pm * 256 + wr * 64 + fr, cl = 128 * ln + wc * 32 + 8 * fq;
        const float* bg = bgu + (size_t)e * 2 * D + cl;
        accq bgl[2], bli[2];
#pragma unroll
        for (int n = 0; n < 2; ++n) { bgl[n] = *(const accq*)(bg + 4 * n); bli[n] = *(const accq*)(bg + D + 4 * n); }
#pragma unroll
        for (int ai = 0; ai < 2; ++ai)
#pragma unroll
            for (int m = 0; m < 4; ++m) {
                float a[8];
#pragma unroll
                for (int n = 0; n < 2; ++n)
#pragma unroll
                    for (int j = 0; j < 4; ++j) {
                        float glu = acc[ai][0][m][n][j] + bgl[n][j], lin = acc[ai][1][m][n][j] + bli[n][j];
                        glu = fminf(glu, 7.0f); lin = fminf(fmaxf(lin, -7.0f), 7.0f);
                        a[4 * n + j] = glu * FRCP(1.0f + __expf(-1.702f * glu)) * (lin + 1.0f);
                    }
                u32x4 w; w.x = cvt_pk_bf16(a[0], a[1]); w.y = cvt_pk_bf16(a[2], a[3]); w.z = cvt_pk_bf16(a[4], a[5]); w.w = cvt_pk_bf16(a[6], a[7]);
                *(u32x4*)(ACT + (size_t)(row0 + ai * 128 + m * 16) * D + cl) = w;
            }
    }
};
struct EpiDown {
    static constexpr bool PERM = true, AFTER_DRAIN = false;
    bf16_t* YB; const float* bdn;
    __device__ __forceinline__ void operator()(const accq (&acc)[2][2][4][2], const pg8::Unit& u, int wr, int wc, int fr, int fq) const {
        constexpr int nN = D / 256;
        const int e = u.pn / nN, ln = u.pn % nN;
        const int row0 = u.pm * 256 + wr * 64 + fr, col0 = ln * 256 + wc * 32 + 8 * fq;
        const float* bp = bdn + (size_t)e * D + col0;
        accq bv[2][2];
#pragma unroll
        for (int bj = 0; bj < 2; ++bj)
#pragma unroll
            for (int n = 0; n < 2; ++n) bv[bj][n] = *(const accq*)(bp + bj * 128 + 4 * n);
#pragma unroll
        for (int ai = 0; ai < 2; ++ai)
#pragma unroll
            for (int m = 0; m < 4; ++m) { bf16_t* rowp = YB + (size_t)(row0 + ai * 128 + m * 16) * D + col0;
#pragma unroll
                for (int bj = 0; bj < 2; ++bj) { const accq v0 = acc[ai][bj][m][0] + bv[bj][0], v1 = acc[ai][bj][m][1] + bv[bj][1];
                    u32x4 w; w.x = cvt_pk_bf16(v0[0], v0[1]); w.y = cvt_pk_bf16(v0[2], v0[3]); w.z = cvt_pk_bf16(v1[0], v1[1]); w.w = cvt_pk_bf16(v1[2], v1[3]);
                    *(u32x4*)(rowp + bj * 128) = w; } }
    }
};
__host__ __device__ __forceinline__ int gu_row_of_col(int n) { return n < D ? 256 * (n / 128) + n % 128 : 256 * ((n - D) / 128) + 128 + (n - D) % 128; }

#ifndef CPU_TEST
__device__ __forceinline__ int lane_now() { int l; asm volatile("v_mbcnt_lo_u32_b32 %0, -1, 0\n\tv_mbcnt_hi_u32_b32 %0, -1, %0" : "=v"(l)); return l; }
#define SHFL_XOR_F(v, m) __builtin_bit_cast(float, __builtin_amdgcn_ds_bpermute((lane_now() ^ (m)) << 2, __builtin_bit_cast(int, (float)(v))))
template <int CTRL> __device__ __forceinline__ float dppf(float v) { return __builtin_bit_cast(float, __builtin_amdgcn_update_dpp(0, __builtin_bit_cast(int, v), CTRL, 0xF, 0xF, true)); }
#define RED1(v) dppf<0xB1>(v)
#define RED2(v) dppf<0x4E>(v)
#define RED4(v) dppf<0x141>(v)
#define RED8(v) dppf<0x140>(v)
#define RFL(x) __builtin_amdgcn_readfirstlane(x)
#define WAVE_SYNC() __builtin_amdgcn_wave_barrier()
#else
#define SHFL_XOR_F(v, m) shfl_xor_f((v), (m))
#define RED1(v) shfl_xor_f((v), 1)
#define RED2(v) shfl_xor_f((v), 2)
#define RED4(v) shfl_xor_f((v), 4)
#define RED8(v) shfl_xor_f((v), 8)
#define RFL(x) rfl_i(x)
#define LAS
#define WAVE_SYNC() simt::wave_sync()
#endif
__device__ __forceinline__ float wave_sum(float v) {
    v += RED1(v); v += RED2(v); v += RED4(v); v += RED8(v); v += SHFL_XOR_F(v, 16); v += SHFL_XOR_F(v, 32);
    return v;
}
static_assert(D % 256 == 0, "row layout: lane l holds float4 j at element 4l + 256j");
constexpr int RJ = D / 256;
__device__ __forceinline__ float row_rms(const f32x4 (&v)[RJ]) {
    float s = 0.f;
#pragma unroll
    for (int j = 0; j < RJ; ++j) s += (v[j][0] * v[j][0] + v[j][1] * v[j][1]) + (v[j][2] * v[j][2] + v[j][3] * v[j][3]);
    return 1.0f / sqrtf(wave_sum(s) * (1.0f / D) + EPS);
}
__device__ __forceinline__ void row_modulate_store(f32x4 (&v)[RJ], float r, const float* g, const float* shift, const float* scale, bf16_t* o, int lane) {
#pragma unroll
    for (int j = 0; j < RJ; ++j) {
        const int e0 = 4 * lane + 256 * j;
        const f32x4 gv = *(const f32x4*)(g + e0), sh = *(const f32x4*)(shift + e0), sc = *(const f32x4*)(scale + e0);
        v[j] = (v[j] * r * gv) * (sc + 1.0f) + sh;
        unsigned lo = pk2(v[j][0], v[j][1]), hi = pk2(v[j][2], v[j][3]);
        *(unsigned long long*)(o + e0) = (unsigned long long)lo | ((unsigned long long)hi << 32);
    }
}
__device__ __forceinline__ void ph_xinit_w(const Ctx& c, int gw, int ngw, int lane) {
    for (int row = gw; row < NTOK; row += ngw) {
        const float* src = row < NLAT ? c.in[I_X] + (size_t)row * D : c.in[I_CTX] + (size_t)(row - NLAT) * D;
        float* dst = c.x() + (size_t)row * D;
#pragma unroll
        for (int j = 0; j < RJ; ++j) *(f32x4*)(dst + 4 * lane + 256 * j) = *(const f32x4*)(src + 4 * lane + 256 * j);
    }
}
__device__ __forceinline__ void ph_norm1_w(const Ctx& c, int l, int gw, int ngw, int lane) {
    for (int row = gw; row < NTOK; row += ngw) {
        const float* xr = row < NLAT ? c.in[I_X] + (size_t)row * D : c.in[I_CTX] + (size_t)(row - NLAT) * D;
        float* dst = c.x() + (size_t)row * D;
        f32x4 v[RJ];
#pragma unroll
        for (int j = 0; j < RJ; ++j) { v[j] = *(const f32x4*)(xr + 4 * lane + 256 * j); *(f32x4*)(dst + 4 * lane + 256 * j) = v[j]; }
        const float r = row_rms(v);
        const float* m = c.mod(l, mod_row(row));
        row_modulate_store(v, r, c.in[I_N1G] + l * D, m, m + D, c.h() + (size_t)row * D, lane);
    }
}
__device__ __forceinline__ void ph_finish_w(const Ctx& c, int l, int nrows, int gw, int ngw, int lane) {
    const bf16_t* U = c.u();
    const bf16_t* OD = c.odir();
    for (int grp = gw; grp < nrows / 4; grp += ngw) {
        const int row0 = 4 * grp;
        int base, pos, len; seg_of(row0, base, pos, len);
        const int is_lat = row0 < NLAT ? 1 : 0, b = is_lat ? row0 / SEQ : (row0 - NLAT) / CTX;
        const int unit = lane >> 3, sub = lane & 7, hd = unit & 3, col0 = unit * 128 + sub * 16;
        const int hc = sub * 16;
        unsigned long long graw[4][4];
#pragma unroll
        for (int j = 0; j < 4; ++j) { const bf16_t* ur = U + (size_t)(row0 + j) * INP; const bf16_t* gate = unit < 4 ? ur + U_GG + unit * 128 + hc : ur + U_MO + (unit - 4) * 128 + hc;
#pragma unroll
            for (int q = 0; q < 4; ++q) graw[j][q] = *(const unsigned long long*)(gate + 4 * q); }
        float o[4][16];
#pragma unroll
        for (int d = 0; d < 2; ++d) {
            const int q = d == 0 ? pos : len - 1 - pos, n = chunk_of(is_lat, q), qi = q % 64;
            const bf16_t* fp = OD + (unit < 4 ? OF_G : OF_M) + ((((size_t)((b * 4 + hd) * 2 + d) * NCH + n) * 4 + qi / 16) * 8 + sub) * 256 + ((qi % 16) / 4) * 64;
#pragma unroll
            for (int e = 0; e < 16; ++e) { const f32x4 v = ldb4(fp + e * 4);
#pragma unroll
                for (int j = 0; j < 4; ++j) o[j][e] = d == 0 ? v[j] : o[j][e] + v[3 - j]; }
        }
        const float* gw_ = unit < 4 ? c.in[I_GNG] + l * 128 + hc : c.in[I_MNG] + l * 512 + (unit - 4) * 128 + hc;
        f32x4 gv[4];
#pragma unroll
        for (int q = 0; q < 4; ++q) gv[q] = *(const f32x4*)(gw_ + 4 * q);
#pragma unroll
        for (int j = 0; j < 4; ++j) {
            float ss = 0.f;
#pragma unroll
            for (int e = 0; e < 16; ++e) ss += o[j][e] * o[j][e];
            ss += RED1(ss); ss += RED2(ss); ss += RED4(ss);
            const float r = 1.0f / sqrtf(ss * (1.0f / 128.f) + EPS);
            unsigned w[8];
#pragma unroll
            for (int q = 0; q < 4; ++q) { const f32x4 ga = cvtb4(graw[j][q]); float t[4];
#pragma unroll
                for (int e = 0; e < 4; ++e) t[e] = o[j][4 * q + e] * r * gv[q][e] * (unit < 4 ? siluf_(ga[e]) : sigmoidf_(ga[e]));
                w[2 * q] = pk2(t[0], t[1]); w[2 * q + 1] = pk2(t[2], t[3]); }
            bf16_t* yr = c.y() + (size_t)(row0 + j) * MIXW + col0;
            *(u32x4*)yr = (u32x4){w[0], w[1], w[2], w[3]}; *(u32x4*)(yr + 8) = (u32x4){w[4], w[5], w[6], w[7]};
            CBAR();
        }
    }
    for (int grp = gw; grp < nrows / 4; grp += ngw) {
        const int srow0 = 4 * grp;
        int base, spos, len; seg_of(srow0, base, spos, len);
        const int is_lat = srow0 < NLAT ? 1 : 0, b = is_lat ? srow0 / SEQ : (srow0 - NLAT) / CTX;
        const int ch0 = 8 * lane, hd = ch0 / 64, wc = (ch0 % 64) / 16, cc0 = ch0 % 16;
        const float dsk = c.in[I_2D][l * 8 + hd];
        unsigned long long xraw[4][2], zraw[4][2];
#pragma unroll
        for (int j = 0; j < 4; ++j) { const int srow = srow0 + j, row = tokrow_of_srow(srow); const bf16_t* xr = c.xbc() + (size_t)srow * 512 + ch0; const bf16_t* ur = U + (size_t)row * INP + U_Z + ch0;
#pragma unroll
            for (int q = 0; q < 2; ++q) { xraw[j][q] = *(const unsigned long long*)(xr + 4 * q); zraw[j][q] = *(const unsigned long long*)(ur + 4 * q); } }
        float acc[4][8];
#pragma unroll
        for (int d = 0; d < 2; ++d) {
            const int q = d == 0 ? spos : len - 1 - spos, n = chunk_of(is_lat, q), qi = q % 64;
            const bf16_t* fp = OD + OF_S + ((((size_t)((b * 8 + hd) * 2 + d) * NCH + n) * 4 + qi / 16) * 4 + wc) * 256 + ((qi % 16) / 4) * 64 + cc0 * 4;
#pragma unroll
            for (int e = 0; e < 8; ++e) { const f32x4 v = ldb4(fp + e * 4);
#pragma unroll
                for (int j = 0; j < 4; ++j) acc[j][e] = d == 0 ? v[j] : acc[j][e] + v[3 - j]; }
        }
        const float* ng = c.in[I_2NG] + l * 512 + ch0;
        const f32x4 g0 = *(const f32x4*)ng, g1 = *(const f32x4*)(ng + 4);
#pragma unroll
        for (int j = 0; j < 4; ++j) {
            const int srow = srow0 + j, row = tokrow_of_srow(srow);
            float yv[8]; float ss = 0.f;
#pragma unroll
            for (int q = 0; q < 2; ++q) { const f32x4 xs = cvtb4(xraw[j][q]), z = cvtb4(zraw[j][q]);
#pragma unroll
                for (int e = 0; e < 4; ++e) { const float t = (acc[j][4 * q + e] + dsk * xs[e]) * siluf_(z[e]); yv[4 * q + e] = t; ss += t * t; } }
            ss += RED1(ss); ss += RED2(ss); ss += RED4(ss); ss += RED8(ss); ss += SHFL_XOR_F(ss, 16);
            const float r = 1.0f / sqrtf(ss * (1.0f / 256.f) + EPS);
            *(u32x4*)(c.y() + (size_t)row * MIXW + 1024 + ch0) = (u32x4){pk2(yv[0] * r * g0[0], yv[1] * r * g0[1]), pk2(yv[2] * r * g0[2], yv[3] * r * g0[3]), pk2(yv[4] * r * g1[0], yv[5] * r * g1[1]), pk2(yv[6] * r * g1[2], yv[7] * r * g1[3])};
            CBAR();
        }
    }
}
constexpr int ROUTE_R = 4, ROUTE_LDS = (ROUTE_R * D + ROUTE_R * NE) * 4;
__device__ __forceinline__ void ph_route_w(const Ctx& c, int l, int nrows, LAS float* wlds, int gw, int ngw, int lane, bool dummy = false) {
    LAS float* hv = wlds; LAS float* lgs = wlds + ROUTE_R * D;
    const float* rw = c.in[I_RW] + (size_t)l * D * NE;
    for (int r0 = gw * ROUTE_R; r0 < nrows; r0 += ngw * ROUTE_R) {
#pragma unroll
        for (int q = 0; q < ROUTE_R; ++q) {
            const int row = r0 + q;
            const float* xr = c.x() + (size_t)row * D;
            f32x4 v[RJ];
#pragma unroll
            for (int j = 0; j < RJ; ++j) v[j] = *(const f32x4*)(xr + 4 * lane + 256 * j);
            const float r = row_rms(v);
            const float* m = c.mod(l, mod_row(row));
            row_modulate_store(v, r, c.in[I_N2G] + l * D, m + 3 * D, m + 4 * D, c.h() + (size_t)row * D, lane);
#pragma unroll
            for (int j = 0; j < RJ; ++j) *(LAS f32x4*)(hv + q * D + 4 * lane + 256 * j) = v[j];
        }
        WAVE_SYNC();
        const int e = lane & 31, kh = lane >> 5;
        float acc[ROUTE_R];
#pragma unroll
        for (int q = 0; q < ROUTE_R; ++q) acc[q] = 0.f;
        for (int k = kh * (D / 2); k < (kh + 1) * (D / 2); k += 4) {
            const float w0 = rw[(size_t)(k + 0) * NE + e], w1 = rw[(size_t)(k + 1) * NE + e], w2 = rw[(size_t)(k + 2) * NE + e], w3 = rw[(size_t)(k + 3) * NE + e];
#pragma unroll
            for (int q = 0; q < ROUTE_R; ++q) { const f32x4 hq = *(const LAS f32x4*)(hv + q * D + k); acc[q] += (hq[0] * w0 + hq[1] * w1) + (hq[2] * w2 + hq[3] * w3); }
        }
#pragma unroll
        for (int q = 0; q < ROUTE_R; ++q) { acc[q] += SHFL_XOR_F(acc[q], 32); if (kh == 0) lgs[q * NE + e] = acc[q] + c.in[I_RB][l * NE + e]; }
        WAVE_SYNC();
        if (lane < ROUTE_R) {
            const int row = r0 + lane;
            float lg[NE];
#pragma unroll
            for (int i = 0; i < NE; ++i) lg[i] = lgs[lane * NE + i];
            int te[TOPK]; float tv[TOPK];
#pragma unroll
            for (int kk = 0; kk < TOPK; ++kk) {
                int best = -1; float bv = 0.f;
#pragma unroll
                for (int i = 0; i < NE; ++i) {
                    bool taken = false;
#pragma unroll
                    for (int j = 0; j < kk; ++j) taken = taken || (te[j] == i);
                    if (!taken && (best < 0 || lg[i] > bv)) { best = i; bv = lg[i]; }
                }
                te[kk] = best; tv[kk] = bv;
            }
            float se = 0.f, ex[TOPK];
#pragma unroll
            for (int kk = 0; kk < TOPK; ++kk) { ex[kk] = expf(tv[kk] - tv[0]); se += ex[kk]; }
#pragma unroll
            for (int kk = 0; kk < TOPK; ++kk) {
                c.tope()[row * TOPK + kk] = te[kk];
                c.topg()[row * TOPK + kk] = ex[kk] / se;
                c.pos()[row * TOPK + kk] = atomicAdd(c.cnt(l) + (dummy ? DEPTH * NE * CNTS : 0) + te[kk] * CNTS, 1);
            }
        }
        WAVE_SYNC();
    }
}
template <class TB> __device__ __forceinline__ void ph_rowtok_w(const Ctx& c, int l, int nrows, TB tb, int gt, int gs) {
    for (int it = gt; it < nrows * TOPK; it += gs) {
        const int d = tb[c.tope()[it]] * 256 + c.pos()[it];
        c.dest()[it] = d; c.rtok()[d] = it / TOPK;
    }
    const int* cn = c.cnt(l);
    for (int it = gt; it < NE * 256; it += gs) {
        const int e = it / 256, p = it % 256, n = cn[e * CNTS], nt = (n + 255) / 256;
        if (nt > 0 && (nt - 1) * 256 + p >= n) c.rtok()[tb[e] * 256 + (nt - 1) * 256 + p] = 0;
    }
}
template <int NR> __device__ __forceinline__ void comb_rows(const Ctx& c, int l, const int (&rows)[NR], int lane, bool dummy) {
    typedef int i32x4 __attribute__((ext_vector_type(4)));
    const bool last = (l == DEPTH - 1);
    i32x4 dd[NR]; f32x4 gk[NR];
#pragma unroll
    for (int a = 0; a < NR; ++a) { dd[a] = *(const i32x4*)(c.dest() + rows[a] * TOPK); gk[a] = *(const f32x4*)(c.topg() + rows[a] * TOPK); }
    f32x4 v[NR][RJ];
#pragma unroll
    for (int a = 0; a < NR; ++a) {
        const float* xr = c.x() + (size_t)rows[a] * D;
        const float* m = c.mod(l, mod_row(rows[a])) + 5 * D;
        const bf16_t* y0 = c.yb() + (size_t)dd[a][0] * D; const bf16_t* y1 = c.yb() + (size_t)dd[a][1] * D; const bf16_t* y2 = c.yb() + (size_t)dd[a][2] * D; const bf16_t* y3 = c.yb() + (size_t)dd[a][3] * D;
#pragma unroll
        for (int j = 0; j < RJ; ++j) { const int e0 = 4 * lane + 256 * j;
            const f32x4 s = (ldb4(y0 + e0) * gk[a][0] + ldb4(y1 + e0) * gk[a][1]) + (ldb4(y2 + e0) * gk[a][2] + ldb4(y3 + e0) * gk[a][3]);
            v[a][j] = *(const f32x4*)(xr + e0) + *(const f32x4*)(m + e0) * s; }
    }
    f32x4 ng[RJ];
    { const float* gp = last ? c.in[I_FNG] : c.in[I_N1G] + (l + 1) * D;
#pragma unroll
      for (int j = 0; j < RJ; ++j) ng[j] = *(const f32x4*)(gp + 4 * lane + 256 * j); }
#pragma unroll
    for (int a = 0; a < NR; ++a) {
        const int row = rows[a];
        f32x4 nsh[RJ], nsc[RJ];
        { const float* mn = c.mod(last ? l : l + 1, mod_row(row));
#pragma unroll
          for (int j = 0; j < RJ; ++j) { nsh[j] = *(const f32x4*)(mn + 4 * lane + 256 * j); nsc[j] = *(const f32x4*)(mn + D + 4 * lane + 256 * j); } }
        const float r = row_rms(v[a]);
        if (last) {
#pragma unroll
            for (int j = 0; j < RJ; ++j) { const int e0 = 4 * lane + 256 * j; *(f32x4*)(c.out + (size_t)row * D + e0) = v[a][j] * r * ng[j]; }
        } else {
            float* xr = c.x() + (size_t)row * D;
#pragma unroll
            for (int j = 0; j < RJ; ++j) *(f32x4*)((dummy ? c.od2() + (size_t)row * D : xr) + 4 * lane + 256 * j) = v[a][j];
            bf16_t* ho = c.h() + (size_t)row * D;
#pragma unroll
            for (int j = 0; j < RJ; ++j) { const f32x4 t = (v[a][j] * r * ng[j]) * (nsc[j] + 1.0f) + nsh[j];
                const unsigned lo = pk2(t[0], t[1]), hi = pk2(t[2], t[3]);
                *(unsigned long long*)(ho + 4 * lane + 256 * j) = (unsigned long long)lo | ((unsigned long long)hi << 32); }
        }
    }
}
__device__ __forceinline__ void ph_combine_w(const Ctx& c, int l, int nrows, int gw, int ngw, int lane, bool dummy = false) {
    int row = gw;
    for (; row + 2 * ngw < nrows; row += 3 * ngw) { const int rows[3] = {row, row + ngw, row + 2 * ngw}; comb_rows<3>(c, l, rows, lane, dummy); }
    if (row + ngw < nrows) { const int rows[2] = {row, row + ngw}; comb_rows<2>(c, l, rows, lane, dummy); }
    else if (row < nrows) { const int rows[1] = {row}; comb_rows<1>(c, l, rows, lane, dummy); }
}
__device__ __forceinline__ void ph_mod_w(const Ctx& c, LAS float* tab, int tid, int blk, int G) {
    LAS float* part = tab + (NB + 1) * D;
    for (int i = tid; i < (NB + 1) * D; i += 512) { const int r = i / D, k = i % D; tab[i] = siluf_(r < NB ? c.in[I_C][r * D + k] : c.in[I_CCTX][k]); }
    __syncthreads();
    const int lane = tid & 63, w = tid >> 6;
    for (int cbk = blk; cbk < DEPTH * 6 * D / 64; cbk += G) {
        const int l = cbk / (6 * D / 64), col = (cbk % (6 * D / 64)) * 64 + lane;
        const float* wp = c.in[I_WMOD] + (size_t)l * D * 6 * D + col + (size_t)(w * (D / 8)) * 6 * D;
        float acc[NB + 1];
#pragma unroll
        for (int r = 0; r <= NB; ++r) acc[r] = 0.f;
        for (int k0 = 0; k0 < D / 8; k0 += 16) { float wv[16];
#pragma unroll
            for (int e = 0; e < 16; ++e) wv[e] = wp[(size_t)(k0 + e) * 6 * D];
#pragma unroll
            for (int e = 0; e < 16; ++e)
#pragma unroll
                for (int r = 0; r <= NB; ++r) acc[r] += tab[r * D + w * (D / 8) + k0 + e] * wv[e]; }
#pragma unroll
        for (int r = 0; r <= NB; ++r) part[(w * (NB + 1) + r) * 64 + lane] = acc[r];
        __syncthreads();
        for (int i = tid; i < (NB + 1) * 64; i += 512) { const int r = i / 64, cc = i % 64; float s = 0.f;
#pragma unroll
            for (int ww = 0; ww < 8; ++ww) s += part[(ww * (NB + 1) + r) * 64 + cc];
            const int colo = (cbk % (6 * D / 64)) * 64 + cc;
            c.mod(l, r)[colo] = s + c.in[I_BMOD][l * 6 * D + colo]; }
        __syncthreads();
    }
}
__host__ __device__ __forceinline__ void ph_foldgate(const Ctx& c, int gt, int gs) {
    for (int it = gt; it < DEPTH * (D / 8) * 512; it += gs) {
        const int col = it % 512, k0 = ((it / 512) % (D / 8)) * 8, l = it / (512 * (D / 8)), d = col / 256, cc = col % 256;
        const float* w2 = c.in[I_GW2] + ((size_t)(l * 2 + d) * 16) * 256 + cc;
        float w2r[16];
#pragma unroll
        for (int r = 0; r < 16; ++r) w2r[r] = w2[r * 256];
        float a[8];
#pragma unroll
        for (int e = 0; e < 8; ++e) { const float* wi = c.in[I_WIN] + ((size_t)l * D + k0 + e) * INW + U_GLR + 16 * d; float s = 0.f;
#pragma unroll
            for (int q = 0; q < 4; ++q) { const f32x4 t = *(const f32x4*)(wi + 4 * q); s += t[0] * w2r[4 * q] + t[1] * w2r[4 * q + 1] + t[2] * w2r[4 * q + 2] + t[3] * w2r[4 * q + 3]; }
            a[e] = s; }
        *(u32x4*)(c.win(l) + (size_t)(INW + col) * D + k0) = (u32x4){pk2(a[0], a[1]), pk2(a[2], a[3]), pk2(a[4], a[5]), pk2(a[6], a[7])};
    }
}

__host__ __device__ __forceinline__ void ph_rwsplit(const Ctx& c, int gt, int gs) {
    for (int it = gt; it < DEPTH * NE * D; it += gs) {
        const int e = it % NE, k = (it / NE) % D, l = it / (NE * D);
        const float w = c.in[I_RW][((size_t)l * D + k) * NE + e];
        const unsigned hi = f2bf(w); const float lo = w - bf2f((bf16_t)hi);
        bf16_t* T = c.wsb(WS_RWT) + (size_t)l * 2 * NE * D;
        T[(size_t)e * D + k] = (bf16_t)hi; T[(size_t)(NE + e) * D + k] = (bf16_t)f2bf(lo);
    }
}

__host__ __device__ __forceinline__ u32x4 pack8(const float* v) { return (u32x4){pk2(v[0], v[1]), pk2(v[2], v[3]), pk2(v[4], v[5]), pk2(v[6], v[7])}; }

struct SegC { int base, len, q0; };
__host__ __device__ __forceinline__ SegC seg_of_chunk(int b, int n) { SegC s; if (n < CTX / 64) { s.base = NLAT + b * CTX; s.len = CTX; s.q0 = 64 * n; } else { s.base = b * SEQ; s.len = SEQ; s.q0 = 64 * (n - CTX / 64); } return s; }
__host__ __device__ __forceinline__ int seg_row(const SegC& s, int dir, int q) { return s.base + (dir == 0 ? q : s.len - 1 - q); }
__host__ __device__ __forceinline__ float tap_at(const bf16_t* U, const SegC& s, int dir, int q, int ucol, bool colmajor) {
    const bool ok = q >= 0 && q < s.len; const int qc = q < 0 ? 0 : (q >= s.len ? s.len - 1 : q);
    const int r = seg_row(s, dir, qc);
    const float v = bf2f(U[(size_t)(colmajor ? tokrow_of_srow(r) : r) * INP + ucol]);
    return ok ? v : 0.f;
}

#ifndef CPU_TEST
#define MFMA16(a, b, c) __builtin_amdgcn_mfma_f32_16x16x32_bf16((a), (b), (c), 0, 0, 0)
#else
#define MFMA16(a, b, c) mfma16_emul((a), (b), (c))
#endif
#ifndef CPU_TEST
#define LDS_BAR() do { asm volatile("s_waitcnt lgkmcnt(0)" ::: "memory"); __builtin_amdgcn_s_barrier(); asm volatile("" ::: "memory"); } while (0)
#else
#define LDS_BAR() __syncthreads()
#endif
typedef LAS unsigned char* ldsp_t;
typedef unsigned long long u64_t;
__device__ __forceinline__ bf16x8 lds_rd16(ldsp_t p) { return *(const LAS bf16x8*)p; }
__device__ __forceinline__ bf16x8 lds_rd8x2(ldsp_t p0, ldsp_t p1) { const u64_t a = *(const LAS u64_t*)p0, b = *(const LAS u64_t*)p1; u32x4 v = {(unsigned)a, (unsigned)(a >> 32), (unsigned)b, (unsigned)(b >> 32)}; return __builtin_bit_cast(bf16x8, v); }
template <int KIND> struct ChainCfg {
    static constexpr int DK = KIND == 2 ? 128 : 64, DV = KIND == 2 ? 64 : 128, NCW = DV / 16, KSPLIT = 8 / NCW, KS = DK / 32, KT = DK / 16, KSL = KS / KSPLIT, KTL = KT / KSPLIT, NPC = DK / 64;
    static constexpr int RS_T = DK * 2 + 16, RS_F = 144, OFF_KB = 64 * RS_T, OFF_KDT = 128 * RS_T, OFF_SC = OFF_KDT + DK * RS_F, BUFSZ = OFF_SC + 1024;
    static constexpr int OFF_P = 2 * BUFSZ, OFF_N = OFF_P + 64 * 144, OFF_DEN = OFF_N + 256, OFF_V = OFF_DEN + 1280, RS_V = DV * 2 + 16;
    static constexpr int LDS_NEED = OFF_V + (KIND == 2 ? 4 * 16 * 64 * 4 : 2 * 64 * RS_V);
    static constexpr int SCB = KIND == 0 ? 256 : KIND == 1 ? 1024 : 512;
    static_assert(LDS_NEED <= 139264, "chain LDS");
};
#ifndef CPU_TEST
#define LDS_ADDF(p, v) (void)__hip_atomic_fetch_add((p), (v), __ATOMIC_RELAXED, __HIP_MEMORY_SCOPE_WORKGROUP)
#else
#define LDS_ADDF(p, v) (*(p) += (v))
#endif
template <int KIND> __device__ __forceinline__ void chain_run(const Ctx& c, ldsp_t lds, int cid, int tid, bool noload = false, bool nostore = false) {
    typedef ChainCfg<KIND> CF;
    constexpr int DK = CF::DK, DV = CF::DV, NCW = CF::NCW, KS = CF::KS, KSL = CF::KSL, KTL = CF::KTL, NPC = CF::NPC, RS_T = CF::RS_T, RS_F = CF::RS_F;
    const int lane = tid & 63, w = RFL(tid >> 6), cc = lane & 15, g = lane >> 4;
    const int wc = w % NCW, kh = w / NCW;
    const bool outw = kh == 0;
    const int dir = cid % 2, hh = KIND == 2 ? (cid / 2) % 8 : (cid / 2) % 4, b = KIND == 2 ? cid / 16 : cid / 8;
    constexpr bool SHQ = KIND != 0, SHD = KIND == 2;
    const bool mir = dir == 1;
    const size_t opc = KIND == 2 ? (size_t)((b * 2 + hh / 4) * 2 + (SHQ ? 0 : dir)) * NCH : (size_t)(SHQ ? cid - dir : cid) * NCH;
    const size_t opd = KIND == 2 ? opc : (size_t)cid * NCH;
    const size_t vpc = (size_t)cid * NCH;
    const bf16_t* gQA = c.wsb(KIND == 0 ? WS_GQA : KIND == 1 ? WS_MQA : WS_SQA) + opc * (64 * DK);
    const bf16_t* gKB = c.wsb(KIND == 0 ? WS_GKB : KIND == 1 ? WS_MKB : WS_SKB) + opc * (64 * DK);
    const bf16_t* gKDT = c.wsb(KIND == 0 ? WS_GKDT : KIND == 1 ? WS_MKDT : WS_SKDT) + opd * (64 * DK);
    const bf16_t* gVT = c.wsb(WS_SVT) + vpc * (64 * DV);
    const bf16_t* gU = c.u() + (KIND == 0 ? U_GV : U_MV) + hh * 128;
    const bf16_t* gVHT = c.wsb(WS_SVHT) + vpc * (64 * DV);
    const unsigned char* gSC = (const unsigned char*)(KIND == 0 ? c.wsf(WS_GAL) + vpc * 64 : KIND == 1 ? c.wsf(WS_MMS) + vpc * 256 : c.wsf(WS_SCS) + vpc * 128);
    bf16_t* Og = c.odir() + (KIND == 0 ? OF_G : KIND == 1 ? OF_M : OF_S) + (size_t)cid * NCH * (4 * NCW * 256) + (wc * 64 + lane) * 4;
    LAS float* DEN = (LAS float*)(lds + CF::OFF_DEN);
    LAS float* XR = (LAS float*)(lds + CF::OFF_V);

    f32x4 S[KTL];
#pragma unroll
    for (int kt = 0; kt < KTL; ++kt) S[kt] = (f32x4){0.f, 0.f, 0.f, 0.f};
    float m0 = -1e30f;
    if (KIND == 1 && tid < 64) ((LAS float*)(lds + CF::OFF_N))[tid] = 0.f;

    u32x4 sq[NPC], sk[NPC], sd[NPC], ssc = {0u, 0u, 0u, 0u}, sv[2]; bf16x8 vf[2], vh[2], vfn[2], vhn[2];
#define CHAIN_LOAD(n_) do { const size_t cb_ = (size_t)(n_); const int nm_ = (int)cb_ < CTX / 64 ? CTX / 64 - 1 - (int)cb_ : CTX / 64 + NCH - 1 - (int)cb_; const size_t cq_ = (SHQ && mir) ? (size_t)nm_ : cb_, cd_ = (SHD && mir) ? (size_t)nm_ : cb_; \
        _Pragma("unroll") for (int q = 0; q < NPC; ++q) { const int p = tid + 512 * q; sq[q] = *(const u32x4*)(gQA + cq_ * (64 * DK) + p * 8); sk[q] = *(const u32x4*)(gKB + cq_ * (64 * DK) + p * 8); if (KIND == 1) sd[q] = *(const u32x4*)(gKDT + cd_ * (64 * DK) + p * 8); } \
        if (tid < CF::SCB / 16) ssc = *(const u32x4*)(gSC + cb_ * CF::SCB + tid * 16); \
        if (KIND == 2) { _Pragma("unroll") for (int s = 0; s < 2; ++s) { if (outw) vfn[s] = *(const bf16x8*)(gVT + cb_ * (64 * DV) + (16 * wc + cc) * 64 + 32 * s + 8 * g); vhn[s] = *(const bf16x8*)(gVHT + cb_ * (64 * DV) + (16 * wc + cc) * 64 + 32 * s + 8 * g); } } \
        else { _Pragma("unroll") for (int q = 0; q < 2; ++q) { const int p = tid + 512 * q; sv[q] = *(const u32x4*)(gU + (size_t)scan_row(b, dir, 64 * (int)cb_ + p / 16) * INP + (p % 16) * 8); } } } while (0)
#define CHAIN_STAGE(buf_) do { ldsp_t d_ = lds + (buf_) * CF::BUFSZ; \
        _Pragma("unroll") for (int q = 0; q < NPC; ++q) { const int p = tid + 512 * q; const int rt0 = p / (DK / 8), ct = p % (DK / 8), rt = (SHQ && mir) ? 63 - rt0 : rt0; *(LAS u32x4*)(d_ + rt * RS_T + ct * 16) = sq[q]; *(LAS u32x4*)(d_ + CF::OFF_KB + rt * RS_T + ct * 16) = sk[q]; \
            if (KIND == 1) *(LAS u32x4*)(d_ + CF::OFF_KDT + (p / 8) * RS_F + (p % 8) * 16) = sd[q]; } \
        if (tid < CF::SCB / 16) *(LAS u32x4*)(d_ + CF::OFF_SC + tid * 16) = ssc; \
        if (KIND == 2) { vf[0] = vfn[0]; vf[1] = vfn[1]; vh[0] = vhn[0]; vh[1] = vhn[1]; } \
        else { _Pragma("unroll") for (int q = 0; q < 2; ++q) { const int p = tid + 512 * q; *(LAS u32x4*)(lds + CF::OFF_V + (buf_) * (64 * CF::RS_V) + (p / 16) * CF::RS_V + (p % 16) * 16) = sv[q]; } } } while (0)
    CHAIN_LOAD(0); CHAIN_STAGE(0);
    LDS_BAR();

    for (int n = 0; n < NCH; ++n) {
        ldsp_t cur = lds + (n & 1) * CF::BUFSZ;
        const LAS float* SC = (const LAS float*)(cur + CF::OFF_SC);
        if (n + 1 < NCH && !noload) CHAIN_LOAD(n + 1);
#pragma unroll
        for (int tt = 0; tt < 2; ++tt) {
            const int t = 2 * w + tt, jt = t >> 2, it = t & 3;
            f32x4 acc = {0.f, 0.f, 0.f, 0.f};
#pragma unroll
            for (int s = 0; s < KS; ++s) acc = MFMA16(lds_rd16(cur + CF::OFF_KB + (16 * jt + cc) * RS_T + (32 * s + 8 * g) * 2), lds_rd16(cur + (16 * it + cc) * RS_T + (32 * s + 8 * g) * 2), acc);
            const int i = 16 * it + cc, j0 = 16 * jt + 4 * g;
            float pi = 0.f;
            if (KIND == 1) pi = fmaxf(m0, SC[i * 4 + 2]);
            if (KIND == 2) pi = SC[i * 2];
            float pv[4];
#pragma unroll
            for (int r = 0; r < 4; ++r) { const int j = j0 + r; float d = 1.f;
                if (KIND == 1) d = __expf(SC[j * 4 + 1] - pi);
                if (KIND == 2) d = __expf(pi - SC[j * 2]);
                pv[r] = j <= i ? acc[r] * d : 0.f; }
            const unsigned p01 = pk2(pv[0], pv[1]), p23 = pk2(pv[2], pv[3]);
            *(LAS u64_t*)(lds + CF::OFF_P + i * 144 + j0 * 2) = (u64_t)p01 | ((u64_t)p23 << 32);
            if (KIND == 1) {
                float unp[4]; { unsigned t0 = p01 << 16, t1 = p01 & 0xffff0000u, t2 = p23 << 16, t3 = p23 & 0xffff0000u; __builtin_memcpy(&unp[0], &t0, 4); __builtin_memcpy(&unp[1], &t1, 4); __builtin_memcpy(&unp[2], &t2, 4); __builtin_memcpy(&unp[3], &t3, 4); }
                float rs_ = (unp[0] + unp[1]) + (unp[2] + unp[3]);
                rs_ += SHFL_XOR_F(rs_, 16); rs_ += SHFL_XOR_F(rs_, 32);
                if (g == 0) DEN[jt * 64 + i] = jt <= it ? rs_ : 0.f;
            }
        }
        f32x4 ai[4], ap[4];
        {
            bf16x8 sf[KSL];
#pragma unroll
            for (int s = 0; s < KSL; ++s) { u32x4 v = {pk2(S[2 * s][0], S[2 * s][1]), pk2(S[2 * s][2], S[2 * s][3]), pk2(S[2 * s + 1][0], S[2 * s + 1][1]), pk2(S[2 * s + 1][2], S[2 * s + 1][3])}; sf[s] = __builtin_bit_cast(bf16x8, v); }
#pragma unroll
            for (int it = 0; it < 4; ++it) {
                ai[it] = (f32x4){0.f, 0.f, 0.f, 0.f};
#pragma unroll
                for (int s = 0; s < KSL; ++s) { ldsp_t qa = cur + (16 * it + cc) * RS_T + (32 * (kh * KSL + s) + 4 * g) * 2; ai[it] = MFMA16(lds_rd8x2(qa, qa + 32), sf[s], ai[it]); }
            }
            if (KIND == 2 && !outw) {
#pragma unroll
                for (int it = 0; it < 4; ++it) *(LAS f32x4*)(XR + ((wc * 4 + it) * 64 + lane) * 4) = ai[it];
            }
        }
        if (KIND == 1) {
            const int row = tid >> 3, part = tid & 7;
            const bf16x8 qr = lds_rd16(cur + row * RS_T + part * 16);
            const LAS float* n0 = (const LAS float*)(lds + CF::OFF_N) + part * 8;
            float sqn = 0.f;
#pragma unroll
            for (int e = 0; e < 8; ++e) sqn += bf2f((bf16_t)qr[e]) * n0[e];
            sqn += RED1(sqn); sqn += RED2(sqn); sqn += RED4(sqn);
            if (part == 0) DEN[4 * 64 + row] = __expf(m0 - fmaxf(m0, SC[row * 4 + 2])) * sqn;
        }
        LDS_BAR();
        float c0 = 1.f, c1 = 1.f;
        if (KIND == 1) { const float rL = SC[63 * 4 + 2], ML = fmaxf(m0, rL); c0 = __expf(m0 - ML); c1 = __expf(rL - ML); }
        if (KIND == 2) c0 = __expf(SC[63 * 2]);
        if (KIND == 1) {
            const int krow = tid >> 3, part = tid & 7;
            const bf16x8 kr = lds_rd16(cur + CF::OFF_KDT + krow * RS_F + part * 16);
            float s = 0.f;
#pragma unroll
            for (int e = 0; e < 8; ++e) s += bf2f((bf16_t)kr[e]);
            s += RED1(s); s += RED2(s); s += RED4(s);
            if (part == 0) { LAS float* np = (LAS float*)(lds + CF::OFF_N) + krow; *np = c0 * *np + c1 * s; }
        }
        if (KIND != 2) {
            const LAS bf16_t* vi = (const LAS bf16_t*)(lds + CF::OFF_V + (n & 1) * (64 * CF::RS_V)) + 16 * wc + cc;
#pragma unroll
            for (int s = 0; s < 2; ++s) { unsigned pkd[4];
#pragma unroll
                for (int e = 0; e < 4; ++e) { const unsigned lo_ = vi[(32 * s + 8 * g + 2 * e) * (CF::RS_V / 2)], hi_ = vi[(32 * s + 8 * g + 2 * e + 1) * (CF::RS_V / 2)]; pkd[e] = lo_ | (hi_ << 16); }
                const u32x4 pv_ = {pkd[0], pkd[1], pkd[2], pkd[3]}; vf[s] = __builtin_bit_cast(bf16x8, pv_); }
        }
        if (outw) {
#pragma unroll
            for (int it = 0; it < 4; ++it) {
                if (KIND == 2) ai[it] = ai[it] + *(const LAS f32x4*)(XR + ((wc * 4 + it) * 64 + lane) * 4);
                ap[it] = KIND == 0 ? ai[it] : (f32x4){0.f, 0.f, 0.f, 0.f};
#pragma unroll
                for (int s = 0; s < 2; ++s) ap[it] = MFMA16(lds_rd16(lds + CF::OFF_P + (16 * it + cc) * 144 + (32 * s + 8 * g) * 2), vf[s], ap[it]);
            }
#pragma unroll
            for (int it = 0; it < 4; ++it) {
                f32x4 ov;
                const int i0 = 16 * it + 4 * g;
                if (KIND == 1) {
                    const f32x4 d0 = *(const LAS f32x4*)(DEN + i0), d1 = *(const LAS f32x4*)(DEN + 64 + i0), d2 = *(const LAS f32x4*)(DEN + 128 + i0), d3 = *(const LAS f32x4*)(DEN + 192 + i0), d4 = *(const LAS f32x4*)(DEN + 256 + i0);
                    const f32x4 den4 = ((d0 + d1) + (d2 + d3)) + d4;
#pragma unroll
                    for (int r = 0; r < 4; ++r) { const f32x4 sc = *(const LAS f32x4*)(SC + (i0 + r) * 4);
                        const float Mi = fmaxf(m0, sc[2]);
                        ov[r] = (ap[it][r] + __expf(m0 - Mi) * ai[it][r]) * FRCP(fmaxf(fabsf(den4[r]), __expf(-sc[0] - Mi))); }
                } else {
#pragma unroll
                    for (int r = 0; r < 4; ++r) { float o = ap[it][r]; if (KIND == 2) o = o + __expf(SC[(i0 + r) * 2]) * ai[it][r]; ov[r] = o; }
                }
                if (!nostore) *(u64_t*)(Og + (size_t)((n * 4 + it) * NCW) * 256) = (u64_t)pk2(ov[0], ov[1]) | ((u64_t)pk2(ov[2], ov[3]) << 32);
            }
        }
#pragma unroll
        for (int kt = 0; kt < KTL; ++kt) {
            const int ktg = kh * KTL + kt;
            if (KIND == 2) S[kt] = S[kt] * c0;
            f32x4 T = KIND == 1 ? (f32x4){0.f, 0.f, 0.f, 0.f} : S[kt];
#pragma unroll
            for (int s = 0; s < 2; ++s) {
                bf16x8 ka;
                if (KIND == 1) ka = lds_rd16(cur + CF::OFF_KDT + (16 * ktg + cc) * RS_F + (32 * s + 8 * g) * 2);
                else {
                    const LAS bf16_t* kb = (const LAS bf16_t*)(cur + CF::OFF_KB) + 16 * ktg + cc; unsigned pk_[4];
#pragma unroll
                    for (int e = 0; e < 4; ++e) { const unsigned lo_ = kb[(32 * s + 8 * g + 2 * e) * (RS_T / 2)], hi_ = kb[(32 * s + 8 * g + 2 * e + 1) * (RS_T / 2)]; pk_[e] = lo_ | (hi_ << 16); }
                    const u32x4 kv_ = {pk_[0], pk_[1], pk_[2], pk_[3]}; ka = __builtin_bit_cast(bf16x8, kv_); }
                T = MFMA16(ka, KIND == 2 ? vh[s] : vf[s], T);
            }
            S[kt] = KIND == 1 ? S[kt] * c0 + T * c1 : T;
            if (KIND == 0) { const f32x4 al = *(const LAS f32x4*)(SC + 16 * ktg + 4 * g); S[kt] = S[kt] * al; }
            if (kt & 1) CBAR();
        }
        if (KIND == 1) m0 = SC[63 * 4] + fmaxf(m0, SC[63 * 4 + 2]);
        if (n + 1 < NCH) CHAIN_STAGE((n + 1) & 1);
        LDS_BAR();
    }
#undef CHAIN_LOAD
#undef CHAIN_STAGE
}
__device__ __forceinline__ void ph_chain(const Ctx& c, ldsp_t lds, int blk, int G, int tid, int kmask = 7) {
    const bool noload = false, nostore = (kmask & 8) != 0;
    (void)G;
    const int ch = blk;
    if (ch < NB * 8) { if (kmask & 1) chain_run<0>(c, lds, ch, tid, noload, nostore); }
    else if (ch < NB * 16) { if (kmask & 2) chain_run<1>(c, lds, ch - NB * 8, tid, noload, nostore); }
    else if (ch < NB * 32) { if (kmask & 4) chain_run<2>(c, lds, ch - NB * 16, tid, noload, nostore); }
}

constexpr int ROUTE_M_LDS = 16 * 33 * 4;
__device__ __forceinline__ void ph_route_m(const Ctx& c, int l, int nrows, LAS float* wl, int gw, int ngw, int lane) {
    const int rr = lane & 15, g = lane >> 4;
    const bf16_t* T = c.wsb(WS_RWT) + (size_t)l * 2 * NE * D;
    for (int tile = gw; tile < nrows / 16; tile += ngw) {
        const int row = 16 * tile + rr;
        const float* xr = c.x() + (size_t)row * D + 8 * g;
        const float* m = c.mod(l, mod_row(16 * tile));
        const float* gp = c.in[I_N2G] + l * D + 8 * g; const float* shp = m + 3 * D + 8 * g; const float* scp = m + 4 * D + 8 * g;
        float ss = 0.f;
        { const float* sp = c.wsf(WS_SSP) + (size_t)row * 64 + 16 * g;
#pragma unroll
          for (int q = 0; q < 16; q += 4) { if (16 * g + q < (D / 256) * 16) { const f32x4 t = *(const f32x4*)(sp + q); ss += (t[0] + t[1]) + (t[2] + t[3]); } } }
        ss += SHFL_XOR_F(ss, 16); ss += SHFL_XOR_F(ss, 32);
        const float r = 1.0f / sqrtf(ss * (1.0f / D) + EPS);
        f32x4 acc0 = {0.f, 0.f, 0.f, 0.f}, acc1 = {0.f, 0.f, 0.f, 0.f};
        bf16_t* hr = c.h() + (size_t)row * D + 8 * g;
        for (int s2 = 0; s2 < D / 32; s2 += 2) {
            f32x4 xv[2][2], gv[2][2], hv[2][2], cv[2][2]; bf16x8 bh[2][2], bl[2][2];
#pragma unroll
            for (int u = 0; u < 2; ++u) { const int s = s2 + u;
                xv[u][0] = *(const f32x4*)(xr + 32 * s); xv[u][1] = *(const f32x4*)(xr + 32 * s + 4); gv[u][0] = *(const f32x4*)(gp + 32 * s); gv[u][1] = *(const f32x4*)(gp + 32 * s + 4);
                hv[u][0] = *(const f32x4*)(shp + 32 * s); hv[u][1] = *(const f32x4*)(shp + 32 * s + 4); cv[u][0] = *(const f32x4*)(scp + 32 * s); cv[u][1] = *(const f32x4*)(scp + 32 * s + 4);
                bh[u][0] = *(const bf16x8*)(T + (size_t)rr * D + 32 * s + 8 * g); bh[u][1] = *(const bf16x8*)(T + (size_t)(16 + rr) * D + 32 * s + 8 * g);
                bl[u][0] = *(const bf16x8*)(T + (size_t)(NE + rr) * D + 32 * s + 8 * g); bl[u][1] = *(const bf16x8*)(T + (size_t)(NE + 16 + rr) * D + 32 * s + 8 * g); }
#pragma unroll
            for (int u = 0; u < 2; ++u) { const int s = s2 + u;
                const f32x4 v0 = (xv[u][0] * r * gv[u][0]) * (cv[u][0] + 1.0f) + hv[u][0], v1 = (xv[u][1] * r * gv[u][1]) * (cv[u][1] + 1.0f) + hv[u][1];
                const u32x4 hi = {pk2(v0[0], v0[1]), pk2(v0[2], v0[3]), pk2(v1[0], v1[1]), pk2(v1[2], v1[3])};
                *(u32x4*)(hr + 32 * s) = hi;
                float lo[8];
#pragma unroll
                for (int e = 0; e < 4; ++e) { const unsigned wv = hi[e]; float fl, fh; unsigned t = wv << 16; __builtin_memcpy(&fl, &t, 4); t = wv & 0xffff0000u; __builtin_memcpy(&fh, &t, 4);
                    lo[2 * e] = (e < 2 ? v0[2 * e] : v1[2 * e - 4]) - fl; lo[2 * e + 1] = (e < 2 ? v0[2 * e + 1] : v1[2 * e - 3]) - fh; }
                const u32x4 lov = {pk2(lo[0], lo[1]), pk2(lo[2], lo[3]), pk2(lo[4], lo[5]), pk2(lo[6], lo[7])};
                const bf16x8 ahi = __builtin_bit_cast(bf16x8, hi), alo = __builtin_bit_cast(bf16x8, lov);
                acc0 = MFMA16(ahi, bh[u][0], acc0); acc0 = MFMA16(alo, bh[u][0], acc0); acc0 = MFMA16(ahi, bl[u][0], acc0);
                acc1 = MFMA16(ahi, bh[u][1], acc1); acc1 = MFMA16(alo, bh[u][1], acc1); acc1 = MFMA16(ahi, bl[u][1], acc1); }
            CBAR();
        }
#pragma unroll
        for (int q = 0; q < 4; ++q) { wl[(4 * g + q) * 33 + rr] = acc0[q] + c.in[I_RB][l * NE + rr]; wl[(4 * g + q) * 33 + 16 + rr] = acc1[q] + c.in[I_RB][l * NE + 16 + rr]; }
        WAVE_SYNC();
        if (lane < 16) {
            const int orow = 16 * tile + lane;
            float lg[NE];
#pragma unroll
            for (int i = 0; i < NE; ++i) lg[i] = wl[lane * 33 + i];
            int te[TOPK]; float tv[TOPK];
#pragma unroll
            for (int kk = 0; kk < TOPK; ++kk) {
                int best = -1; float bv = 0.f;
#pragma unroll
                for (int i = 0; i < NE; ++i) {
                    bool taken = false;
#pragma unroll
                    for (int j = 0; j < kk; ++j) taken = taken || (te[j] == i);
                    if (!taken && (best < 0 || lg[i] > bv)) { best = i; bv = lg[i]; }
                }
                te[kk] = best; tv[kk] = bv;
            }
            float se = 0.f, ex[TOPK];
#pragma unroll
            for (int kk = 0; kk < TOPK; ++kk) { ex[kk] = expf(tv[kk] - tv[0]); se += ex[kk]; }
#pragma unroll
            for (int kk = 0; kk < TOPK; ++kk) {
                c.tope()[orow * TOPK + kk] = te[kk];
                c.topg()[orow * TOPK + kk] = ex[kk] / se;
                c.pos()[orow * TOPK + kk] = atomicAdd(c.cnt(l) + te[kk] * CNTS, 1);
            }
        }
        WAVE_SYNC();
    }
}

constexpr int ROUTE_B_LDS = (8 * 16 * 32 + 16 * 33) * 4;
#ifndef CPU_TEST
__device__ __forceinline__ int lds_fetch_inc(LAS int* p) { return __hip_atomic_fetch_add(p, 1, __ATOMIC_RELAXED, __HIP_MEMORY_SCOPE_WORKGROUP); }
#else
static inline int lds_fetch_inc(int* p) { const int o = *p; *p = o + 1; return o; }
#endif
static_assert(TOPK == 4 && 4640 * 4 >= ROUTE_B_LDS, "route LDS map");
__device__ __forceinline__ void ph_route_b(const Ctx& c, int l, int nrows, LAS float* bl, int blk, int G, int tid, bool dummy = false) {
    constexpr int SPW = D / 256, BATCH = SPW >= 4 ? 4 : (SPW >= 2 ? 2 : 1);
    const int lane = tid & 63, w = RFL(tid >> 6), rr = lane & 15, g = lane >> 4;
    const bf16_t* T = c.wsb(WS_RWT) + (size_t)l * 2 * NE * D;
    LAS float* part = bl; LAS float* lgs = bl + 8 * 16 * 32;
    LAS int* lcnt = (LAS int*)(bl + 4640); LAS int* lbase = lcnt + 32; LAS unsigned* lrec = (LAS unsigned*)(lbase + 32);
    if (tid < 32) lcnt[tid] = 0;
    int nit = 0;
    for (int tile = blk; tile < nrows / 16; tile += G, ++nit) {
        const int row = 16 * tile + rr;
        const float* xr = c.x() + (size_t)row * D + 8 * g;
        const float* m = c.mod(l, mod_row(16 * tile));
        const float* gp = c.in[I_N2G] + l * D + 8 * g; const float* shp = m + 3 * D + 8 * g; const float* scp = m + 4 * D + 8 * g;
        f32x4 sst[4];
        { const float* sp = c.wsf(WS_SSP) + (size_t)row * 64 + 16 * g;
#pragma unroll
          for (int q = 0; q < 4; ++q) { sst[q] = f32x4{0.f, 0.f, 0.f, 0.f}; if (16 * g + 4 * q < (D / 256) * 16) sst[q] = *(const f32x4*)(sp + 4 * q); } }
        float r = 0.f;
        f32x4 acc0 = {0.f, 0.f, 0.f, 0.f}, acc1 = {0.f, 0.f, 0.f, 0.f};
        bf16_t* hr = c.h() + (size_t)row * D + 8 * g;
        for (int s2 = w * SPW; s2 < (w + 1) * SPW; s2 += BATCH) {
            f32x4 xv[BATCH][2], gv[BATCH][2], hv[BATCH][2], cv[BATCH][2]; bf16x8 bh[BATCH][2], bw[BATCH][2];
#pragma unroll
            for (int u = 0; u < BATCH; ++u) { const int s = s2 + u;
                xv[u][0] = *(const f32x4*)(xr + 32 * s); xv[u][1] = *(const f32x4*)(xr + 32 * s + 4); gv[u][0] = *(const f32x4*)(gp + 32 * s); gv[u][1] = *(const f32x4*)(gp + 32 * s + 4);
                hv[u][0] = *(const f32x4*)(shp + 32 * s); hv[u][1] = *(const f32x4*)(shp + 32 * s + 4); cv[u][0] = *(const f32x4*)(scp + 32 * s); cv[u][1] = *(const f32x4*)(scp + 32 * s + 4);
                bh[u][0] = *(const bf16x8*)(T + (size_t)rr * D + 32 * s + 8 * g); bh[u][1] = *(const bf16x8*)(T + (size_t)(16 + rr) * D + 32 * s + 8 * g);
                bw[u][0] = *(const bf16x8*)(T + (size_t)(NE + rr) * D + 32 * s + 8 * g); bw[u][1] = *(const bf16x8*)(T + (size_t)(NE + 16 + rr) * D + 32 * s + 8 * g); }
            if (s2 == w * SPW) {
                float ss = 0.f;
#pragma unroll
                for (int q = 0; q < 4; ++q) { if (16 * g + 4 * q < (D / 256) * 16) ss += (sst[q][0] + sst[q][1]) + (sst[q][2] + sst[q][3]); }
                ss += SHFL_XOR_F(ss, 16); ss += SHFL_XOR_F(ss, 32);
                r = 1.0f / sqrtf(ss * (1.0f / D) + EPS);
            }
#pragma unroll
            for (int u = 0; u < BATCH; ++u) { const int s = s2 + u;
                const f32x4 v0 = (xv[u][0] * r * gv[u][0]) * (cv[u][0] + 1.0f) + hv[u][0], v1 = (xv[u][1] * r * gv[u][1]) * (cv[u][1] + 1.0f) + hv[u][1];
                const u32x4 hi = {pk2(v0[0], v0[1]), pk2(v0[2], v0[3]), pk2(v1[0], v1[1]), pk2(v1[2], v1[3])};
                *(u32x4*)(hr + 32 * s) = hi;
                float lo[8];
#pragma unroll
                for (int e = 0; e < 4; ++e) { const unsigned wv = hi[e]; float fl, fh; unsigned t = wv << 16; __builtin_memcpy(&fl, &t, 4); t = wv & 0xffff0000u; __builtin_memcpy(&fh, &t, 4);
                    lo[2 * e] = (e < 2 ? v0[2 * e] : v1[2 * e - 4]) - fl; lo[2 * e + 1] = (e < 2 ? v0[2 * e + 1] : v1[2 * e - 3]) - fh; }
                const u32x4 lov = {pk2(lo[0], lo[1]), pk2(lo[2], lo[3]), pk2(lo[4], lo[5]), pk2(lo[6], lo[7])};
                const bf16x8 ahi = __builtin_bit_cast(bf16x8, hi), alo = __builtin_bit_cast(bf16x8, lov);
                acc0 = MFMA16(ahi, bh[u][0], acc0); acc0 = MFMA16(alo, bh[u][0], acc0); acc0 = MFMA16(ahi, bw[u][0], acc0);
                acc1 = MFMA16(ahi, bh[u][1], acc1); acc1 = MFMA16(alo, bh[u][1], acc1); acc1 = MFMA16(ahi, bw[u][1], acc1); }
        }
#pragma unroll
        for (int q = 0; q < 4; ++q) { part[(w * 16 + 4 * g + q) * 32 + rr] = acc0[q]; part[(w * 16 + 4 * g + q) * 32 + 16 + rr] = acc1[q]; }
        LDS_BAR();
        { const int prow = tid >> 5, e = tid & 31; float s = c.in[I_RB][l * NE + e];
#pragma unroll
          for (int ww = 0; ww < 8; ++ww) s += part[(ww * 16 + prow) * 32 + e];
          lgs[prow * 33 + e] = s; }
        LDS_BAR();
        if (tid < 16) {
            const int orow = 16 * tile + tid;
            float lg[NE];
#pragma unroll
            for (int i = 0; i < NE; ++i) lg[i] = lgs[tid * 33 + i];
            int te[TOPK]; float tv[TOPK];
#pragma unroll
            for (int kk = 0; kk < TOPK; ++kk) {
                int best = -1; float bv = 0.f;
#pragma unroll
                for (int i = 0; i < NE; ++i) {
                    bool taken = false;
#pragma unroll
                    for (int j = 0; j < kk; ++j) taken = taken || (te[j] == i);
                    if (!taken && (best < 0 || lg[i] > bv)) { best = i; bv = lg[i]; }
                }
                te[kk] = best; tv[kk] = bv;
            }
            float se = 0.f, ex[TOPK];
#pragma unroll
            for (int kk = 0; kk < TOPK; ++kk) { ex[kk] = expf(tv[kk] - tv[0]); se += ex[kk]; }
#pragma unroll
            for (int kk = 0; kk < TOPK; ++kk) {
                c.tope()[orow * TOPK + kk] = te[kk];
                c.topg()[orow * TOPK + kk] = ex[kk] / se;
                lrec[nit * 64 + tid * TOPK + kk] = ((unsigned)te[kk] << 16) | (unsigned)lds_fetch_inc(lcnt + te[kk]);
            }
        }
    }
    LDS_BAR();
    if (tid < 32) { const int n = lcnt[tid]; lbase[tid] = n ? atomicAdd(c.cnt(l) + (dummy ? DEPTH * NE * CNTS : 0) + tid * CNTS, n) : 0; }
    LDS_BAR();
    for (int i = tid; i < nit * 64; i += 512) { const int tile = blk + (i >> 6) * G; const unsigned rec = lrec[i]; c.pos()[64 * tile + (i & 63)] = lbase[rec >> 16] + (int)(rec & 0xffffu); }
}

__host__ __device__ __forceinline__ f32x4 silu4(f32x4 x) { return (f32x4){siluf_(x[0]), siluf_(x[1]), siluf_(x[2]), siluf_(x[3])}; }
__host__ __device__ __forceinline__ f32x4 exp4(f32x4 x) { return (f32x4){FEXP(x[0]), FEXP(x[1]), FEXP(x[2]), FEXP(x[3])}; }
__host__ __device__ __forceinline__ f32x4 logsig4(f32x4 x) { return (f32x4){logsigmoidf_(x[0]), logsigmoidf_(x[1]), logsigmoidf_(x[2]), logsigmoidf_(x[3])}; }
__host__ __device__ __forceinline__ f32x4 min4(f32x4 x, float m) { return (f32x4){fminf(x[0], m), fminf(x[1], m), fminf(x[2], m), fminf(x[3], m)}; }
__host__ __device__ __forceinline__ u64_t pk4(f32x4 v) { return (u64_t)pk2(v[0], v[1]) | ((u64_t)pk2(v[2], v[3]) << 32); }
__host__ __device__ __forceinline__ f32x4 tap4_at(const bf16_t* U, const SegC& s, int dir, int q, int ucol, bool colmajor) {
    const bool ok = q >= 0 && q < s.len; const int qc = q < 0 ? 0 : (q >= s.len ? s.len - 1 : q);
    const int r = seg_row(s, dir, qc);
    const f32x4 v = ldb4(U + (size_t)(colmajor ? tokrow_of_srow(r) : r) * INP + ucol);
    return ok ? v : (f32x4){0.f, 0.f, 0.f, 0.f};
}
__host__ __device__ __forceinline__ void store_t8(bf16_t* base, int t0, const f32x4 (&x)[8]) {
#pragma unroll
    for (int cc = 0; cc < 4; ++cc) *(u32x4*)(base + cc * 64 + t0) = (u32x4){pk2(x[0][cc], x[1][cc]), pk2(x[2][cc], x[3][cc]), pk2(x[4][cc], x[5][cc]), pk2(x[6][cc], x[7][cc])};
}
__host__ __device__ __forceinline__ u64_t tapraw4_at(const bf16_t* U, const SegC& s, int dir, int q, int ucol, bool colmajor) {
    const int qc = q < 0 ? 0 : (q >= s.len ? s.len - 1 : q); const int r = seg_row(s, dir, qc);
    return *(const u64_t*)(U + (size_t)(colmajor ? tokrow_of_srow(r) : r) * INP + ucol);
}
__host__ __device__ __forceinline__ bf16_t tapraw1_at(const bf16_t* U, const SegC& s, int dir, int q, int ucol, bool colmajor) {
    const int qc = q < 0 ? 0 : (q >= s.len ? s.len - 1 : q); const int r = seg_row(s, dir, qc);
    return U[(size_t)(colmajor ? tokrow_of_srow(r) : r) * INP + ucol];
}
__host__ __device__ __forceinline__ f32x4 tapcvt4(u64_t raw, const SegC& s, int q) { return (q >= 0 && q < s.len) ? cvtb4(raw) : (f32x4){0.f, 0.f, 0.f, 0.f}; }
__host__ __device__ __forceinline__ void ph_prep4(const Ctx& c, int l, int gt, int gs, int sel = 31) {
    const bf16_t* U = c.u();
    const int rot = (int)CH_G * 16;
    const int gt1 = gt, gt2 = (gt + gs - rot % gs) % gs, gt3 = (gt + gs - (3 * rot) % gs) % gs, gt4 = (gt + gs - (5 * rot) % gs) % gs;
    if (sel & 1) for (int it = gt1; it < (int)CH_G * 16; it += gs) {
        const int k = 4 * (it % 16), hh = (it / 16) % 4, n = (it / 64) % NCH, dir = (it / (64 * NCH)) % 2, b = it / (128 * NCH), cid = (b * 4 + hh) * 2 + dir;
        const SegC sg = seg_of_chunk(b, n);
        const int row0 = seg_row(sg, dir, sg.q0), rs = dir == 0 ? 1 : -1;
        const f32x4 bg = *(const f32x4*)(c.in[I_GBG] + (l * 2 + dir) * 256 + hh * 64 + k);
        const size_t cb = ((size_t)cid * NCH + n);
        bf16_t* QA = c.wsb(WS_GQA) + cb * 4096 + k; bf16_t* KB = c.wsb(WS_GKB) + cb * 4096 + k; bf16_t* KDT = c.wsb(WS_GKDT) + cb * 4096 + k * 64;
        const bf16_t* uq = U + (size_t)row0 * INP + U_GQ + hh * 64 + k; const bf16_t* uk = U + (size_t)row0 * INP + U_GK + hh * 64 + k; const bf16_t* ug = U + (size_t)row0 * INP + U_GGK + dir * 256 + hh * 64 + k;
        f32x4 crun = {0.f, 0.f, 0.f, 0.f};
        u64_t nq[8], nk[8], ng[8];
#pragma unroll
        for (int e = 0; e < 8; ++e) { nq[e] = *(const u64_t*)(uq + (long)rs * e * INP); nk[e] = *(const u64_t*)(uk + (long)rs * e * INP); ng[e] = *(const u64_t*)(ug + (long)rs * e * INP); }
        for (int i0 = 0; i0 < 64; i0 += 8) { const int nb = i0 + 8 < 64 ? i0 + 8 : i0;
            u64_t cq[8], ck[8], cg[8]; f32x4 kd[8];
#pragma unroll
            for (int e = 0; e < 8; ++e) { cq[e] = nq[e]; ck[e] = nk[e]; cg[e] = ng[e]; }
#pragma unroll
            for (int e = 0; e < 8; ++e) { nq[e] = *(const u64_t*)(uq + (long)rs * (nb + e) * INP); nk[e] = *(const u64_t*)(uk + (long)rs * (nb + e) * INP); ng[e] = *(const u64_t*)(ug + (long)rs * (nb + e) * INP); }
            CBAR();
#pragma unroll
            for (int e = 0; e < 8; ++e) { crun = crun + logsig4(cvtb4(cg[e]) + bg) * (1.0f / 16.0f);
                kd[e] = cvtb4(ck[e]) * exp4(min4(-crun, 60.f));
                *(u64_t*)(QA + (i0 + e) * 64) = pk4(cvtb4(cq[e]) * 0.125f * exp4(crun)); *(u64_t*)(KB + (i0 + e) * 64) = pk4(kd[e]); }
        }
        *(f32x4*)(c.wsf(WS_GAL) + cb * 64 + k) = exp4(crun);
    }
    if (sel & 4) for (int it = gt2; it < (int)CH_G * 32; it += gs) {
        const int k = 4 * (it % 16), hh = (it / 16) % 4, which = (it / 64) % 2, n = (it / 128) % NCH, dir = (it / (128 * NCH)) % 2, b = it / (256 * NCH), cid = (b * 4 + hh) * 2 + dir;
        if (which == 0 && dir == 1) continue;
        const SegC sg = seg_of_chunk(b, n);
        const int row0 = seg_row(sg, dir, sg.q0), rs = dir == 0 ? 1 : -1;
        const float bi = c.in[I_MBI][l * 8 + dir * 4 + hh], bf = c.in[I_MBF][l * 8 + dir * 4 + hh];
        const bf16_t* MG = U + (size_t)row0 * INP + U_MG + dir * 4 + hh;
        const size_t cb = ((size_t)cid * NCH + n);
        float rmaxL = 0.f;
        if (which == 1) {
            float F = 0.f, rmax = -1e30f; float* MS = c.wsf(WS_MMS) + cb * 256;
            for (int i0 = 0; i0 < 64; i0 += 16) { float ig[16], lf[16];
#pragma unroll
                for (int e = 0; e < 16; ++e) { ig[e] = bf2f(MG[(long)rs * (i0 + e) * INP]); lf[e] = bf2f(MG[(long)rs * (i0 + e) * INP + 8]); }
#pragma unroll
                for (int e = 0; e < 16; ++e) { F += logsigmoidf_(lf[e] + bf); const float bjv = ig[e] + bi - F; rmax = fmaxf(rmax, bjv); if (k == 0) *(f32x4*)(MS + (i0 + e) * 4) = (f32x4){F, bjv, rmax, 0.f}; } }
            rmaxL = rmax;
        }
        bf16_t* OT = c.wsb(which == 0 ? WS_MQA : WS_MKB) + cb * 4096 + k; bf16_t* KDT = c.wsb(WS_MKDT) + cb * 4096 + k * 64;
        const int cch = which * 256 + hh * 64 + k;
        f32x4 w[7];
#pragma unroll
        for (int j = 0; j < 7; ++j) w[j] = *(const f32x4*)(c.in[I_MCW] + ((size_t)l * 7 + (dir == 0 ? j : 6 - j)) * 512 + cch);
        const f32x4 bc = *(const f32x4*)(c.in[I_MCB] + l * 512 + cch);
        f32x4 win[14];
#pragma unroll
        for (int t = 0; t < 6; ++t) win[t] = tap4_at(U, sg, dir, sg.q0 + t - 3, U_MQK + cch, false);
        float F = 0.f;
        u64_t nt[8]; bf16_t ni[8], nf[8];
#pragma unroll
        for (int e = 0; e < 8; ++e) { nt[e] = tapraw4_at(U, sg, dir, sg.q0 + e + 3, U_MQK + cch, false); ni[e] = MG[(long)rs * e * INP]; nf[e] = MG[(long)rs * e * INP + 8]; }
        for (int i0 = 0; i0 < 64; i0 += 8) { const int nb = i0 + 8 < 64 ? i0 + 8 : i0; f32x4 kd[8]; float ig[8], lf[8];
#pragma unroll
            for (int e = 0; e < 8; ++e) { win[6 + e] = tapcvt4(nt[e], sg, sg.q0 + i0 + e + 3); ig[e] = bf2f(ni[e]); lf[e] = bf2f(nf[e]); }
#pragma unroll
            for (int e = 0; e < 8; ++e) { nt[e] = tapraw4_at(U, sg, dir, sg.q0 + nb + e + 3, U_MQK + cch, false); ni[e] = MG[(long)rs * (nb + e) * INP]; nf[e] = MG[(long)rs * (nb + e) * INP + 8]; }
            CBAR();
#pragma unroll
            for (int e = 0; e < 8; ++e) { f32x4 a = bc;
#pragma unroll
                for (int j = 0; j < 7; ++j) a = a + w[j] * win[e + j];
                f32x4 v = silu4(a); if (which == 1) v = v * 0.125f;
                F += logsigmoidf_(lf[e] + bf);
                if (dir == 0) *(u64_t*)(OT + (i0 + e) * 64) = pk4(v);
                kd[e] = v * FEXP(ig[e] + bi - F - rmaxL); }
            if (which == 1) store_t8(KDT, i0, kd);
#pragma unroll
            for (int t = 0; t < 6; ++t) win[t] = win[t + 8]; }
    }
    if (sel & 8) for (int it = gt3; it < (int)CH_SG * 32; it += gs) {
        const int s = 4 * (it % 32), g = (it / 32) % 2, which = (it / 64) % 2, n = (it / 128) % NCH, dir = 0, b = it / (128 * NCH), gid = (b * 2 + g) * 2 + dir;
        const SegC sg = seg_of_chunk(b, n);
        const size_t cb = ((size_t)gid * NCH + n);
        bf16_t* OT = c.wsb(which == 0 ? WS_SKB : WS_SQA) + cb * 8192 + s; bf16_t* KDT = c.wsb(WS_SKDT) + cb * 8192 + s * 64;
        const int cch = 512 + which * 256 + g * 128 + s;
        f32x4 w[7];
#pragma unroll
        for (int j = 0; j < 7; ++j) w[j] = *(const f32x4*)(c.in[I_2CW] + ((size_t)l * 7 + (dir == 0 ? j : 6 - j)) * 1024 + cch);
        const f32x4 bc = *(const f32x4*)(c.in[I_2CB] + l * 1024 + cch);
        f32x4 win[14];
#pragma unroll
        for (int t = 0; t < 6; ++t) win[t] = tap4_at(U, sg, dir, sg.q0 + t - 3, U_XBC + cch, true);
        u64_t nt[8];
#pragma unroll
        for (int e = 0; e < 8; ++e) nt[e] = tapraw4_at(U, sg, dir, sg.q0 + e + 3, U_XBC + cch, true);
        for (int i0 = 0; i0 < 64; i0 += 8) { const int nb = i0 + 8 < 64 ? i0 + 8 : i0; f32x4 v[8];
#pragma unroll
            for (int e = 0; e < 8; ++e) win[6 + e] = tapcvt4(nt[e], sg, sg.q0 + i0 + e + 3);
#pragma unroll
            for (int e = 0; e < 8; ++e) nt[e] = tapraw4_at(U, sg, dir, sg.q0 + nb + e + 3, U_XBC + cch, true);
            CBAR();
#pragma unroll
            for (int e = 0; e < 8; ++e) { f32x4 a = bc;
#pragma unroll
                for (int j = 0; j < 7; ++j) a = a + w[j] * win[e + j];
                v[e] = silu4(a); *(u64_t*)(OT + (i0 + e) * 128) = pk4(v[e]); }
#pragma unroll
            for (int t = 0; t < 6; ++t) win[t] = win[t + 8]; }
    }
    if (sel & 16) for (int it = gt4; it < (int)CH_S * 16; it += gs) {
        const int p = 4 * (it % 16), hh = (it / 16) % 8, n = (it / 128) % NCH, dir = (it / (128 * NCH)) % 2, b = it / (256 * NCH), cid = (b * 8 + hh) * 2 + dir;
        const SegC sg = seg_of_chunk(b, n);
        const float Ah = -expf(c.in[I_2AL][l * 16 + dir * 8 + hh]), dtb = c.in[I_2DTB][l * 16 + dir * 8 + hh];
        const int cdt = U_DT + dir * 8 + hh;
        float cumL = 0.f;
        for (int i0 = 0; i0 < 64; i0 += 16) { float t[16];
#pragma unroll
            for (int e = 0; e < 16; ++e) t[e] = tap_at(U, sg, dir, sg.q0 + i0 + e, cdt, true);
#pragma unroll
            for (int e = 0; e < 16; ++e) cumL += softplusf_(t[e] + dtb) * Ah; }
        const size_t cb = ((size_t)cid * NCH + n);
        bf16_t* VT = c.wsb(WS_SVT) + cb * 4096 + p * 64; bf16_t* VHT = c.wsb(WS_SVHT) + cb * 4096 + p * 64; float* CS = c.wsf(WS_SCS) + cb * 128;
        const int cx = hh * 64 + p;
        f32x4 wx[7];
#pragma unroll
        for (int j = 0; j < 7; ++j) wx[j] = *(const f32x4*)(c.in[I_2CW] + ((size_t)l * 7 + (dir == 0 ? j : 6 - j)) * 1024 + cx);
        const f32x4 bx = *(const f32x4*)(c.in[I_2CB] + l * 1024 + cx);
        f32x4 win[14];
#pragma unroll
        for (int t = 0; t < 6; ++t) win[t] = tap4_at(U, sg, dir, sg.q0 + t - 3, U_XBC + cx, true);
        float crun = 0.f;
        u64_t nt[8]; bf16_t nd[8];
#pragma unroll
        for (int e = 0; e < 8; ++e) { nt[e] = tapraw4_at(U, sg, dir, sg.q0 + e + 3, U_XBC + cx, true); nd[e] = tapraw1_at(U, sg, dir, sg.q0 + e, cdt, true); }
        for (int i0 = 0; i0 < 64; i0 += 8) { const int nb = i0 + 8 < 64 ? i0 + 8 : i0; float dv[8]; f32x4 a[8], h[8];
#pragma unroll
            for (int e = 0; e < 8; ++e) { win[6 + e] = tapcvt4(nt[e], sg, sg.q0 + i0 + e + 3); dv[e] = bf2f(nd[e]); }
#pragma unroll
            for (int e = 0; e < 8; ++e) { nt[e] = tapraw4_at(U, sg, dir, sg.q0 + nb + e + 3, U_XBC + cx, true); nd[e] = tapraw1_at(U, sg, dir, sg.q0 + nb + e, cdt, true); }
            CBAR();
#pragma unroll
            for (int e = 0; e < 8; ++e) { f32x4 ax = bx;
#pragma unroll
                for (int j = 0; j < 7; ++j) ax = ax + wx[j] * win[e + j];
                const f32x4 xs = silu4(ax); const float dtv = softplusf_(dv[e] + dtb);
                crun += dtv * Ah; a[e] = xs * dtv; h[e] = a[e] * FEXP(cumL - crun);
                if (dir == 0) *(u64_t*)(c.xbc() + (size_t)seg_row(sg, 0, sg.q0 + i0 + e) * 512 + cx) = pk4(xs);
                if (p == 0) { CS[(i0 + e) * 2] = crun; CS[(i0 + e) * 2 + 1] = dtv; } }
            store_t8(VT, i0, a); store_t8(VHT, i0, h);
#pragma unroll
            for (int t = 0; t < 6; ++t) win[t] = win[t + 8]; }
    }
}

constexpr int NPH = 11, NSTEPS = 1 + DEPTH * NPH;
enum { PH_NORM1 = 0, PH_GIN, PH_PREP, PH_SCAN, PH_FIN, PH_GOUT, PH_ROUTE, PH_SCAT, PH_G1, PH_G2, PH_COMB };
constexpr int IT_IN = (D / 64) * (INW / 32), IT_OUT = (MIXW / 64) * (D / 32), IT_GU = (D / 64) * (2 * D / 32), IT_DN = (D / 64) * (D / 32);

#ifndef CPU_TEST
constexpr int LDS_BYTES = 147456, LDS_CTL = 139264;
#define LDS_WAIT() asm volatile("s_waitcnt lgkmcnt(0)" ::: "memory")
typedef __attribute__((address_space(1))) u32x4 g_u32x4;

struct TItem { const float* W; bf16_t* WT; int K, N, mode, item; };
constexpr int IT_DENSE = IT_IN + IT_OUT, IT_MOE = NE * (IT_GU + IT_DN);
__device__ __forceinline__ TItem titem_of(const Ctx& c, int layer, int it) {
    TItem t;
    if (layer < 0) { const int l = it / IT_DENSE; int r = it % IT_DENSE;
        if (r < IT_IN) { t.W = c.in[I_WIN] + (size_t)l * D * INW; t.K = D; t.N = INW; t.WT = c.win(l); t.mode = 0; t.item = r; return t; } r -= IT_IN;
        t.W = c.in[I_WOUT] + (size_t)l * MIXW * D; t.K = MIXW; t.N = D; t.WT = c.wout(l); t.mode = 0; t.item = r; return t; }
    const int l = layer, e = it / (IT_GU + IT_DN); int r = it % (IT_GU + IT_DN);
    if (r < IT_GU) { t.W = c.in[I_WGU] + ((size_t)l * NE + e) * D * 2 * D; t.K = D; t.N = 2 * D; t.WT = c.wgu(l) + (size_t)e * 2 * D * D; t.mode = 1; t.item = r; }
    else { t.W = c.in[I_WDN] + ((size_t)l * NE + e) * D * D; t.K = D; t.N = D; t.WT = c.wdn(l) + (size_t)e * D * D; t.mode = 0; t.item = r - IT_GU; }
    return t;
}
__device__ __forceinline__ void titem_load(const TItem& t, float (&v)[32], int lane) {
    const int nblk = t.N / 32, kb = t.item / nblk, nb = t.item % nblk;
    const float* src = t.W + (size_t)(64 * kb + (lane >> 5)) * t.N + 32 * nb + (lane & 31);
#pragma unroll
    for (int i = 0; i < 32; ++i) v[i] = __builtin_nontemporal_load(src + (size_t)(2 * i) * t.N);
}
__device__ __forceinline__ void titem_store(const TItem& t, const float (&v)[32], LAS float* scr, int lane) {
    const int nblk = t.N / 32, kb = t.item / nblk, nb = t.item % nblk, k0 = 64 * kb, n0 = 32 * nb;
#pragma unroll
    for (int i = 0; i < 32; ++i) scr[(2 * i + (lane >> 5)) * 33 + (lane & 31)] = v[i];
    LDS_WAIT(); asm volatile("" ::: "memory");
    const int c = lane & 7;
    const int r0 = t.mode ? gu_row_of_col(n0) : n0;
#pragma unroll
    for (int j = 0; j < 4; ++j) { const int n = (lane >> 3) + 8 * j; const LAS float* s = scr + (8 * c) * 33 + n;
        u32x4 o; o.x = pk2(s[0 * 33], s[1 * 33]); o.y = pk2(s[2 * 33], s[3 * 33]); o.z = pk2(s[4 * 33], s[5 * 33]); o.w = pk2(s[6 * 33], s[7 * 33]);
        __builtin_nontemporal_store(o, (u32x4*)(t.WT + (size_t)(r0 + n) * t.K + k0 + 8 * c)); }
    LDS_WAIT(); asm volatile("" ::: "memory");
}
__device__ __forceinline__ void ph_transposes(const Ctx& c, LAS unsigned char* lds, int layer, int gw, int ngw, int wave, int lane) {
    LAS float* scr = (LAS float*)(lds + wave * 16384);
    const int nit = layer < 0 ? DEPTH * IT_DENSE : IT_MOE;
    int it = gw;
    if (it >= nit) return;
    TItem cur = titem_of(c, layer, it); float va[32], vb[32];
    titem_load(cur, va, lane);
    for (;;) {
        const int nx = it + ngw; const bool more = nx < nit;
        TItem nxt = cur;
        if (more) { nxt = titem_of(c, layer, nx); titem_load(nxt, vb, lane); }
        titem_store(cur, va, scr, lane);
        if (!more) break;
#pragma unroll
        for (int i = 0; i < 32; ++i) va[i] = vb[i];
        cur = nxt; it = nx;
    }
}

#define FRESH() Ctx c; { const KAS Args* kp_ = (const KAS Args*)__builtin_amdgcn_kernarg_segment_ptr(); asm volatile("" : "+s"(kp_)); c.in = kp_->in; c.out = kp_->out; c.ws = kp_->ws; } \
    int lane; asm volatile("v_mbcnt_lo_u32_b32 %0, -1, 0\n\tv_mbcnt_hi_u32_b32 %0, -1, %0" : "=v"(lane)); const int wave = wave_s, tid = wave * 64 + lane, gt = blk * 512 + tid, gs = G * 512; (void)gt; (void)gs;
__global__ void __launch_bounds__(512, 2) mega_fwd(Args args) {
    extern __shared__ __attribute__((aligned(16))) unsigned char lds_raw[];
    LAS unsigned char* lds = (LAS unsigned char*)lds_raw;
    const int G = gridDim.x, blk = blockIdx.x;
    const int wave_s = __builtin_amdgcn_readfirstlane((int)threadIdx.x >> 6);
    const int lo = args.lo, hi = args.hi;
    for (int u = threadIdx.x; u < (LDS_BYTES - LDS_CTL) / 4; u += 512) ((LAS unsigned*)(lds + LDS_CTL))[u] = 0u;
    __syncthreads();
    volatile LAS unsigned* xbw = (volatile LAS unsigned*)(lds + LDS_CTL + 1024);
    unsigned* barw = (unsigned*)(args.ws + WS_CTL) + CW_BAR + args.li * XCD_BAR_WORDS;
    XcdBarrier bar; bar.bar = barw; bar.x = 0; bar.st = xbw;
    if (hi - lo > 1) bar = xcd_barrier_post(barw, xbw);
    LAS int* tb = (LAS int*)(lds + LDS_CTL + 2048);
    static_assert(2048 + TB_WORDS * 4 <= 4096 && 4096 + NE * 4 <= LDS_BYTES - LDS_CTL, "LDS control region");
#ifndef PHASE_MASK
#define PHASE_MASK 0xFFFFu
#endif
#define EN(p) (((PHASE_MASK) >> (p)) & 1u)
#ifndef DUP_MASK
#define DUP_MASK 0u
#endif
#define DUP(p) (((DUP_MASK) >> (p)) & 1u)
#define IN(s) (lo <= (s) && (s) < hi)
#define SEAM(s) do { if (IN(s) && IN((s) + 1)) xcd_barrier(bar); } while (0)

    if (EN(12) && IN(0)) {
        FRESH();
        const int psel = (hi == 1) ? args.pad : 15;
        if (psel & 1) ph_transposes(c, lds, -1, blk * 8 + wave, G * 8, wave, lane);
        __syncthreads();
        if (psel & 2) ph_mod_w(c, (LAS float*)lds, tid, blk, G);
        if (psel & 8) { ph_foldgate(c, gt, gs); ph_rwsplit(c, gt, gs); }
    }
    SEAM(0);
    for (int l = 0; l < DEPTH; ++l) {
        const int s0 = 1 + l * NPH;
        const bool last = (l == DEPTH - 1);
        const int nrows = last ? NLAT : NTOK;
        if (l == 0) {
            if (EN(PH_NORM1) && IN(s0 + PH_NORM1)) { FRESH(); ph_norm1_w(c, l, blk * 8 + wave, G * 8, lane); }
            SEAM(s0 + PH_NORM1);
        }
        if (EN(PH_GIN) && IN(s0 + PH_GIN)) {
            FRESH();
            pg8::Gemm g{c.h(), c.win(l), NTOK, INP, D}; DenseOrder S; S.init(NTOK, INP, G, blk);
            EpiU E{c.u(), INP};
            pg8::gemm_phase<EpiU, DenseOrder, true, true>(lds, g, S, E, tid);
            if (DUP(PH_GIN)) pg8::gemm_phase<EpiU, DenseOrder, true, true>(lds, g, S, E, tid);
        }
        SEAM(s0 + PH_GIN);
        if (EN(PH_PREP) && IN(s0 + PH_PREP)) { FRESH(); ph_prep4(c, l, gt, gs, (args.li > 0 && s0 + PH_PREP == lo) ? args.pad : 31); }
        SEAM(s0 + PH_PREP);
        if (EN(PH_SCAN) && IN(s0 + PH_SCAN)) { FRESH(); ph_chain(c, lds, blk, G, tid, (hi == s0 + PH_SCAN + 1 && args.pad >= 64) ? (args.pad & 15) : 7); }
        SEAM(s0 + PH_SCAN);
        if (EN(PH_FIN) && IN(s0 + PH_FIN)) { FRESH(); ph_finish_w(c, l, nrows, blk * 8 + wave, G * 8, lane); if (DUP(PH_FIN)) ph_finish_w(c, l, nrows, blk * 8 + wave, G * 8, lane); }
        SEAM(s0 + PH_FIN);
        if (EN(PH_GOUT) && IN(s0 + PH_GOUT)) {
            FRESH();
            pg8::Gemm g{c.y(), c.wout(l), nrows, D, MIXW}; DenseOrder S; S.init(nrows, D, G, blk);
            EpiResid E{c.x(), c.mod(l, 0), c.wsf(WS_SSP)};
            pg8::gemm_phase<EpiResid, DenseOrder, true, true>(lds, g, S, E, tid);
        }
        SEAM(s0 + PH_GOUT);
        if (EN(PH_ROUTE) && IN(s0 + PH_ROUTE)) { FRESH(); if (DUP(PH_ROUTE)) { ph_route_b(c, l, nrows, (LAS float*)lds, blk, G, tid, true); __syncthreads(); } ph_route_b(c, l, nrows, (LAS float*)lds, blk, G, tid); }
        SEAM(s0 + PH_ROUTE);
        if (IN(s0 + PH_SCAT) || IN(s0 + PH_G1) || IN(s0 + PH_G2)) {
            FRESH();
            LAS int* ntl = (LAS int*)(lds + LDS_CTL + 4096);
            if (tid < NE) ntl[tid] = (c.cnt(l)[tid * CNTS] + 255) / 256;
            __syncthreads();
            if (tid < NE) { int a = 0; for (int e = 0; e < NE; ++e) a += (e < tid) ? ntl[e] : 0; tb[tid] = a; const int nt = ntl[tid]; for (int t = 0; t < nt; ++t) tb[NE + 1 + a + t] = tid; if (tid == NE - 1) tb[NE] = a + nt; }
            __syncthreads();
        }
        if (EN(PH_SCAT) && IN(s0 + PH_SCAT)) { FRESH(); ph_rowtok_w(c, l, nrows, (const LAS int*)tb, gt, gs); ph_transposes(c, lds, l, blk * 8 + wave, G * 8, wave, lane); }
        SEAM(s0 + PH_SCAT);
        if (EN(PH_G1) && IN(s0 + PH_G1)) {
            FRESH();
            LAS unsigned short* gtab = (LAS unsigned short*)(lds + 131072);
            MoeOrderG<const LAS int*, const LAS unsigned short*> S(tb, 2 * D / 256, G, blk, gtab, c.rtok());
            { pg8::Unit uu; const int* rt_ = c.rtok(); for (int i = 0; i < 16 && S.next(i, uu); ++i) for (int r = tid; r < 256; r += 512) gtab[i * 256 + r] = (unsigned short)rt_[uu.pm * 256 + r]; }
            __syncthreads();
            pg8::Gemm g{c.h(), c.wgu(l), NTOK, NE * 2 * D, D};
            EpiSwiglu E{c.act(), c.in[I_BGU] + (size_t)l * NE * 2 * D};
            pg8::gemm_phase<EpiSwiglu, MoeOrderG<const LAS int*, const LAS unsigned short*>, true, true>(lds, g, S, E, tid);
        }
        SEAM(s0 + PH_G1);
        if (EN(PH_G2) && IN(s0 + PH_G2)) {
            FRESH();
            pg8::Gemm g{c.act(), c.wdn(l), MAXROWS, NE * D, D}; MoeOrder<const LAS int*> S{tb, D / 256, G, blk, 8, 0};
            EpiDown E{c.yb(), c.in[I_BDN] + (size_t)l * NE * D};
            pg8::gemm_phase<EpiDown, MoeOrder<const LAS int*>, true, true>(lds, g, S, E, tid);
            if (DUP(PH_G2)) pg8::gemm_phase<EpiDown, MoeOrder<const LAS int*>, true, true>(lds, g, S, E, tid);
        }
        SEAM(s0 + PH_G2);
        if (EN(PH_COMB) && IN(s0 + PH_COMB)) { FRESH(); if (DUP(PH_COMB) && l < DEPTH - 1) ph_combine_w(c, l, nrows, blk * 8 + wave, G * 8, lane, true); ph_combine_w(c, l, nrows, blk * 8 + wave, G * 8, lane); }
        SEAM(s0 + PH_COMB);
    }
#undef IN
#undef SEAM
}

#ifndef MK_MULTI
#define MK_MULTI 0
#endif
extern "C" void kernel_launch(void* const* d_in, const int* in_sizes, int n_in, void* d_out, int out_size, void* d_ws, size_t ws_size, hipStream_t stream) {
    static int grid = 0;
    if (grid == 0) {
        if (n_in != N_IN || out_size != NLAT * D || ws_size < WS_END) { fprintf(stderr, "kernel_launch: unexpected shapes (n_in %d out %d ws %zu need %zu)\n", n_in, out_size, ws_size, (size_t)WS_END); grid = -1; return; }
        int dev = 0, cus = 0;
        if (hipGetDevice(&dev) != hipSuccess || hipDeviceGetAttribute(&cus, hipDeviceAttributeMultiprocessorCount, dev) != hipSuccess) { grid = -1; return; }
        if (hipFuncSetAttribute((const void*)mega_fwd, hipFuncAttributeMaxDynamicSharedMemorySize, LDS_BYTES) != hipSuccess) { fprintf(stderr, "kernel_launch: hipFuncSetAttribute failed\n"); grid = -1; return; }
        int per_cu = 0;
        (void)hipOccupancyMaxActiveBlocksPerMultiprocessor(&per_cu, (const void*)mega_fwd, 512, LDS_BYTES);
        (void)hipGetLastError();
        grid = cus;
        if (grid < NB * 32) { fprintf(stderr, "kernel_launch: needs at least %d CUs (one scan chain per workgroup), device has %d\n", NB * 32, cus); grid = -1; return; }
    }
    if (grid < 0) return;
    (void)hipMemsetAsync((char*)d_ws + WS_CTL, 0, CTL_BYTES, stream);
    Args a{};
    for (int i = 0; i < N_IN; ++i) a.in[i] = (const float*)d_in[i];
    a.out = (float*)d_out; a.ws = (unsigned char*)d_ws;
#if MK_MULTI
    for (int s = 0; s < NSTEPS; ++s) { a.lo = s; a.hi = s + 1; hipLaunchKernelGGL(mega_fwd, dim3(grid), dim3(512), LDS_BYTES, stream, a); }
#elif defined(PROBE_PRO)
    a.lo = 0; a.hi = 1; a.li = 0; a.pad = PROBE_PRO; hipLaunchKernelGGL(mega_fwd, dim3(grid), dim3(512), LDS_BYTES, stream, a);
    a.lo = 0; a.hi = NSTEPS; a.li = 1; a.pad = 0; hipLaunchKernelGGL(mega_fwd, dim3(grid), dim3(512), LDS_BYTES, stream, a);
#elif defined(PROBE_PH)
    { int lo = 0; for (int l = 0; l <= DEPTH; ++l) { const int s = 1 + l * NPH + PROBE_PH; a.lo = lo; a.hi = l < DEPTH ? s + 1 : NSTEPS; a.li = l; a.pad = PROBE_SEL; hipLaunchKernelGGL(mega_fwd, dim3(grid), dim3(512), LDS_BYTES, stream, a); lo = s; } }
#else
    a.lo = 0; a.hi = NSTEPS;
    hipLaunchKernelGGL(mega_fwd, dim3(grid), dim3(512), LDS_BYTES, stream, a);
#endif
}

#else
static void transposes_cpu(const Ctx& c) {
    for (int l = 0; l < DEPTH; ++l) {
        for (int k = 0; k < D; ++k) for (int n = 0; n < INW; ++n) c.win(l)[(size_t)n * D + k] = (bf16_t)f2bf(c.in[I_WIN][((size_t)l * D + k) * INW + n]);
        for (int k = 0; k < MIXW; ++k) for (int n = 0; n < D; ++n) c.wout(l)[(size_t)n * MIXW + k] = (bf16_t)f2bf(c.in[I_WOUT][((size_t)l * MIXW + k) * D + n]);
        for (int e = 0; e < NE; ++e) {
            for (int k = 0; k < D; ++k) for (int n = 0; n < 2 * D; ++n) c.wgu(l)[((size_t)e * 2 * D + gu_row_of_col(n)) * D + k] = (bf16_t)f2bf(c.in[I_WGU][(((size_t)l * NE + e) * D + k) * 2 * D + n]);
            for (int k = 0; k < D; ++k) for (int n = 0; n < D; ++n) c.wdn(l)[((size_t)e * D + n) * D + k] = (bf16_t)f2bf(c.in[I_WDN][(((size_t)l * NE + e) * D + k) * D + n]);
        }
    }
}
template <class Sched> static int gemm_cpu_arow(const Sched& S, const pg8::Unit& u, int r) { if constexpr (Sched::GATHER) return S.rowtok[u.pm * 256 + r]; else return u.pm * 256 + r; }
template <class Epi, class Sched> static void gemm_cpu(const pg8::Gemm& g, Sched S, const Epi& E, int G) {
    static float T[256][256];
    for (int cblk = 0; cblk < G; ++cblk) {
        S.c = cblk;
        for (int i = 0;; ++i) {
            pg8::Unit u; if (!S.next(i, u)) break;
            for (int r = 0; r < 256; ++r) for (int cc = 0; cc < 256; ++cc) {
                const bf16_t* a = g.A + (size_t)gemm_cpu_arow(S, u, r) * g.K; const bf16_t* b = g.Bt + (size_t)(u.pn * 256 + cc) * g.K;
                float s = 0.f; for (int k = 0; k < g.K; ++k) s += bf2f(a[k]) * bf2f(b[k]);
                T[r][cc] = s;
            }
            for (int wid = 0; wid < 8; ++wid) for (int lane = 0; lane < 64; ++lane) {
                const int wr = wid >> 2, wc = wid & 3, fr = lane & 15, fq = lane >> 4;
                accq acc[2][2][4][2];
                for (int ai = 0; ai < 2; ++ai) for (int bj = 0; bj < 2; ++bj) for (int m = 0; m < 4; ++m) for (int n = 0; n < 2; ++n) for (int j = 0; j < 4; ++j) {
                    const int r = 128 * ai + 64 * wr + 16 * m + fr;
                    const int cc = Epi::PERM ? 128 * bj + 32 * wc + 8 * fq + 4 * n + j : 128 * bj + 32 * wc + 16 * n + 4 * fq + j;
                    acc[ai][bj][m][n][j] = T[r][cc];
                }
                E(acc, u, wr, wc, fr, fq);
            }
        }
    }
}
constexpr int LDS_BYTES = 147456;
#define COOP(G_, body_) simt::launch(G_, 512, LDS_BYTES, [&]() { const int tid = threadIdx.x, lane = tid & 63, wave = tid >> 6, blk = blockIdx.x, G = gridDim.x; unsigned char* lds = simt::lds_base; (void)lane; (void)wave; (void)blk; (void)G; (void)lds; body_; })
extern "C" void kernel_launch(void* const* d_in, const int* in_sizes, int n_in, void* d_out, int out_size, void* d_ws, size_t ws_size, hipStream_t stream) {
    Ctx c; c.in = (const float* const*)d_in; c.out = (float*)d_out; c.ws = (unsigned char*)d_ws;
    memset((char*)d_ws + WS_CTL, 0, CTL_BYTES);
    const int G = 256, GC = 8;
    transposes_cpu(c);
    COOP(GC, { ph_mod_w(c, (float*)lds, tid, blk, G); });
    ph_foldgate(c, 0, 1); ph_rwsplit(c, 0, 1);
    for (int l = 0; l < DEPTH; ++l) {
        const bool last = (l == DEPTH - 1); const int nrows = last ? NLAT : NTOK;
        if (l == 0) COOP(GC, ph_norm1_w(c, l, blk * 8 + wave, G * 8, lane));
        { pg8::Gemm g{c.h(), c.win(l), NTOK, INP, D}; DenseOrder S; S.init(NTOK, INP, G, 0); EpiU E{c.u(), INP}; gemm_cpu(g, S, E, G); }
        ph_prep4(c, l, 0, 1);
        COOP(NB * 32, ph_chain(c, lds, blk, G, tid));
        COOP(GC, ph_finish_w(c, l, nrows, blk * 8 + wave, G * 8, lane));
        { pg8::Gemm g{c.y(), c.wout(l), nrows, D, MIXW}; DenseOrder S; S.init(nrows, D, G, 0); EpiResid E{c.x(), c.mod(l, 0), c.wsf(WS_SSP)}; gemm_cpu(g, S, E, G); }
        COOP(GC, ph_route_b(c, l, nrows, (float*)lds, blk, G, tid));
        int tb[TB_WORDS]; expert_tile_base(c.cnt(l), tb);
        COOP(GC, ph_rowtok_w(c, l, nrows, (const int*)tb, blk * 512 + tid, G * 512));
        { pg8::Gemm g{c.h(), c.wgu(l), NTOK, NE * 2 * D, D}; MoeOrderG<const int*, const unsigned short*> S(tb, 2 * D / 256, G, 0, nullptr, c.rtok()); EpiSwiglu E{c.act(), c.in[I_BGU] + (size_t)l * NE * 2 * D}; gemm_cpu(g, S, E, G); }
        { pg8::Gemm g{c.act(), c.wdn(l), MAXROWS, NE * D, D}; MoeOrder<const int*> S{tb, D / 256, G, 0}; EpiDown E{c.yb(), c.in[I_BDN] + (size_t)l * NE * D}; gemm_cpu(g, S, E, G); }
        COOP(GC, ph_combine_w(c, l, nrows, blk * 8 + wave, G * 8, lane));
    }
}
#endif
```
